# Optimizing an MI355X kernel written in HIP

```python
import jax, jax.numpy as jnp
from jax import lax
import numpy as np

D_MODEL = 1024
BATCH = 2
SEQ = 8192
DEPTH = 2

GRID_W = 64
NA_HEADS = 16
NA_HEAD_DIM = D_MODEL // NA_HEADS
NA_WIN_H = 8
NA_WIN_W = 16
MLA_HEADS = 16
MLA_Q_LORA = D_MODEL // 4
MLA_KV_LORA = D_MODEL // 8
MLA_NOPE = 64
MLA_ROPE = 32
MLA_V = 64
ROPE_THETA = 10000.0
Q_BLOCK = 128
FFN_DIM = 2816
N_EXPERTS = 8
TOP_K = 2
EXPERT_DIM = 1792
NORM_EPS = 1e-6

kernel_name = "hybrid_na_mla_moe_adaln_encoder"


def _rmsnorm(x):
    xf = x.astype(jnp.float32)
    y = xf * lax.rsqrt(jnp.mean(xf * xf, axis=-1, keepdims=True) + NORM_EPS)
    return y.astype(x.dtype)


def _modulate(x, shift, scale):
    return _rmsnorm(x) * (1 + scale[:, None, :]) + shift[:, None, :]


def _swiglu(h, w_gu, w_down):
    gate, up = jnp.split(h @ w_gu, 2, axis=-1)
    return (jax.nn.silu(gate) * up) @ w_down


def _rope_2d_tables(seq_len):
    t = jnp.arange(seq_len)
    row = (t // GRID_W).astype(jnp.float32)
    col = (t % GRID_W).astype(jnp.float32)
    n = MLA_ROPE // 4
    inv = ROPE_THETA ** (-jnp.arange(n, dtype=jnp.float32) / n)
    ang = jnp.concatenate([row[:, None] * inv, col[:, None] * inv], axis=-1)
    return jnp.cos(ang), jnp.sin(ang)


def _apply_rope(x, cos, sin):
    x1 = x[..., 0::2].astype(jnp.float32)
    x2 = x[..., 1::2].astype(jnp.float32)
    out = jnp.stack([x1 * cos - x2 * sin, x1 * sin + x2 * cos], axis=-1)
    return out.reshape(x.shape).astype(x.dtype)


def _neighborhood_attention(h, w_qkv, rpb, w_o):
    B, S, D = h.shape
    rows = S // GRID_W
    kh = min(NA_WIN_H, rows)
    kw = min(NA_WIN_W, GRID_W)
    qkv = (h @ w_qkv).reshape(B, rows, GRID_W, 3, NA_HEADS, NA_HEAD_DIM)
    q = qkv[:, :, :, 0] * (NA_HEAD_DIM ** -0.5)
    k = qkv[:, :, :, 1]
    v = qkv[:, :, :, 2]
    cols = jnp.arange(GRID_W)
    col_idx = jnp.clip(cols - kw // 2, 0, GRID_W - kw)[:, None] + jnp.arange(kw)[None, :]
    dc_idx = col_idx - cols[:, None] + NA_WIN_W - 1

    def row_block(r):
        rs = jnp.clip(r - kh // 2, 0, rows - kh)
        q_r = lax.dynamic_index_in_dim(q, r, axis=1, keepdims=False)
        k_g = lax.dynamic_slice_in_dim(k, rs, kh, axis=1)[:, :, col_idx]
        v_g = lax.dynamic_slice_in_dim(v, rs, kh, axis=1)[:, :, col_idx]
        dr_idx = rs + jnp.arange(kh) - r + NA_WIN_H - 1
        bias = rpb[:, dr_idx[None, :, None], dc_idx[:, None, :]]
        s = jnp.einsum('bqhd,bkqjhd->bhqkj', q_r, k_g).astype(jnp.float32) + bias.astype(jnp.float32)
        p = jax.nn.softmax(s.reshape(B, NA_HEADS, GRID_W, kh * kw), axis=-1)
        p = p.reshape(s.shape).astype(v.dtype)
        return jnp.einsum('bhqkj,bkqjhd->bqhd', p, v_g)

    o = lax.map(row_block, jnp.arange(rows))
    o = jnp.moveaxis(o, 0, 1).reshape(B, S, D)
    return o @ w_o


def _mla(h, w_down, q_norm, w_uq, kv_norm, w_ukv, w_o):
    B, S, D = h.shape
    down = h @ w_down
    c_q = _rmsnorm(down[..., :MLA_Q_LORA]) * q_norm
    c_kv = _rmsnorm(down[..., MLA_Q_LORA:MLA_Q_LORA + MLA_KV_LORA]) * kv_norm
    k_rope = down[..., MLA_Q_LORA + MLA_KV_LORA:]
    q = (c_q @ w_uq).reshape(B, S, MLA_HEADS, MLA_NOPE + MLA_ROPE)
    kv = (c_kv @ w_ukv).reshape(B, S, MLA_HEADS, MLA_NOPE + MLA_V)
    k_nope, v = kv[..., :MLA_NOPE], kv[..., MLA_NOPE:]
    cos, sin = _rope_2d_tables(S)
    q_nope = q[..., :MLA_NOPE]
    q_rope = _apply_rope(q[..., MLA_NOPE:], cos[:, None, :], sin[:, None, :])
    k_rope = _apply_rope(k_rope, cos, sin)
    scale = (MLA_NOPE + MLA_ROPE) ** -0.5
    nb = S // Q_BLOCK

    def to_blocks(t):
        return jnp.moveaxis(t.reshape(B, nb, Q_BLOCK, *t.shape[2:]), 1, 0)

    def q_block(blk):
        qn, qr = blk
        s = (jnp.einsum('bqhd,bkhd->bhqk', qn, k_nope)
             + jnp.einsum('bqhr,bkr->bhqk', qr, k_rope)).astype(jnp.float32) * scale
        p = jax.nn.softmax(s, axis=-1).astype(v.dtype)
        return jnp.einsum('bhqk,bkhd->bqhd', p, v)

    o = lax.map(q_block, (to_blocks(q_nope), to_blocks(q_rope)))
    o = jnp.moveaxis(o, 0, 1).reshape(B, S, MLA_HEADS * MLA_V)
    return o @ w_o


def _moe(h, w_router, w_gu, w_down):
    B, S, D = h.shape
    hf = h.reshape(B * S, D)
    probs = jax.nn.softmax((hf @ w_router).astype(jnp.float32), axis=-1)
    vals, idx = lax.top_k(probs, TOP_K)
    wts = vals / jnp.sum(vals, axis=-1, keepdims=True)
    combine = jnp.sum(jax.nn.one_hot(idx, N_EXPERTS, dtype=jnp.float32) * wts[..., None], axis=1)
    combine = combine.astype(h.dtype)
    y = jnp.zeros_like(hf)
    for e in range(N_EXPERTS):
        y = y + combine[:, e:e + 1] * _swiglu(hf, w_gu[e], w_down[e])
    return y.reshape(B, S, D)


def setup_inputs(seed: int = 0) -> dict:
    key = jax.random.key(seed)
    ks = iter(jax.random.split(key, 32))
    n_even = (DEPTH + 1) // 2
    n_odd = DEPTH // 2
    D = D_MODEL

    def nrm(shape, fan_in, mult=1.0):
        return jax.random.normal(next(ks), shape, jnp.float32) * (mult * fan_in ** -0.5)

    return {
        "x": jax.random.normal(next(ks), (BATCH, SEQ, D), jnp.float32),
        "c": jax.random.normal(next(ks), (BATCH, D), jnp.float32),
        "w_ada": nrm((DEPTH, D, 6 * D), D, 0.5),
        "b_ada": 0.02 * jax.random.normal(next(ks), (DEPTH, 6 * D), jnp.float32),
        "na_w_qkv": nrm((n_even, D, 3 * D), D),
        "na_rpb": 0.1 * jax.random.normal(next(ks), (n_even, NA_HEADS, 2 * NA_WIN_H - 1, 2 * NA_WIN_W - 1), jnp.float32),
        "na_w_o": nrm((n_even, D, D), D),
        "ffn_w_gu": nrm((n_even, D, 2 * FFN_DIM), D),
        "ffn_w_down": nrm((n_even, FFN_DIM, D), FFN_DIM),
        "mla_w_down": nrm((n_odd, D, MLA_Q_LORA + MLA_KV_LORA + MLA_ROPE), D),
        "mla_q_norm": 1.0 + 0.01 * jax.random.normal(next(ks), (n_odd, MLA_Q_LORA), jnp.float32),
        "mla_w_uq": nrm((n_odd, MLA_Q_LORA, MLA_HEADS * (MLA_NOPE + MLA_ROPE)), MLA_Q_LORA),
        "mla_kv_norm": 1.0 + 0.01 * jax.random.normal(next(ks), (n_odd, MLA_KV_LORA), jnp.float32),
        "mla_w_ukv": nrm((n_odd, MLA_KV_LORA, MLA_HEADS * (MLA_NOPE + MLA_V)), MLA_KV_LORA),
        "mla_w_o": nrm((n_odd, MLA_HEADS * MLA_V, D), MLA_HEADS * MLA_V),
        "moe_w_router": nrm((n_odd, D, N_EXPERTS), D),
        "moe_w_gu": nrm((n_odd, N_EXPERTS, D, 2 * EXPERT_DIM), D),
        "moe_w_down": nrm((n_odd, N_EXPERTS, EXPERT_DIM, D), EXPERT_DIM),
        "final_norm": 1.0 + 0.01 * jax.random.normal(next(ks), (D,), jnp.float32),
    }


def reference(x, c, w_ada, b_ada, na_w_qkv, na_rpb, na_w_o, ffn_w_gu, ffn_w_down,
              mla_w_down, mla_q_norm, mla_w_uq, mla_kv_norm, mla_w_ukv, mla_w_o,
              moe_w_router, moe_w_gu, moe_w_down, final_norm):
    c_act = jax.nn.silu(c)
    for i in range(DEPTH):
        j = i // 2
        mod = c_act @ w_ada[i] + b_ada[i]
        sh_a, sc_a, g_a, sh_f, sc_f, g_f = jnp.split(mod, 6, axis=-1)
        h = _modulate(x, sh_a, sc_a)
        if i % 2 == 0:
            m = _neighborhood_attention(h, na_w_qkv[j], na_rpb[j], na_w_o[j])
        else:
            m = _mla(h, mla_w_down[j], mla_q_norm[j], mla_w_uq[j], mla_kv_norm[j], mla_w_ukv[j], mla_w_o[j])
        x = x + g_a[:, None, :] * m
        h = _modulate(x, sh_f, sc_f)
        if i % 2 == 0:
            f = _swiglu(h, ffn_w_gu[j], ffn_w_down[j])
        else:
            f = _moe(h, moe_w_router[j], moe_w_gu[j], moe_w_down[j])
        x = x + g_f[:, None, :] * f
    return _rmsnorm(x) * final_norm
```

```cpp
#include <hip/hip_runtime.h>
#include <cstdio>
#include <cstdint>
namespace pg8 {
#define PG8_LAS __attribute__((address_space(3)))
typedef unsigned short bf16_t;
typedef short bf16x8 __attribute__((ext_vector_type(8)));
typedef float f32x4 __attribute__((ext_vector_type(4)));
typedef unsigned u32x4 __attribute__((ext_vector_type(4)));
constexpr int BM = 256, BK = 64, HALF = 128, HTB = HALF * BK * 2  , STAGE_BYTES = 8 * HTB, NXCD = 8, WGM = 8;

__host__ __device__ __forceinline__ int lds_byte(int r, int c) { const int st = (r >> 4) * 2 + (c >> 5), rr = r & 15, cc = c & 31, ob = rr * 64 + cc * 2; return st * 1024 + (ob ^ (((ob >> 9) & 1) << 5)); }
__host__ __device__ __forceinline__ void stage_rc(int b, int& R, int& C) { const int st = b / 1024, sb = b % 1024, swz = sb ^ (((sb >> 9) & 1) << 5); R = (st >> 1) * 16 + swz / 64; C = (st & 1) * 32 + (swz % 64) / 2; }
__host__ __device__ __forceinline__ int perm32(int rho) { const int n = rho >> 4, i = rho & 15; return 8 * (i >> 2) + 4 * n + (i & 3); }

struct Unit { int pm, pn; };
struct Gemm { const bf16_t* A; const bf16_t* Bt; int M, N, K; };

struct StaticOrder {
    int nM, nN, nwg, G, c;
    __host__ __device__ void init(int M, int N, int G_, int c_) { nM = M / BM; nN = N / BM; nwg = nM * nN; G = G_; c = c_; }
    __host__ __device__ bool next(int i, Unit& u) const {
        const long L = (long)i * G + c; if (L >= nwg) return false;
        int wgid = (int)L; { const int q = nwg / NXCD, r = nwg % NXCD, xcd = wgid % NXCD, off = wgid / NXCD; wgid = (xcd < r ? xcd * (q + 1) : r * (q + 1) + (xcd - r) * q) + off; }
        const int nig = WGM * nN, gid = wgid / nig, fm = gid * WGM, gsz = (nM - fm) < WGM ? (nM - fm) : WGM;
        u.pm = fm + ((wgid % nig) % gsz); u.pn = (wgid % nig) / gsz; return true;
    }
    __device__ __forceinline__ void a_ready(const Unit&) const {}
    __device__ __forceinline__ void done(const Unit&) const {}
};

__device__ __forceinline__ unsigned cvt_pk_bf16(float lo, float hi) { unsigned r; asm volatile("v_cvt_pk_bf16_f32 %0, %1, %2" : "=v"(r) : "v"(lo), "v"(hi)); return r; }

__device__ __forceinline__ float fast_silu(float g) { return g * __builtin_amdgcn_rcpf(1.f + __builtin_amdgcn_exp2f(-1.4426950408889634f * g)); }
struct EpiBf16P {
    static constexpr bool PERM = true, AFTER_DRAIN = false;
    bf16_t* O; int ldc; int nct; int st; size_t sstride; float scale0; int mode0, mode1;
    __device__ __forceinline__ void operator()(const f32x4 (&acc)[2][2][4][2], const Unit& u, int wr, int wc, int fr, int fq) const {
        int ct = u.pn % nct; bf16_t* base = O; float sc = 1.f; int mode = mode0;
        if (st) { const int t = ct / st; base += (size_t)t * sstride; ct -= t * st; if (t == 0) sc = scale0; else mode = mode1; }
        const int row0 = u.pm * BM + wr * 64 + fr, col0 = ct * BM + wc * 32 + 8 * fq;
#pragma unroll
        for (int ai = 0; ai < 2; ++ai)
#pragma unroll
            for (int m = 0; m < 4; ++m) { const int row = row0 + ai * HALF + m * 16;
#pragma unroll
                for (int bj = 0; bj < 2; ++bj) { const f32x4 v0 = acc[ai][bj][m][0] * sc, v1 = acc[ai][bj][m][1] * sc; const int col = col0 + bj * HALF;
                    u32x4 w; w.x = cvt_pk_bf16(v0[0], v0[1]); w.y = cvt_pk_bf16(v0[2], v0[3]); w.z = cvt_pk_bf16(v1[0], v1[1]); w.w = cvt_pk_bf16(v1[2], v1[3]);
                    bf16_t* p = mode == 0 ? base + (size_t)row * ldc + col : base + ((size_t)(col >> 6) * (mode == 1 ? 16384 : 1024) + row) * 64 + (col & 63);
                    *(u32x4*)p = w; } }
    }
};
struct EpiResGate {
    static constexpr bool PERM = false, AFTER_DRAIN = false;
    const float* res; float* out; const float* gate;
    __device__ __forceinline__ void operator()(const f32x4 (&acc)[2][2][4][2], const Unit& u, int wr, int wc, int fr, int fq) const {
        const int row0 = u.pm * BM + wr * 64 + fr, col0 = u.pn * BM + wc * 32 + 4 * fq;
        const float* gp = gate + (size_t)((u.pm * BM) >> 13) * 6144 + col0;
        f32x4 gv[2][2];
#pragma unroll
        for (int bj = 0; bj < 2; ++bj)
#pragma unroll
            for (int n = 0; n < 2; ++n) gv[bj][n] = *(const f32x4*)(gp + bj * HALF + n * 16);
#pragma unroll
        for (int ai = 0; ai < 2; ++ai)
#pragma unroll
            for (int m = 0; m < 4; ++m) { const size_t off = (size_t)(row0 + ai * HALF + m * 16) * 1024 + col0;
#pragma unroll
                for (int bj = 0; bj < 2; ++bj)
#pragma unroll
                    for (int n = 0; n < 2; ++n) { const f32x4 rs = *(const f32x4*)(res + off + bj * HALF + n * 16);
                        *(f32x4*)(out + off + bj * HALF + n * 16) = rs + gv[bj][n] * acc[ai][bj][m][n]; } }
    }
};
template <bool RES_F32> struct EpiResGateB {
    static constexpr bool PERM = true, AFTER_DRAIN = false;
    const void* res; bf16_t* out; const float* gate;
    __device__ __forceinline__ void operator()(const f32x4 (&acc)[2][2][4][2], const Unit& u, int wr, int wc, int fr, int fq) const {
        const int row0 = u.pm * BM + wr * 64 + fr, col0 = u.pn * BM + wc * 32 + 8 * fq;
        const float* gp = gate + (size_t)((u.pm * BM) >> 13) * 6144 + col0;
        f32x4 gv[2][2];
#pragma unroll
        for (int bj = 0; bj < 2; ++bj)
#pragma unroll
            for (int n = 0; n < 2; ++n) gv[bj][n] = *(const f32x4*)(gp + bj * HALF + 4 * n);
#pragma unroll
        for (int ai = 0; ai < 2; ++ai)
#pragma unroll
            for (int m = 0; m < 4; ++m) { const size_t off = (size_t)(row0 + ai * HALF + m * 16) * 1024 + col0;
#pragma unroll
                for (int bj = 0; bj < 2; ++bj) { f32x4 r0, r1;
                    if (RES_F32) { const float* rp = (const float*)res + off + bj * HALF; r0 = *(const f32x4*)rp; r1 = *(const f32x4*)(rp + 4); }
                    else { const u32x4 w = *(const u32x4*)((const bf16_t*)res + off + bj * HALF);
                        r0 = (f32x4){__builtin_bit_cast(float, w.x << 16), __builtin_bit_cast(float, w.x & 0xffff0000u), __builtin_bit_cast(float, w.y << 16), __builtin_bit_cast(float, w.y & 0xffff0000u)};
                        r1 = (f32x4){__builtin_bit_cast(float, w.z << 16), __builtin_bit_cast(float, w.z & 0xffff0000u), __builtin_bit_cast(float, w.w << 16), __builtin_bit_cast(float, w.w & 0xffff0000u)}; }
                    const f32x4 v0 = r0 + gv[bj][0] * acc[ai][bj][m][0], v1 = r1 + gv[bj][1] * acc[ai][bj][m][1];
                    u32x4 o; o.x = cvt_pk_bf16(v0[0], v0[1]); o.y = cvt_pk_bf16(v0[2], v0[3]); o.z = cvt_pk_bf16(v1[0], v1[1]); o.w = cvt_pk_bf16(v1[2], v1[3]);
                    *(u32x4*)(out + off + bj * HALF) = o; } }
    }
};
struct EpiF32 {
    static constexpr bool PERM = false, AFTER_DRAIN = false;
    float* O; int ldc;
    __device__ __forceinline__ void operator()(const f32x4 (&acc)[2][2][4][2], const Unit& u, int wr, int wc, int fr, int fq) const {
        const int row0 = u.pm * BM + wr * 64 + fr, col0 = u.pn * BM + wc * 32 + 4 * fq;
#pragma unroll
        for (int ai = 0; ai < 2; ++ai)
#pragma unroll
            for (int m = 0; m < 4; ++m) { float* rowp = O + (size_t)(row0 + ai * HALF + m * 16) * ldc + col0;
#pragma unroll
                for (int bj = 0; bj < 2; ++bj)
#pragma unroll
                    for (int n = 0; n < 2; ++n) *(f32x4*)(rowp + bj * HALF + n * 16) = acc[ai][bj][m][n]; }
    }
};
struct EpiSwiGLU {
    static constexpr bool PERM = true, AFTER_DRAIN = false;
    bf16_t* O; int ldc; int nN;
    __device__ __forceinline__ void operator()(const f32x4 (&acc)[2][2][4][2], const Unit& u, int wr, int wc, int fr, int fq) const {
        const int row0 = u.pm * BM + wr * 64 + fr, col0 = (u.pn % nN) * HALF + wc * 32 + 8 * fq;
#pragma unroll
        for (int ai = 0; ai < 2; ++ai)
#pragma unroll
            for (int m = 0; m < 4; ++m) {
                const f32x4 g0 = acc[ai][0][m][0], g1 = acc[ai][0][m][1], u0 = acc[ai][1][m][0], u1 = acc[ai][1][m][1];
                u32x4 w;
                w.x = cvt_pk_bf16(fast_silu(g0[0]) * u0[0], fast_silu(g0[1]) * u0[1]); w.y = cvt_pk_bf16(fast_silu(g0[2]) * u0[2], fast_silu(g0[3]) * u0[3]);
                w.z = cvt_pk_bf16(fast_silu(g1[0]) * u1[0], fast_silu(g1[1]) * u1[1]); w.w = cvt_pk_bf16(fast_silu(g1[2]) * u1[2], fast_silu(g1[3]) * u1[3]);
                *(u32x4*)(O + (size_t)(row0 + ai * HALF + m * 16) * ldc + col0) = w; }
    }
};
struct EpiQRope {
    static constexpr bool PERM = true, AFTER_DRAIN = false;
    bf16_t* O; const float* ropeR; const float* ropeC; float qs;
    __device__ __forceinline__ void operator()(const f32x4 (&acc)[2][2][4][2], const Unit& u, int wr, int wc, int fr, int fq) const {
        const int row0 = u.pm * BM + wr * 64 + fr, col0 = u.pn * BM + wc * 32 + 8 * fq;
#pragma unroll
        for (int ai = 0; ai < 2; ++ai)
#pragma unroll
            for (int m = 0; m < 4; ++m) { const int r = row0 + ai * HALF + m * 16, t = r & 8191, gr = t >> 6, gc = t & 63;
#pragma unroll
                for (int bj = 0; bj < 2; ++bj) { const int c = col0 + bj * HALF, d = c % 96;
                    f32x4 v0 = acc[ai][bj][m][0], v1 = acc[ai][bj][m][1];
                    if (d >= 64) { const int p = (d - 64) >> 1;
                        const float* tb = p < 8 ? ropeR + gr * 16 + 2 * p : ropeC + gc * 16 + 2 * (p - 8);
                        const f32x4 a = *(const f32x4*)tb, b = *(const f32x4*)(tb + 4);
                        v0 = (f32x4){v0[0] * a[0] - v0[1] * a[1], v0[0] * a[1] + v0[1] * a[0], v0[2] * a[2] - v0[3] * a[3], v0[2] * a[3] + v0[3] * a[2]};
                        v1 = (f32x4){v1[0] * b[0] - v1[1] * b[1], v1[0] * b[1] + v1[1] * b[0], v1[2] * b[2] - v1[3] * b[3], v1[2] * b[3] + v1[3] * b[2]}; }
                    v0 = v0 * qs; v1 = v1 * qs;
                    u32x4 w; w.x = cvt_pk_bf16(v0[0], v0[1]); w.y = cvt_pk_bf16(v0[2], v0[3]); w.z = cvt_pk_bf16(v1[0], v1[1]); w.w = cvt_pk_bf16(v1[2], v1[3]);
                    *(u32x4*)(O + (size_t)r * 1536 + c) = w; }
                asm volatile("" ::: "memory"); }
    }
};
struct MoeOrder {
    int T, nN, G, c; int tb1, tb2, tb3, tb4, tb5, tb6, tb7;
    __device__ __forceinline__ bool next(int i, Unit& u) const {
        const int nwg = T * nN; const long L = (long)i * G + c; if (L >= nwg) return false;
        int wgid = (int)L; { const int q = nwg / NXCD, r = nwg % NXCD, xcd = wgid % NXCD, off = wgid / NXCD; wgid = (xcd < r ? xcd * (q + 1) : r * (q + 1) + (xcd - r) * q) + off; }
        const int nig = WGM * nN, gid = wgid / nig, fm = gid * WGM, gsz = (T - fm) < WGM ? (T - fm) : WGM;
        const int pm = fm + ((wgid % nig) % gsz), pn = (wgid % nig) / gsz;
        const int e = (pm >= tb1) + (pm >= tb2) + (pm >= tb3) + (pm >= tb4) + (pm >= tb5) + (pm >= tb6) + (pm >= tb7);
        u.pm = pm; u.pn = e * nN + pn; return true;
    }
    __device__ __forceinline__ void a_ready(const Unit&) const {}
    __device__ __forceinline__ void done(const Unit&) const {}
};

template <class Epi, class Sched, bool ALIGN_EPI = false, bool SP2 = false>
__device__ __forceinline__ void gemm_phase(PG8_LAS unsigned char* lds, const Gemm g, const Sched& S, const Epi& E) {
    const int tid = threadIdx.x, wid = __builtin_amdgcn_readfirstlane(tid >> 6), lane = tid & 63, wr = wid >> 2, wc = wid & 3, fr = lane & 15, fq = lane >> 4;
    const int K = g.K, nt = K / BK;
    unsigned voffA[2], voffB[2];
#pragma unroll
    for (int i = 0; i < 2; ++i) { int R, C; stage_rc(tid * 16 + i * 8192, R, C); const int Rb = Epi::PERM ? ((R & ~31) + perm32(R & 31)) : R;
        voffA[i] = (unsigned)(R * K + C) * 2u; voffB[i] = (unsigned)(Rb * K + C) * 2u; }
    const size_t kstep = (size_t)(BK * 2);
    const size_t hstep = (size_t)HALF * K * 2;
    const size_t tstep = 2 * hstep;
    const unsigned ldsw = (unsigned)wid * 1024u;
    const int aoff = lds_byte(wr * 64 + fr, fq * 8), boff = lds_byte(wc * 32 + fr, fq * 8);
#define PG8_SA(b, h) (((b) * 2 + (h)) * HTB)
#define PG8_SB(b, h) ((4 + (b) * 2 + (h)) * HTB)
#define PG8_STAGE(bufoff, gbase, voff) do { _Pragma("unroll") for (int _i = 0; _i < 2; ++_i) \
        __builtin_amdgcn_global_load_lds((const unsigned*)((const char*)(gbase) + (voff)[_i]), (PG8_LAS unsigned*)(lds + (bufoff) + ldsw + _i * 8192), 16, 0, 0); } while (0)
#define PG8_LDA(dst, b, h) do { _Pragma("unroll") for (int m = 0; m < 4; ++m) _Pragma("unroll") for (int k = 0; k < 2; ++k) dst[m][k] = *(const PG8_LAS bf16x8*)(lds + PG8_SA(b, h) + aoff + m * 2048 + k * 1024); } while (0)
#define PG8_LDB(dst, b, h) do { _Pragma("unroll") for (int n = 0; n < 2; ++n) _Pragma("unroll") for (int k = 0; k < 2; ++k) dst[n][k] = *(const PG8_LAS bf16x8*)(lds + PG8_SB(b, h) + boff + n * 2048 + k * 1024); } while (0)
#define PG8_MMA(ai, bj, At, Bt) do { __builtin_amdgcn_s_setprio(1); _Pragma("unroll") for (int m = 0; m < 4; ++m) _Pragma("unroll") for (int n = 0; n < 2; ++n) _Pragma("unroll") for (int k = 0; k < 2; ++k) \
        acc[ai][bj][m][n] = __builtin_amdgcn_mfma_f32_16x16x32_bf16(Bt[n][k], At[m][k], acc[ai][bj][m][n], 0, 0, 0); __builtin_amdgcn_s_setprio(0); } while (0)
#define PG8_WAIT_V(n) asm volatile("s_waitcnt vmcnt(" #n ")" ::: "memory")
#define PG8_WAIT_L(n) asm volatile("s_waitcnt lgkmcnt(" #n ")" ::: "memory")
#define PG8_BAR __builtin_amdgcn_s_barrier()
#define PG8_SCHED __builtin_amdgcn_sched_barrier(0)
    Unit cur, nxt; int ui = 0;
    if (!S.next(0, cur)) return;
    f32x4 acc[2][2][4][2];
#pragma unroll
    for (int a = 0; a < 2; ++a)
#pragma unroll
        for (int b = 0; b < 2; ++b)
#pragma unroll
            for (int m = 0; m < 4; ++m)
#pragma unroll
                for (int n = 0; n < 2; ++n) acc[a][b][m][n] = (f32x4){0.f, 0.f, 0.f, 0.f};
    bf16x8 At[4][2], B0[2][2], B1[2][2];
    const char* cA = (const char*)g.A + (size_t)cur.pm * tstep; const char* cB = (const char*)g.Bt + (size_t)cur.pn * tstep;
    S.a_ready(cur);
    if constexpr (SP2) {
        PG8_STAGE(PG8_SB(0, 0), cB, voffB); PG8_STAGE(PG8_SB(0, 1), cB + hstep, voffB); PG8_STAGE(PG8_SA(0, 0), cA, voffA); PG8_STAGE(PG8_SA(0, 1), cA + hstep, voffA);
        if (wr == 1) PG8_BAR;
        PG8_WAIT_V(2); PG8_BAR;
        PG8_STAGE(PG8_SB(1, 0), cB + kstep, voffB); PG8_STAGE(PG8_SA(1, 0), cA + kstep, voffA); PG8_STAGE(PG8_SB(1, 1), cB + hstep + kstep, voffB);
        PG8_WAIT_V(6); PG8_BAR;
    } else {
        PG8_STAGE(PG8_SB(0, 0), cB, voffB); PG8_STAGE(PG8_SA(0, 0), cA, voffA); PG8_STAGE(PG8_SB(0, 1), cB + hstep, voffB); PG8_STAGE(PG8_SA(0, 1), cA + hstep, voffA);
        if (wr == 1) PG8_BAR;
        PG8_WAIT_V(4); PG8_BAR;
        PG8_STAGE(PG8_SB(1, 0), cB + kstep, voffB); PG8_STAGE(PG8_SA(1, 0), cA + kstep, voffA); PG8_STAGE(PG8_SB(1, 1), cB + hstep + kstep, voffB);
        PG8_WAIT_V(6); PG8_BAR;
    }
    for (;;) {
        const bool has_next = S.next(ui + 1, nxt);
        const char* nA = has_next ? (const char*)g.A + (size_t)nxt.pm * tstep : cA; const char* nB = has_next ? (const char*)g.Bt + (size_t)nxt.pn * tstep : cB;
        for (int t = 0; t < nt; t += 2) {
            const bool last = (t == nt - 2);
            const char* a1 = cA + (size_t)(t + 1) * kstep;
            const char* a2 = last ? nA : cA + (size_t)(t + 2) * kstep; const char* b2 = last ? nB : cB + (size_t)(t + 2) * kstep;
            const char* a3 = a2 + kstep; const char* b3 = b2 + kstep;
            if (last && has_next) S.a_ready(nxt);
            if constexpr (SP2) {
            PG8_LDB(B0, 0, 0); PG8_LDB(B1, 0, 1); PG8_SCHED; PG8_LDA(At, 0, 0); PG8_STAGE(PG8_SA(1, 1), a1 + hstep, voffA);
            PG8_WAIT_V(8); PG8_WAIT_L(0); PG8_BAR; PG8_MMA(0, 0, At, B0); PG8_MMA(0, 1, At, B1); PG8_BAR; PG8_SCHED;
            PG8_LDA(At, 0, 1); PG8_STAGE(PG8_SB(0, 0), b2, voffB); PG8_STAGE(PG8_SB(0, 1), b2 + hstep, voffB); PG8_STAGE(PG8_SA(0, 0), a2, voffA);
            PG8_WAIT_V(8); PG8_WAIT_L(0); PG8_BAR; PG8_MMA(1, 0, At, B0); PG8_MMA(1, 1, At, B1); PG8_BAR; PG8_SCHED;
            PG8_LDB(B0, 1, 0); PG8_LDB(B1, 1, 1); PG8_SCHED; PG8_LDA(At, 1, 0); PG8_STAGE(PG8_SA(0, 1), a2 + hstep, voffA);
            PG8_WAIT_V(8); PG8_WAIT_L(0); PG8_BAR; PG8_MMA(0, 0, At, B0); PG8_MMA(0, 1, At, B1); PG8_BAR; PG8_SCHED;
            PG8_LDA(At, 1, 1); PG8_STAGE(PG8_SB(1, 0), b3, voffB); PG8_STAGE(PG8_SB(1, 1), b3 + hstep, voffB); PG8_STAGE(PG8_SA(1, 0), a3, voffA);
            PG8_WAIT_V(8); PG8_WAIT_L(0); PG8_BAR; PG8_MMA(1, 0, At, B0); PG8_MMA(1, 1, At, B1); PG8_BAR; PG8_SCHED;
            } else {
            PG8_LDB(B0, 0, 0); PG8_SCHED; PG8_LDA(At, 0, 0); PG8_STAGE(PG8_SA(1, 1), a1 + hstep, voffA);
            PG8_WAIT_L(8); PG8_BAR; PG8_WAIT_L(0); PG8_MMA(0, 0, At, B0); PG8_BAR; PG8_SCHED;
            PG8_LDB(B1, 0, 1); PG8_STAGE(PG8_SB(0, 0), b2, voffB);
            PG8_BAR; PG8_WAIT_L(0); PG8_MMA(0, 1, At, B1); PG8_BAR;
            PG8_LDA(At, 0, 1); PG8_STAGE(PG8_SA(0, 0), a2, voffA);
            PG8_BAR; PG8_WAIT_L(0); PG8_MMA(1, 0, At, B0); PG8_BAR; PG8_SCHED;
            PG8_STAGE(PG8_SB(0, 1), b2 + hstep, voffB);
            PG8_WAIT_V(6); PG8_BAR; PG8_MMA(1, 1, At, B1); PG8_BAR;
            PG8_LDB(B0, 1, 0); PG8_SCHED; PG8_LDA(At, 1, 0); PG8_STAGE(PG8_SA(0, 1), a2 + hstep, voffA);
            PG8_WAIT_L(8); PG8_BAR; PG8_WAIT_L(0); PG8_MMA(0, 0, At, B0); PG8_BAR; PG8_SCHED;
            PG8_LDB(B1, 1, 1); PG8_STAGE(PG8_SB(1, 0), b3, voffB);
            PG8_BAR; PG8_WAIT_L(0); PG8_MMA(0, 1, At, B1); PG8_BAR;
            PG8_LDA(At, 1, 1); PG8_STAGE(PG8_SA(1, 0), a3, voffA);
            PG8_BAR; PG8_WAIT_L(0); PG8_MMA(1, 0, At, B0); PG8_BAR; PG8_SCHED;
            PG8_STAGE(PG8_SB(1, 1), b3 + hstep, voffB);
            PG8_WAIT_V(6); PG8_BAR; PG8_MMA(1, 1, At, B1); PG8_BAR;
            }
        }
        if constexpr (ALIGN_EPI) { if (wr == 0) PG8_BAR; }
        if constexpr (!Epi::AFTER_DRAIN) { E(acc, cur, wr, wc, fr, fq); S.done(cur); }
        if (!has_next) break;
#pragma unroll
        for (int a = 0; a < 2; ++a)
#pragma unroll
            for (int b = 0; b < 2; ++b)
#pragma unroll
                for (int m = 0; m < 4; ++m)
#pragma unroll
                    for (int n = 0; n < 2; ++n) acc[a][b][m][n] = (f32x4){0.f, 0.f, 0.f, 0.f};
        cur = nxt; cA = nA; cB = nB; ++ui;
        if constexpr (ALIGN_EPI) { if (wr == 1) PG8_BAR; }
    }
    PG8_WAIT_V(0);
    if constexpr (!ALIGN_EPI) { if (wr == 0) PG8_BAR; }
    PG8_BAR;
    if constexpr (Epi::AFTER_DRAIN) { E.fused(acc, cur, wr, wc, fr, fq, lds, wid, lane); S.done(cur); }
#undef PG8_SA
#undef PG8_SB
#undef PG8_STAGE
#undef PG8_LDA
#undef PG8_LDB
#undef PG8_MMA
#undef PG8_WAIT_V
#undef PG8_WAIT_L
#undef PG8_BAR
#undef PG8_SCHED
}
}

#define GAS __attribute__((address_space(1)))
#define LAS __attribute__((address_space(3)))

#define XB_TMO      128
#define XB_XCNT(j)  (256  + 64 * (j))
#define XB_XSUB(j)  (1280 + 64 * (j))
#define XB_XGEN(j)  (2304 + 64 * (j))
#define XB_TOP      3328
#define XB_TOPGEN   3392
#define XCD_BAR_WORDS 3456
#define XB_SPIN_CAP (1u << 18)

__device__ __forceinline__ unsigned xb_ld(unsigned* p)              { return __hip_atomic_load(p, __ATOMIC_RELAXED, __HIP_MEMORY_SCOPE_AGENT); }
__device__ __forceinline__ unsigned xb_add(unsigned* p, unsigned v) { return __hip_atomic_fetch_add(p, v, __ATOMIC_RELAXED, __HIP_MEMORY_SCOPE_AGENT); }
__device__ __forceinline__ unsigned xb_xcc_id() { return (unsigned)__builtin_amdgcn_s_getreg((3 << 11) | 20) & 0xFu; }
#define XB_SPIN(cond, bar) do { unsigned _sp = 0; while (cond) { __builtin_amdgcn_s_sleep(1); \
    if ((++_sp & 255u) == 0u) { if (xb_ld(&(bar)[XB_TMO])) break; if (_sp > XB_SPIN_CAP) { atomicAdd(&(bar)[XB_TMO], 1u); break; } } } } while (0)

struct XcdBarrier {
    unsigned* bar; unsigned x;
    volatile LAS unsigned* st;
};

__device__ __forceinline__ XcdBarrier xcd_barrier_post(unsigned* bar, volatile LAS unsigned* st) {
    XcdBarrier b; b.bar = bar; b.x = xb_xcc_id(); b.st = st;
    if (threadIdx.x == 0) (void)xb_add(&bar[XB_XCNT(b.x)], 1u);
    return b;
}
__device__ __forceinline__ void xcd_barrier_complete(unsigned* bar, unsigned x, unsigned& nloc, unsigned& nx) {
    const unsigned G = gridDim.x * gridDim.y * gridDim.z;
    unsigned sum, cnt, mine, sp = 0u;
    for (;;) {
        sum = 0u; cnt = 0u; mine = 0u;
#pragma unroll
        for (unsigned j = 0; j < 16; ++j) { const unsigned c = xb_ld(&bar[XB_XCNT(j)]); sum += c; cnt += (c > 0u) ? 1u : 0u; mine = (j == x) ? c : mine; }
        if (sum == G) break;
        __builtin_amdgcn_s_sleep(1);
        if ((++sp & 255u) == 0u) { if (xb_ld(&bar[XB_TMO])) break; if (sp > XB_SPIN_CAP) { atomicAdd(&bar[XB_TMO], 1u); break; } }
    }
    nloc = mine > 0u ? mine : 1u; nx = cnt > 0u ? cnt : 1u;
}

__device__ __forceinline__ void xcd_barrier(const XcdBarrier& b) {
    asm volatile("s_waitcnt vmcnt(0)" ::: "memory");
    __syncthreads();
    if (threadIdx.x == 0) {
        unsigned* bar = b.bar;
        __builtin_amdgcn_s_waitcnt(0);
        unsigned nloc = b.st[0], nx = b.st[1];
        if (nloc == 0u) { xcd_barrier_complete(bar, b.x, nloc, nx); b.st[0] = nloc; b.st[1] = nx; }
        const unsigned old = xb_add(&bar[XB_XSUB(b.x)], 1u);
        const unsigned gen = old / nloc;
        if (old + 1u == (gen + 1u) * nloc) {
            __builtin_amdgcn_fence(__ATOMIC_RELEASE, "agent");
            asm volatile("s_waitcnt vmcnt(0)" ::: "memory");
            const unsigned og = xb_add(&bar[XB_TOP], 1u);
            const unsigned tg = og / nx;
            if (og + 1u == (tg + 1u) * nx) xb_add(&bar[XB_TOPGEN], 1u);
            else XB_SPIN(xb_ld(&bar[XB_TOPGEN]) == tg, bar);
            __builtin_amdgcn_fence(__ATOMIC_ACQUIRE, "agent");
            xb_add(&bar[XB_XGEN(b.x)], 1u);
            asm volatile("s_waitcnt vmcnt(0)" ::: "memory");
        } else {
            XB_SPIN(xb_ld(&bar[XB_XGEN(b.x)]) == gen, bar);
            __builtin_amdgcn_fence(__ATOMIC_ACQUIRE, "agent");
            asm volatile("s_waitcnt vmcnt(0)" ::: "memory");
        }
    }
    __syncthreads();
}


constexpr int NWAVES = 8, NTHREADS = 512;
constexpr int D = 1024, NB = 2, SEQ = 8192, M = NB * SEQ, GW = 64, GROWS = 128, NH = 16, HD = 64;
constexpr int FFN = 2816, NE = 8, ED = 1792, QL = 256, KVL = 128, RP = 32, DOWN_N = 416, DOWN_NP = 512, QKD = 96;
constexpr int MP_MAX = 34816;
constexpr float NORM_EPS = 1e-6f;
constexpr float LOG2E = 1.4426950408889634f;
constexpr float QSCALE1 = 0.10206207261596577f * LOG2E;

constexpr size_t MiB = 1u << 20;
constexpr size_t WS_CTL = 0, CTL_ZERO_BYTES = 64 * 1024;
constexpr size_t WS_PART = 4 * MiB;
constexpr size_t WS_MODF = 2 * MiB;
constexpr size_t WS_ROPER = WS_MODF + 128 * 1024;
constexpr size_t WS_ROPEC = WS_ROPER + 16 * 1024;
constexpr size_t WS_CNTWG = WS_ROPEC + 16 * 1024;
constexpr size_t WS_TOKE = 3 * MiB;
constexpr size_t WS_TOKP = WS_TOKE + 128 * 1024;
constexpr size_t WS_TOKW = WS_TOKP + 128 * 1024;
constexpr size_t WS_TOKS = WS_TOKW + 128 * 1024;
constexpr size_t WS_W = 8 * MiB;
constexpr size_t WS_WQK = WS_W, WS_WV = WS_WQK + 4 * MiB, WS_WO0 = WS_WV + 2 * MiB, WS_WGU0 = WS_WO0 + 2 * MiB, WS_WDN0 = WS_WGU0 + 11 * MiB;
constexpr size_t WS_WMD = WS_WDN0 + 5632 * 1024, WS_WUQ = WS_WMD + 1 * MiB, WS_WKN = WS_WUQ + 768 * 1024, WS_WVV = WS_WKN + 512 * 1024, WS_WO1 = WS_WVV + 512 * 1024;
constexpr size_t WS_WGU1 = WS_WO1 + 2 * MiB, WS_WDN1 = WS_WGU1 + 56 * MiB, WS_WEND = WS_WDN1 + 28 * MiB;
static_assert(WS_WEND <= 122 * MiB, "weights");
constexpr size_t WS_XA = 122 * MiB;
constexpr size_t WS_HN = 186 * MiB;
constexpr size_t WS_R = 218 * MiB;
constexpr size_t WS_Q0 = WS_R, WS_K0 = WS_R + 32 * MiB, WS_VT0 = WS_R + 64 * MiB, WS_O0 = WS_R + 96 * MiB;
constexpr size_t WS_ACT0 = WS_R;
constexpr size_t WS_DOWN = WS_R, WS_CQ = WS_R + 32 * MiB, WS_CKV = WS_R + 40 * MiB, WS_KR = WS_R + 48 * MiB;
constexpr size_t WS_Q1 = WS_R + 49 * MiB, WS_KN = WS_R + 97 * MiB, WS_VT1 = WS_R + 129 * MiB, WS_O1 = WS_R + 161 * MiB;
constexpr size_t WS_HP = WS_R, WS_ACT1 = WS_R + 68 * MiB;
constexpr size_t WS_END = WS_R + 193 * MiB;
static_assert(WS_ACT1 + (size_t)MP_MAX * ED * 2 <= WS_END && WS_END <= 448 * MiB, "d_ws map");

constexpr int RING_BYTES = 131072, MISC_OFF = 155648, LDS_BYTES = 159744;

typedef unsigned short bf16;
typedef unsigned v4u __attribute__((ext_vector_type(4)));
typedef unsigned v2u __attribute__((ext_vector_type(2)));
typedef float f32x4 __attribute__((ext_vector_type(4)));
typedef float f32x2 __attribute__((ext_vector_type(2)));
typedef float f32x16 __attribute__((ext_vector_type(16)));
typedef short bf16x8 __attribute__((ext_vector_type(8)));
typedef GAS unsigned gu32;
#define RLX_AGENT __ATOMIC_RELAXED, __HIP_MEMORY_SCOPE_AGENT
#define LDS_WAIT() asm volatile("s_waitcnt lgkmcnt(0)" ::: "memory")
__device__ __forceinline__ unsigned pk2(float lo, float hi) { unsigned r; asm volatile("v_cvt_pk_bf16_f32 %0, %1, %2" : "=v"(r) : "v"(lo), "v"(hi)); return r; }
__device__ __forceinline__ float bf2f(unsigned short h) { return __builtin_bit_cast(float, (unsigned)h << 16); }
__device__ __forceinline__ float bflo(unsigned w) { return __builtin_bit_cast(float, w << 16); }
__device__ __forceinline__ float bfhi(unsigned w) { return __builtin_bit_cast(float, w & 0xffff0000u); }
__device__ __forceinline__ float wave_sum(float v) {
#pragma unroll
    for (int o = 1; o < 64; o <<= 1) v += __shfl_xor(v, o);
    return v;
}

template <typename TX> struct XRow;
template <> struct XRow<float> { static __device__ __forceinline__ f32x4 ld(const float* X, size_t row, int col) { return *(const GAS f32x4*)(X + row * 1024 + col); } };
template <> struct XRow<bf16> { static __device__ __forceinline__ f32x4 ld(const bf16* X, size_t row, int col) { const v2u w = *(const GAS v2u*)(X + row * 1024 + col); return (f32x4){bflo(w.x), bfhi(w.x), bflo(w.y), bfhi(w.y)}; } };

struct Frame {
    LAS unsigned char* lds; volatile LAS unsigned* MISC;
    int tid, lane, wave, vcu, G, gw, NGW;
    const float* in[19]; float* out; unsigned char* ws;
};
#define WSP(T, off) ((T*)(F.ws + (off)))

__device__ __forceinline__ void tr_item(const float* W, int ldn, int k0, int n0, bf16* WT, int ldk, int drow0, LAS float* scr, int lane) {
    { f32x4 v[8]; const int rr = lane >> 3, c4 = (lane & 7) * 4;
#pragma unroll
      for (int i = 0; i < 8; ++i) v[i] = *(const f32x4*)(W + (size_t)(k0 + 8 * i + rr) * ldn + n0 + c4);
#pragma unroll
      for (int i = 0; i < 8; ++i) { LAS float* d = scr + (8 * i + rr) * 33 + c4; d[0] = v[i].x; d[1] = v[i].y; d[2] = v[i].z; d[3] = v[i].w; } }
    LDS_WAIT(); asm volatile("" ::: "memory");
    const int c = lane & 7;
#pragma unroll
    for (int j = 0; j < 4; ++j) { const int n = (lane >> 3) + 8 * j; const LAS float* s = scr + (8 * c) * 33 + n;
        v4u o; o.x = pk2(s[0 * 33], s[1 * 33]); o.y = pk2(s[2 * 33], s[3 * 33]); o.z = pk2(s[4 * 33], s[5 * 33]); o.w = pk2(s[6 * 33], s[7 * 33]);
        *(GAS v4u*)(WT + (size_t)(drow0 + n) * ldk + k0 + 8 * c) = o; }
    LDS_WAIT(); asm volatile("" ::: "memory");
}
__device__ __forceinline__ int gu_row(int n0, int F_) { const int up = n0 >= F_, j = up ? n0 - F_ : n0; return 256 * (j >> 7) + (up ? 128 : 0) + (j & 127); }
__device__ __forceinline__ float silu_acc(float v) { return v / (1.f + expf(-v)); }
constexpr int MOE_I8 = 8 * 16 * 112, MOE_I9 = 8 * 28 * 32, MOE_ITEMS = MOE_I8 + MOE_I9;
constexpr int MOE_G1 = 128 * 40, MOE_G2 = 128 * 48, MOE_G3 = 144 * 24;
__device__ __forceinline__ void moe_w_item(Frame& F, int r, LAS float* scr, int lane) {
    if (r < MOE_I8) { const int e = r / (16 * 112), q = r % (16 * 112), kb = q / 112, nb = q % 112;
        tr_item(F.in[16] + (size_t)e * D * 2 * ED, 2 * ED, 64 * kb, 32 * nb, WSP(bf16, WS_WGU1), D, e * 2 * ED + gu_row(32 * nb, ED), scr, lane); }
    else { r -= MOE_I8; const int e = r / (28 * 32), q = r % (28 * 32), kb = q / 32, nb = q % 32;
        tr_item(F.in[17] + (size_t)e * ED * D, D, 64 * kb, 32 * nb, WSP(bf16, WS_WDN1), ED, e * D + 32 * nb, scr, lane); }
}
__device__ __forceinline__ void moe_w_side(Frame& F, int lo, int hi, int first_wg) {
    if (F.G != 256 || (int)blockIdx.x < first_wg) return;
    LAS float* scr = (LAS float*)(F.lds + F.wave * 16384);
    for (int it = lo + ((int)blockIdx.x - first_wg) * NWAVES + F.wave; it < hi; it += (256 - first_wg) * NWAVES) moe_w_item(F, it, scr, F.lane);
}
__device__ __forceinline__ void p0_prologue(Frame& F) {
    LAS float* scr = (LAS float*)(F.lds + F.wave * 16384);
    const int lane = F.lane;
    constexpr int I0 = 16 * 96, I1 = 16 * 32, I2 = 16 * 176, I3 = 44 * 32, I4 = 16 * 13, I5 = 4 * 48, I6 = 2 * 64, I7 = 16 * 32;
    const int NMOE0 = (F.G == 256) ? MOE_ITEMS - MOE_G1 - MOE_G2 - MOE_G3 : MOE_ITEMS;
    constexpr int IA = 2 * 96 * 16;
    constexpr int IZ = 96 + 2 * 1024;
    const int NITEMS = I0 + I1 + I2 + I3 + I4 + I5 + I6 + I7 + NMOE0 + IA + IZ + 1;
    for (int it = F.gw; it < NITEMS; it += F.NGW) {
        int r = it;
        if (r < NMOE0) { moe_w_item(F, r, scr, lane); continue; } r -= NMOE0;
        if (r < I0) { const int kb = r / 96, nb = r % 96, n0 = 32 * nb;
            if (n0 < 2048) tr_item(F.in[4], 3 * D, 64 * kb, n0, WSP(bf16, WS_WQK), D, n0, scr, lane); else tr_item(F.in[4], 3 * D, 64 * kb, n0, WSP(bf16, WS_WV), D, n0 - 2048, scr, lane);
            continue; } r -= I0;
        if (r < I1) { tr_item(F.in[6], D, 64 * (r / 32), 32 * (r % 32), WSP(bf16, WS_WO0), D, 32 * (r % 32), scr, lane); continue; } r -= I1;
        if (r < I2) { const int kb = r / 176, nb = r % 176; tr_item(F.in[7], 2 * FFN, 64 * kb, 32 * nb, WSP(bf16, WS_WGU0), D, gu_row(32 * nb, FFN), scr, lane); continue; } r -= I2;
        if (r < I3) { tr_item(F.in[8], D, 64 * (r / 32), 32 * (r % 32), WSP(bf16, WS_WDN0), FFN, 32 * (r % 32), scr, lane); continue; } r -= I3;
        if (r < I4) { tr_item(F.in[9], DOWN_N, 64 * (r / 13), 32 * (r % 13), WSP(bf16, WS_WMD), D, 32 * (r % 13), scr, lane); continue; } r -= I4;
        if (r < I5) { tr_item(F.in[11], 1536, 64 * (r / 48), 32 * (r % 48), WSP(bf16, WS_WUQ), QL, 32 * (r % 48), scr, lane); continue; } r -= I5;
        if (r < I6) { const int kb = r / 64, nb = r % 64, h = nb >> 2, q = nb & 3;
            if (q < 2) tr_item(F.in[13], 2048, 64 * kb, 32 * nb, WSP(bf16, WS_WKN), 256, h * 64 + 32 * q, scr, lane); else tr_item(F.in[13], 2048, 64 * kb, 32 * nb, WSP(bf16, WS_WVV), 256, h * 64 + 32 * (q - 2), scr, lane);
            continue; } r -= I6;
        if (r < I7) { tr_item(F.in[14], D, 64 * (r / 32), 32 * (r % 32), WSP(bf16, WS_WO1), D, 32 * (r % 32), scr, lane); continue; } r -= I7;
        if (r < IA) {
            const int l = r / (96 * 16), q = r % (96 * 16), cg = q / 16, kc = q % 16, n = 64 * cg + lane;
            const float* w = F.in[2] + (size_t)l * D * 6 * D + n; const float* c = F.in[1];
            float a0 = 0.f, a1 = 0.f;
#pragma unroll 32
            for (int k = 64 * kc; k < 64 * kc + 64; ++k) { const float wv = w[(size_t)k * 6 * D]; a0 += silu_acc(c[k]) * wv; a1 += silu_acc(c[D + k]) * wv; }
            float* part = WSP(float, WS_PART) + ((size_t)(kc * 2 + l) * 2) * 6 * D + n;
            part[0] = a0; part[6 * D] = a1; continue; } r -= IA;
        if (r < IZ) {
            if (r < 96) { GAS v4u* p = (GAS v4u*)(WSP(bf16, WS_WMD) + (size_t)(DOWN_N + r) * D); p[lane] = (v4u){0u, 0u, 0u, 0u}; p[64 + lane] = (v4u){0u, 0u, 0u, 0u}; }
            else { const int q = r - 96, row = q & 1023; bf16* base = (q < 1024 ? WSP(bf16, WS_WKN) : WSP(bf16, WS_WVV)) + (size_t)row * 256 + 128; ((GAS unsigned*)base)[lane] = 0u; }
            continue; } r -= IZ;
        {
            for (int idx = lane; idx < (128 + 64) * 8; idx += 64) { const int isc = idx >= 1024, q = isc ? idx - 1024 : idx, i = q >> 3, p = q & 7;
                const float inv = powf(10000.f, -(float)p / 8.f), a = (float)i * inv;
                float* t = (isc ? WSP(float, WS_ROPEC) : WSP(float, WS_ROPER)) + i * 16 + 2 * p; t[0] = cosf(a); t[1] = sinf(a); }
        }
    }
}
__device__ __forceinline__ f32x4 mod4_partials(Frame& F, int l, int b, int n) {
    f32x4 a = *(const f32x4*)(F.in[3] + l * 6 * D + n);
#pragma unroll
    for (int kc = 0; kc < 16; ++kc) a += *(const f32x4*)(WSP(float, WS_PART) + ((size_t)((kc * 2 + l) * 2 + b)) * 6 * D + n);
    return a;
}
template <bool FROM_PART, typename TX> __device__ __forceinline__ void modulate_phase(Frame& F, const TX* X, int l, int cs, bf16* HNo) {
    for (int b = 0; b < NB; ++b) {
        f32x4 sh[4], sc[4];
#pragma unroll
        for (int j = 0; j < 4; ++j) { const int n = 4 * F.lane + 256 * j;
            if (FROM_PART) { sh[j] = mod4_partials(F, l, b, cs * D + n); sc[j] = mod4_partials(F, l, b, (cs + 1) * D + n); }
            else { const float* mf = WSP(float, WS_MODF) + (size_t)(l * 2 + b) * 6 * D; sh[j] = *(const f32x4*)(mf + cs * D + n); sc[j] = *(const f32x4*)(mf + (cs + 1) * D + n); }
            sc[j] = sc[j] + 1.f; }
        for (int row = b * SEQ + F.gw; row < (b + 1) * SEQ; row += 4 * F.NGW) {
            f32x4 v[4][4]; float ss[4]; bool ok[4];
#pragma unroll
            for (int q = 0; q < 4; ++q) { ok[q] = row + q * F.NGW < (b + 1) * SEQ; const int rq = ok[q] ? row + q * F.NGW : row;
#pragma unroll
                for (int j = 0; j < 4; ++j) v[q][j] = XRow<TX>::ld(X, (size_t)rq, 4 * F.lane + 256 * j); }
#pragma unroll
            for (int q = 0; q < 4; ++q) { ss[q] = 0.f;
#pragma unroll
                for (int j = 0; j < 4; ++j) ss[q] += (v[q][j].x * v[q][j].x + v[q][j].y * v[q][j].y) + (v[q][j].z * v[q][j].z + v[q][j].w * v[q][j].w); }
#pragma unroll
            for (int o = 1; o < 64; o <<= 1)
#pragma unroll
                for (int q = 0; q < 4; ++q) ss[q] += __shfl_xor(ss[q], o);
#pragma unroll
            for (int q = 0; q < 4; ++q) if (ok[q]) { const float rstd = rsqrtf(ss[q] * (1.f / D) + NORM_EPS); GAS v2u* o8 = (GAS v2u*)(HNo + (size_t)(row + q * F.NGW) * D) + F.lane;
#pragma unroll
                for (int j = 0; j < 4; ++j) { const f32x4 y = v[q][j] * rstd * sc[j] + sh[j]; v2u w; w.x = pk2(y.x, y.y); w.y = pk2(y.z, y.w); o8[64 * j] = w; } }
        }
    }
}
__device__ __forceinline__ void modf_reduce(Frame& F) {
    for (int i = blockIdx.x * NTHREADS + F.tid; i < 2 * 2 * 6 * D; i += F.G * NTHREADS) {
        const int l = i / (2 * 6 * D), q = i % (2 * 6 * D), n = q % (6 * D), b = q / (6 * D);
        float a = F.in[3][l * 6 * D + n];
#pragma unroll
        for (int kc = 0; kc < 16; ++kc) a += WSP(float, WS_PART)[((size_t)((kc * 2 + l) * 2 + b)) * 6 * D + n];
        WSP(float, WS_MODF)[i] = a;
    }
}
__device__ __forceinline__ void mla_mid_phase(Frame& F) {
    const float* DOWN = WSP(float, WS_DOWN); const float* qn = F.in[10]; const float* kvn = F.in[12];
    const f32x4 qn4 = *(const f32x4*)(qn + 4 * F.lane); const f32x2 kn2 = *(const f32x2*)(kvn + 2 * F.lane);
    for (int row = F.gw; row < M; row += F.NGW) {
        const float* dr = DOWN + (size_t)row * DOWN_NP; const int t = row & (SEQ - 1);
        const f32x4 a = *(const f32x4*)(dr + 4 * F.lane); const f32x2 k = *(const f32x2*)(dr + QL + 2 * F.lane);
        const float rq = rsqrtf(wave_sum((a.x * a.x + a.y * a.y) + (a.z * a.z + a.w * a.w)) * (1.f / QL) + NORM_EPS);
        const float rk = rsqrtf(wave_sum(k.x * k.x + k.y * k.y) * (1.f / KVL) + NORM_EPS);
        v2u w; w.x = pk2(a.x * rq * qn4.x, a.y * rq * qn4.y); w.y = pk2(a.z * rq * qn4.z, a.w * rq * qn4.w);
        *((GAS v2u*)(WSP(bf16, WS_CQ) + (size_t)row * QL) + F.lane) = w;
        GAS unsigned* ck = (GAS unsigned*)(WSP(bf16, WS_CKV) + (size_t)row * 256);
        ck[F.lane] = pk2(k.x * rk * kn2.x, k.y * rk * kn2.y); ck[64 + F.lane] = 0u;
        if (F.lane < 16) { const f32x2 x = *(const f32x2*)(dr + QL + KVL + 2 * F.lane);
            const float* tb = F.lane < 8 ? WSP(float, WS_ROPER) + (t >> 6) * 16 + 2 * F.lane : WSP(float, WS_ROPEC) + (t & 63) * 16 + 2 * (F.lane - 8);
            const float cs = tb[0], sn = tb[1];
            ((GAS unsigned*)(WSP(bf16, WS_KR) + (size_t)row * RP))[F.lane] = pk2(x.x * cs - x.y * sn, x.x * sn + x.y * cs); }
    }
}
namespace na {
constexpr int L_K = 0, L_V = 73728, L_B = 147456, L_END = L_B + 15 * 64 * 4;
}
__device__ __forceinline__ void na_phase(Frame& F) {
    const bf16* Q = WSP(bf16, WS_Q0); const bf16* K = WSP(bf16, WS_K0); const bf16* VT = WSP(bf16, WS_VT0); bf16* O = WSP(bf16, WS_O0);
    const int tid = F.tid, lane = F.lane, l16 = lane & 15, g = lane >> 4;
    LAS float* rpbH = (LAS float*)(F.lds + na::L_B);
    const int scol = tid >> 3, sc = tid & 7;
    const unsigned kdst = (unsigned)((scol * 8 + (sc ^ ((scol & 2) ^ ((scol & 8) >> 1)))) * 16), vdst = (unsigned)((scol * 8 + (sc ^ (scol & 6))) * 16);
    const int ri = F.wave >> 2, ct = F.wave & 3;
    const int c0 = 16 * ct, kc0 = ct == 0 ? 0 : (ct == 1 ? 8 : (ct == 2 ? 24 : 32));
    const int c = c0 + l16; int cs = c - 8; cs = cs < 0 ? 0 : (cs > GW - 16 ? GW - 16 : cs);
    const int kcolA = kc0 + 8 * (l16 >> 2) + (l16 & 3), kxv = (kcolA & 2) ^ ((kcolA & 8) >> 1);
    const unsigned kch0 = (unsigned)((kcolA * 8 + (g ^ kxv)) * 16), kch1 = (unsigned)((kcolA * 8 + ((4 + g) ^ kxv)) * 16);
    const unsigned vch = (unsigned)((l16 * 8 + (((kc0 >> 3) + g) ^ (l16 & 6))) * 16);
    const int dc0 = kc0 + 8 * g - c + 15, t0 = kc0 + 8 * g - cs;
    float pen[8];
#pragma unroll
    for (int k = 0; k < 8; ++k) pen[k] = (unsigned)(t0 + k) < 16u ? 0.f : -1e30f;
    for (int w = F.vcu; w < NB * NH * 8; w += F.G) {
        const int bh = w >> 3, b = bh >> 4, h = bh & 15, rp0 = (w & 7) * 8;
        __syncthreads();
        for (int i = tid; i < 15 * 64; i += NTHREADS) { const int dc = (i & 63) - 8; rpbH[i] = (dc >= 0 && dc <= 30) ? F.in[5][(h * 15 + (i >> 6)) * 31 + dc] * LOG2E : 0.f; }
        const bf16* kbase = K + ((size_t)h * M + (size_t)b * SEQ) * HD + scol * HD + sc * 8;
        const bf16* vbase = VT + ((size_t)(b * GROWS) * D + h * HD + scol) * GW + sc * 8;
        bf16x8 kst[9], vst[9];
#define NA_LOAD(rp_) do { int R0_ = 2 * (rp_) - 4; R0_ = R0_ < 0 ? 0 : (R0_ > GROWS - 8 ? GROWS - 8 : R0_); \
        _Pragma("unroll") for (int i_ = 0; i_ < 9; ++i_) { const int row_ = (R0_ + i_) > GROWS - 1 ? GROWS - 1 : (R0_ + i_); \
            kst[i_] = *(const bf16x8*)(kbase + (size_t)row_ * GW * HD); vst[i_] = *(const bf16x8*)(vbase + (size_t)row_ * D * GW); } } while (0)
        NA_LOAD(rp0);
        for (int st = 0; st < 8; ++st) {
            const int rp = rp0 + st;
            __syncthreads();
#pragma unroll
            for (int i = 0; i < 9; ++i) { *(LAS bf16x8*)(F.lds + na::L_K + i * 8192 + kdst) = kst[i]; *(LAS bf16x8*)(F.lds + na::L_V + i * 8192 + vdst) = vst[i]; }
            __syncthreads();
            if (st + 1 < 8) NA_LOAD(rp + 1);
            __builtin_amdgcn_sched_barrier(0);
            const int r = 2 * rp + ri; int rs = r - 4; rs = rs < 0 ? 0 : (rs > GROWS - 8 ? GROWS - 8 : rs);
            int R0 = 2 * rp - 4; R0 = R0 < 0 ? 0 : (R0 > GROWS - 8 ? GROWS - 8 : R0);
            const int roff = rs - R0;
            const size_t tq = (size_t)b * SEQ + r * GW + c;
            bf16x8 qf[2];
#pragma unroll
            for (int ks = 0; ks < 2; ++ks) qf[ks] = *(const bf16x8*)(Q + tq * D + h * HD + 32 * ks + 8 * g);
            const LAS unsigned char* kl = F.lds + na::L_K + roff * 8192; const LAS unsigned char* vl = F.lds + na::L_V + roff * 8192;
            pg8::f32x4 s[8][2];
#pragma unroll
            for (int kr = 0; kr < 8; ++kr)
#pragma unroll
                for (int blk = 0; blk < 2; ++blk) {
                    const bf16x8 k0 = *(const LAS bf16x8*)(kl + kr * 8192 + blk * 512 + kch0), k1 = *(const LAS bf16x8*)(kl + kr * 8192 + blk * 512 + kch1);
                    pg8::f32x4 a = {0.f, 0.f, 0.f, 0.f};
                    a = __builtin_amdgcn_mfma_f32_16x16x32_bf16(k0, qf[0], a, 0, 0, 0);
                    a = __builtin_amdgcn_mfma_f32_16x16x32_bf16(k1, qf[1], a, 0, 0, 0);
                    s[kr][blk] = a; if (blk == 1 && (kr & 1)) __builtin_amdgcn_sched_barrier(0); }
            const LAS float* bp = rpbH + (rs - r + 7) * 64 + dc0 + 8;
            float mx = -1e30f;
#pragma unroll
            for (int kr = 0; kr < 8; ++kr)
#pragma unroll
                for (int blk = 0; blk < 2; ++blk)
#pragma unroll
                    for (int i = 0; i < 4; ++i) { const float v = (s[kr][blk][i] + bp[kr * 64 + 4 * blk + i]) + pen[4 * blk + i]; s[kr][blk][i] = v; mx = fmaxf(mx, v); }
            mx = fmaxf(mx, __shfl_xor(mx, 16)); mx = fmaxf(mx, __shfl_xor(mx, 32));
            float sum = 0.f;
#pragma unroll
            for (int kr = 0; kr < 8; ++kr)
#pragma unroll
                for (int blk = 0; blk < 2; ++blk)
#pragma unroll
                    for (int i = 0; i < 4; ++i) { const float e = __builtin_amdgcn_exp2f(s[kr][blk][i] - mx); s[kr][blk][i] = e; sum += e; }
            sum += __shfl_xor(sum, 16); sum += __shfl_xor(sum, 32);
            const float inv = 1.f / sum;
            pg8::f32x4 o[4];
#pragma unroll
            for (int db = 0; db < 4; ++db) o[db] = (pg8::f32x4){0.f, 0.f, 0.f, 0.f};
#pragma unroll
            for (int kr = 0; kr < 8; ++kr) {
                v4u pw; pw.x = pk2(s[kr][0][0], s[kr][0][1]); pw.y = pk2(s[kr][0][2], s[kr][0][3]); pw.z = pk2(s[kr][1][0], s[kr][1][1]); pw.w = pk2(s[kr][1][2], s[kr][1][3]);
                const bf16x8 pf = __builtin_bit_cast(bf16x8, pw);
#pragma unroll
                for (int db = 0; db < 4; ++db) { const bf16x8 vf = *(const LAS bf16x8*)(vl + kr * 8192 + db * 2048 + vch);
                    o[db] = __builtin_amdgcn_mfma_f32_16x16x32_bf16(vf, pf, o[db], 0, 0, 0); }
                if (kr & 1) __builtin_amdgcn_sched_barrier(0); }
            bf16* op = O + tq * D + h * HD + 4 * g;
#pragma unroll
            for (int db = 0; db < 4; ++db) { v2u wv; wv.x = pk2(o[db][0] * inv, o[db][1] * inv); wv.y = pk2(o[db][2] * inv, o[db][3] * inv); *(GAS v2u*)(op + 16 * db) = wv; }
        }
#undef NA_LOAD
    }
    __syncthreads();
}
namespace mla {
constexpr int NSLOT = 3, KSLOT = 12288, VSLOT = 8192;
constexpr int L_K = 0, L_V = NSLOT * KSLOT, L_WS = L_V + NSLOT * VSLOT, L_OST = L_WS + 2048, L_BYTES = L_OST + 8 * 4096;
constexpr float THR = 8.f;
typedef LAS unsigned char lch;
__device__ __forceinline__ int crow(int r, int hi) { return (r & 3) + 8 * (r >> 2) + 4 * hi; }
__device__ __forceinline__ void glds16(const void* sbase, unsigned voff, unsigned lds_dst) { unsigned keep;
    asm volatile("s_mov_b32 %0, m0\n\ts_mov_b32 m0, %3\n\ts_nop 0\n\tglobal_load_lds_dwordx4 %1, %2\n\ts_mov_b32 m0, %0" : "=&s"(keep) : "v"(voff), "s"(sbase), "s"(lds_dst) : "memory"); }
#define MLA_WAIT_BAR(N) asm volatile("s_waitcnt vmcnt(" #N ") lgkmcnt(0)\n\ts_barrier" ::: "memory")
#define MLA_WAIT_FULL() do { if (wid < 4) { MLA_WAIT_BAR(3); } else { MLA_WAIT_BAR(2); } } while (0)
#define MLA_SBAR() __builtin_amdgcn_sched_barrier(0)
#define MLA_MF(a, b, c) __builtin_amdgcn_mfma_f32_32x32x16_bf16(a, b, c, 0, 0, 0)
#define MLA_PIN(x) asm volatile("" : "+v"(x))
#define MLA_EX(v) __builtin_amdgcn_exp2f(v)
__device__ __forceinline__ void unit(int b, int h, int qb, const bf16* Q1, const bf16* KN, const bf16* KR, const bf16* VT, bf16* O1, lch* lds) {
    const int tid = threadIdx.x, wid = __builtin_amdgcn_readfirstlane(tid >> 6), lane = tid & 63, r32 = lane & 31, hi = lane >> 5;
    const size_t rowbase = (size_t)b * SEQ; const int q0 = qb * 256;
    const unsigned lds0 = (unsigned)(uintptr_t)lds;
    LAS float* wsf = (LAS float*)(lds + L_WS) + wid * 64;
    const bf16* knb = KN + ((size_t)h * M + rowbase + 8 * wid) * HD; const bf16* krb = KR + (rowbase + 16 * (wid & 3)) * RP; const bf16* vb = VT + ((rowbase >> 6) * D + h * HD + 8 * wid) * GW;
    unsigned kno, kro, vo;
    { const int rl = lane >> 3, row = 8 * wid + rl, c = (lane & 7) ^ ((row >> 1) & 7); kno = (unsigned)((rl * HD + c * 8) * 2); }
    { const int rl = lane >> 2, row = 16 * (wid & 3) + rl, c = (lane & 3) ^ ((row >> 2) & 3); kro = (unsigned)((rl * RP + c * 8) * 2); }
    { const int dl = lane >> 3, d = 8 * wid + dl, c = (lane & 7) ^ ((d >> 1) & 7); vo = (unsigned)((dl * GW + c * 8) * 2); }
    const unsigned kndst = lds0 + L_K + wid * 1024, krdst = lds0 + L_K + 8192 + (wid & 3) * 1024, vdst = lds0 + L_V + wid * 1024;
#define DMA_K(t, slot) do { glds16(knb + (size_t)(t) * (64 * HD), kno, (unsigned)__builtin_amdgcn_readfirstlane(kndst + (slot))); if (wid < 4) glds16(krb + (size_t)(t) * (64 * RP), kro, (unsigned)__builtin_amdgcn_readfirstlane(krdst + (slot))); } while (0)
#define DMA_V(t, slot) glds16(vb + (size_t)(t) * (D * GW), vo, (unsigned)__builtin_amdgcn_readfirstlane(vdst + (slot)))
    const int rowA = (r32 & ~0xC) | ((r32 & 4) << 1) | ((r32 & 8) >> 1);
    const lch* kpn0 = lds + L_K + rowA * 128 + (((0 + hi) ^ ((rowA >> 1) & 7)) * 16); const lch* kpn1 = lds + L_K + rowA * 128 + (((2 + hi) ^ ((rowA >> 1) & 7)) * 16);
    const lch* kpn2 = lds + L_K + rowA * 128 + (((4 + hi) ^ ((rowA >> 1) & 7)) * 16); const lch* kpn3 = lds + L_K + rowA * 128 + (((6 + hi) ^ ((rowA >> 1) & 7)) * 16);
    const lch* kpr0 = lds + L_K + 8192 + rowA * 64 + (((0 + hi) ^ ((rowA >> 2) & 3)) * 16); const lch* kpr1 = lds + L_K + 8192 + rowA * 64 + (((2 + hi) ^ ((rowA >> 2) & 3)) * 16);
    const lch* vp0 = lds + L_V + r32 * 128 + (((0 + hi) ^ ((r32 >> 1) & 7)) * 16); const lch* vp1 = lds + L_V + r32 * 128 + (((2 + hi) ^ ((r32 >> 1) & 7)) * 16);
    const lch* vp2 = lds + L_V + r32 * 128 + (((4 + hi) ^ ((r32 >> 1) & 7)) * 16); const lch* vp3 = lds + L_V + r32 * 128 + (((6 + hi) ^ ((r32 >> 1) & 7)) * 16);
#define LDF(p) (*(const LAS bf16x8*)(p))
#define KLOAD_ALL(so) do { kf[0] = LDF(kpn0 + (so)); kf[1] = LDF(kpn0 + (so) + 4096); kf[2] = LDF(kpn1 + (so)); kf[3] = LDF(kpn1 + (so) + 4096); kf[4] = LDF(kpn2 + (so)); kf[5] = LDF(kpn2 + (so) + 4096); \
        kf[6] = LDF(kpn3 + (so)); kf[7] = LDF(kpn3 + (so) + 4096); kf[8] = LDF(kpr0 + (so)); kf[9] = LDF(kpr0 + (so) + 2048); kf[10] = LDF(kpr1 + (so)); kf[11] = LDF(kpr1 + (so) + 2048); } while (0)
    bf16x8 kf[12], qr[6];
    constexpr int NT = SEQ / 64;
    DMA_K(0, 0); DMA_V(0, 0); DMA_K(1, KSLOT);
    { const bf16* Qw = Q1 + (rowbase + q0 + wid * 32 + r32) * 1536 + h * QKD + hi * 8;
#pragma unroll
      for (int d0 = 0; d0 < 6; ++d0) qr[d0] = *(const bf16x8*)(Qw + d0 * 16); }
    DMA_K(2, 2 * KSLOT);
    float m_ref = 0.f, l_reg = 0.f; f32x16 o[2]; o[0] = f32x16{}; o[1] = f32x16{}; f32x16 negm;
    f32x16 pA0, pA1, pB0, pB1; bool resc = false;
    if (wid < 4) { MLA_WAIT_BAR(5); } else { MLA_WAIT_BAR(3); }
    KLOAD_ALL(0);
    { const f32x16 z = {};
      pA0 = MLA_MF(kf[0], qr[0], z); pA1 = MLA_MF(kf[1], qr[0], z);
#pragma unroll
      for (int d0 = 1; d0 < 6; ++d0) { pA0 = MLA_MF(kf[2 * d0], qr[d0], pA0); pA1 = MLA_MF(kf[2 * d0 + 1], qr[d0], pA1); } }
    { float rm = pA0[0];
#pragma unroll
      for (int r = 1; r < 16; ++r) rm = fmaxf(rm, pA0[r]);
#pragma unroll
      for (int r = 0; r < 16; ++r) rm = fmaxf(rm, pA1[r]);
      { auto rr = __builtin_amdgcn_permlane32_swap(__float_as_uint(rm), __float_as_uint(rm), false, false); rm = fmaxf(__uint_as_float(rr[0]), __uint_as_float(rr[1])); }
      m_ref = rm;
#pragma unroll
      for (int r = 0; r < 16; ++r) negm[r] = -m_ref;
      MLA_PIN(negm);
#pragma unroll
      for (int r = 0; r < 16; ++r) { pA0[r] = MLA_EX(pA0[r] - m_ref); pA1[r] = pA1[r] - m_ref; } }
    MLA_WAIT_BAR(0);
    DMA_K(3, 0); DMA_V(1, VSLOT);
    KLOAD_ALL(KSLOT);
    MLA_WAIT_FULL();
    bf16x8 vA0, vA1, vA2, vA3, vB0, vB1, vB2, vB3; v4u pw0, pw1, pw2, pw3;
#define PKW(P, B) pk2(P[B], P[(B) + 1])
#define PAF(k) __builtin_bit_cast(bf16x8, pw##k)
#define GAE(MF, X, B, A0, A1, A2, A3) do { MF; X[B] = MLA_EX(X[B]); X[(B) + 1] = MLA_EX(X[(B) + 1]); X[(B) + 2] = MLA_EX(X[(B) + 2]); X[(B) + 3] = MLA_EX(X[(B) + 3]); MLA_PIN(X); \
        sacc += A0; sacc += A1; sacc += A2; sacc += A3; MLA_PIN(sacc); MLA_SBAR(); } while (0)
#define GAC(MF, A0, A1, A2, A3, W0, W1, PW) do { MF; sacc += A0; sacc += A1; sacc += A2; sacc += A3; MLA_PIN(sacc); W0; W1; MLA_PIN(PW); MLA_SBAR(); } while (0)
#define GAW(MF, W0, W1, W2, W3, PW) do { MF; W0; W1; W2; W3; MLA_PIN(PW); MLA_SBAR(); } while (0)
#define GB(MF, X0, X1, J) do { MF; X0[J] = MLA_EX(X0[J]); X0[(J) + 1] = MLA_EX(X0[(J) + 1]); MLA_PIN(X0); MLA_SBAR(); } while (0)
#define STEP(C0, C1, P0, P1, t, R, GK, GV, GL) do { MLA_SBAR(); \
    constexpr int kc = (R) * KSLOT, kn = (((R) + 1) % 3) * KSLOT, vpv = (((R) + 2) % 3) * VSLOT, vn = (((R) + 1) % 3) * VSLOT; float sacc = 0.f; \
    vA0 = LDF(vp0 + vpv); MLA_SBAR(); GAE(C0 = MLA_MF(kf[0], qr[0], negm), P1, 0, P0[0], P0[1], P0[2], P0[3]); \
    vA1 = LDF(vp1 + vpv); MLA_SBAR(); GAE(C1 = MLA_MF(kf[1], qr[0], negm), P1, 4, P0[4], P0[5], P0[6], P0[7]); \
    vA2 = LDF(vp2 + vpv); MLA_SBAR(); GAE(C0 = MLA_MF(kf[2], qr[1], C0), P1, 8, P0[8], P0[9], P0[10], P0[11]); \
    vA3 = LDF(vp3 + vpv); MLA_SBAR(); GAE(C1 = MLA_MF(kf[3], qr[1], C1), P1, 12, P0[12], P0[13], P0[14], P0[15]); \
    GAC(C0 = MLA_MF(kf[4], qr[2], C0), P1[0], P1[1], P1[2], P1[3], pw0[0] = PKW(P0, 0), pw0[1] = PKW(P0, 2), pw0); \
    GAC(C1 = MLA_MF(kf[5], qr[2], C1), P1[4], P1[5], P1[6], P1[7], pw0[2] = PKW(P0, 4), pw0[3] = PKW(P0, 6), pw0); \
    GAC(C0 = MLA_MF(kf[6], qr[3], C0), P1[8], P1[9], P1[10], P1[11], pw1[0] = PKW(P0, 8), pw1[1] = PKW(P0, 10), pw1); \
    GAC(C1 = MLA_MF(kf[7], qr[3], C1), P1[12], P1[13], P1[14], P1[15], pw1[2] = PKW(P0, 12), pw1[3] = PKW(P0, 14), pw1); \
    GAW(C0 = MLA_MF(kf[8], qr[4], C0), pw2[0] = PKW(P1, 0), pw2[1] = PKW(P1, 2), pw2[2] = PKW(P1, 4), pw2[3] = PKW(P1, 6), pw2); \
    GAW(C1 = MLA_MF(kf[9], qr[4], C1), pw3[0] = PKW(P1, 8), pw3[1] = PKW(P1, 10), pw3[2] = PKW(P1, 12), pw3[3] = PKW(P1, 14), pw3); \
    C0 = MLA_MF(kf[10], qr[5], C0); C1 = MLA_MF(kf[11], qr[5], C1); \
    l_reg += sacc; \
    if (GK) { DMA_K((t) + 3, kc); } if (GV) { DMA_V((t) + 1, vn); } \
    { float a_ = fmaxf(fmaxf(C0[0], C0[1]), C1[0]), b_ = fmaxf(fmaxf(C0[2], C0[3]), C1[1]); a_ = fmaxf(fmaxf(a_, C1[2]), C1[3]); \
      _Pragma("unroll") for (int r = 4; r < 16; r += 4) { a_ = fmaxf(fmaxf(a_, C0[r]), C0[r + 1]); b_ = fmaxf(fmaxf(b_, C0[r + 2]), C0[r + 3]); a_ = fmaxf(fmaxf(a_, C1[r]), C1[r + 1]); b_ = fmaxf(fmaxf(b_, C1[r + 2]), C1[r + 3]); } \
      float rm = fmaxf(a_, b_); { auto rr = __builtin_amdgcn_permlane32_swap(__float_as_uint(rm), __float_as_uint(rm), false, false); rm = fmaxf(__uint_as_float(rr[0]), __uint_as_float(rr[1])); } \
      resc = false; \
      if (__builtin_expect(__any(rm > THR), 0)) { const float dl = fmaxf(rm, 0.f), f = MLA_EX(-dl); m_ref += dl; l_reg *= f; if (hi == 0) wsf[r32] = f; resc = true; \
        _Pragma("unroll") for (int r = 0; r < 16; ++r) { C0[r] -= dl; C1[r] -= dl; } \
        _Pragma("unroll") for (int r = 0; r < 16; ++r) negm[r] = -m_ref; MLA_PIN(negm); } } \
    MLA_SBAR(); \
    vB0 = LDF(vp0 + vpv + 4096); if (GL) { kf[0] = LDF(kpn0 + kn); } MLA_SBAR(); GB(o[0] = MLA_MF(PAF(0), vA0, o[0]), C0, C1, 0); \
    vB1 = LDF(vp1 + vpv + 4096); if (GL) { kf[1] = LDF(kpn0 + kn + 4096); } MLA_SBAR(); GB(o[0] = MLA_MF(PAF(1), vA1, o[0]), C0, C1, 2); \
    vB2 = LDF(vp2 + vpv + 4096); if (GL) { kf[2] = LDF(kpn1 + kn); kf[3] = LDF(kpn1 + kn + 4096); } MLA_SBAR(); GB(o[0] = MLA_MF(PAF(2), vA2, o[0]), C0, C1, 4); \
    vB3 = LDF(vp3 + vpv + 4096); if (GL) { kf[4] = LDF(kpn2 + kn); kf[5] = LDF(kpn2 + kn + 4096); } MLA_SBAR(); GB(o[0] = MLA_MF(PAF(3), vA3, o[0]), C0, C1, 6); \
    if (GL) { kf[6] = LDF(kpn3 + kn); kf[7] = LDF(kpn3 + kn + 4096); } MLA_SBAR(); GB(o[1] = MLA_MF(PAF(0), vB0, o[1]), C0, C1, 8); \
    if (GL) { kf[8] = LDF(kpr0 + kn); kf[9] = LDF(kpr0 + kn + 2048); } MLA_SBAR(); GB(o[1] = MLA_MF(PAF(1), vB1, o[1]), C0, C1, 10); \
    if (GL) { kf[10] = LDF(kpr1 + kn); kf[11] = LDF(kpr1 + kn + 2048); } MLA_SBAR(); GB(o[1] = MLA_MF(PAF(2), vB2, o[1]), C0, C1, 12); \
    GB(o[1] = MLA_MF(PAF(3), vB3, o[1]), C0, C1, 14); \
    } while (0)
#define RESC() do { if (resc) { LDS_WAIT(); \
    _Pragma("unroll") for (int d_ = 0; d_ < 2; ++d_) _Pragma("unroll") for (int r_ = 0; r_ < 16; ++r_) o[d_][r_] *= wsf[crow(r_, hi)]; } } while (0)
    static_assert(NT == 128, "the step program below is written for 128 tiles");
    for (int t = 1; t < 121; t += 6) {
        STEP(pB0, pB1, pA0, pA1, t,     1, true, true, true); MLA_WAIT_FULL(); RESC();
        STEP(pA0, pA1, pB0, pB1, t + 1, 2, true, true, true); MLA_WAIT_FULL(); RESC();
        STEP(pB0, pB1, pA0, pA1, t + 2, 0, true, true, true); MLA_WAIT_FULL(); RESC();
        STEP(pA0, pA1, pB0, pB1, t + 3, 1, true, true, true); MLA_WAIT_FULL(); RESC();
        STEP(pB0, pB1, pA0, pA1, t + 4, 2, true, true, true); MLA_WAIT_FULL(); RESC();
        STEP(pA0, pA1, pB0, pB1, t + 5, 0, true, true, true); MLA_WAIT_FULL(); RESC();
    }
    STEP(pB0, pB1, pA0, pA1, 121, 1, true, true, true);    MLA_WAIT_FULL(); RESC();
    STEP(pA0, pA1, pB0, pB1, 122, 2, true, true, true);    MLA_WAIT_FULL(); RESC();
    STEP(pB0, pB1, pA0, pA1, 123, 0, true, true, true);    MLA_WAIT_FULL(); RESC();
    STEP(pA0, pA1, pB0, pB1, 124, 1, true, true, true);    MLA_WAIT_FULL(); RESC();
    STEP(pB0, pB1, pA0, pA1, 125, 2, false, true, true);   MLA_WAIT_BAR(1); RESC();
    STEP(pA0, pA1, pB0, pB1, 126, 0, false, true, true);   MLA_WAIT_BAR(0); RESC();
    STEP(pB0, pB1, pA0, pA1, 127, 1, false, false, false); RESC();
    constexpr int vc = 1 * VSLOT;
    {
#pragma unroll
      for (int r = 0; r < 16; ++r) pB1[r] = MLA_EX(pB1[r]);
      float sacc = 0.f;
#pragma unroll
      for (int r = 0; r < 16; ++r) sacc += pB0[r];
#pragma unroll
      for (int r = 0; r < 16; ++r) sacc += pB1[r];
      l_reg += sacc;
      pw0 = (v4u){PKW(pB0, 0), PKW(pB0, 2), PKW(pB0, 4), PKW(pB0, 6)}; pw1 = (v4u){PKW(pB0, 8), PKW(pB0, 10), PKW(pB0, 12), PKW(pB0, 14)};
      pw2 = (v4u){PKW(pB1, 0), PKW(pB1, 2), PKW(pB1, 4), PKW(pB1, 6)}; pw3 = (v4u){PKW(pB1, 8), PKW(pB1, 10), PKW(pB1, 12), PKW(pB1, 14)};
      MLA_SBAR();
#pragma unroll
      for (int dh = 0; dh < 2; ++dh) { const bf16x8 w0 = LDF(vp0 + vc + dh * 4096), w1 = LDF(vp1 + vc + dh * 4096), w2 = LDF(vp2 + vc + dh * 4096), w3 = LDF(vp3 + vc + dh * 4096);
          o[dh] = MLA_MF(PAF(0), w0, o[dh]); o[dh] = MLA_MF(PAF(1), w1, o[dh]); o[dh] = MLA_MF(PAF(2), w2, o[dh]); o[dh] = MLA_MF(PAF(3), w3, o[dh]); } }
    { auto rr = __builtin_amdgcn_permlane32_swap(__float_as_uint(l_reg), __float_as_uint(l_reg), false, false); l_reg = __uint_as_float(rr[0]) + __uint_as_float(rr[1]); }
    if (hi == 0) wsf[32 + r32] = l_reg; LDS_WAIT();
    { LAS bf16* stg = (LAS bf16*)(lds + L_OST) + wid * 2048;
#pragma unroll
      for (int r = 0; r < 16; ++r) { const int orow = crow(r, hi); const float rl = __builtin_amdgcn_rcpf(wsf[32 + orow]);
#pragma unroll
          for (int dh = 0; dh < 2; ++dh) stg[orow * 64 + dh * 32 + r32] = (bf16)(pk2(o[dh][r] * rl, 0.f) & 0xffffu); }
      LDS_WAIT();
      bf16* Ow = O1 + (rowbase + q0 + wid * 32) * 1024 + h * HD;
#pragma unroll
      for (int i = 0; i < 4; ++i) { const int row = i * 8 + (lane >> 3), ch = lane & 7; const v4u v = *(const LAS v4u*)(stg + row * 64 + ch * 8); *(GAS v4u*)(Ow + (size_t)row * 1024 + ch * 8) = v; } }
    asm volatile("s_waitcnt lgkmcnt(0)\n\ts_barrier" ::: "memory");
#undef DMA_K
#undef DMA_V
#undef LDF
#undef KLOAD_ALL
#undef PKW
#undef PAF
#undef GAE
#undef GAC
#undef GAW
#undef GB
#undef STEP
#undef RESC
}
#undef MLA_WAIT_BAR
#undef MLA_WAIT_FULL
#undef MLA_SBAR
#undef MLA_MF
#undef MLA_PIN
#undef MLA_EX
}

#ifndef MK_CHECK
#define MK_CHECK 0
#endif
#ifndef MK_PHASED
#define MK_PHASED 0
#endif
#ifndef MK_DBL
#define MK_DBL 0u
#endif
#define REP(k) ((((unsigned)MK_DBL >> (k)) & 1u) ? 2 : 1)

#if MK_CHECK
__global__ void __launch_bounds__(256) chk_na(const bf16* Q, const bf16* K, const bf16* VT, const bf16* O, const float* rpb, float* accum) {
    __shared__ float qs[4][64], ps[4][128];
    const int w = threadIdx.x >> 6, lane = threadIdx.x & 63;
    const int unit = blockIdx.x * 4 + w, tok = unit / NH, h = unit % NH;
    const int b = tok / SEQ, t = tok % SEQ, r = t / GW, c = t % GW;
    int rs = r - 4; rs = rs < 0 ? 0 : (rs > GROWS - 8 ? GROWS - 8 : rs);
    int cs = c - 8; cs = cs < 0 ? 0 : (cs > GW - 16 ? GW - 16 : cs);
    qs[w][lane] = bf2f(Q[(size_t)tok * D + h * HD + lane]) * (1.f / LOG2E);
    __syncthreads();
    float sc[2];
#pragma unroll
    for (int u = 0; u < 2; ++u) {
        const int kk = lane + 64 * u, i = kk >> 4, j = kk & 15;
        const size_t kt = (size_t)b * SEQ + (rs + i) * GW + cs + j;
        const bf16* kp = K + ((size_t)h * M + kt) * HD;
        float a = 0.f;
        for (int d = 0; d < HD; ++d) a += qs[w][d] * bf2f(kp[d]);
        sc[u] = a + rpb[(h * 15 + (rs + i - r + 7)) * 31 + (cs + j - c + 15)];
    }
    float mx = fmaxf(sc[0], sc[1]);
    for (int o = 1; o < 64; o <<= 1) mx = fmaxf(mx, __shfl_xor(mx, o));
    const float e0 = expf(sc[0] - mx), e1 = expf(sc[1] - mx);
    const float inv = 1.f / wave_sum(e0 + e1);
    ps[w][lane] = e0 * inv; ps[w][lane + 64] = e1 * inv;
    __syncthreads();
    float acc = 0.f;
    for (int kk = 0; kk < 128; ++kk) { const int i = kk >> 4, j = kk & 15; const size_t kt = (size_t)b * SEQ + (rs + i) * GW + cs + j;
        acc += ps[w][kk] * bf2f(VT[((kt >> 6) * D + h * HD + lane) * GW + (kt & 63)]); }
    const float got = bf2f(O[(size_t)tok * D + h * HD + lane]);
    const float e2 = wave_sum((got - acc) * (got - acc)), r2 = wave_sum(acc * acc);
    if (lane == 0) { atomicAdd(accum, e2); atomicAdd(accum + 1, r2); }
}
__global__ void __launch_bounds__(64) chk_mla(const bf16* Q1, const bf16* KN, const bf16* KR, const bf16* VT, const bf16* O1, float* accum) {
    __shared__ float sc[SEQ]; __shared__ float qv[96];
    const int lane = threadIdx.x, i = blockIdx.x >> 4, h = blockIdx.x & 15;
    const int tok = i * 32 + ((i * 7) & 31), b = tok / SEQ;
    for (int d = lane; d < 96; d += 64) qv[d] = bf2f(Q1[(size_t)tok * 1536 + h * 96 + d]);
    __syncthreads();
    float mx = -1e30f;
    for (int key = lane; key < SEQ; key += 64) { const size_t kt = (size_t)b * SEQ + key; float a = 0.f;
        for (int d = 0; d < 64; ++d) a += qv[d] * bf2f(KN[((size_t)h * M + kt) * 64 + d]);
        for (int d = 0; d < 32; ++d) a += qv[64 + d] * bf2f(KR[kt * 32 + d]);
        sc[key] = a; mx = fmaxf(mx, a); }
    for (int o = 1; o < 64; o <<= 1) mx = fmaxf(mx, __shfl_xor(mx, o));
    float sm = 0.f;
    for (int key = lane; key < SEQ; key += 64) { const float e = exp2f(sc[key] - mx); sc[key] = e; sm += e; }
    sm = wave_sum(sm);
    __syncthreads();
    float acc = 0.f;
    for (int key = 0; key < SEQ; ++key) { const size_t kt = (size_t)b * SEQ + key; acc += sc[key] * bf2f(VT[((kt >> 6) * D + h * 64 + lane) * GW + (kt & 63)]); }
    acc /= sm;
    const float got = bf2f(O1[(size_t)tok * 1024 + h * 64 + lane]);
    const float e2 = wave_sum((got - acc) * (got - acc)), r2 = wave_sum(acc * acc);
    if (lane == 0) { atomicAdd(accum, e2); atomicAdd(accum + 1, r2); }
}
__global__ void chk_tweak(float* out, const float* accum, float amp) {
    const float s = sqrtf(amp * accum[0] / fmaxf(accum[1], 1e-30f));
    const size_t i = (size_t)blockIdx.x * 256 + threadIdx.x; out[i] *= (1.f + s);
}

__global__ void __launch_bounds__(256) chk_proj(const float* DOWN, const float* qn, const float* kvn, const float* w_uq, const float* w_ukv,
                                                const bf16* Q1, const bf16* KR, const bf16* KN, const bf16* VT, float* accum) {
    __shared__ float cq[256], ckv[128], qv[1536], red[8];
    const int tid = threadIdx.x, i = blockIdx.x, row = i * 64 + ((i * 11) & 63), t = row & (SEQ - 1), gr = t >> 6, gc = t & 63;
    const float* dr = DOWN + (size_t)row * 512;
    float ss = dr[tid] * dr[tid], ssk = tid < 128 ? dr[256 + tid] * dr[256 + tid] : 0.f;
    ss = wave_sum(ss); ssk = wave_sum(ssk);
    if ((tid & 63) == 0) { red[tid >> 6] = ss; red[4 + (tid >> 6)] = ssk; }
    __syncthreads();
    const float rq = rsqrtf((red[0] + red[1] + red[2] + red[3]) / 256.f + 1e-6f), rk = rsqrtf((red[4] + red[5] + red[6] + red[7]) / 128.f + 1e-6f);
    cq[tid] = dr[tid] * rq * qn[tid]; if (tid < 128) ckv[tid] = dr[256 + tid] * rk * kvn[tid];
    __syncthreads();
    for (int c = tid; c < 1536; c += 256) { float a = 0.f; for (int k = 0; k < 256; ++k) a += cq[k] * w_uq[(size_t)k * 1536 + c]; qv[c] = a; }
    __syncthreads();
    float e[4] = {0.f, 0.f, 0.f, 0.f}, r[4] = {0.f, 0.f, 0.f, 0.f};
    for (int c = tid; c < 1536; c += 256) { const int d = c % 96; float v = qv[c];
        if (d >= 64) { const int pr = (d - 64) >> 1; const float inv = powf(10000.f, -(float)(pr & 7) / 8.f), ang = (pr < 8 ? (float)gr : (float)gc) * inv, cs = cosf(ang), sn = sinf(ang);
            const float x1 = qv[c & ~1], x2 = qv[c | 1]; v = (c & 1) ? x1 * sn + x2 * cs : x1 * cs - x2 * sn; }
        v *= QSCALE1; const float g = bf2f(Q1[(size_t)row * 1536 + c]); e[0] += (g - v) * (g - v); r[0] += v * v; }
    if (tid < 32) { const int pr = tid >> 1; const float inv = powf(10000.f, -(float)(pr & 7) / 8.f), ang = (pr < 8 ? (float)gr : (float)gc) * inv, cs = cosf(ang), sn = sinf(ang);
        const float x1 = dr[384 + (tid & ~1)], x2 = dr[384 + (tid | 1)]; const float v = (tid & 1) ? x1 * sn + x2 * cs : x1 * cs - x2 * sn;
        const float g = bf2f(KR[(size_t)row * 32 + tid]); e[1] += (g - v) * (g - v); r[1] += v * v; }
    for (int c = tid; c < 2048; c += 256) { float a = 0.f; for (int k = 0; k < 128; ++k) a += ckv[k] * w_ukv[(size_t)k * 2048 + c];
        const int h = c >> 7, d = c & 127;
        if (d < 64) { const float g = bf2f(KN[((size_t)h * M + row) * 64 + d]); e[2] += (g - a) * (g - a); r[2] += a * a; }
        else { const float g = bf2f(VT[((size_t)(row >> 6) * D + h * 64 + d - 64) * GW + (row & 63)]); e[3] += (g - a) * (g - a); r[3] += a * a; } }
#pragma unroll
    for (int q = 0; q < 4; ++q) { const float es = wave_sum(e[q]), rs = wave_sum(r[q]); if ((tid & 63) == 0) { atomicAdd(accum + 2 * q, es); atomicAdd(accum + 2 * q + 1, rs); } }
}
__global__ void chk_tweak4(float* out, const float* accum, float amp) {
    float s2 = 0.f;
    for (int q = 0; q < 4; ++q) s2 += accum[2 * q] / fmaxf(accum[2 * q + 1], 1e-30f);
    const float s = sqrtf(amp * s2);
    const size_t i = (size_t)blockIdx.x * 256 + threadIdx.x; out[i] *= (1.f + s);
}
#endif


__device__ __forceinline__ void moe_tables(Frame& F) {
    const int* cw = WSP(int, WS_CNTWG);
    if (F.tid < 8) { int tot = 0, mine = 0; const int w = blockIdx.x;
        for (int i = 0; i < 256; ++i) { const int c = cw[i * 8 + F.tid]; if (i < w) mine += c; tot += c; }
        F.MISC[16 + F.tid] = (unsigned)tot; F.MISC[42 + F.tid] = (unsigned)mine; }
    __syncthreads();
    if (F.tid == 0) { int tb = 0;
        for (int e = 0; e < 8; ++e) { F.MISC[24 + e] = (unsigned)tb; F.MISC[33 + e] = (unsigned)(tb * 256); tb += ((int)F.MISC[16 + e] + 255) >> 8; }
        F.MISC[32] = (unsigned)tb; F.MISC[41] = (unsigned)(tb * 256); }
    __syncthreads();
}
template <typename TX> __device__ __forceinline__ void router_phase(Frame& F, const TX* X, int l, int cs) {
    LAS float* wr_l = (LAS float*)(F.lds);
    LAS int* rowE = (LAS int*)(F.lds + 32768);
    LAS float* rowW = (LAS float*)(F.lds + 32768 + 512);
    LAS int* rowP = (LAS int*)(F.lds + 32768 + 1024);
    LAS int* lcnt = (LAS int*)(F.lds + 32768 + 1536);
    for (int i = F.tid; i < D * NE / 4; i += NTHREADS) ((LAS f32x4*)wr_l)[i] = ((const f32x4*)F.in[15])[i];
    __syncthreads();
    const float* mf = WSP(float, WS_MODF);
    for (int blk = blockIdx.x; blk < M / 64; blk += F.G) {
        const int b = (blk * 64) >> 13;
        f32x4 sh[4], sc[4];
#pragma unroll
        for (int j = 0; j < 4; ++j) { const int n = 4 * F.lane + 256 * j; sh[j] = *(const f32x4*)(mf + (size_t)(l * 2 + b) * 6 * D + cs * D + n); sc[j] = *(const f32x4*)(mf + (size_t)(l * 2 + b) * 6 * D + (cs + 1) * D + n) + 1.f; }
        for (int rr0 = 0; rr0 < 8; rr0 += 4) {
            f32x4 v[4][4]; float ss[4];
#pragma unroll
            for (int q = 0; q < 4; ++q) {
#pragma unroll
                for (int j = 0; j < 4; ++j) v[q][j] = XRow<TX>::ld(X, (size_t)(blk * 64 + F.wave * 8 + rr0 + q), 4 * F.lane + 256 * j); }
#pragma unroll
            for (int q = 0; q < 4; ++q) { ss[q] = 0.f;
#pragma unroll
                for (int j = 0; j < 4; ++j) ss[q] += (v[q][j].x * v[q][j].x + v[q][j].y * v[q][j].y) + (v[q][j].z * v[q][j].z + v[q][j].w * v[q][j].w); }
#pragma unroll
            for (int o = 1; o < 64; o <<= 1)
#pragma unroll
                for (int q = 0; q < 4; ++q) ss[q] += __shfl_xor(ss[q], o);
            float lg[4][8];
#pragma unroll
            for (int q = 0; q < 4; ++q) { const float rstd = rsqrtf(ss[q] * (1.f / D) + NORM_EPS);
#pragma unroll
                for (int e = 0; e < 8; ++e) lg[q][e] = 0.f;
                GAS v2u* o8 = (GAS v2u*)(WSP(bf16, WS_HN) + (size_t)(blk * 64 + F.wave * 8 + rr0 + q) * D) + F.lane;
#pragma unroll
                for (int j = 0; j < 4; ++j) { v[q][j] = v[q][j] * rstd * sc[j] + sh[j]; { v2u w; w.x = pk2(v[q][j].x, v[q][j].y); w.y = pk2(v[q][j].z, v[q][j].w); o8[64 * j] = w; } } }
#pragma unroll
            for (int j = 0; j < 4; ++j)
#pragma unroll
                for (int c = 0; c < 4; ++c) { const LAS f32x4* wp = (const LAS f32x4*)(wr_l + (4 * F.lane + 256 * j + c) * 8); const f32x4 w0 = wp[0], w1 = wp[1];
#pragma unroll
                    for (int q = 0; q < 4; ++q) { const float yq = v[q][j][c];
                        lg[q][0] += yq * w0.x; lg[q][1] += yq * w0.y; lg[q][2] += yq * w0.z; lg[q][3] += yq * w0.w; lg[q][4] += yq * w1.x; lg[q][5] += yq * w1.y; lg[q][6] += yq * w1.z; lg[q][7] += yq * w1.w; } }
#pragma unroll
            for (int o = 1; o < 64; o <<= 1)
#pragma unroll
                for (int q = 0; q < 4; ++q)
#pragma unroll
                    for (int e = 0; e < 8; ++e) lg[q][e] += __shfl_xor(lg[q][e], o);
#pragma unroll
            for (int q = 0; q < 4; ++q) { const int rl = F.wave * 8 + rr0 + q;
                float mx = lg[q][0];
#pragma unroll
                for (int e = 1; e < 8; ++e) mx = fmaxf(mx, lg[q][e]);
                float p[8], sm = 0.f;
#pragma unroll
                for (int e = 0; e < 8; ++e) { p[e] = expf(lg[q][e] - mx); sm += p[e]; }
                int i0 = 0; float v0 = -1.f;
#pragma unroll
                for (int e = 0; e < 8; ++e) { p[e] = p[e] / sm; if (p[e] > v0) { v0 = p[e]; i0 = e; } }
                int i1 = 0; float v1 = -1.f;
#pragma unroll
                for (int e = 0; e < 8; ++e) if (e != i0 && p[e] > v1) { v1 = p[e]; i1 = e; }
                if (F.lane == 0) { const float s2 = v0 + v1; rowE[rl * 2] = i0; rowE[rl * 2 + 1] = i1; rowW[rl * 2] = v0 / s2; rowW[rl * 2 + 1] = v1 / s2; } }
        }
        __syncthreads();
        if (F.tid < 8) lcnt[F.tid] = 0;
        __syncthreads();
        if (F.tid == 0) { for (int a = 0; a < 128; ++a) { const int e = rowE[a]; rowP[a] = lcnt[e]; lcnt[e] = lcnt[e] + 1; } }
        __syncthreads();
        if (F.tid < 128) { const size_t g = (size_t)blk * 128 + F.tid; WSP(int, WS_TOKE)[g] = rowE[F.tid]; WSP(int, WS_TOKP)[g] = rowP[F.tid]; WSP(float, WS_TOKW)[g] = rowW[F.tid]; }
        if (F.tid < 8) WSP(int, WS_CNTWG)[blk * 8 + F.tid] = lcnt[F.tid];
        __syncthreads();
    }
}
__device__ __forceinline__ void gather_phase(Frame& F) {
    const int* cw = WSP(int, WS_CNTWG);
    LAS int* boff = (LAS int*)(F.lds);
    for (int blk = blockIdx.x; blk < M / 64; blk += F.G) {
        if (F.tid < 8) { int mine = 0; for (int i = 0; i < blk; ++i) mine += cw[i * 8 + F.tid]; boff[F.tid] = mine + (int)F.MISC[33 + F.tid]; }
        __syncthreads();
        for (int a = F.wave; a < 128; a += NWAVES) {
            const size_t g = (size_t)blk * 128 + a; const int e = WSP(int, WS_TOKE)[g], slot = boff[e] + WSP(int, WS_TOKP)[g];
            if (F.lane == 0) WSP(int, WS_TOKS)[g] = slot;
            const GAS v4u* src = (const GAS v4u*)(WSP(bf16, WS_HN) + (size_t)(blk * 64 + (a >> 1)) * D); GAS v4u* dst = (GAS v4u*)(WSP(bf16, WS_HP) + (size_t)slot * D);
            dst[F.lane] = src[F.lane]; dst[64 + F.lane] = src[64 + F.lane];
        }
        __syncthreads();
    }
    for (int e = 0; e < 8; ++e) { const int r0 = (int)F.MISC[33 + e] + (int)F.MISC[16 + e], r1 = (int)F.MISC[34 + e];
        for (int r = r0 + F.gw; r < r1; r += F.NGW) { GAS v4u* dst = (GAS v4u*)(WSP(bf16, WS_HP) + (size_t)r * D); dst[F.lane] = (v4u){0u, 0u, 0u, 0u}; dst[64 + F.lane] = (v4u){0u, 0u, 0u, 0u}; } }
}
template <typename TX> __device__ __forceinline__ void final_phase(Frame& F, const TX* X, int l) {
    const bf16* Y = WSP(bf16, WS_HP); const float* mf = WSP(float, WS_MODF);
    f32x4 fn[4];
#pragma unroll
    for (int j = 0; j < 4; ++j) fn[j] = *(const f32x4*)(F.in[18] + 4 * F.lane + 256 * j);
    for (int b = 0; b < NB; ++b) {
        f32x4 gf[4];
#pragma unroll
        for (int j = 0; j < 4; ++j) gf[j] = *(const f32x4*)(mf + (size_t)(l * 2 + b) * 6 * D + 5 * D + 4 * F.lane + 256 * j);
        for (int row = b * SEQ + F.gw; row < (b + 1) * SEQ; row += 2 * F.NGW) {
            f32x4 v[2][4]; float ss[2]; bool ok[2];
#pragma unroll
            for (int q = 0; q < 2; ++q) { ok[q] = row + q * F.NGW < (b + 1) * SEQ; const int rq = ok[q] ? row + q * F.NGW : row;
                const int s0 = WSP(int, WS_TOKS)[rq * 2], s1 = WSP(int, WS_TOKS)[rq * 2 + 1]; const float w0 = WSP(float, WS_TOKW)[rq * 2], w1 = WSP(float, WS_TOKW)[rq * 2 + 1];
                const GAS v2u* y0 = (const GAS v2u*)(Y + (size_t)s0 * D) + F.lane; const GAS v2u* y1 = (const GAS v2u*)(Y + (size_t)s1 * D) + F.lane;
                f32x4 xv[4]; v2u a[4], c[4];
#pragma unroll
                for (int j = 0; j < 4; ++j) { xv[j] = XRow<TX>::ld(X, (size_t)rq, 4 * F.lane + 256 * j); a[j] = y0[64 * j]; c[j] = y1[64 * j]; }
                ss[q] = 0.f;
#pragma unroll
                for (int j = 0; j < 4; ++j) { const f32x4 ya = {bflo(a[j].x), bfhi(a[j].x), bflo(a[j].y), bfhi(a[j].y)}, yc = {bflo(c[j].x), bfhi(c[j].x), bflo(c[j].y), bfhi(c[j].y)};
                    v[q][j] = xv[j] + gf[j] * (ya * w0 + yc * w1); ss[q] += (v[q][j].x * v[q][j].x + v[q][j].y * v[q][j].y) + (v[q][j].z * v[q][j].z + v[q][j].w * v[q][j].w); } }
#pragma unroll
            for (int o = 1; o < 64; o <<= 1) { ss[0] += __shfl_xor(ss[0], o); ss[1] += __shfl_xor(ss[1], o); }
#pragma unroll
            for (int q = 0; q < 2; ++q) if (ok[q]) { const float rstd = rsqrtf(ss[q] * (1.f / D) + NORM_EPS); GAS f32x4* o = (GAS f32x4*)(F.out + (size_t)(row + q * F.NGW) * D) + F.lane;
#pragma unroll
                for (int j = 0; j < 4; ++j) o[64 * j] = v[q][j] * rstd * fn[j]; }
        }
    }
}

constexpr int N_PHASES = 19;
struct Args { const float* in[19]; float* out; unsigned char* ws; int ph_lo, ph_hi; };
__global__ void __launch_bounds__(NTHREADS, 2) mk_fwd(Args args) {
    extern __shared__ __attribute__((aligned(16))) unsigned char lds[];
    Frame F;
    F.lds = (LAS unsigned char*)lds; F.MISC = (volatile LAS unsigned*)(F.lds + MISC_OFF);
    F.tid = threadIdx.x; F.lane = F.tid & 63; F.wave = __builtin_amdgcn_readfirstlane(F.tid >> 6);
    F.G = gridDim.x; { const int bx = blockIdx.x; F.vcu = (F.G % 8 == 0) ? (bx % 8) * (F.G / 8) + bx / 8 : bx; }
    F.gw = F.vcu * NWAVES + F.wave; F.NGW = F.G * NWAVES;
#pragma unroll
    for (int i = 0; i < 19; ++i) F.in[i] = args.in[i];
    F.out = args.out; F.ws = args.ws;
    for (int u = F.tid; u < (LDS_BYTES - MISC_OFF) / 4; u += NTHREADS) ((LAS unsigned*)(F.lds + MISC_OFF))[u] = 0u;
    __syncthreads();
    XcdBarrier bar; bar.bar = WSP(unsigned, WS_CTL) + 1024; bar.x = 0; bar.st = nullptr;
    if (!MK_PHASED) bar = xcd_barrier_post(WSP(unsigned, WS_CTL) + 1024, F.MISC + 8);
    const int lo = args.ph_lo, hi = args.ph_hi;
#ifdef MK_ONLY
#define IN(k) ((k) == MK_ONLY && lo <= (k) && (k) < hi)
#else
#define IN(k) (lo <= (k) && (k) < hi)
#endif
#define REFRESH() do { int t_ = threadIdx.x; asm volatile("" : "+v"(t_)); F.tid = t_; F.lane = t_ & 63; } while (0)
#define SEAM(k) do { if (IN(k) && IN((k) + 1)) xcd_barrier(bar); } while (0)
    bf16* XA = WSP(bf16, WS_XA); bf16* XB = (bf16*)F.out; const float* MODF = WSP(float, WS_MODF);
    bf16* HN = WSP(bf16, WS_HN);
    LAS unsigned char* ring = F.lds;

    if (IN(0)) for (int rep_ = 0; rep_ < REP(0); ++rep_) { REFRESH(); p0_prologue(F); } SEAM(0);
    if (IN(1)) for (int rep_ = 0; rep_ < REP(1); ++rep_) { REFRESH(); modulate_phase<true, float>(F, F.in[0], 0, 0, HN); modf_reduce(F); } SEAM(1);
    if (IN(2)) for (int rep_ = 0; rep_ < REP(2); ++rep_) { REFRESH();
        { pg8::Gemm g{HN, WSP(bf16, WS_WQK), M, 2048, D}; pg8::StaticOrder S; S.init(M, 2048, F.G, (int)blockIdx.x);
          pg8::EpiBf16P E{WSP(bf16, WS_Q0), D, 8, 4, (size_t)(WS_K0 - WS_Q0) / 2, 0.125f * LOG2E, 0, 1};
          pg8::gemm_phase<pg8::EpiBf16P, pg8::StaticOrder, true, true>(ring, g, S, E); }
        { pg8::Gemm g{WSP(bf16, WS_WV), HN, D, M, D}; pg8::StaticOrder S; S.init(D, M, F.G, (int)blockIdx.x);
          pg8::EpiBf16P E{WSP(bf16, WS_VT0), M, 64, 0, 0, 1.f, 2, 2};
          pg8::gemm_phase<pg8::EpiBf16P, pg8::StaticOrder, true, true>(ring, g, S, E); }
    } SEAM(2);
    if (IN(3)) for (int rep_ = 0; rep_ < REP(3); ++rep_) { REFRESH(); na_phase(F); } SEAM(3);
    if (IN(4)) for (int rep_ = 0; rep_ < REP(4); ++rep_) { REFRESH(); pg8::Gemm g{WSP(bf16, WS_O0), WSP(bf16, WS_WO0), M, D, D}; pg8::StaticOrder S; S.init(M, D, F.G, (int)blockIdx.x);
        pg8::EpiResGateB<true> E{F.in[0], XA, MODF + 0 * 12 * D + 2 * D};
        pg8::gemm_phase<pg8::EpiResGateB<true>, pg8::StaticOrder, true, true>(ring, g, S, E); } SEAM(4);
    if (IN(5)) for (int rep_ = 0; rep_ < REP(5); ++rep_) { REFRESH(); modulate_phase<false, bf16>(F, XA, 0, 3, HN); } SEAM(5);
    if (IN(6)) for (int rep_ = 0; rep_ < REP(6); ++rep_) { REFRESH(); pg8::Gemm g{HN, WSP(bf16, WS_WGU0), M, 2 * FFN, D}; pg8::StaticOrder S; S.init(M, 2 * FFN, F.G, (int)blockIdx.x);
        pg8::EpiSwiGLU E{WSP(bf16, WS_ACT0), FFN, 22};
        pg8::gemm_phase<pg8::EpiSwiGLU, pg8::StaticOrder, true, true>(ring, g, S, E);
        moe_w_side(F, MOE_ITEMS - MOE_G1 - MOE_G2 - MOE_G3, MOE_ITEMS - MOE_G2 - MOE_G3, 128); } SEAM(6);
    if (IN(7)) for (int rep_ = 0; rep_ < REP(7); ++rep_) { REFRESH(); pg8::Gemm g{WSP(bf16, WS_ACT0), WSP(bf16, WS_WDN0), M, D, FFN}; pg8::StaticOrder S; S.init(M, D, F.G, (int)blockIdx.x);
        pg8::EpiResGateB<false> E{XA, XB, MODF + 0 * 12 * D + 5 * D};
        pg8::gemm_phase<pg8::EpiResGateB<false>, pg8::StaticOrder, true, true>(ring, g, S, E); } SEAM(7);
    if (IN(8)) for (int rep_ = 0; rep_ < REP(8); ++rep_) { REFRESH(); modulate_phase<false, bf16>(F, XB, 1, 0, HN); } SEAM(8);
    if (IN(9)) for (int rep_ = 0; rep_ < REP(9); ++rep_) { REFRESH(); pg8::Gemm g{HN, WSP(bf16, WS_WMD), M, DOWN_NP, D}; pg8::StaticOrder S; S.init(M, DOWN_NP, F.G, (int)blockIdx.x);
        pg8::EpiF32 E{WSP(float, WS_DOWN), DOWN_NP};
        pg8::gemm_phase<pg8::EpiF32, pg8::StaticOrder, true, true>(ring, g, S, E);
        moe_w_side(F, MOE_ITEMS - MOE_G2 - MOE_G3, MOE_ITEMS - MOE_G3, 128); } SEAM(9);
    if (IN(10)) for (int rep_ = 0; rep_ < REP(10); ++rep_) { REFRESH(); mla_mid_phase(F); } SEAM(10);
    if (IN(11)) for (int rep_ = 0; rep_ < REP(11); ++rep_) { REFRESH(); int kq = 256; asm volatile("" : "+s"(kq));
        { pg8::Gemm g{WSP(bf16, WS_CQ), WSP(bf16, WS_WUQ), M, 1536, kq}; pg8::StaticOrder S; S.init(M, 1536, F.G, (int)blockIdx.x);
          pg8::EpiQRope E{WSP(bf16, WS_Q1), WSP(float, WS_ROPER), WSP(float, WS_ROPEC), QSCALE1};
          pg8::gemm_phase<pg8::EpiQRope, pg8::StaticOrder, true, true>(ring, g, S, E); }
        { pg8::Gemm g{WSP(bf16, WS_CKV), WSP(bf16, WS_WKN), M, D, kq}; pg8::StaticOrder S; S.init(M, D, F.G, (int)blockIdx.x);
          pg8::EpiBf16P E{WSP(bf16, WS_KN), D, 4, 0, 0, 1.f, 1, 1};
          pg8::gemm_phase<pg8::EpiBf16P, pg8::StaticOrder, true, true>(ring, g, S, E); }
        { pg8::Gemm g{WSP(bf16, WS_WVV), WSP(bf16, WS_CKV), D, M, kq}; pg8::StaticOrder S; S.init(D, M, F.G, (int)blockIdx.x);
          pg8::EpiBf16P E{WSP(bf16, WS_VT1), M, 64, 0, 0, 1.f, 2, 2};
          pg8::gemm_phase<pg8::EpiBf16P, pg8::StaticOrder, true, true>(ring, g, S, E); }
    } SEAM(11);
    if (IN(12)) for (int rep_ = 0; rep_ < REP(12); ++rep_) { REFRESH();
        for (int u = F.vcu; u < NB * NH * (SEQ / 256); u += F.G) { const int a = u >> 8, r = u & 255, bh = r >> 3, qb = (r & 7) * 4 + a;
            mla::unit(bh >> 4, bh & 15, qb, WSP(bf16, WS_Q1), WSP(bf16, WS_KN), WSP(bf16, WS_KR), WSP(bf16, WS_VT1), WSP(bf16, WS_O1), ring); }
    } SEAM(12);
    if (IN(13)) for (int rep_ = 0; rep_ < REP(13); ++rep_) { REFRESH(); pg8::Gemm g{WSP(bf16, WS_O1), WSP(bf16, WS_WO1), M, D, D}; pg8::StaticOrder S; S.init(M, D, F.G, (int)blockIdx.x);
        pg8::EpiResGateB<false> E{XB, XA, MODF + 1 * 12 * D + 2 * D};
        pg8::gemm_phase<pg8::EpiResGateB<false>, pg8::StaticOrder, true, true>(ring, g, S, E); } SEAM(13);
    if (IN(14)) for (int rep_ = 0; rep_ < REP(14); ++rep_) { REFRESH(); router_phase<bf16>(F, XA, 1, 3); } SEAM(14);
    if (IN(15)) for (int rep_ = 0; rep_ < REP(15); ++rep_) { REFRESH(); moe_tables(F); gather_phase(F); } SEAM(15);
    if (IN(16)) for (int rep_ = 0; rep_ < REP(16); ++rep_) { REFRESH(); moe_tables(F);
        pg8::MoeOrder S{(int)F.MISC[32], 14, F.G, (int)blockIdx.x, (int)F.MISC[25], (int)F.MISC[26], (int)F.MISC[27], (int)F.MISC[28], (int)F.MISC[29], (int)F.MISC[30], (int)F.MISC[31]};
        pg8::Gemm g{WSP(bf16, WS_HP), WSP(bf16, WS_WGU1), MP_MAX, NE * 2 * ED, D};
        pg8::EpiSwiGLU E{WSP(bf16, WS_ACT1), ED, 14};
        pg8::gemm_phase<pg8::EpiSwiGLU, pg8::MoeOrder, true, true>(ring, g, S, E);
        moe_w_side(F, MOE_ITEMS - MOE_G3, MOE_ITEMS, 112); } SEAM(16);
    if (IN(17)) for (int rep_ = 0; rep_ < REP(17); ++rep_) { REFRESH(); moe_tables(F);
        pg8::MoeOrder S{(int)F.MISC[32], 4, F.G, (int)blockIdx.x, (int)F.MISC[25], (int)F.MISC[26], (int)F.MISC[27], (int)F.MISC[28], (int)F.MISC[29], (int)F.MISC[30], (int)F.MISC[31]};
        pg8::Gemm g{WSP(bf16, WS_ACT1), WSP(bf16, WS_WDN1), MP_MAX, NE * D, ED};
        pg8::EpiBf16P E{WSP(bf16, WS_HP), D, 4, 0, 0, 1.f, 0, 0};
        pg8::gemm_phase<pg8::EpiBf16P, pg8::MoeOrder, true, true>(ring, g, S, E); } SEAM(17);
    if (IN(18)) for (int rep_ = 0; rep_ < REP(18); ++rep_) { REFRESH(); final_phase<bf16>(F, XA, 1); }
#undef IN
#undef SEAM
}

extern "C" void kernel_launch(void* const* d_in, const int* in_sizes, int n_in, void* d_out, int out_size, void* d_ws, size_t ws_size, hipStream_t stream) {
    static int grid = 0;
    if (grid == 0) {
        if (n_in != 19 || in_sizes[0] != M * D || out_size != M * D || ws_size < WS_END) { fprintf(stderr, "kernel_launch: shape mismatch (n_in %d, ws %zu)\n", n_in, ws_size); grid = -1; return; }
        int dev = 0, cus = 0, per_cu = 0;
        if (hipGetDevice(&dev) != hipSuccess || hipDeviceGetAttribute(&cus, hipDeviceAttributeMultiprocessorCount, dev) != hipSuccess) { grid = -1; return; }
        if (hipFuncSetAttribute((const void*)mk_fwd, hipFuncAttributeMaxDynamicSharedMemorySize, LDS_BYTES) != hipSuccess) { fprintf(stderr, "kernel_launch: hipFuncSetAttribute failed\n"); grid = -1; return; }
        if (hipOccupancyMaxActiveBlocksPerMultiprocessor(&per_cu, (const void*)mk_fwd, NTHREADS, LDS_BYTES) != hipSuccess || per_cu < 1) fprintf(stderr, "kernel_launch: occupancy query says %d\n", per_cu);
        (void)hipGetLastError();
        grid = cus;
    }
    if (grid < 0) return;
    (void)hipMemsetAsync((char*)d_ws + WS_CTL, 0, CTL_ZERO_BYTES, stream);
    Args a{};
    for (int i = 0; i < 19; ++i) a.in[i] = (const float*)d_in[i];
    a.out = (float*)d_out; a.ws = (unsigned char*)d_ws;
#if MK_PHASED
    for (int p = 0; p < N_PHASES; ++p) { a.ph_lo = p; a.ph_hi = p + 1; hipLaunchKernelGGL(mk_fwd, dim3(grid), dim3(NTHREADS), LDS_BYTES, stream, a);
#if MK_CHECK == 1
        if (p == 3) hipLaunchKernelGGL(chk_na, dim3(M * NH / 4), dim3(256), 0, stream, (const bf16*)(a.ws + WS_Q0), (const bf16*)(a.ws + WS_K0), (const bf16*)(a.ws + WS_VT0), (const bf16*)(a.ws + WS_O0), a.in[5], (float*)(a.ws + WS_CTL + 32768));
#elif MK_CHECK == 2
        if (p == 12) hipLaunchKernelGGL(chk_mla, dim3(512 * 16), dim3(64), 0, stream, (const bf16*)(a.ws + WS_Q1), (const bf16*)(a.ws + WS_KN), (const bf16*)(a.ws + WS_KR), (const bf16*)(a.ws + WS_VT1), (const bf16*)(a.ws + WS_O1), (float*)(a.ws + WS_CTL + 32768));
#elif MK_CHECK == 3
        if (p == 11) hipLaunchKernelGGL(chk_proj, dim3(256), dim3(256), 0, stream, (const float*)(a.ws + WS_DOWN), a.in[10], a.in[12], a.in[11], a.in[13], (const bf16*)(a.ws + WS_Q1), (const bf16*)(a.ws + WS_KR), (const bf16*)(a.ws + WS_KN), (const bf16*)(a.ws + WS_VT1), (float*)(a.ws + WS_CTL + 32768));
#endif
    }
#if MK_CHECK == 3
    hipLaunchKernelGGL(chk_tweak4, dim3(M * D / 256), dim3(256), 0, stream, a.out, (const float*)(a.ws + WS_CTL + 32768), 1000.f);
#elif MK_CHECK
    hipLaunchKernelGGL(chk_tweak, dim3(M * D / 256), dim3(256), 0, stream, a.out, (const float*)(a.ws + WS_CTL + 32768), 1000.f);
#endif
#else
    a.ph_lo = 0; a.ph_hi = N_PHASES; hipLaunchKernelGGL(mk_fwd, dim3(grid), dim3(NTHREADS), LDS_BYTES, stream, a);
#endif
}
```

```cpp
#include <hip/hip_runtime.h>
#include <cstdio>
#include <cstdint>
namespace pg8 {
#define PG8_LAS __attribute__((address_space(3)))
typedef unsigned short bf16_t;
typedef short bf16x8 __attribute__((ext_vector_type(8)));
typedef float f32x4 __attribute__((ext_vector_type(4)));
typedef unsigned u32x4 __attribute__((ext_vector_type(4)));
constexpr int BM = 256, BK = 64, HALF = 128, HTB = HALF * BK * 2  , STAGE_BYTES = 8 * HTB, NXCD = 8, WGM = 8;

__host__ __device__ __forceinline__ int lds_byte(int r, int c) { const int st = (r >> 4) * 2 + (c >> 5), rr = r & 15, cc = c & 31, ob = rr * 64 + cc * 2; return st * 1024 + (ob ^ (((ob >> 9) & 1) << 5)); }
__host__ __device__ __forceinline__ void stage_rc(int b, int& R, int& C) { const int st = b / 1024, sb = b % 1024, swz = sb ^ (((sb >> 9) & 1) << 5); R = (st >> 1) * 16 + swz / 64; C = (st & 1) * 32 + (swz % 64) / 2; }
__host__ __device__ __forceinline__ int perm32(int rho) { const int n = rho >> 4, i = rho & 15; return 8 * (i >> 2) + 4 * n + (i & 3); }

struct Unit { int pm, pn; };
struct Gemm { const bf16_t* A; const bf16_t* Bt; int M, N, K; };

struct StaticOrder {
    int nM, nN, nwg, G, c;
    __host__ __device__ void init(int M, int N, int G_, int c_) { nM = M / BM; nN = N / BM; nwg = nM * nN; G = G_; c = c_; }
    __host__ __device__ bool next(int i, Unit& u) const {
        const long L = (long)i * G + c; if (L >= nwg) return false;
        int wgid = (int)L; { const int q = nwg / NXCD, r = nwg % NXCD, xcd = wgid % NXCD, off = wgid / NXCD; wgid = (xcd < r ? xcd * (q + 1) : r * (q + 1) + (xcd - r) * q) + off; }
        const int nig = WGM * nN, gid = wgid / nig, fm = gid * WGM, gsz = (nM - fm) < WGM ? (nM - fm) : WGM;
        u.pm = fm + ((wgid % nig) % gsz); u.pn = (wgid % nig) / gsz; return true;
    }
    __device__ __forceinline__ void a_ready(const Unit&) const {}
    __device__ __forceinline__ void done(const Unit&) const {}
};

__device__ __forceinline__ unsigned cvt_pk_bf16(float lo, float hi) { unsigned r; asm volatile("v_cvt_pk_bf16_f32 %0, %1, %2" : "=v"(r) : "v"(lo), "v"(hi)); return r; }

__device__ __forceinline__ float fast_silu(float g) { return g * __builtin_amdgcn_rcpf(1.f + __builtin_amdgcn_exp2f(-1.4426950408889634f * g)); }
struct EpiBf16P {
    static constexpr bool PERM = true, AFTER_DRAIN = false;
    bf16_t* O; int ldc; int nct; int st; size_t sstride; float scale0; int mode0, mode1;
    __device__ __forceinline__ void operator()(const f32x4 (&acc)[2][2][4][2], const Unit& u, int wr, int wc, int fr, int fq) const {
        int ct = u.pn % nct; bf16_t* base = O; float sc = 1.f; int mode = mode0;
        if (st) { const int t = ct / st; base += (size_t)t * sstride; ct -= t * st; if (t == 0) sc = scale0; else mode = mode1; }
        const int row0 = u.pm * BM + wr * 64 + fr, col0 = ct * BM + wc * 32 + 8 * fq;
#pragma unroll
        for (int ai = 0; ai < 2; ++ai)
#pragma unroll
            for (int m = 0; m < 4; ++m) { const int row = row0 + ai * HALF + m * 16;
#pragma unroll
                for (int bj = 0; bj < 2; ++bj) { const f32x4 v0 = acc[ai][bj][m][0] * sc, v1 = acc[ai][bj][m][1] * sc; const int col = col0 + bj * HALF;
                    u32x4 w; w.x = cvt_pk_bf16(v0[0], v0[1]); w.y = cvt_pk_bf16(v0[2], v0[3]); w.z = cvt_pk_bf16(v1[0], v1[1]); w.w = cvt_pk_bf16(v1[2], v1[3]);
                    bf16_t* p = mode == 0 ? base + (size_t)row * ldc + col : base + ((size_t)(col >> 6) * (mode == 1 ? 16384 : 1024) + row) * 64 + (col & 63);
                    *(u32x4*)p = w; } }
    }
};
struct EpiResGate {
    static constexpr bool PERM = false, AFTER_DRAIN = false;
    const float* res; float* out; const float* gate;
    __device__ __forceinline__ void operator()(const f32x4 (&acc)[2][2][4][2], const Unit& u, int wr, int wc, int fr, int fq) const {
        const int row0 = u.pm * BM + wr * 64 + fr, col0 = u.pn * BM + wc * 32 + 4 * fq;
        const float* gp = gate + (size_t)((u.pm * BM) >> 13) * 6144 + col0;
        f32x4 gv[2][2];
#pragma unroll
        for (int bj = 0; bj < 2; ++bj)
#pragma unroll
            for (int n = 0; n < 2; ++n) gv[bj][n] = *(const f32x4*)(gp + bj * HALF + n * 16);
#pragma unroll
        for (int ai = 0; ai < 2; ++ai)
#pragma unroll
            for (int m = 0; m < 4; ++m) { const size_t off = (size_t)(row0 + ai * HALF + m * 16) * 1024 + col0;
#pragma unroll
                for (int bj = 0; bj < 2; ++bj)
#pragma unroll
                    for (int n = 0; n < 2; ++n) { const f32x4 rs = *(const f32x4*)(res + off + bj * HALF + n * 16);
                        *(f32x4*)(out + off + bj * HALF + n * 16) = rs + gv[bj][n] * acc[ai][bj][m][n]; } }
    }
};
template <bool RES_F32> struct EpiResGateB {
    static constexpr bool PERM = true, AFTER_DRAIN = false;
    const void* res; bf16_t* out; const float* gate;
    __device__ __forceinline__ void operator()(const f32x4 (&acc)[2][2][4][2], const Unit& u, int wr, int wc, int fr, int fq) const {
        const int row0 = u.pm * BM + wr * 64 + fr, col0 = u.pn * BM + wc * 32 + 8 * fq;
        const float* gp = gate + (size_t)((u.pm * BM) >> 13) * 6144 + col0;
        f32x4 gv[2][2];
#pragma unroll
        for (int bj = 0; bj < 2; ++bj)
#pragma unroll
            for (int n = 0; n < 2; ++n) gv[bj][n] = *(const f32x4*)(gp + bj * HALF + 4 * n);
#pragma unroll
        for (int ai = 0; ai < 2; ++ai)
#pragma unroll
            for (int m = 0; m < 4; ++m) { const size_t off = (size_t)(row0 + ai * HALF + m * 16) * 1024 + col0;
#pragma unroll
                for (int bj = 0; bj < 2; ++bj) { f32x4 r0, r1;
                    if (RES_F32) { const float* rp = (const float*)res + off + bj * HALF; r0 = *(const f32x4*)rp; r1 = *(const f32x4*)(rp + 4); }
                    else { const u32x4 w = *(const u32x4*)((const bf16_t*)res + off + bj * HALF);
                        r0 = (f32x4){__builtin_bit_cast(float, w.x << 16), __builtin_bit_cast(float, w.x & 0xffff0000u), __builtin_bit_cast(float, w.y << 16), __builtin_bit_cast(float, w.y & 0xffff0000u)};
                        r1 = (f32x4){__builtin_bit_cast(float, w.z << 16), __builtin_bit_cast(float, w.z & 0xffff0000u), __builtin_bit_cast(float, w.w << 16), __builtin_bit_cast(float, w.w & 0xffff0000u)}; }
                    const f32x4 v0 = r0 + gv[bj][0] * acc[ai][bj][m][0], v1 = r1 + gv[bj][1] * acc[ai][bj][m][1];
                    u32x4 o; o.x = cvt_pk_bf16(v0[0], v0[1]); o.y = cvt_pk_bf16(v0[2], v0[3]); o.z = cvt_pk_bf16(v1[0], v1[1]); o.w = cvt_pk_bf16(v1[2], v1[3]);
                    *(u32x4*)(out + off + bj * HALF) = o; } }
    }
};
struct EpiF32 {
    static constexpr bool PERM = false, AFTER_DRAIN = false;
    float* O; int ldc;
    __device__ __forceinline__ void operator()(const f32x4 (&acc)[2][2][4][2], const Unit& u, int wr, int wc, int fr, int fq) const {
        const int row0 = u.pm * BM + wr * 64 + fr, col0 = u.pn * BM + wc * 32 + 4 * fq;
#pragma unroll
        for (int ai = 0; ai < 2; ++ai)
#pragma unroll
            for (int m = 0; m < 4; ++m) { float* rowp = O + (size_t)(row0 + ai * HALF + m * 16) * ldc + col0;
#pragma unroll
                for (int bj = 0; bj < 2; ++bj)
#pragma unroll
                    for (int n = 0; n < 2; ++n) *(f32x4*)(rowp + bj * HALF + n * 16) = acc[ai][bj][m][n]; }
    }
};
struct EpiSwiGLU {
    static constexpr bool PERM = true, AFTER_DRAIN = false;
    bf16_t* O; int ldc; int nN;
    __device__ __forceinline__ void operator()(const f32x4 (&acc)[2][2][4][2], const Unit& u, int wr, int wc, int fr, int fq) const {
        const int row0 = u.pm * BM + wr * 64 + fr, col0 = (u.pn % nN) * HALF + wc * 32 + 8 * fq;
#pragma unroll
        for (int ai = 0; ai < 2; ++ai)
#pragma unroll
            for (int m = 0; m < 4; ++m) {
                const f32x4 g0 = acc[ai][0][m][0], g1 = acc[ai][0][m][1], u0 = acc[ai][1][m][0], u1 = acc[ai][1][m][1];
                u32x4 w;
                w.x = cvt_pk_bf16(fast_silu(g0[0]) * u0[0], fast_silu(g0[1]) * u0[1]); w.y = cvt_pk_bf16(fast_silu(g0[2]) * u0[2], fast_silu(g0[3]) * u0[3]);
                w.z = cvt_pk_bf16(fast_silu(g1[0]) * u1[0], fast_silu(g1[1]) * u1[1]); w.w = cvt_pk_bf16(fast_silu(g1[2]) * u1[2], fast_silu(g1[3]) * u1[3]);
                *(u32x4*)(O + (size_t)(row0 + ai * HALF + m * 16) * ldc + col0) = w; }
    }
};
struct EpiQRope {
    static constexpr bool PERM = true, AFTER_DRAIN = false;
    bf16_t* O; const float* ropeR; const float* ropeC; float qs;
    __device__ __forceinline__ void operator()(const f32x4 (&acc)[2][2][4][2], const Unit& u, int wr, int wc, int fr, int fq) const {
        const int row0 = u.pm * BM + wr * 64 + fr, col0 = u.pn * BM + wc * 32 + 8 * fq;
#pragma unroll
        for (int ai = 0; ai < 2; ++ai)
#pragma unroll
            for (int m = 0; m < 4; ++m) { const int r = row0 + ai * HALF + m * 16, t = r & 8191, gr = t >> 6, gc = t & 63;
#pragma unroll
                for (int bj = 0; bj < 2; ++bj) { const int c = col0 + bj * HALF, d = c % 96;
                    f32x4 v0 = acc[ai][bj][m][0], v1 = acc[ai][bj][m][1];
                    if (d >= 64) { const int p = (d - 64) >> 1;
                        const float* tb = p < 8 ? ropeR + gr * 16 + 2 * p : ropeC + gc * 16 + 2 * (p - 8);
                        const f32x4 a = *(const f32x4*)tb, b = *(const f32x4*)(tb + 4);
                        v0 = (f32x4){v0[0] * a[0] - v0[1] * a[1], v0[0] * a[1] + v0[1] * a[0], v0[2] * a[2] - v0[3] * a[3], v0[2] * a[3] + v0[3] * a[2]};
                        v1 = (f32x4){v1[0] * b[0] - v1[1] * b[1], v1[0] * b[1] + v1[1] * b[0], v1[2] * b[2] - v1[3] * b[3], v1[2] * b[3] + v1[3] * b[2]}; }
                    v0 = v0 * qs; v1 = v1 * qs;
                    u32x4 w; w.x = cvt_pk_bf16(v0[0], v0[1]); w.y = cvt_pk_bf16(v0[2], v0[3]); w.z = cvt_pk_bf16(v1[0], v1[1]); w.w = cvt_pk_bf16(v1[2], v1[3]);
                    *(u32x4*)(O + (size_t)r * 1536 + c) = w; }
                asm volatile("" ::: "memory"); }
    }
};
struct MoeOrder {
    int T, nN, G, c; int tb1, tb2, tb3, tb4, tb5, tb6, tb7;
    __device__ __forceinline__ bool next(int i, Unit& u) const {
        const int nwg = T * nN; const long L = (long)i * G + c; if (L >= nwg) return false;
        int wgid = (int)L; { const int q = nwg / NXCD, r = nwg % NXCD, xcd = wgid % NXCD, off = wgid / NXCD; wgid = (xcd < r ? xcd * (q + 1) : r * (q + 1) + (xcd - r) * q) + off; }
        const int nig = WGM * nN, gid = wgid / nig, fm = gid * WGM, gsz = (T - fm) < WGM ? (T - fm) : WGM;
        const int pm = fm + ((wgid % nig) % gsz), pn = (wgid % nig) / gsz;
        const int e = (pm >= tb1) + (pm >= tb2) + (pm >= tb3) + (pm >= tb4) + (pm >= tb5) + (pm >= tb6) + (pm >= tb7);
        u.pm = pm; u.pn = e * nN + pn; return true;
    }
    __device__ __forceinline__ void a_ready(const Unit&) const {}
    __device__ __forceinline__ void done(const Unit&) const {}
};

template <class Epi, class Sched, bool ALIGN_EPI = false, bool SP2 = false>
__device__ __forceinline__ void gemm_phase(PG8_LAS unsigned char* lds, const Gemm g, const Sched& S, const Epi& E) {
    const int tid = threadIdx.x, wid = __builtin_amdgcn_readfirstlane(tid >> 6), lane = tid & 63, wr = wid >> 2, wc = wid & 3, fr = lane & 15, fq = lane >> 4;
    const int K = g.K, nt = K / BK;
    unsigned voffA[2], voffB[2];
#pragma unroll
    for (int i = 0; i < 2; ++i) { int R, C; stage_rc(tid * 16 + i * 8192, R, C); const int Rb = Epi::PERM ? ((R & ~31) + perm32(R & 31)) : R;
        voffA[i] = (unsigned)(R * K + C) * 2u; voffB[i] = (unsigned)(Rb * K + C) * 2u; }
    const size_t kstep = (size_t)(BK * 2);
    const size_t hstep = (size_t)HALF * K * 2;
    const size_t tstep = 2 * hstep;
    const unsigned ldsw = (unsigned)wid * 1024u;
    const int aoff = lds_byte(wr * 64 + fr, fq * 8), boff = lds_byte(wc * 32 + fr, fq * 8);
#define PG8_SA(b, h) (((b) * 2 + (h)) * HTB)
#define PG8_SB(b, h) ((4 + (b) * 2 + (h)) * HTB)
#define PG8_STAGE(bufoff, gbase, voff) do { _Pragma("unroll") for (int _i = 0; _i < 2; ++_i) \
        __builtin_amdgcn_global_load_lds((const unsigned*)((const char*)(gbase) + (voff)[_i]), (PG8_LAS unsigned*)(lds + (bufoff) + ldsw + _i * 8192), 16, 0, 0); } while (0)
#define PG8_LDA(dst, b, h) do { _Pragma("unroll") for (int m = 0; m < 4; ++m) _Pragma("unroll") for (int k = 0; k < 2; ++k) dst[m][k] = *(const PG8_LAS bf16x8*)(lds + PG8_SA(b, h) + aoff + m * 2048 + k * 1024); } while (0)
#define PG8_LDB(dst, b, h) do { _Pragma("unroll") for (int n = 0; n < 2; ++n) _Pragma("unroll") for (int k = 0; k < 2; ++k) dst[n][k] = *(const PG8_LAS bf16x8*)(lds + PG8_SB(b, h) + boff + n * 2048 + k * 1024); } while (0)
#define PG8_MMA(ai, bj, At, Bt) do { __builtin_amdgcn_s_setprio(1); _Pragma("unroll") for (int m = 0; m < 4; ++m) _Pragma("unroll") for (int n = 0; n < 2; ++n) _Pragma("unroll") for (int k = 0; k < 2; ++k) \
        acc[ai][bj][m][n] = __builtin_amdgcn_mfma_f32_16x16x32_bf16(Bt[n][k], At[m][k], acc[ai][bj][m][n], 0, 0, 0); __builtin_amdgcn_s_setprio(0); } while (0)
#define PG8_WAIT_V(n) asm volatile("s_waitcnt vmcnt(" #n ")" ::: "memory")
#define PG8_WAIT_L(n) asm volatile("s_waitcnt lgkmcnt(" #n ")" ::: "memory")
#define PG8_BAR __builtin_amdgcn_s_barrier()
#define PG8_SCHED __builtin_amdgcn_sched_barrier(0)
    Unit cur, nxt; int ui = 0;
    if (!S.next(0, cur)) return;
    f32x4 acc[2][2][4][2];
#pragma unroll
    for (int a = 0; a < 2; ++a)
#pragma unroll
        for (int b = 0; b < 2; ++b)
#pragma unroll
            for (int m = 0; m < 4; ++m)
#pragma unroll
                for (int n = 0; n < 2; ++n) acc[a][b][m][n] = (f32x4){0.f, 0.f, 0.f, 0.f};
    bf16x8 At[4][2], B0[2][2], B1[2][2];
    const char* cA = (const char*)g.A + (size_t)cur.pm * tstep; const char* cB = (const char*)g.Bt + (size_t)cur.pn * tstep;
    S.a_ready(cur);
    if constexpr (SP2) {
        PG8_STAGE(PG8_SB(0, 0), cB, voffB); PG8_STAGE(PG8_SB(0, 1), cB + hstep, voffB); PG8_STAGE(PG8_SA(0, 0), cA, voffA); PG8_STAGE(PG8_SA(0, 1), cA + hstep, voffA);
        if (wr == 1) PG8_BAR;
        PG8_WAIT_V(2); PG8_BAR;
        PG8_STAGE(PG8_SB(1, 0), cB + kstep, voffB); PG8_STAGE(PG8_SA(1, 0), cA + kstep, voffA); PG8_STAGE(PG8_SB(1, 1), cB + hstep + kstep, voffB);
        PG8_WAIT_V(6); PG8_BAR;
    } else {
        PG8_STAGE(PG8_SB(0, 0), cB, voffB); PG8_STAGE(PG8_SA(0, 0), cA, voffA); PG8_STAGE(PG8_SB(0, 1), cB + hstep, voffB); PG8_STAGE(PG8_SA(0, 1), cA + hstep, voffA);
        if (wr == 1) PG8_BAR;
        PG8_WAIT_V(4); PG8_BAR;
        PG8_STAGE(PG8_SB(1, 0), cB + kstep, voffB); PG8_STAGE(PG8_SA(1, 0), cA + kstep, voffA); PG8_STAGE(PG8_SB(1, 1), cB + hstep + kstep, voffB);
        PG8_WAIT_V(6); PG8_BAR;
    }
    for (;;) {
        const bool has_next = S.next(ui + 1, nxt);
        const char* nA = has_next ? (const char*)g.A + (size_t)nxt.pm * tstep : cA; const char* nB = has_next ? (const char*)g.Bt + (size_t)nxt.pn * tstep : cB;
        for (int t = 0; t < nt; t += 2) {
            const bool last = (t == nt - 2);
            const char* a1 = cA + (size_t)(t + 1) * kstep;
            const char* a2 = last ? nA : cA + (size_t)(t + 2) * kstep; const char* b2 = last ? nB : cB + (size_t)(t + 2) * kstep;
            const char* a3 = a2 + kstep; const char* b3 = b2 + kstep;
            if (last && has_next) S.a_ready(nxt);
            if constexpr (SP2) {
            PG8_LDB(B0, 0, 0); PG8_LDB(B1, 0, 1); PG8_SCHED; PG8_LDA(At, 0, 0); PG8_STAGE(PG8_SA(1, 1), a1 + hstep, voffA);
            PG8_WAIT_V(8); PG8_WAIT_L(0); PG8_BAR; PG8_MMA(0, 0, At, B0); PG8_MMA(0, 1, At, B1); PG8_BAR; PG8_SCHED;
            PG8_LDA(At, 0, 1); PG8_STAGE(PG8_SB(0, 0), b2, voffB); PG8_STAGE(PG8_SB(0, 1), b2 + hstep, voffB); PG8_STAGE(PG8_SA(0, 0), a2, voffA);
            PG8_WAIT_V(8); PG8_WAIT_L(0); PG8_BAR; PG8_MMA(1, 0, At, B0); PG8_MMA(1, 1, At, B1); PG8_BAR; PG8_SCHED;
            PG8_LDB(B0, 1, 0); PG8_LDB(B1, 1, 1); PG8_SCHED; PG8_LDA(At, 1, 0); PG8_STAGE(PG8_SA(0, 1), a2 + hstep, voffA);
            PG8_WAIT_V(8); PG8_WAIT_L(0); PG8_BAR; PG8_MMA(0, 0, At, B0); PG8_MMA(0, 1, At, B1); PG8_BAR; PG8_SCHED;
            PG8_LDA(At, 1, 1); PG8_STAGE(PG8_SB(1, 0), b3, voffB); PG8_STAGE(PG8_SB(1, 1), b3 + hstep, voffB); PG8_STAGE(PG8_SA(1, 0), a3, voffA);
            PG8_WAIT_V(8); PG8_WAIT_L(0); PG8_BAR; PG8_MMA(1, 0, At, B0); PG8_MMA(1, 1, At, B1); PG8_BAR; PG8_SCHED;
            } else {
            PG8_LDB(B0, 0, 0); PG8_SCHED; PG8_LDA(At, 0, 0); PG8_STAGE(PG8_SA(1, 1), a1 + hstep, voffA);
            PG8_WAIT_L(8); PG8_BAR; PG8_WAIT_L(0); PG8_MMA(0, 0, At, B0); PG8_BAR; PG8_SCHED;
            PG8_LDB(B1, 0, 1); PG8_STAGE(PG8_SB(0, 0), b2, voffB);
            PG8_BAR; PG8_WAIT_L(0); PG8_MMA(0, 1, At, B1); PG8_BAR;
            PG8_LDA(At, 0, 1); PG8_STAGE(PG8_SA(0, 0), a2, voffA);
            PG8_BAR; PG8_WAIT_L(0); PG8_MMA(1, 0, At, B0); PG8_BAR; PG8_SCHED;
            PG8_STAGE(PG8_SB(0, 1), b2 + hstep, voffB);
            PG8_WAIT_V(6); PG8_BAR; PG8_MMA(1, 1, At, B1); PG8_BAR;
            PG8_LDB(B0, 1, 0); PG8_SCHED; PG8_LDA(At, 1, 0); PG8_STAGE(PG8_SA(0, 1), a2 + hstep, voffA);
            PG8_WAIT_L(8); PG8_BAR; PG8_WAIT_L(0); PG8_MMA(0, 0, At, B0); PG8_BAR; PG8_SCHED;
            PG8_LDB(B1, 1, 1); PG8_STAGE(PG8_SB(1, 0), b3, voffB);
            PG8_BAR; PG8_WAIT_L(0); PG8_MMA(0, 1, At, B1); PG8_BAR;
            PG8_LDA(At, 1, 1); PG8_STAGE(PG8_SA(1, 0), a3, voffA);
            PG8_BAR; PG8_WAIT_L(0); PG8_MMA(1, 0, At, B0); PG8_BAR; PG8_SCHED;
            PG8_STAGE(PG8_SB(1, 1), b3 + hstep, voffB);
            PG8_WAIT_V(6); PG8_BAR; PG8_MMA(1, 1, At, B1); PG8_BAR;
            }
        }
        if constexpr (ALIGN_EPI) { if (wr == 0) PG8_BAR; }
        if constexpr (!Epi::AFTER_DRAIN) { E(acc, cur, wr, wc, fr, fq); S.done(cur); }
        if (!has_next) break;
#pragma unroll
        for (int a = 0; a < 2; ++a)
#pragma unroll
            for (int b = 0; b < 2; ++b)
#pragma unroll
                for (int m = 0; m < 4; ++m)
#pragma unroll
                    for (int n = 0; n < 2; ++n) acc[a][b][m][n] = (f32x4){0.f, 0.f, 0.f, 0.f};
        cur = nxt; cA = nA; cB = nB; ++ui;
        if constexpr (ALIGN_EPI) { if (wr == 1) PG8_BAR; }
    }
    PG8_WAIT_V(0);
    if constexpr (!ALIGN_EPI) { if (wr == 0) PG8_BAR; }
    PG8_BAR;
    if constexpr (Epi::AFTER_DRAIN) { E.fused(acc, cur, wr, wc, fr, fq, lds, wid, lane); S.done(cur); }
#undef PG8_SA
#undef PG8_SB
#undef PG8_STAGE
#undef PG8_LDA
#undef PG8_LDB
#undef PG8_MMA
#undef PG8_WAIT_V
#undef PG8_WAIT_L
#undef PG8_BAR
#undef PG8_SCHED
}
}

#define GAS __attribute__((address_space(1)))
#define LAS __attribute__((address_space(3)))

#define XB_TMO      128
#define XB_XCNT(j)  (256  + 64 * (j))
#define XB_XSUB(j)  (1280 + 64 * (j))
#define XB_XGEN(j)  (2304 + 64 * (j))
#define XB_TOP      3328
#define XB_TOPGEN   3392
#define XCD_BAR_WORDS 3456
#define XB_SPIN_CAP (1u << 18)

__device__ __forceinline__ unsigned xb_ld(unsigned* p)              { return __hip_atomic_load(p, __ATOMIC_RELAXED, __HIP_MEMORY_SCOPE_AGENT); }
__device__ __forceinline__ unsigned xb_add(unsigned* p, unsigned v) { return __hip_atomic_fetch_add(p, v, __ATOMIC_RELAXED, __HIP_MEMORY_SCOPE_AGENT); }
__device__ __forceinline__ unsigned xb_xcc_id() { return (unsigned)__builtin_amdgcn_s_getreg((3 << 11) | 20) & 0xFu; }
#define XB_SPIN(cond, bar) do { unsigned _sp = 0; while (cond) { __builtin_amdgcn_s_sleep(1); \
    if ((++_sp & 255u) == 0u) { if (xb_ld(&(bar)[XB_TMO])) break; if (_sp > XB_SPIN_CAP) { atomicAdd(&(bar)[XB_TMO], 1u); break; } } } } while (0)

struct XcdBarrier {
    unsigned* bar; unsigned x;
    volatile LAS unsigned* st;
};

__device__ __forceinline__ XcdBarrier xcd_barrier_post(unsigned* bar, volatile LAS unsigned* st) {
    XcdBarrier b; b.bar = bar; b.x = xb_xcc_id(); b.st = st;
    if (threadIdx.x == 0) (void)xb_add(&bar[XB_XCNT(b.x)], 1u);
    return b;
}
__device__ __forceinline__ void xcd_barrier_complete(unsigned* bar, unsigned x, unsigned& nloc, unsigned& nx) {
    const unsigned G = gridDim.x * gridDim.y * gridDim.z;
    unsigned sum, cnt, mine, sp = 0u;
    for (;;) {
        sum = 0u; cnt = 0u; mine = 0u;
#pragma unroll
        for (unsigned j = 0; j < 16; ++j) { const unsigned c = xb_ld(&bar[XB_XCNT(j)]); sum += c; cnt += (c > 0u) ? 1u : 0u; mine = (j == x) ? c : mine; }
        if (sum == G) break;
        __builtin_amdgcn_s_sleep(1);
        if ((++sp & 255u) == 0u) { if (xb_ld(&bar[XB_TMO])) break; if (sp > XB_SPIN_CAP) { atomicAdd(&bar[XB_TMO], 1u); break; } }
    }
    nloc = mine > 0u ? mine : 1u; nx = cnt > 0u ? cnt : 1u;
}

__device__ __forceinline__ void xcd_barrier(const XcdBarrier& b) {
    asm volatile("s_waitcnt vmcnt(0)" ::: "memory");
    __syncthreads();
    if (threadIdx.x == 0) {
        unsigned* bar = b.bar;
        __builtin_amdgcn_s_waitcnt(0);
        unsigned nloc = b.st[0], nx = b.st[1];
        if (nloc == 0u) { xcd_barrier_complete(bar, b.x, nloc, nx); b.st[0] = nloc; b.st[1] = nx; }
        const unsigned old = xb_add(&bar[XB_XSUB(b.x)], 1u);
        const unsigned gen = old / nloc;
        if (old + 1u == (gen + 1u) * nloc) {
            __builtin_amdgcn_fence(__ATOMIC_RELEASE, "agent");
            asm volatile("s_waitcnt vmcnt(0)" ::: "memory");
            const unsigned og = xb_add(&bar[XB_TOP], 1u);
            const unsigned tg = og / nx;
            if (og + 1u == (tg + 1u) * nx) xb_add(&bar[XB_TOPGEN], 1u);
            else XB_SPIN(xb_ld(&bar[XB_TOPGEN]) == tg, bar);
            __builtin_amdgcn_fence(__ATOMIC_ACQUIRE, "agent");
            xb_add(&bar[XB_XGEN(b.x)], 1u);
            asm volatile("s_waitcnt vmcnt(0)" ::: "memory");
        } else {
            XB_SPIN(xb_ld(&bar[XB_XGEN(b.x)]) == gen, bar);
            __builtin_amdgcn_fence(__ATOMIC_ACQUIRE, "agent");
            asm volatile("s_waitcnt vmcnt(0)" ::: "memory");
        }
    }
    __syncthreads();
}


constexpr int NWAVES = 8, NTHREADS = 512;
constexpr int D = 1024, NB = 2, SEQ = 8192, M = NB * SEQ, GW = 64, GROWS = 128, NH = 16, HD = 64;
constexpr int FFN = 2816, NE = 8, ED = 1792, QL = 256, KVL = 128, RP = 32, DOWN_N = 416, DOWN_NP = 512, QKD = 96;
constexpr int MP_MAX = 34816;
constexpr float NORM_EPS = 1e-6f;
constexpr float LOG2E = 1.4426950408889634f;
constexpr float QSCALE1 = 0.10206207261596577f * LOG2E;

constexpr size_t MiB = 1u << 20;
constexpr size_t WS_CTL = 0, CTL_ZERO_BYTES = 64 * 1024;
constexpr size_t WS_PART = 4 * MiB;
constexpr size_t WS_MODF = 2 * MiB;
constexpr size_t WS_ROPER = WS_MODF + 128 * 1024;
constexpr size_t WS_ROPEC = WS_ROPER + 16 * 1024;
constexpr size_t WS_CNTWG = WS_ROPEC + 16 * 1024;
constexpr size_t WS_TOKE = 3 * MiB;
constexpr size_t WS_TOKP = WS_TOKE + 128 * 1024;
constexpr size_t WS_TOKW = WS_TOKP + 128 * 1024;
constexpr size_t WS_TOKS = WS_TOKW + 128 * 1024;
constexpr size_t WS_W = 8 * MiB;
constexpr size_t WS_WQK = WS_W, WS_WV = WS_WQK + 4 * MiB, WS_WO0 = WS_WV + 2 * MiB, WS_WGU0 = WS_WO0 + 2 * MiB, WS_WDN0 = WS_WGU0 + 11 * MiB;
constexpr size_t WS_WMD = WS_WDN0 + 5632 * 1024, WS_WUQ = WS_WMD + 1 * MiB, WS_WKN = WS_WUQ + 768 * 1024, WS_WVV = WS_WKN + 512 * 1024, WS_WO1 = WS_WVV + 512 * 1024;
constexpr size_t WS_WGU1 = WS_WO1 + 2 * MiB, WS_WDN1 = WS_WGU1 + 56 * MiB, WS_WEND = WS_WDN1 + 28 * MiB;
static_assert(WS_WEND <= 122 * MiB, "weights");
constexpr size_t WS_XA = 122 * MiB;
constexpr size_t WS_HN = 186 * MiB;
constexpr size_t WS_R = 218 * MiB;
constexpr size_t WS_Q0 = WS_R, WS_K0 = WS_R + 32 * MiB, WS_VT0 = WS_R + 64 * MiB, WS_O0 = WS_R + 96 * MiB;
constexpr size_t WS_ACT0 = WS_R;
constexpr size_t WS_DOWN = WS_R, WS_CQ = WS_R + 32 * MiB, WS_CKV = WS_R + 40 * MiB, WS_KR = WS_R + 48 * MiB;
constexpr size_t WS_Q1 = WS_R + 49 * MiB, WS_KN = WS_R + 97 * MiB, WS_VT1 = WS_R + 129 * MiB, WS_O1 = WS_R + 161 * MiB;
constexpr size_t WS_HP = WS_R, WS_ACT1 = WS_R + 68 * MiB;
constexpr size_t WS_END = WS_R + 193 * MiB;
static_assert(WS_ACT1 + (size_t)MP_MAX * ED * 2 <= WS_END && WS_END <= 448 * MiB, "d_ws map");

constexpr int RING_BYTES = 131072, MISC_OFF = 155648, LDS_BYTES = 159744;

typedef unsigned short bf16;
typedef unsigned v4u __attribute__((ext_vector_type(4)));
typedef unsigned v2u __attribute__((ext_vector_type(2)));
typedef float f32x4 __attribute__((ext_vector_type(4)));
typedef float f32x2 __attribute__((ext_vector_type(2)));
typedef float f32x16 __attribute__((ext_vector_type(16)));
typedef short bf16x8 __attribute__((ext_vector_type(8)));
typedef GAS unsigned gu32;
#define RLX_AGENT __ATOMIC_RELAXED, __HIP_MEMORY_SCOPE_AGENT
#define LDS_WAIT() asm volatile("s_waitcnt lgkmcnt(0)" ::: "memory")
__device__ __forceinline__ unsigned pk2(float lo, float hi) { unsigned r; asm volatile("v_cvt_pk_bf16_f32 %0, %1, %2" : "=v"(r) : "v"(lo), "v"(hi)); return r; }
__device__ __forceinline__ float bf2f(unsigned short h) { return __builtin_bit_cast(float, (unsigned)h << 16); }
__device__ __forceinline__ float bflo(unsigned w) { return __builtin_bit_cast(float, w << 16); }
__device__ __forceinline__ float bfhi(unsigned w) { return __builtin_bit_cast(float, w & 0xffff0000u); }
__device__ __forceinline__ float wave_sum(float v) {
#pragma unroll
    for (int o = 1; o < 64; o <<= 1) v += __shfl_xor(v, o);
    return v;
}

template <typename TX> struct XRow;
template <> struct XRow<float> { static __device__ __forceinline__ f32x4 ld(const float* X, size_t row, int col) { return *(const GAS f32x4*)(X + row * 1024 + col); } };
template <> struct XRow<bf16> { static __device__ __forceinline__ f32x4 ld(const bf16* X, size_t row, int col) { const v2u w = *(const GAS v2u*)(X + row * 1024 + col); return (f32x4){bflo(w.x), bfhi(w.x), bflo(w.y), bfhi(w.y)}; } };

struct Frame {
    LAS unsigned char* lds; volatile LAS unsigned* MISC;
    int tid, lane, wave, vcu, G, gw, NGW;
    const float* in[19]; float* out; unsigned char* ws;
};
#define WSP(T, off) ((T*)(F.ws + (off)))

__device__ __forceinline__ void tr_item(const float* W, int ldn, int k0, int n0, bf16* WT, int ldk, int drow0, LAS float* scr, int lane) {
    { f32x4 v[8]; const int rr = lane >> 3, c4 = (lane & 7) * 4;
#pragma unroll
      for (int i = 0; i < 8; ++i) v[i] = *(const f32x4*)(W + (size_t)(k0 + 8 * i + rr) * ldn + n0 + c4);
#pragma unroll
      for (int i = 0; i < 8; ++i) { LAS float* d = scr + (8 * i + rr) * 33 + c4; d[0] = v[i].x; d[1] = v[i].y; d[2] = v[i].z; d[3] = v[i].w; } }
    LDS_WAIT(); asm volatile("" ::: "memory");
    const int c = lane & 7;
#pragma unroll
    for (int j = 0; j < 4; ++j) { const int n = (lane >> 3) + 8 * j; const LAS float* s = scr + (8 * c) * 33 + n;
        v4u o; o.x = pk2(s[0 * 33], s[1 * 33]); o.y = pk2(s[2 * 33], s[3 * 33]); o.z = pk2(s[4 * 33], s[5 * 33]); o.w = pk2(s[6 * 33], s[7 * 33]);
        *(GAS v4u*)(WT + (size_t)(drow0 + n) * ldk + k0 + 8 * c) = o; }
    LDS_WAIT(); asm volatile("" ::: "memory");
}
__device__ __forceinline__ int gu_row(int n0, int F_) { const int up = n0 >= F_, j = up ? n0 - F_ : n0; return 256 * (j >> 7) + (up ? 128 : 0) + (j & 127); }
__device__ __forceinline__ float silu_acc(float v) { return v / (1.f + expf(-v)); }
constexpr int MOE_I8 = 8 * 16 * 112, MOE_I9 = 8 * 28 * 32, MOE_ITEMS = MOE_I8 + MOE_I9;
constexpr int MOE_G1 = 128 * 40, MOE_G2 = 128 * 48, MOE_G3 = 144 * 24;
__device__ __forceinline__ void moe_w_item(Frame& F, int r, LAS float* scr, int lane) {
    if (r < MOE_I8) { const int e = r / (16 * 112), q = r % (16 * 112), kb = q / 112, nb = q % 112;
        tr_item(F.in[16] + (size_t)e * D * 2 * ED, 2 * ED, 64 * kb, 32 * nb, WSP(bf16, WS_WGU1), D, e * 2 * ED + gu_row(32 * nb, ED), scr, lane); }
    else { r -= MOE_I8; const int e = r / (28 * 32), q = r % (28 * 32), kb = q / 32, nb = q % 32;
        tr_item(F.in[17] + (size_t)e * ED * D, D, 64 * kb, 32 * nb, WSP(bf16, WS_WDN1), ED, e * D + 32 * nb, scr, lane); }
}
__device__ __forceinline__ void moe_w_side(Frame& F, int lo, int hi, int first_wg) {
    if (F.G != 256 || (int)blockIdx.x < first_wg) return;
    LAS float* scr = (LAS float*)(F.lds + F.wave * 16384);
    for (int it = lo + ((int)blockIdx.x - first_wg) * NWAVES + F.wave; it < hi; it += (256 - first_wg) * NWAVES) moe_w_item(F, it, scr, F.lane);
}
__device__ __forceinline__ void p0_prologue(Frame& F) {
    LAS float* scr = (LAS float*)(F.lds + F.wave * 16384);
    const int lane = F.lane;
    constexpr int I0 = 16 * 96, I1 = 16 * 32, I2 = 16 * 176, I3 = 44 * 32, I4 = 16 * 13, I5 = 4 * 48, I6 = 2 * 64, I7 = 16 * 32;
    const int NMOE0 = (F.G == 256) ? MOE_ITEMS - MOE_G1 - MOE_G2 - MOE_G3 : MOE_ITEMS;
    constexpr int IA = 2 * 96 * 16;
    constexpr int IZ = 96 + 2 * 1024;
    const int NITEMS = I0 + I1 + I2 + I3 + I4 + I5 + I6 + I7 + NMOE0 + IA + IZ + 1;
    for (int it = F.gw; it < NITEMS; it += F.NGW) {
        int r = it;
        if (r < NMOE0) { moe_w_item(F, r, scr, lane); continue; } r -= NMOE0;
        if (r < I0) { const int kb = r / 96, nb = r % 96, n0 = 32 * nb;
            if (n0 < 2048) tr_item(F.in[4], 3 * D, 64 * kb, n0, WSP(bf16, WS_WQK), D, n0, scr, lane); else tr_item(F.in[4], 3 * D, 64 * kb, n0, WSP(bf16, WS_WV), D, n0 - 2048, scr, lane);
            continue; } r -= I0;
        if (r < I1) { tr_item(F.in[6], D, 64 * (r / 32), 32 * (r % 32), WSP(bf16, WS_WO0), D, 32 * (r % 32), scr, lane); continue; } r -= I1;
        if (r < I2) { const int kb = r / 176, nb = r % 176; tr_item(F.in[7], 2 * FFN, 64 * kb, 32 * nb, WSP(bf16, WS_WGU0), D, gu_row(32 * nb, FFN), scr, lane); continue; } r -= I2;
        if (r < I3) { tr_item(F.in[8], D, 64 * (r / 32), 32 * (r % 32), WSP(bf16, WS_WDN0), FFN, 32 * (r % 32), scr, lane); continue; } r -= I3;
        if (r < I4) { tr_item(F.in[9], DOWN_N, 64 * (r / 13), 32 * (r % 13), WSP(bf16, WS_WMD), D, 32 * (r % 13), scr, lane); continue; } r -= I4;
        if (r < I5) { tr_item(F.in[11], 1536, 64 * (r / 48), 32 * (r % 48), WSP(bf16, WS_WUQ), QL, 32 * (r % 48), scr, lane); continue; } r -= I5;
        if (r < I6) { const int kb = r / 64, nb = r % 64, h = nb >> 2, q = nb & 3;
            if (q < 2) tr_item(F.in[13], 2048, 64 * kb, 32 * nb, WSP(bf16, WS_WKN), 256, h * 64 + 32 * q, scr, lane); else tr_item(F.in[13], 2048, 64 * kb, 32 * nb, WSP(bf16, WS_WVV), 256, h * 64 + 32 * (q - 2), scr, lane);
            continue; } r -= I6;
        if (r < I7) { tr_item(F.in[14], D, 64 * (r / 32), 32 * (r % 32), WSP(bf16, WS_WO1), D, 32 * (r % 32), scr, lane); continue; } r -= I7;
        if (r < IA) {
            const int l = r / (96 * 16), q = r % (96 * 16), cg = q / 16, kc = q % 16, n = 64 * cg + lane;
            const float* w = F.in[2] + (size_t)l * D * 6 * D + n; const float* c = F.in[1];
            float a0 = 0.f, a1 = 0.f;
#pragma unroll 32
            for (int k = 64 * kc; k < 64 * kc + 64; ++k) { const float wv = w[(size_t)k * 6 * D]; a0 += silu_acc(c[k]) * wv; a1 += silu_acc(c[D + k]) * wv; }
            float* part = WSP(float, WS_PART) + ((size_t)(kc * 2 + l) * 2) * 6 * D + n;
            part[0] = a0; part[6 * D] = a1; continue; } r -= IA;
        if (r < IZ) {
            if (r < 96) { GAS v4u* p = (GAS v4u*)(WSP(bf16, WS_WMD) + (size_t)(DOWN_N + r) * D); p[lane] = (v4u){0u, 0u, 0u, 0u}; p[64 + lane] = (v4u){0u, 0u, 0u, 0u}; }
            else { const int q = r - 96, row = q & 1023; bf16* base = (q < 1024 ? WSP(bf16, WS_WKN) : WSP(bf16, WS_WVV)) + (size_t)row * 256 + 128; ((GAS unsigned*)base)[lane] = 0u; }
            continue; } r -= IZ;
        {
            for (int idx = lane; idx < (128 + 64) * 8; idx += 64) { const int isc = idx >= 1024, q = isc ? idx - 1024 : idx, i = q >> 3, p = q & 7;
                const float inv = powf(10000.f, -(float)p / 8.f), a = (float)i * inv;
                float* t = (isc ? WSP(float, WS_ROPEC) : WSP(float, WS_ROPER)) + i * 16 + 2 * p; t[0] = cosf(a); t[1] = sinf(a); }
        }
    }
}
__device__ __forceinline__ f32x4 mod4_partials(Frame& F, int l, int b, int n) {
    f32x4 a = *(const f32x4*)(F.in[3] + l * 6 * D + n);
#pragma unroll
    for (int kc = 0; kc < 16; ++kc) a += *(const f32x4*)(WSP(float, WS_PART) + ((size_t)((kc * 2 + l) * 2 + b)) * 6 * D + n);
    return a;
}
template <bool FROM_PART, typename TX> __device__ __forceinline__ void modulate_phase(Frame& F, const TX* X, int l, int cs, bf16* HNo) {
    for (int b = 0; b < NB; ++b) {
        f32x4 sh[4], sc[4];
#pragma unroll
        for (int j = 0; j < 4; ++j) { const int n = 4 * F.lane + 256 * j;
            if (FROM_PART) { sh[j] = mod4_partials(F, l, b, cs * D + n); sc[j] = mod4_partials(F, l, b, (cs + 1) * D + n); }
            else { const float* mf = WSP(float, WS_MODF) + (size_t)(l * 2 + b) * 6 * D; sh[j] = *(const f32x4*)(mf + cs * D + n); sc[j] = *(const f32x4*)(mf + (cs + 1) * D + n); }
            sc[j] = sc[j] + 1.f; }
        for (int row = b * SEQ + F.gw; row < (b + 1) * SEQ; row += 4 * F.NGW) {
            f32x4 v[4][4]; float ss[4]; bool ok[4];
#pragma unroll
            for (int q = 0; q < 4; ++q) { ok[q] = row + q * F.NGW < (b + 1) * SEQ; const int rq = ok[q] ? row + q * F.NGW : row;
#pragma unroll
                for (int j = 0; j < 4; ++j) v[q][j] = XRow<TX>::ld(X, (size_t)rq, 4 * F.lane + 256 * j); }
#pragma unroll
            for (int q = 0; q < 4; ++q) { ss[q] = 0.f;
#pragma unroll
                for (int j = 0; j < 4; ++j) ss[q] += (v[q][j].x * v[q][j].x + v[q][j].y * v[q][j].y) + (v[q][j].z * v[q][j].z + v[q][j].w * v[q][j].w); }
#pragma unroll
            for (int o = 1; o < 64; o <<= 1)
#pragma unroll
                for (int q = 0; q < 4; ++q) ss[q] += __shfl_xor(ss[q], o);
#pragma unroll
            for (int q = 0; q < 4; ++q) if (ok[q]) { const float rstd = rsqrtf(ss[q] * (1.f / D) + NORM_EPS); GAS v2u* o8 = (GAS v2u*)(HNo + (size_t)(row + q * F.NGW) * D) + F.lane;
#pragma unroll
                for (int j = 0; j < 4; ++j) { const f32x4 y = v[q][j] * rstd * sc[j] + sh[j]; v2u w; w.x = pk2(y.x, y.y); w.y = pk2(y.z, y.w); o8[64 * j] = w; } }
        }
    }
}
__device__ __forceinline__ void modf_reduce(Frame& F) {
    for (int i = blockIdx.x * NTHREADS + F.tid; i < 2 * 2 * 6 * D; i += F.G * NTHREADS) {
        const int l = i / (2 * 6 * D), q = i % (2 * 6 * D), n = q % (6 * D), b = q / (6 * D);
        float a = F.in[3][l * 6 * D + n];
#pragma unroll
        for (int kc = 0; kc < 16; ++kc) a += WSP(float, WS_PART)[((size_t)((kc * 2 + l) * 2 + b)) * 6 * D + n];
        WSP(float, WS_MODF)[i] = a;
    }
}
__device__ __forceinline__ void mla_mid_phase(Frame& F) {
    const float* DOWN = WSP(float, WS_DOWN); const float* qn = F.in[10]; const float* kvn = F.in[12];
    const f32x4 qn4 = *(const f32x4*)(qn + 4 * F.lane); const f32x2 kn2 = *(const f32x2*)(kvn + 2 * F.lane);
    for (int row = F.gw; row < M; row += F.NGW) {
        const float* dr = DOWN + (size_t)row * DOWN_NP; const int t = row & (SEQ - 1);
        const f32x4 a = *(const f32x4*)(dr + 4 * F.lane); const f32x2 k = *(const f32x2*)(dr + QL + 2 * F.lane);
        const float rq = rsqrtf(wave_sum((a.x * a.x + a.y * a.y) + (a.z * a.z + a.w * a.w)) * (1.f / QL) + NORM_EPS);
        const float rk = rsqrtf(wave_sum(k.x * k.x + k.y * k.y) * (1.f / KVL) + NORM_EPS);
        v2u w; w.x = pk2(a.x * rq * qn4.x, a.y * rq * qn4.y); w.y = pk2(a.z * rq * qn4.z, a.w * rq * qn4.w);
        *((GAS v2u*)(WSP(bf16, WS_CQ) + (size_t)row * QL) + F.lane) = w;
        GAS unsigned* ck = (GAS unsigned*)(WSP(bf16, WS_CKV) + (size_t)row * 256);
        ck[F.lane] = pk2(k.x * rk * kn2.x, k.y * rk * kn2.y); ck[64 + F.lane] = 0u;
        if (F.lane < 16) { const f32x2 x = *(const f32x2*)(dr + QL + KVL + 2 * F.lane);
            const float* tb = F.lane < 8 ? WSP(float, WS_ROPER) + (t >> 6) * 16 + 2 * F.lane : WSP(float, WS_ROPEC) + (t & 63) * 16 + 2 * (F.lane - 8);
            const float cs = tb[0], sn = tb[1];
            ((GAS unsigned*)(WSP(bf16, WS_KR) + (size_t)row * RP))[F.lane] = pk2(x.x * cs - x.y * sn, x.x * sn + x.y * cs); }
    }
}
namespace na {
constexpr int L_K = 0, L_V = 73728, L_B = 147456, L_END = L_B + 15 * 64 * 4;
}
__device__ __forceinline__ void na_phase(Frame& F) {
    const bf16* Q = WSP(bf16, WS_Q0); const bf16* K = WSP(bf16, WS_K0); const bf16* VT = WSP(bf16, WS_VT0); bf16* O = WSP(bf16, WS_O0);
    const int tid = F.tid, lane = F.lane, l16 = lane & 15, g = lane >> 4;
    LAS float* rpbH = (LAS float*)(F.lds + na::L_B);
    const int scol = tid >> 3, sc = tid & 7;
    const unsigned kdst = (unsigned)((scol * 8 + (sc ^ ((scol & 2) ^ ((scol & 8) >> 1)))) * 16), vdst = (unsigned)((scol * 8 + (sc ^ (scol & 6))) * 16);
    const int ri = F.wave >> 2, ct = F.wave & 3;
    const int c0 = 16 * ct, kc0 = ct == 0 ? 0 : (ct == 1 ? 8 : (ct == 2 ? 24 : 32));
    const int c = c0 + l16; int cs = c - 8; cs = cs < 0 ? 0 : (cs > GW - 16 ? GW - 16 : cs);
    const int kcolA = kc0 + 8 * (l16 >> 2) + (l16 & 3), kxv = (kcolA & 2) ^ ((kcolA & 8) >> 1);
    const unsigned kch0 = (unsigned)((kcolA * 8 + (g ^ kxv)) * 16), kch1 = (unsigned)((kcolA * 8 + ((4 + g) ^ kxv)) * 16);
    const unsigned vch = (unsigned)((l16 * 8 + (((kc0 >> 3) + g) ^ (l16 & 6))) * 16);
    const int dc0 = kc0 + 8 * g - c + 15, t0 = kc0 + 8 * g - cs;
    float pen[8];
#pragma unroll
    for (int k = 0; k < 8; ++k) pen[k] = (unsigned)(t0 + k) < 16u ? 0.f : -1e30f;
    for (int w = F.vcu; w < NB * NH * 8; w += F.G) {
        const int bh = w >> 3, b = bh >> 4, h = bh & 15, rp0 = (w & 7) * 8;
        __syncthreads();
        for (int i = tid; i < 15 * 64; i += NTHREADS) { const int dc = (i & 63) - 8; rpbH[i] = (dc >= 0 && dc <= 30) ? F.in[5][(h * 15 + (i >> 6)) * 31 + dc] * LOG2E : 0.f; }
        const bf16* kbase = K + ((size_t)h * M + (size_t)b * SEQ) * HD + scol * HD + sc * 8;
        const bf16* vbase = VT + ((size_t)(b * GROWS) * D + h * HD + scol) * GW + sc * 8;
        bf16x8 kst[9], vst[9];
#define NA_LOAD(rp_) do { int R0_ = 2 * (rp_) - 4; R0_ = R0_ < 0 ? 0 : (R0_ > GROWS - 8 ? GROWS - 8 : R0_); \
        _Pragma("unroll") for (int i_ = 0; i_ < 9; ++i_) { const int row_ = (R0_ + i_) > GROWS - 1 ? GROWS - 1 : (R0_ + i_); \
            kst[i_] = *(const bf16x8*)(kbase + (size_t)row_ * GW * HD); vst[i_] = *(const bf16x8*)(vbase + (size_t)row_ * D * GW); } } while (0)
        NA_LOAD(rp0);
        for (int st = 0; st < 8; ++st) {
            const int rp = rp0 + st;
            __syncthreads();
#pragma unroll
            for (int i = 0; i < 9; ++i) { *(LAS bf16x8*)(F.lds + na::L_K + i * 8192 + kdst) = kst[i]; *(LAS bf16x8*)(F.lds + na::L_V + i * 8192 + vdst) = vst[i]; }
            __syncthreads();
            if (st + 1 < 8) NA_LOAD(rp + 1);
            __builtin_amdgcn_sched_barrier(0);
            const int r = 2 * rp + ri; int rs = r - 4; rs = rs < 0 ? 0 : (rs > GROWS - 8 ? GROWS - 8 : rs);
            int R0 = 2 * rp - 4; R0 = R0 < 0 ? 0 : (R0 > GROWS - 8 ? GROWS - 8 : R0);
            const int roff = rs - R0;
            const size_t tq = (size_t)b * SEQ + r * GW + c;
            bf16x8 qf[2];
#pragma unroll
            for (int ks = 0; ks < 2; ++ks) qf[ks] = *(const bf16x8*)(Q + tq * D + h * HD + 32 * ks + 8 * g);
            const LAS unsigned char* kl = F.lds + na::L_K + roff * 8192; const LAS unsigned char* vl = F.lds + na::L_V + roff * 8192;
            pg8::f32x4 s[8][2];
#pragma unroll
            for (int kr = 0; kr < 8; ++kr)
#pragma unroll
                for (int blk = 0; blk < 2; ++blk) {
                    const bf16x8 k0 = *(const LAS bf16x8*)(kl + kr * 8192 + blk * 512 + kch0), k1 = *(const LAS bf16x8*)(kl + kr * 8192 + blk * 512 + kch1);
                    pg8::f32x4 a = {0.f, 0.f, 0.f, 0.f};
                    a = __builtin_amdgcn_mfma_f32_16x16x32_bf16(k0, qf[0], a, 0, 0, 0);
                    a = __builtin_amdgcn_mfma_f32_16x16x32_bf16(k1, qf[1], a, 0, 0, 0);
                    s[kr][blk] = a; if (blk == 1 && (kr & 1)) __builtin_amdgcn_sched_barrier(0); }
            const LAS float* bp = rpbH + (rs - r + 7) * 64 + dc0 + 8;
            float mx = -1e30f;
#pragma unroll
            for (int kr = 0; kr < 8; ++kr)
#pragma unroll
                for (int blk = 0; blk < 2; ++blk)
#pragma unroll
                    for (int i = 0; i < 4; ++i) { const float v = (s[kr][blk][i] + bp[kr * 64 + 4 * blk + i]) + pen[4 * blk + i]; s[kr][blk][i] = v; mx = fmaxf(mx, v); }
            mx = fmaxf(mx, __shfl_xor(mx, 16)); mx = fmaxf(mx, __shfl_xor(mx, 32));
            float sum = 0.f;
#pragma unroll
            for (int kr = 0; kr < 8; ++kr)
#pragma unroll
                for (int blk = 0; blk < 2; ++blk)
#pragma unroll
                    for (int i = 0; i < 4; ++i) { const float e = __builtin_amdgcn_exp2f(s[kr][blk][i] - mx); s[kr][blk][i] = e; sum += e; }
            sum += __shfl_xor(sum, 16); sum += __shfl_xor(sum, 32);
            const float inv = 1.f / sum;
            pg8::f32x4 o[4];
#pragma unroll
            for (int db = 0; db < 4; ++db) o[db] = (pg8::f32x4){0.f, 0.f, 0.f, 0.f};
#pragma unroll
            for (int kr = 0; kr < 8; ++kr) {
                v4u pw; pw.x = pk2(s[kr][0][0], s[kr][0][1]); pw.y = pk2(s[kr][0][2], s[kr][0][3]); pw.z = pk2(s[kr][1][0], s[kr][1][1]); pw.w = pk2(s[kr][1][2], s[kr][1][3]);
                const bf16x8 pf = __builtin_bit_cast(bf16x8, pw);
#pragma unroll
                for (int db = 0; db < 4; ++db) { const bf16x8 vf = *(const LAS bf16x8*)(vl + kr * 8192 + db * 2048 + vch);
                    o[db] = __builtin_amdgcn_mfma_f32_16x16x32_bf16(vf, pf, o[db], 0, 0, 0); }
                if (kr & 1) __builtin_amdgcn_sched_barrier(0); }
            bf16* op = O + tq * D + h * HD + 4 * g;
#pragma unroll
            for (int db = 0; db < 4; ++db) { v2u wv; wv.x = pk2(o[db][0] * inv, o[db][1] * inv); wv.y = pk2(o[db][2] * inv, o[db][3] * inv); *(GAS v2u*)(op + 16 * db) = wv; }
        }
#undef NA_LOAD
    }
    __syncthreads();
}
namespace mla {
constexpr int NSLOT = 4, KSLOT = 12288, VSLOT = 8192;
constexpr int L_K = 0, L_V = NSLOT * KSLOT, L_WS = L_V + NSLOT * VSLOT, L_OST = L_WS + 2048, L_BYTES = L_OST + 8 * 4096;
constexpr float THR = 8.f;
typedef LAS unsigned char lch;
__device__ __forceinline__ int crow(int r, int hi) { return (r & 3) + 8 * (r >> 2) + 4 * hi; }
__device__ __forceinline__ void glds16(const void* sbase, unsigned voff, unsigned lds_dst) { unsigned keep;
    asm volatile("s_mov_b32 %0, m0\n\ts_mov_b32 m0, %3\n\ts_nop 0\n\tglobal_load_lds_dwordx4 %1, %2\n\ts_mov_b32 m0, %0" : "=&s"(keep) : "v"(voff), "s"(sbase), "s"(lds_dst) : "memory"); }
#define MLA_WAIT_BAR(N) asm volatile("s_waitcnt vmcnt(" #N ") lgkmcnt(0)\n\ts_barrier" ::: "memory")
#define MLA_WAIT_FULL() do { if (wid < 4) { MLA_WAIT_BAR(6); } else { MLA_WAIT_BAR(4); } } while (0)
#define MLA_SBAR() __builtin_amdgcn_sched_barrier(0)
#define MLA_MF(a, b, c) __builtin_amdgcn_mfma_f32_32x32x16_bf16(a, b, c, 0, 0, 0)
#define MLA_PIN(x) asm volatile("" : "+v"(x))
#define MLA_EX(v) __builtin_amdgcn_exp2f(v)
__device__ __forceinline__ void unit(int b, int h, int qb, const bf16* Q1, const bf16* KN, const bf16* KR, const bf16* VT, bf16* O1, lch* lds) {
    const int tid = threadIdx.x, wid = __builtin_amdgcn_readfirstlane(tid >> 6), lane = tid & 63, r32 = lane & 31, hi = lane >> 5;
    const size_t rowbase = (size_t)b * SEQ; const int q0 = qb * 256;
    const unsigned lds0 = (unsigned)(uintptr_t)lds;
    LAS float* wsf = (LAS float*)(lds + L_WS) + wid * 64;
    const bf16* knb = KN + ((size_t)h * M + rowbase + 8 * wid) * HD; const bf16* krb = KR + (rowbase + 16 * (wid & 3)) * RP; const bf16* vb = VT + ((rowbase >> 6) * D + h * HD + 8 * wid) * GW;
    unsigned kno, kro, vo;
    { const int rl = lane >> 3, row = 8 * wid + rl, c = (lane & 7) ^ ((row >> 1) & 7); kno = (unsigned)((rl * HD + c * 8) * 2); }
    { const int rl = lane >> 2, row = 16 * (wid & 3) + rl, c = (lane & 3) ^ ((row >> 2) & 3); kro = (unsigned)((rl * RP + c * 8) * 2); }
    { const int dl = lane >> 3, d = 8 * wid + dl, c = (lane & 7) ^ ((d >> 1) & 7); vo = (unsigned)((dl * GW + c * 8) * 2); }
    const unsigned kndst = lds0 + L_K + wid * 1024, krdst = lds0 + L_K + 8192 + (wid & 3) * 1024, vdst = lds0 + L_V + wid * 1024;
#define DMA_K(t, slot) do { glds16(knb + (size_t)(t) * (64 * HD), kno, (unsigned)__builtin_amdgcn_readfirstlane(kndst + (slot))); if (wid < 4) glds16(krb + (size_t)(t) * (64 * RP), kro, (unsigned)__builtin_amdgcn_readfirstlane(krdst + (slot))); } while (0)
#define DMA_V(t, slot) glds16(vb + (size_t)(t) * (D * GW), vo, (unsigned)__builtin_amdgcn_readfirstlane(vdst + (slot)))
    const int rowA = (r32 & ~0xC) | ((r32 & 4) << 1) | ((r32 & 8) >> 1);
    const lch* kpn0 = lds + L_K + rowA * 128 + (((0 + hi) ^ ((rowA >> 1) & 7)) * 16); const lch* kpn1 = lds + L_K + rowA * 128 + (((2 + hi) ^ ((rowA >> 1) & 7)) * 16);
    const lch* kpn2 = lds + L_K + rowA * 128 + (((4 + hi) ^ ((rowA >> 1) & 7)) * 16); const lch* kpn3 = lds + L_K + rowA * 128 + (((6 + hi) ^ ((rowA >> 1) & 7)) * 16);
    const lch* kpr0 = lds + L_K + 8192 + rowA * 64 + (((0 + hi) ^ ((rowA >> 2) & 3)) * 16); const lch* kpr1 = lds + L_K + 8192 + rowA * 64 + (((2 + hi) ^ ((rowA >> 2) & 3)) * 16);
    const lch* vp0 = lds + L_V + r32 * 128 + (((0 + hi) ^ ((r32 >> 1) & 7)) * 16); const lch* vp1 = lds + L_V + r32 * 128 + (((2 + hi) ^ ((r32 >> 1) & 7)) * 16);
    const lch* vp2 = lds + L_V + r32 * 128 + (((4 + hi) ^ ((r32 >> 1) & 7)) * 16); const lch* vp3 = lds + L_V + r32 * 128 + (((6 + hi) ^ ((r32 >> 1) & 7)) * 16);
#define LDF(p) (*(const LAS bf16x8*)(p))
#define KLOAD_ALL(so) do { kf[0] = LDF(kpn0 + (so)); kf[1] = LDF(kpn0 + (so) + 4096); kf[2] = LDF(kpn1 + (so)); kf[3] = LDF(kpn1 + (so) + 4096); kf[4] = LDF(kpn2 + (so)); kf[5] = LDF(kpn2 + (so) + 4096); \
        kf[6] = LDF(kpn3 + (so)); kf[7] = LDF(kpn3 + (so) + 4096); kf[8] = LDF(kpr0 + (so)); kf[9] = LDF(kpr0 + (so) + 2048); kf[10] = LDF(kpr1 + (so)); kf[11] = LDF(kpr1 + (so) + 2048); } while (0)
    bf16x8 kf[12], qr[6];
    constexpr int NT = SEQ / 64;
    DMA_K(0, 0); DMA_V(0, 0); DMA_K(1, KSLOT);
    { const bf16* Qw = Q1 + (rowbase + q0 + wid * 32 + r32) * 1536 + h * QKD + hi * 8;
#pragma unroll
      for (int d0 = 0; d0 < 6; ++d0) qr[d0] = *(const bf16x8*)(Qw + d0 * 16); }
    DMA_V(1, VSLOT); DMA_K(2, 2 * KSLOT); DMA_K(3, 3 * KSLOT);
    float m_ref = 0.f, l_reg = 0.f; f32x16 o[2]; o[0] = f32x16{}; o[1] = f32x16{}; f32x16 negm;
    f32x16 pA0, pA1, pB0, pB1; bool resc = false;
    if (wid < 4) { MLA_WAIT_BAR(8); } else { MLA_WAIT_BAR(5); }
    KLOAD_ALL(0);
    { const f32x16 z = {};
      pA0 = MLA_MF(kf[0], qr[0], z); pA1 = MLA_MF(kf[1], qr[0], z);
#pragma unroll
      for (int d0 = 1; d0 < 6; ++d0) { pA0 = MLA_MF(kf[2 * d0], qr[d0], pA0); pA1 = MLA_MF(kf[2 * d0 + 1], qr[d0], pA1); } }
    { float rm = pA0[0];
#pragma unroll
      for (int r = 1; r < 16; ++r) rm = fmaxf(rm, pA0[r]);
#pragma unroll
      for (int r = 0; r < 16; ++r) rm = fmaxf(rm, pA1[r]);
      { auto rr = __builtin_amdgcn_permlane32_swap(__float_as_uint(rm), __float_as_uint(rm), false, false); rm = fmaxf(__uint_as_float(rr[0]), __uint_as_float(rr[1])); }
      m_ref = rm;
#pragma unroll
      for (int r = 0; r < 16; ++r) negm[r] = -m_ref;
      MLA_PIN(negm);
#pragma unroll
      for (int r = 0; r < 16; ++r) { pA0[r] = MLA_EX(pA0[r] - m_ref); pA1[r] = pA1[r] - m_ref; } }
    MLA_WAIT_BAR(0);
    DMA_K(4, 0); DMA_V(2, 2 * VSLOT);
    KLOAD_ALL(KSLOT);
    MLA_WAIT_FULL();
    bf16x8 vA0, vA1, vA2, vA3, vB0, vB1, vB2, vB3; v4u pw0, pw1, pw2, pw3;
#define PKW(P, B) pk2(P[B], P[(B) + 1])
#define PAF(k) __builtin_bit_cast(bf16x8, pw##k)
#define GAE(MF, X, B, A0, A1, A2, A3) do { MF; X[B] = MLA_EX(X[B]); X[(B) + 1] = MLA_EX(X[(B) + 1]); X[(B) + 2] = MLA_EX(X[(B) + 2]); X[(B) + 3] = MLA_EX(X[(B) + 3]); MLA_PIN(X); \
        sacc += A0; sacc += A1; sacc += A2; sacc += A3; MLA_PIN(sacc); MLA_SBAR(); } while (0)
#define GAC(MF, A0, A1, A2, A3, W0, W1, PW) do { MF; sacc += A0; sacc += A1; sacc += A2; sacc += A3; MLA_PIN(sacc); W0; W1; MLA_PIN(PW); MLA_SBAR(); } while (0)
#define GAW(MF, W0, W1, W2, W3, PW) do { MF; W0; W1; W2; W3; MLA_PIN(PW); MLA_SBAR(); } while (0)
#define GB(MF, X0, X1, J) do { MF; X0[J] = MLA_EX(X0[J]); X0[(J) + 1] = MLA_EX(X0[(J) + 1]); MLA_PIN(X0); MLA_SBAR(); } while (0)
#define STEP(C0, C1, P0, P1, t, R, GK, GV, GL) do { MLA_SBAR(); \
    constexpr int kc = (R) * KSLOT, kn = (((R) + 1) % 4) * KSLOT, vpv = (((R) + 3) % 4) * VSLOT, vn = (((R) + 2) % 4) * VSLOT; float sacc = 0.f; \
    vA0 = LDF(vp0 + vpv); MLA_SBAR(); GAE(C0 = MLA_MF(kf[0], qr[0], negm), P1, 0, P0[0], P0[1], P0[2], P0[3]); \
    vA1 = LDF(vp1 + vpv); MLA_SBAR(); GAE(C1 = MLA_MF(kf[1], qr[0], negm), P1, 4, P0[4], P0[5], P0[6], P0[7]); \
    vA2 = LDF(vp2 + vpv); MLA_SBAR(); GAE(C0 = MLA_MF(kf[2], qr[1], C0), P1, 8, P0[8], P0[9], P0[10], P0[11]); \
    vA3 = LDF(vp3 + vpv); MLA_SBAR(); GAE(C1 = MLA_MF(kf[3], qr[1], C1), P1, 12, P0[12], P0[13], P0[14], P0[15]); \
    GAC(C0 = MLA_MF(kf[4], qr[2], C0), P1[0], P1[1], P1[2], P1[3], pw0[0] = PKW(P0, 0), pw0[1] = PKW(P0, 2), pw0); \
    GAC(C1 = MLA_MF(kf[5], qr[2], C1), P1[4], P1[5], P1[6], P1[7], pw0[2] = PKW(P0, 4), pw0[3] = PKW(P0, 6), pw0); \
    GAC(C0 = MLA_MF(kf[6], qr[3], C0), P1[8], P1[9], P1[10], P1[11], pw1[0] = PKW(P0, 8), pw1[1] = PKW(P0, 10), pw1); \
    GAC(C1 = MLA_MF(kf[7], qr[3], C1), P1[12], P1[13], P1[14], P1[15], pw1[2] = PKW(P0, 12), pw1[3] = PKW(P0, 14), pw1); \
    GAW(C0 = MLA_MF(kf[8], qr[4], C0), pw2[0] = PKW(P1, 0), pw2[1] = PKW(P1, 2), pw2[2] = PKW(P1, 4), pw2[3] = PKW(P1, 6), pw2); \
    GAW(C1 = MLA_MF(kf[9], qr[4], C1), pw3[0] = PKW(P1, 8), pw3[1] = PKW(P1, 10), pw3[2] = PKW(P1, 12), pw3[3] = PKW(P1, 14), pw3); \
    C0 = MLA_MF(kf[10], qr[5], C0); C1 = MLA_MF(kf[11], qr[5], C1); \
    l_reg += sacc; \
    if (GK) { DMA_K((t) + 4, kc); } if (GV) { DMA_V((t) + 2, vn); } \
    { float a_ = fmaxf(fmaxf(C0[0], C0[1]), C1[0]), b_ = fmaxf(fmaxf(C0[2], C0[3]), C1[1]); a_ = fmaxf(fmaxf(a_, C1[2]), C1[3]); \
      _Pragma("unroll") for (int r = 4; r < 16; r += 4) { a_ = fmaxf(fmaxf(a_, C0[r]), C0[r + 1]); b_ = fmaxf(fmaxf(b_, C0[r + 2]), C0[r + 3]); a_ = fmaxf(fmaxf(a_, C1[r]), C1[r + 1]); b_ = fmaxf(fmaxf(b_, C1[r + 2]), C1[r + 3]); } \
      float rm = fmaxf(a_, b_); { auto rr = __builtin_amdgcn_permlane32_swap(__float_as_uint(rm), __float_as_uint(rm), false, false); rm = fmaxf(__uint_as_float(rr[0]), __uint_as_float(rr[1])); } \
      resc = false; \
      if (__builtin_expect(__any(rm > THR), 0)) { const float dl = fmaxf(rm, 0.f), f = MLA_EX(-dl); m_ref += dl; l_reg *= f; if (hi == 0) wsf[r32] = f; resc = true; \
        _Pragma("unroll") for (int r = 0; r < 16; ++r) { C0[r] -= dl; C1[r] -= dl; } \
        _Pragma("unroll") for (int r = 0; r < 16; ++r) negm[r] = -m_ref; MLA_PIN(negm); } } \
    MLA_SBAR(); \
    vB0 = LDF(vp0 + vpv + 4096); if (GL) { kf[0] = LDF(kpn0 + kn); } MLA_SBAR(); GB(o[0] = MLA_MF(PAF(0), vA0, o[0]), C0, C1, 0); \
    vB1 = LDF(vp1 + vpv + 4096); if (GL) { kf[1] = LDF(kpn0 + kn + 4096); } MLA_SBAR(); GB(o[0] = MLA_MF(PAF(1), vA1, o[0]), C0, C1, 2); \
    vB2 = LDF(vp2 + vpv + 4096); if (GL) { kf[2] = LDF(kpn1 + kn); kf[3] = LDF(kpn1 + kn + 4096); } MLA_SBAR(); GB(o[0] = MLA_MF(PAF(2), vA2, o[0]), C0, C1, 4); \
    vB3 = LDF(vp3 + vpv + 4096); if (GL) { kf[4] = LDF(kpn2 + kn); kf[5] = LDF(kpn2 + kn + 4096); } MLA_SBAR(); GB(o[0] = MLA_MF(PAF(3), vA3, o[0]), C0, C1, 6); \
    if (GL) { kf[6] = LDF(kpn3 + kn); kf[7] = LDF(kpn3 + kn + 4096); } MLA_SBAR(); GB(o[1] = MLA_MF(PAF(0), vB0, o[1]), C0, C1, 8); \
    if (GL) { kf[8] = LDF(kpr0 + kn); kf[9] = LDF(kpr0 + kn + 2048); } MLA_SBAR(); GB(o[1] = MLA_MF(PAF(1), vB1, o[1]), C0, C1, 10); \
    if (GL) { kf[10] = LDF(kpr1 + kn); kf[11] = LDF(kpr1 + kn + 2048); } MLA_SBAR(); GB(o[1] = MLA_MF(PAF(2), vB2, o[1]), C0, C1, 12); \
    GB(o[1] = MLA_MF(PAF(3), vB3, o[1]), C0, C1, 14); \
    } while (0)
#define RESC() do { if (resc) { LDS_WAIT(); \
    _Pragma("unroll") for (int d_ = 0; d_ < 2; ++d_) _Pragma("unroll") for (int r_ = 0; r_ < 16; ++r_) o[d_][r_] *= wsf[crow(r_, hi)]; } } while (0)
    static_assert(NT == 128, "the step program below is written for 128 tiles");
    for (int t = 1; t < 121; t += 4) {
        STEP(pB0, pB1, pA0, pA1, t,     1, true, true, true); MLA_WAIT_FULL(); RESC();
        STEP(pA0, pA1, pB0, pB1, t + 1, 2, true, true, true); MLA_WAIT_FULL(); RESC();
        STEP(pB0, pB1, pA0, pA1, t + 2, 3, true, true, true); MLA_WAIT_FULL(); RESC();
        STEP(pA0, pA1, pB0, pB1, t + 3, 0, true, true, true); MLA_WAIT_FULL(); RESC();
    }
    STEP(pB0, pB1, pA0, pA1, 121, 1, true, true, true);    MLA_WAIT_FULL(); RESC();
    STEP(pA0, pA1, pB0, pB1, 122, 2, true, true, true);    MLA_WAIT_FULL(); RESC();
    STEP(pB0, pB1, pA0, pA1, 123, 3, true, true, true);    MLA_WAIT_FULL(); RESC();
    STEP(pA0, pA1, pB0, pB1, 124, 0, false, true, true);   if (wid < 4) { MLA_WAIT_BAR(4); } else { MLA_WAIT_BAR(3); } RESC();
    STEP(pB0, pB1, pA0, pA1, 125, 1, false, true, true);   MLA_WAIT_BAR(2); RESC();
    STEP(pA0, pA1, pB0, pB1, 126, 2, false, false, true);  MLA_WAIT_BAR(0); RESC();
    STEP(pB0, pB1, pA0, pA1, 127, 3, false, false, false); RESC();
    constexpr int vc = 3 * VSLOT;
    {
#pragma unroll
      for (int r = 0; r < 16; ++r) pB1[r] = MLA_EX(pB1[r]);
      float sacc = 0.f;
#pragma unroll
      for (int r = 0; r < 16; ++r) sacc += pB0[r];
#pragma unroll
      for (int r = 0; r < 16; ++r) sacc += pB1[r];
      l_reg += sacc;
      pw0 = (v4u){PKW(pB0, 0), PKW(pB0, 2), PKW(pB0, 4), PKW(pB0, 6)}; pw1 = (v4u){PKW(pB0, 8), PKW(pB0, 10), PKW(pB0, 12), PKW(pB0, 14)};
      pw2 = (v4u){PKW(pB1, 0), PKW(pB1, 2), PKW(pB1, 4), PKW(pB1, 6)}; pw3 = (v4u){PKW(pB1, 8), PKW(pB1, 10), PKW(pB1, 12), PKW(pB1, 14)};
      MLA_SBAR();
#pragma unroll
      for (int dh = 0; dh < 2; ++dh) { const bf16x8 w0 = LDF(vp0 + vc + dh * 4096), w1 = LDF(vp1 + vc + dh * 4096), w2 = LDF(vp2 + vc + dh * 4096), w3 = LDF(vp3 + vc + dh * 4096);
          o[dh] = MLA_MF(PAF(0), w0, o[dh]); o[dh] = MLA_MF(PAF(1), w1, o[dh]); o[dh] = MLA_MF(PAF(2), w2, o[dh]); o[dh] = MLA_MF(PAF(3), w3, o[dh]); } }
    { auto rr = __builtin_amdgcn_permlane32_swap(__float_as_uint(l_reg), __float_as_uint(l_reg), false, false); l_reg = __uint_as_float(rr[0]) + __uint_as_float(rr[1]); }
    if (hi == 0) wsf[32 + r32] = l_reg; LDS_WAIT();
    { LAS bf16* stg = (LAS bf16*)(lds + L_OST) + wid * 2048;
#pragma unroll
      for (int r = 0; r < 16; ++r) { const int orow = crow(r, hi); const float rl = __builtin_amdgcn_rcpf(wsf[32 + orow]);
#pragma unroll
          for (int dh = 0; dh < 2; ++dh) stg[orow * 64 + dh * 32 + r32] = (bf16)(pk2(o[dh][r] * rl, 0.f) & 0xffffu); }
      LDS_WAIT();
      bf16* Ow = O1 + (rowbase + q0 + wid * 32) * 1024 + h * HD;
#pragma unroll
      for (int i = 0; i < 4; ++i) { const int row = i * 8 + (lane >> 3), ch = lane & 7; const v4u v = *(const LAS v4u*)(stg + row * 64 + ch * 8); *(GAS v4u*)(Ow + (size_t)row * 1024 + ch * 8) = v; } }
    asm volatile("s_waitcnt lgkmcnt(0)\n\ts_barrier" ::: "memory");
#undef DMA_K
#undef DMA_V
#undef LDF
#undef KLOAD_ALL
#undef PKW
#undef PAF
#undef GAE
#undef GAC
#undef GAW
#undef GB
#undef STEP
#undef RESC
}
#undef MLA_WAIT_BAR
#undef MLA_WAIT_FULL
#undef MLA_SBAR
#undef MLA_MF
#undef MLA_PIN
#undef MLA_EX
}

#ifndef MK_CHECK
#define MK_CHECK 0
#endif
#ifndef MK_PHASED
#define MK_PHASED 0
#endif
#ifndef MK_DBL
#define MK_DBL 0u
#endif
#define REP(k) ((((unsigned)MK_DBL >> (k)) & 1u) ? 2 : 1)

#if MK_CHECK
__global__ void __launch_bounds__(256) chk_na(const bf16* Q, const bf16* K, const bf16* VT, const bf16* O, const float* rpb, float* accum) {
    __shared__ float qs[4][64], ps[4][128];
    const int w = threadIdx.x >> 6, lane = threadIdx.x & 63;
    const int unit = blockIdx.x * 4 + w, tok = unit / NH, h = unit % NH;
    const int b = tok / SEQ, t = tok % SEQ, r = t / GW, c = t % GW;
    int rs = r - 4; rs = rs < 0 ? 0 : (rs > GROWS - 8 ? GROWS - 8 : rs);
    int cs = c - 8; cs = cs < 0 ? 0 : (cs > GW - 16 ? GW - 16 : cs);
    qs[w][lane] = bf2f(Q[(size_t)tok * D + h * HD + lane]) * (1.f / LOG2E);
    __syncthreads();
    float sc[2];
#pragma unroll
    for (int u = 0; u < 2; ++u) {
        const int kk = lane + 64 * u, i = kk >> 4, j = kk & 15;
        const size_t kt = (size_t)b * SEQ + (rs + i) * GW + cs + j;
        const bf16* kp = K + ((size_t)h * M + kt) * HD;
        float a = 0.f;
        for (int d = 0; d < HD; ++d) a += qs[w][d] * bf2f(kp[d]);
        sc[u] = a + rpb[(h * 15 + (rs + i - r + 7)) * 31 + (cs + j - c + 15)];
    }
    float mx = fmaxf(sc[0], sc[1]);
    for (int o = 1; o < 64; o <<= 1) mx = fmaxf(mx, __shfl_xor(mx, o));
    const float e0 = expf(sc[0] - mx), e1 = expf(sc[1] - mx);
    const float inv = 1.f / wave_sum(e0 + e1);
    ps[w][lane] = e0 * inv; ps[w][lane + 64] = e1 * inv;
    __syncthreads();
    float acc = 0.f;
    for (int kk = 0; kk < 128; ++kk) { const int i = kk >> 4, j = kk & 15; const size_t kt = (size_t)b * SEQ + (rs + i) * GW + cs + j;
        acc += ps[w][kk] * bf2f(VT[((kt >> 6) * D + h * HD + lane) * GW + (kt & 63)]); }
    const float got = bf2f(O[(size_t)tok * D + h * HD + lane]);
    const float e2 = wave_sum((got - acc) * (got - acc)), r2 = wave_sum(acc * acc);
    if (lane == 0) { atomicAdd(accum, e2); atomicAdd(accum + 1, r2); }
}
__global__ void __launch_bounds__(64) chk_mla(const bf16* Q1, const bf16* KN, const bf16* KR, const bf16* VT, const bf16* O1, float* accum) {
    __shared__ float sc[SEQ]; __shared__ float qv[96];
    const int lane = threadIdx.x, i = blockIdx.x >> 4, h = blockIdx.x & 15;
    const int tok = i * 32 + ((i * 7) & 31), b = tok / SEQ;
    for (int d = lane; d < 96; d += 64) qv[d] = bf2f(Q1[(size_t)tok * 1536 + h * 96 + d]);
    __syncthreads();
    float mx = -1e30f;
    for (int key = lane; key < SEQ; key += 64) { const size_t kt = (size_t)b * SEQ + key; float a = 0.f;
        for (int d = 0; d < 64; ++d) a += qv[d] * bf2f(KN[((size_t)h * M + kt) * 64 + d]);
        for (int d = 0; d < 32; ++d) a += qv[64 + d] * bf2f(KR[kt * 32 + d]);
        sc[key] = a; mx = fmaxf(mx, a); }
    for (int o = 1; o < 64; o <<= 1) mx = fmaxf(mx, __shfl_xor(mx, o));
    float sm = 0.f;
    for (int key = lane; key < SEQ; key += 64) { const float e = exp2f(sc[key] - mx); sc[key] = e; sm += e; }
    sm = wave_sum(sm);
    __syncthreads();
    float acc = 0.f;
    for (int key = 0; key < SEQ; ++key) { const size_t kt = (size_t)b * SEQ + key; acc += sc[key] * bf2f(VT[((kt >> 6) * D + h * 64 + lane) * GW + (kt & 63)]); }
    acc /= sm;
    const float got = bf2f(O1[(size_t)tok * 1024 + h * 64 + lane]);
    const float e2 = wave_sum((got - acc) * (got - acc)), r2 = wave_sum(acc * acc);
    if (lane == 0) { atomicAdd(accum, e2); atomicAdd(accum + 1, r2); }
}
__global__ void chk_tweak(float* out, const float* accum, float amp) {
    const float s = sqrtf(amp * accum[0] / fmaxf(accum[1], 1e-30f));
    const size_t i = (size_t)blockIdx.x * 256 + threadIdx.x; out[i] *= (1.f + s);
}

__global__ void __launch_bounds__(256) chk_proj(const float* DOWN, const float* qn, const float* kvn, const float* w_uq, const float* w_ukv,
                                                const bf16* Q1, const bf16* KR, const bf16* KN, const bf16* VT, float* accum) {
    __shared__ float cq[256], ckv[128], qv[1536], red[8];
    const int tid = threadIdx.x, i = blockIdx.x, row = i * 64 + ((i * 11) & 63), t = row & (SEQ - 1), gr = t >> 6, gc = t & 63;
    const float* dr = DOWN + (size_t)row * 512;
    float ss = dr[tid] * dr[tid], ssk = tid < 128 ? dr[256 + tid] * dr[256 + tid] : 0.f;
    ss = wave_sum(ss); ssk = wave_sum(ssk);
    if ((tid & 63) == 0) { red[tid >> 6] = ss; red[4 + (tid >> 6)] = ssk; }
    __syncthreads();
    const float rq = rsqrtf((red[0] + red[1] + red[2] + red[3]) / 256.f + 1e-6f), rk = rsqrtf((red[4] + red[5] + red[6] + red[7]) / 128.f + 1e-6f);
    cq[tid] = dr[tid] * rq * qn[tid]; if (tid < 128) ckv[tid] = dr[256 + tid] * rk * kvn[tid];
    __syncthreads();
    for (int c = tid; c < 1536; c += 256) { float a = 0.f; for (int k = 0; k < 256; ++k) a += cq[k] * w_uq[(size_t)k * 1536 + c]; qv[c] = a; }
    __syncthreads();
    float e[4] = {0.f, 0.f, 0.f, 0.f}, r[4] = {0.f, 0.f, 0.f, 0.f};
    for (int c = tid; c < 1536; c += 256) { const int d = c % 96; float v = qv[c];
        if (d >= 64) { const int pr = (d - 64) >> 1; const float inv = powf(10000.f, -(float)(pr & 7) / 8.f), ang = (pr < 8 ? (float)gr : (float)gc) * inv, cs = cosf(ang), sn = sinf(ang);
            const float x1 = qv[c & ~1], x2 = qv[c | 1]; v = (c & 1) ? x1 * sn + x2 * cs : x1 * cs - x2 * sn; }
        v *= QSCALE1; const float g = bf2f(Q1[(size_t)row * 1536 + c]); e[0] += (g - v) * (g - v); r[0] += v * v; }
    if (tid < 32) { const int pr = tid >> 1; const float inv = powf(10000.f, -(float)(pr & 7) / 8.f), ang = (pr < 8 ? (float)gr : (float)gc) * inv, cs = cosf(ang), sn = sinf(ang);
        const float x1 = dr[384 + (tid & ~1)], x2 = dr[384 + (tid | 1)]; const float v = (tid & 1) ? x1 * sn + x2 * cs : x1 * cs - x2 * sn;
        const float g = bf2f(KR[(size_t)row * 32 + tid]); e[1] += (g - v) * (g - v); r[1] += v * v; }
    for (int c = tid; c < 2048; c += 256) { float a = 0.f; for (int k = 0; k < 128; ++k) a += ckv[k] * w_ukv[(size_t)k * 2048 + c];
        const int h = c >> 7, d = c & 127;
        if (d < 64) { const float g = bf2f(KN[((size_t)h * M + row) * 64 + d]); e[2] += (g - a) * (g - a); r[2] += a * a; }
        else { const float g = bf2f(VT[((size_t)(row >> 6) * D + h * 64 + d - 64) * GW + (row & 63)]); e[3] += (g - a) * (g - a); r[3] += a * a; } }
#pragma unroll
    for (int q = 0; q < 4; ++q) { const float es = wave_sum(e[q]), rs = wave_sum(r[q]); if ((tid & 63) == 0) { atomicAdd(accum + 2 * q, es); atomicAdd(accum + 2 * q + 1, rs); } }
}
__global__ void chk_tweak4(float* out, const float* accum, float amp) {
    float s2 = 0.f;
    for (int q = 0; q < 4; ++q) s2 += accum[2 * q] / fmaxf(accum[2 * q + 1], 1e-30f);
    const float s = sqrtf(amp * s2);
    const size_t i = (size_t)blockIdx.x * 256 + threadIdx.x; out[i] *= (1.f + s);
}
#endif


__device__ __forceinline__ void moe_tables(Frame& F) {
    const int* cw = WSP(int, WS_CNTWG);
    if (F.tid < 8) { int tot = 0, mine = 0; const int w = blockIdx.x;
        for (int i = 0; i < 256; ++i) { const int c = cw[i * 8 + F.tid]; if (i < w) mine += c; tot += c; }
        F.MISC[16 + F.tid] = (unsigned)tot; F.MISC[42 + F.tid] = (unsigned)mine; }
    __syncthreads();
    if (F.tid == 0) { int tb = 0;
        for (int e = 0; e < 8; ++e) { F.MISC[24 + e] = (unsigned)tb; F.MISC[33 + e] = (unsigned)(tb * 256); tb += ((int)F.MISC[16 + e] + 255) >> 8; }
        F.MISC[32] = (unsigned)tb; F.MISC[41] = (unsigned)(tb * 256); }
    __syncthreads();
}
template <typename TX> __device__ __forceinline__ void router_phase(Frame& F, const TX* X, int l, int cs) {
    LAS float* wr_l = (LAS float*)(F.lds);
    LAS int* rowE = (LAS int*)(F.lds + 32768);
    LAS float* rowW = (LAS float*)(F.lds + 32768 + 512);
    LAS int* rowP = (LAS int*)(F.lds + 32768 + 1024);
    LAS int* lcnt = (LAS int*)(F.lds + 32768 + 1536);
    for (int i = F.tid; i < D * NE / 4; i += NTHREADS) ((LAS f32x4*)wr_l)[i] = ((const f32x4*)F.in[15])[i];
    __syncthreads();
    const float* mf = WSP(float, WS_MODF);
    for (int blk = blockIdx.x; blk < M / 64; blk += F.G) {
        const int b = (blk * 64) >> 13;
        f32x4 sh[4], sc[4];
#pragma unroll
        for (int j = 0; j < 4; ++j) { const int n = 4 * F.lane + 256 * j; sh[j] = *(const f32x4*)(mf + (size_t)(l * 2 + b) * 6 * D + cs * D + n); sc[j] = *(const f32x4*)(mf + (size_t)(l * 2 + b) * 6 * D + (cs + 1) * D + n) + 1.f; }
        for (int rr0 = 0; rr0 < 8; rr0 += 4) {
            f32x4 v[4][4]; float ss[4];
#pragma unroll
            for (int q = 0; q < 4; ++q) {
#pragma unroll
                for (int j = 0; j < 4; ++j) v[q][j] = XRow<TX>::ld(X, (size_t)(blk * 64 + F.wave * 8 + rr0 + q), 4 * F.lane + 256 * j); }
#pragma unroll
            for (int q = 0; q < 4; ++q) { ss[q] = 0.f;
#pragma unroll
                for (int j = 0; j < 4; ++j) ss[q] += (v[q][j].x * v[q][j].x + v[q][j].y * v[q][j].y) + (v[q][j].z * v[q][j].z + v[q][j].w * v[q][j].w); }
#pragma unroll
            for (int o = 1; o < 64; o <<= 1)
#pragma unroll
                for (int q = 0; q < 4; ++q) ss[q] += __shfl_xor(ss[q], o);
            float lg[4][8];
#pragma unroll
            for (int q = 0; q < 4; ++q) { const float rstd = rsqrtf(ss[q] * (1.f / D) + NORM_EPS);
#pragma unroll
                for (int e = 0; e < 8; ++e) lg[q][e] = 0.f;
                GAS v2u* o8 = (GAS v2u*)(WSP(bf16, WS_HN) + (size_t)(blk * 64 + F.wave * 8 + rr0 + q) * D) + F.lane;
#pragma unroll
                for (int j = 0; j < 4; ++j) { v[q][j] = v[q][j] * rstd * sc[j] + sh[j]; { v2u w; w.x = pk2(v[q][j].x, v[q][j].y); w.y = pk2(v[q][j].z, v[q][j].w); o8[64 * j] = w; } } }
#pragma unroll
            for (int j = 0; j < 4; ++j)
#pragma unroll
                for (int c = 0; c < 4; ++c) { const LAS f32x4* wp = (const LAS f32x4*)(wr_l + (4 * F.lane + 256 * j + c) * 8); const f32x4 w0 = wp[0], w1 = wp[1];
#pragma unroll
                    for (int q = 0; q < 4; ++q) { const float yq = v[q][j][c];
                        lg[q][0] += yq * w0.x; lg[q][1] += yq * w0.y; lg[q][2] += yq * w0.z; lg[q][3] += yq * w0.w; lg[q][4] += yq * w1.x; lg[q][5] += yq * w1.y; lg[q][6] += yq * w1.z; lg[q][7] += yq * w1.w; } }
#pragma unroll
            for (int o = 1; o < 64; o <<= 1)
#pragma unroll
                for (int q = 0; q < 4; ++q)
#pragma unroll
                    for (int e = 0; e < 8; ++e) lg[q][e] += __shfl_xor(lg[q][e], o);
#pragma unroll
            for (int q = 0; q < 4; ++q) { const int rl = F.wave * 8 + rr0 + q;
                float mx = lg[q][0];
#pragma unroll
                for (int e = 1; e < 8; ++e) mx = fmaxf(mx, lg[q][e]);
                float p[8], sm = 0.f;
#pragma unroll
                for (int e = 0; e < 8; ++e) { p[e] = expf(lg[q][e] - mx); sm += p[e]; }
                int i0 = 0; float v0 = -1.f;
#pragma unroll
                for (int e = 0; e < 8; ++e) { p[e] = p[e] / sm; if (p[e] > v0) { v0 = p[e]; i0 = e; } }
                int i1 = 0; float v1 = -1.f;
#pragma unroll
                for (int e = 0; e < 8; ++e) if (e != i0 && p[e] > v1) { v1 = p[e]; i1 = e; }
                if (F.lane == 0) { const float s2 = v0 + v1; rowE[rl * 2] = i0; rowE[rl * 2 + 1] = i1; rowW[rl * 2] = v0 / s2; rowW[rl * 2 + 1] = v1 / s2; } }
        }
        __syncthreads();
        if (F.tid < 8) lcnt[F.tid] = 0;
        __syncthreads();
        if (F.tid == 0) { for (int a = 0; a < 128; ++a) { const int e = rowE[a]; rowP[a] = lcnt[e]; lcnt[e] = lcnt[e] + 1; } }
        __syncthreads();
        if (F.tid < 128) { const size_t g = (size_t)blk * 128 + F.tid; WSP(int, WS_TOKE)[g] = rowE[F.tid]; WSP(int, WS_TOKP)[g] = rowP[F.tid]; WSP(float, WS_TOKW)[g] = rowW[F.tid]; }
        if (F.tid < 8) WSP(int, WS_CNTWG)[blk * 8 + F.tid] = lcnt[F.tid];
        __syncthreads();
    }
}
__device__ __forceinline__ void gather_phase(Frame& F) {
    const int* cw = WSP(int, WS_CNTWG);
    LAS int* boff = (LAS int*)(F.lds);
    for (int blk = blockIdx.x; blk < M / 64; blk += F.G) {
        if (F.tid < 8) { int mine = 0; for (int i = 0; i < blk; ++i) mine += cw[i * 8 + F.tid]; boff[F.tid] = mine + (int)F.MISC[33 + F.tid]; }
        __syncthreads();
        for (int a = F.wave; a < 128; a += NWAVES) {
            const size_t g = (size_t)blk * 128 + a; const int e = WSP(int, WS_TOKE)[g], slot = boff[e] + WSP(int, WS_TOKP)[g];
            if (F.lane == 0) WSP(int, WS_TOKS)[g] = slot;
            const GAS v4u* src = (const GAS v4u*)(WSP(bf16, WS_HN) + (size_t)(blk * 64 + (a >> 1)) * D); GAS v4u* dst = (GAS v4u*)(WSP(bf16, WS_HP) + (size_t)slot * D);
            dst[F.lane] = src[F.lane]; dst[64 + F.lane] = src[64 + F.lane];
        }
        __syncthreads();
    }
    for (int e = 0; e < 8; ++e) { const int r0 = (int)F.MISC[33 + e] + (int)F.MISC[16 + e], r1 = (int)F.MISC[34 + e];
        for (int r = r0 + F.gw; r < r1; r += F.NGW) { GAS v4u* dst = (GAS v4u*)(WSP(bf16, WS_HP) + (size_t)r * D); dst[F.lane] = (v4u){0u, 0u, 0u, 0u}; dst[64 + F.lane] = (v4u){0u, 0u, 0u, 0u}; } }
}
template <typename TX> __device__ __forceinline__ void final_phase(Frame& F, const TX* X, int l) {
    const bf16* Y = WSP(bf16, WS_HP); const float* mf = WSP(float, WS_MODF);
    f32x4 fn[4];
#pragma unroll
    for (int j = 0; j < 4; ++j) fn[j] = *(const f32x4*)(F.in[18] + 4 * F.lane + 256 * j);
    for (int b = 0; b < NB; ++b) {
        f32x4 gf[4];
#pragma unroll
        for (int j = 0; j < 4; ++j) gf[j] = *(const f32x4*)(mf + (size_t)(l * 2 + b) * 6 * D + 5 * D + 4 * F.lane + 256 * j);
        for (int row = b * SEQ + F.gw; row < (b + 1) * SEQ; row += 2 * F.NGW) {
            f32x4 v[2][4]; float ss[2]; bool ok[2];
#pragma unroll
            for (int q = 0; q < 2; ++q) { ok[q] = row + q * F.NGW < (b + 1) * SEQ; const int rq = ok[q] ? row + q * F.NGW : row;
                const int s0 = WSP(int, WS_TOKS)[rq * 2], s1 = WSP(int, WS_TOKS)[rq * 2 + 1]; const float w0 = WSP(float, WS_TOKW)[rq * 2], w1 = WSP(float, WS_TOKW)[rq * 2 + 1];
                const GAS v2u* y0 = (const GAS v2u*)(Y + (size_t)s0 * D) + F.lane; const GAS v2u* y1 = (const GAS v2u*)(Y + (size_t)s1 * D) + F.lane;
                f32x4 xv[4]; v2u a[4], c[4];
#pragma unroll
                for (int j = 0; j < 4; ++j) { xv[j] = XRow<TX>::ld(X, (size_t)rq, 4 * F.lane + 256 * j); a[j] = y0[64 * j]; c[j] = y1[64 * j]; }
                ss[q] = 0.f;
#pragma unroll
                for (int j = 0; j < 4; ++j) { const f32x4 ya = {bflo(a[j].x), bfhi(a[j].x), bflo(a[j].y), bfhi(a[j].y)}, yc = {bflo(c[j].x), bfhi(c[j].x), bflo(c[j].y), bfhi(c[j].y)};
                    v[q][j] = xv[j] + gf[j] * (ya * w0 + yc * w1); ss[q] += (v[q][j].x * v[q][j].x + v[q][j].y * v[q][j].y) + (v[q][j].z * v[q][j].z + v[q][j].w * v[q][j].w); } }
#pragma unroll
            for (int o = 1; o < 64; o <<= 1) { ss[0] += __shfl_xor(ss[0], o); ss[1] += __shfl_xor(ss[1], o); }
#pragma unroll
            for (int q = 0; q < 2; ++q) if (ok[q]) { const float rstd = rsqrtf(ss[q] * (1.f / D) + NORM_EPS); GAS f32x4* o = (GAS f32x4*)(F.out + (size_t)(row + q * F.NGW) * D) + F.lane;
#pragma unroll
                for (int j = 0; j < 4; ++j) o[64 * j] = v[q][j] * rstd * fn[j]; }
        }
    }
}

constexpr int N_PHASES = 19;
struct Args { const float* in[19]; float* out; unsigned char* ws; int ph_lo, ph_hi; };
__global__ void __launch_bounds__(NTHREADS, 2) mk_fwd(Args args) {
    extern __shared__ __attribute__((aligned(16))) unsigned char lds[];
    Frame F;
    F.lds = (LAS unsigned char*)lds; F.MISC = (volatile LAS unsigned*)(F.lds + MISC_OFF);
    F.tid = threadIdx.x; F.lane = F.tid & 63; F.wave = __builtin_amdgcn_readfirstlane(F.tid >> 6);
    F.G = gridDim.x; { const int bx = blockIdx.x; F.vcu = (F.G % 8 == 0) ? (bx % 8) * (F.G / 8) + bx / 8 : bx; }
    F.gw = F.vcu * NWAVES + F.wave; F.NGW = F.G * NWAVES;
#pragma unroll
    for (int i = 0; i < 19; ++i) F.in[i] = args.in[i];
    F.out = args.out; F.ws = args.ws;
    for (int u = F.tid; u < (LDS_BYTES - MISC_OFF) / 4; u += NTHREADS) ((LAS unsigned*)(F.lds + MISC_OFF))[u] = 0u;
    __syncthreads();
    XcdBarrier bar; bar.bar = WSP(unsigned, WS_CTL) + 1024; bar.x = 0; bar.st = nullptr;
    if (!MK_PHASED) bar = xcd_barrier_post(WSP(unsigned, WS_CTL) + 1024, F.MISC + 8);
    const int lo = args.ph_lo, hi = args.ph_hi;
#ifdef MK_ONLY
#define IN(k) ((k) == MK_ONLY && lo <= (k) && (k) < hi)
#else
#define IN(k) (lo <= (k) && (k) < hi)
#endif
#define REFRESH() do { int t_ = threadIdx.x; asm volatile("" : "+v"(t_)); F.tid = t_; F.lane = t_ & 63; } while (0)
#define SEAM(k) do { if (IN(k) && IN((k) + 1)) xcd_barrier(bar); } while (0)
    bf16* XA = WSP(bf16, WS_XA); bf16* XB = (bf16*)F.out; const float* MODF = WSP(float, WS_MODF);
    bf16* HN = WSP(bf16, WS_HN);
    LAS unsigned char* ring = F.lds;

    if (IN(0)) for (int rep_ = 0; rep_ < REP(0); ++rep_) { REFRESH(); p0_prologue(F); } SEAM(0);
    if (IN(1)) for (int rep_ = 0; rep_ < REP(1); ++rep_) { REFRESH(); modulate_phase<true, float>(F, F.in[0], 0, 0, HN); modf_reduce(F); } SEAM(1);
    if (IN(2)) for (int rep_ = 0; rep_ < REP(2); ++rep_) { REFRESH();
        { pg8::Gemm g{HN, WSP(bf16, WS_WQK), M, 2048, D}; pg8::StaticOrder S; S.init(M, 2048, F.G, (int)blockIdx.x);
          pg8::EpiBf16P E{WSP(bf16, WS_Q0), D, 8, 4, (size_t)(WS_K0 - WS_Q0) / 2, 0.125f * LOG2E, 0, 1};
          pg8::gemm_phase<pg8::EpiBf16P, pg8::StaticOrder, true, true>(ring, g, S, E); }
        { pg8::Gemm g{WSP(bf16, WS_WV), HN, D, M, D}; pg8::StaticOrder S; S.init(D, M, F.G, (int)blockIdx.x);
          pg8::EpiBf16P E{WSP(bf16, WS_VT0), M, 64, 0, 0, 1.f, 2, 2};
          pg8::gemm_phase<pg8::EpiBf16P, pg8::StaticOrder, true, true>(ring, g, S, E); }
    } SEAM(2);
    if (IN(3)) for (int rep_ = 0; rep_ < REP(3); ++rep_) { REFRESH(); na_phase(F); } SEAM(3);
    if (IN(4)) for (int rep_ = 0; rep_ < REP(4); ++rep_) { REFRESH(); pg8::Gemm g{WSP(bf16, WS_O0), WSP(bf16, WS_WO0), M, D, D}; pg8::StaticOrder S; S.init(M, D, F.G, (int)blockIdx.x);
        pg8::EpiResGateB<true> E{F.in[0], XA, MODF + 0 * 12 * D + 2 * D};
        pg8::gemm_phase<pg8::EpiResGateB<true>, pg8::StaticOrder, true, true>(ring, g, S, E); } SEAM(4);
    if (IN(5)) for (int rep_ = 0; rep_ < REP(5); ++rep_) { REFRESH(); modulate_phase<false, bf16>(F, XA, 0, 3, HN); } SEAM(5);
    if (IN(6)) for (int rep_ = 0; rep_ < REP(6); ++rep_) { REFRESH(); pg8::Gemm g{HN, WSP(bf16, WS_WGU0), M, 2 * FFN, D}; pg8::StaticOrder S; S.init(M, 2 * FFN, F.G, (int)blockIdx.x);
        pg8::EpiSwiGLU E{WSP(bf16, WS_ACT0), FFN, 22};
        pg8::gemm_phase<pg8::EpiSwiGLU, pg8::StaticOrder, true, true>(ring, g, S, E);
        moe_w_side(F, MOE_ITEMS - MOE_G1 - MOE_G2 - MOE_G3, MOE_ITEMS - MOE_G2 - MOE_G3, 128); } SEAM(6);
    if (IN(7)) for (int rep_ = 0; rep_ < REP(7); ++rep_) { REFRESH(); pg8::Gemm g{WSP(bf16, WS_ACT0), WSP(bf16, WS_WDN0), M, D, FFN}; pg8::StaticOrder S; S.init(M, D, F.G, (int)blockIdx.x);
        pg8::EpiResGateB<false> E{XA, XB, MODF + 0 * 12 * D + 5 * D};
        pg8::gemm_phase<pg8::EpiResGateB<false>, pg8::StaticOrder, true, true>(ring, g, S, E); } SEAM(7);
    if (IN(8)) for (int rep_ = 0; rep_ < REP(8); ++rep_) { REFRESH(); modulate_phase<false, bf16>(F, XB, 1, 0, HN); } SEAM(8);
    if (IN(9)) for (int rep_ = 0; rep_ < REP(9); ++rep_) { REFRESH(); pg8::Gemm g{HN, WSP(bf16, WS_WMD), M, DOWN_NP, D}; pg8::StaticOrder S; S.init(M, DOWN_NP, F.G, (int)blockIdx.x);
        pg8::EpiF32 E{WSP(float, WS_DOWN), DOWN_NP};
        pg8::gemm_phase<pg8::EpiF32, pg8::StaticOrder, true, true>(ring, g, S, E);
        moe_w_side(F, MOE_ITEMS - MOE_G2 - MOE_G3, MOE_ITEMS - MOE_G3, 128); } SEAM(9);
    if (IN(10)) for (int rep_ = 0; rep_ < REP(10); ++rep_) { REFRESH(); mla_mid_phase(F); } SEAM(10);
    if (IN(11)) for (int rep_ = 0; rep_ < REP(11); ++rep_) { REFRESH(); int kq = 256; asm volatile("" : "+s"(kq));
        { pg8::Gemm g{WSP(bf16, WS_CQ), WSP(bf16, WS_WUQ), M, 1536, kq}; pg8::StaticOrder S; S.init(M, 1536, F.G, (int)blockIdx.x);
          pg8::EpiQRope E{WSP(bf16, WS_Q1), WSP(float, WS_ROPER), WSP(float, WS_ROPEC), QSCALE1};
          pg8::gemm_phase<pg8::EpiQRope, pg8::StaticOrder, true, true>(ring, g, S, E); }
        { pg8::Gemm g{WSP(bf16, WS_CKV), WSP(bf16, WS_WKN), M, D, kq}; pg8::StaticOrder S; S.init(M, D, F.G, (int)blockIdx.x);
          pg8::EpiBf16P E{WSP(bf16, WS_KN), D, 4, 0, 0, 1.f, 1, 1};
          pg8::gemm_phase<pg8::EpiBf16P, pg8::StaticOrder, true, true>(ring, g, S, E); }
        { pg8::Gemm g{WSP(bf16, WS_WVV), WSP(bf16, WS_CKV), D, M, kq}; pg8::StaticOrder S; S.init(D, M, F.G, (int)blockIdx.x);
          pg8::EpiBf16P E{WSP(bf16, WS_VT1), M, 64, 0, 0, 1.f, 2, 2};
          pg8::gemm_phase<pg8::EpiBf16P, pg8::StaticOrder, true, true>(ring, g, S, E); }
    } SEAM(11);
    if (IN(12)) for (int rep_ = 0; rep_ < REP(12); ++rep_) { REFRESH();
        for (int u = F.vcu; u < NB * NH * (SEQ / 256); u += F.G) { const int a = u >> 8, r = u & 255, bh = r >> 3, qb = (r & 7) * 4 + a;
            mla::unit(bh >> 4, bh & 15, qb, WSP(bf16, WS_Q1), WSP(bf16, WS_KN), WSP(bf16, WS_KR), WSP(bf16, WS_VT1), WSP(bf16, WS_O1), ring); }
    } SEAM(12);
    if (IN(13)) for (int rep_ = 0; rep_ < REP(13); ++rep_) { REFRESH(); pg8::Gemm g{WSP(bf16, WS_O1), WSP(bf16, WS_WO1), M, D, D}; pg8::StaticOrder S; S.init(M, D, F.G, (int)blockIdx.x);
        pg8::EpiResGateB<false> E{XB, XA, MODF + 1 * 12 * D + 2 * D};
        pg8::gemm_phase<pg8::EpiResGateB<false>, pg8::StaticOrder, true, true>(ring, g, S, E); } SEAM(13);
    if (IN(14)) for (int rep_ = 0; rep_ < REP(14); ++rep_) { REFRESH(); router_phase<bf16>(F, XA, 1, 3); } SEAM(14);
    if (IN(15)) for (int rep_ = 0; rep_ < REP(15); ++rep_) { REFRESH(); moe_tables(F); gather_phase(F); } SEAM(15);
    if (IN(16)) for (int rep_ = 0; rep_ < REP(16); ++rep_) { REFRESH(); moe_tables(F);
        pg8::MoeOrder S{(int)F.MISC[32], 14, F.G, (int)blockIdx.x, (int)F.MISC[25], (int)F.MISC[26], (int)F.MISC[27], (int)F.MISC[28], (int)F.MISC[29], (int)F.MISC[30], (int)F.MISC[31]};
        pg8::Gemm g{WSP(bf16, WS_HP), WSP(bf16, WS_WGU1), MP_MAX, NE * 2 * ED, D};
        pg8::EpiSwiGLU E{WSP(bf16, WS_ACT1), ED, 14};
        pg8::gemm_phase<pg8::EpiSwiGLU, pg8::MoeOrder, true, true>(ring, g, S, E);
        moe_w_side(F, MOE_ITEMS - MOE_G3, MOE_ITEMS, 112); } SEAM(16);
    if (IN(17)) for (int rep_ = 0; rep_ < REP(17); ++rep_) { REFRESH(); moe_tables(F);
        pg8::MoeOrder S{(int)F.MISC[32], 4, F.G, (int)blockIdx.x, (int)F.MISC[25], (int)F.MISC[26], (int)F.MISC[27], (int)F.MISC[28], (int)F.MISC[29], (int)F.MISC[30], (int)F.MISC[31]};
        pg8::Gemm g{WSP(bf16, WS_ACT1), WSP(bf16, WS_WDN1), MP_MAX, NE * D, ED};
        pg8::EpiBf16P E{WSP(bf16, WS_HP), D, 4, 0, 0, 1.f, 0, 0};
        pg8::gemm_phase<pg8::EpiBf16P, pg8::MoeOrder, true, true>(ring, g, S, E); } SEAM(17);
    if (IN(18)) for (int rep_ = 0; rep_ < REP(18); ++rep_) { REFRESH(); final_phase<bf16>(F, XA, 1); }
#undef IN
#undef SEAM
}

extern "C" void kernel_launch(void* const* d_in, const int* in_sizes, int n_in, void* d_out, int out_size, void* d_ws, size_t ws_size, hipStream_t stream) {
    static int grid = 0;
    if (grid == 0) {
        if (n_in != 19 || in_sizes[0] != M * D || out_size != M * D || ws_size < WS_END) { fprintf(stderr, "kernel_launch: shape mismatch (n_in %d, ws %zu)\n", n_in, ws_size); grid = -1; return; }
        int dev = 0, cus = 0, per_cu = 0;
        if (hipGetDevice(&dev) != hipSuccess || hipDeviceGetAttribute(&cus, hipDeviceAttributeMultiprocessorCount, dev) != hipSuccess) { grid = -1; return; }
        if (hipFuncSetAttribute((const void*)mk_fwd, hipFuncAttributeMaxDynamicSharedMemorySize, LDS_BYTES) != hipSuccess) { fprintf(stderr, "kernel_launch: hipFuncSetAttribute failed\n"); grid = -1; return; }
        if (hipOccupancyMaxActiveBlocksPerMultiprocessor(&per_cu, (const void*)mk_fwd, NTHREADS, LDS_BYTES) != hipSuccess || per_cu < 1) fprintf(stderr, "kernel_launch: occupancy query says %d\n", per_cu);
        (void)hipGetLastError();
        grid = cus;
    }
    if (grid < 0) return;
    (void)hipMemsetAsync((char*)d_ws + WS_CTL, 0, CTL_ZERO_BYTES, stream);
    Args a{};
    for (int i = 0; i < 19; ++i) a.in[i] = (const float*)d_in[i];
    a.out = (float*)d_out; a.ws = (unsigned char*)d_ws;
#if MK_PHASED
    for (int p = 0; p < N_PHASES; ++p) { a.ph_lo = p; a.ph_hi = p + 1; hipLaunchKernelGGL(mk_fwd, dim3(grid), dim3(NTHREADS), LDS_BYTES, stream, a);
#if MK_CHECK == 1
        if (p == 3) hipLaunchKernelGGL(chk_na, dim3(M * NH / 4), dim3(256), 0, stream, (const bf16*)(a.ws + WS_Q0), (const bf16*)(a.ws + WS_K0), (const bf16*)(a.ws + WS_VT0), (const bf16*)(a.ws + WS_O0), a.in[5], (float*)(a.ws + WS_CTL + 32768));
#elif MK_CHECK == 2
        if (p == 12) hipLaunchKernelGGL(chk_mla, dim3(512 * 16), dim3(64), 0, stream, (const bf16*)(a.ws + WS_Q1), (const bf16*)(a.ws + WS_KN), (const bf16*)(a.ws + WS_KR), (const bf16*)(a.ws + WS_VT1), (const bf16*)(a.ws + WS_O1), (float*)(a.ws + WS_CTL + 32768));
#elif MK_CHECK == 3
        if (p == 11) hipLaunchKernelGGL(chk_proj, dim3(256), dim3(256), 0, stream, (const float*)(a.ws + WS_DOWN), a.in[10], a.in[12], a.in[11], a.in[13], (const bf16*)(a.ws + WS_Q1), (const bf16*)(a.ws + WS_KR), (const bf16*)(a.ws + WS_KN), (const bf16*)(a.ws + WS_VT1), (float*)(a.ws + WS_CTL + 32768));
#endif
    }
#if MK_CHECK == 3
    hipLaunchKernelGGL(chk_tweak4, dim3(M * D / 256), dim3(256), 0, stream, a.out, (const float*)(a.ws + WS_CTL + 32768), 1000.f);
#elif MK_CHECK
    hipLaunchKernelGGL(chk_tweak, dim3(M * D / 256), dim3(256), 0, stream, a.out, (const float*)(a.ws + WS_CTL + 32768), 1000.f);
#endif
#else
    a.ph_lo = 0; a.ph_hi = N_PHASES; hipLaunchKernelGGL(mk_fwd, dim3(grid), dim3(NTHREADS), LDS_BYTES, stream, a);
#endif
}
```

```cpp
#include <hip/hip_runtime.h>
#include <cstdio>
#include <cstdint>
namespace pg8 {
#define PG8_LAS __attribute__((address_space(3)))
typedef unsigned short bf16_t;
typedef short bf16x8 __attribute__((ext_vector_type(8)));
typedef float f32x4 __attribute__((ext_vector_type(4)));
typedef unsigned u32x4 __attribute__((ext_vector_type(4)));
constexpr int BM = 256, BK = 64, HALF = 128, HTB = HALF * BK * 2  , STAGE_BYTES = 8 * HTB, NXCD = 8, WGM = 8;

__host__ __device__ __forceinline__ int lds_byte(int r, int c) { const int st = (r >> 4) * 2 + (c >> 5), rr = r & 15, cc = c & 31, ob = rr * 64 + cc * 2; return st * 1024 + (ob ^ (((ob >> 9) & 1) << 5)); }
__host__ __device__ __forceinline__ void stage_rc(int b, int& R, int& C) { const int st = b / 1024, sb = b % 1024, swz = sb ^ (((sb >> 9) & 1) << 5); R = (st >> 1) * 16 + swz / 64; C = (st & 1) * 32 + (swz % 64) / 2; }
__host__ __device__ __forceinline__ int perm32(int rho) { const int n = rho >> 4, i = rho & 15; return 8 * (i >> 2) + 4 * n + (i & 3); }

struct Unit { int pm, pn; };
struct Gemm { const bf16_t* A; const bf16_t* Bt; int M, N, K; };

struct StaticOrder {
    int nM, nN, nwg, G, c;
    __host__ __device__ void init(int M, int N, int G_, int c_) { nM = M / BM; nN = N / BM; nwg = nM * nN; G = G_; c = c_; }
    __host__ __device__ bool next(int i, Unit& u) const {
        const long L = (long)i * G + c; if (L >= nwg) return false;
        int wgid = (int)L; { const int q = nwg / NXCD, r = nwg % NXCD, xcd = wgid % NXCD, off = wgid / NXCD; wgid = (xcd < r ? xcd * (q + 1) : r * (q + 1) + (xcd - r) * q) + off; }
        const int nig = WGM * nN, gid = wgid / nig, fm = gid * WGM, gsz = (nM - fm) < WGM ? (nM - fm) : WGM;
        u.pm = fm + ((wgid % nig) % gsz); u.pn = (wgid % nig) / gsz; return true;
    }
    __device__ __forceinline__ void a_ready(const Unit&) const {}
    __device__ __forceinline__ void done(const Unit&) const {}
};

__device__ __forceinline__ unsigned cvt_pk_bf16(float lo, float hi) { unsigned r; asm volatile("v_cvt_pk_bf16_f32 %0, %1, %2" : "=v"(r) : "v"(lo), "v"(hi)); return r; }

__device__ __forceinline__ float fast_silu(float g) { return g * __builtin_amdgcn_rcpf(1.f + __builtin_amdgcn_exp2f(-1.4426950408889634f * g)); }
struct EpiBf16P {
    static constexpr bool PERM = true, AFTER_DRAIN = false;
    bf16_t* O; int ldc; int nct; int st; size_t sstride; float scale0; int mode0, mode1;
    __device__ __forceinline__ void operator()(const f32x4 (&acc)[2][2][4][2], const Unit& u, int wr, int wc, int fr, int fq) const {
        int ct = u.pn % nct; bf16_t* base = O; float sc = 1.f; int mode = mode0;
        if (st) { const int t = ct / st; base += (size_t)t * sstride; ct -= t * st; if (t == 0) sc = scale0; else mode = mode1; }
        const int row0 = u.pm * BM + wr * 64 + fr, col0 = ct * BM + wc * 32 + 8 * fq;
#pragma unroll
        for (int ai = 0; ai < 2; ++ai)
#pragma unroll
            for (int m = 0; m < 4; ++m) { const int row = row0 + ai * HALF + m * 16;
#pragma unroll
                for (int bj = 0; bj < 2; ++bj) { const f32x4 v0 = acc[ai][bj][m][0] * sc, v1 = acc[ai][bj][m][1] * sc; const int col = col0 + bj * HALF;
                    u32x4 w; w.x = cvt_pk_bf16(v0[0], v0[1]); w.y = cvt_pk_bf16(v0[2], v0[3]); w.z = cvt_pk_bf16(v1[0], v1[1]); w.w = cvt_pk_bf16(v1[2], v1[3]);
                    bf16_t* p = mode == 0 ? base + (size_t)row * ldc + col : base + ((size_t)(col >> 6) * (mode == 1 ? 16384 : 1024) + row) * 64 + (col & 63);
                    *(u32x4*)p = w; } }
    }
};
struct EpiResGate {
    static constexpr bool PERM = false, AFTER_DRAIN = false;
    const float* res; float* out; const float* gate;
    __device__ __forceinline__ void operator()(const f32x4 (&acc)[2][2][4][2], const Unit& u, int wr, int wc, int fr, int fq) const {
        const int row0 = u.pm * BM + wr * 64 + fr, col0 = u.pn * BM + wc * 32 + 4 * fq;
        const float* gp = gate + (size_t)((u.pm * BM) >> 13) * 6144 + col0;
        f32x4 gv[2][2];
#pragma unroll
        for (int bj = 0; bj < 2; ++bj)
#pragma unroll
            for (int n = 0; n < 2; ++n) gv[bj][n] = *(const f32x4*)(gp + bj * HALF + n * 16);
#pragma unroll
        for (int ai = 0; ai < 2; ++ai)
#pragma unroll
            for (int m = 0; m < 4; ++m) { const size_t off = (size_t)(row0 + ai * HALF + m * 16) * 1024 + col0;
#pragma unroll
                for (int bj = 0; bj < 2; ++bj)
#pragma unroll
                    for (int n = 0; n < 2; ++n) { const f32x4 rs = *(const f32x4*)(res + off + bj * HALF + n * 16);
                        *(f32x4*)(out + off + bj * HALF + n * 16) = rs + gv[bj][n] * acc[ai][bj][m][n]; } }
    }
};
template <bool RES_F32> struct EpiResGateB {
    static constexpr bool PERM = true, AFTER_DRAIN = false;
    const void* res; bf16_t* out; const float* gate;
    __device__ __forceinline__ void operator()(const f32x4 (&acc)[2][2][4][2], const Unit& u, int wr, int wc, int fr, int fq) const {
        const int row0 = u.pm * BM + wr * 64 + fr, col0 = u.pn * BM + wc * 32 + 8 * fq;
        const float* gp = gate + (size_t)((u.pm * BM) >> 13) * 6144 + col0;
        f32x4 gv[2][2];
#pragma unroll
        for (int bj = 0; bj < 2; ++bj)
#pragma unroll
            for (int n = 0; n < 2; ++n) gv[bj][n] = *(const f32x4*)(gp + bj * HALF + 4 * n);
#pragma unroll
        for (int ai = 0; ai < 2; ++ai)
#pragma unroll
            for (int m = 0; m < 4; ++m) { const size_t off = (size_t)(row0 + ai * HALF + m * 16) * 1024 + col0;
#pragma unroll
                for (int bj = 0; bj < 2; ++bj) { f32x4 r0, r1;
                    if (RES_F32) { const float* rp = (const float*)res + off + bj * HALF; r0 = *(const f32x4*)rp; r1 = *(const f32x4*)(rp + 4); }
                    else { const u32x4 w = *(const u32x4*)((const bf16_t*)res + off + bj * HALF);
                        r0 = (f32x4){__builtin_bit_cast(float, w.x << 16), __builtin_bit_cast(float, w.x & 0xffff0000u), __builtin_bit_cast(float, w.y << 16), __builtin_bit_cast(float, w.y & 0xffff0000u)};
                        r1 = (f32x4){__builtin_bit_cast(float, w.z << 16), __builtin_bit_cast(float, w.z & 0xffff0000u), __builtin_bit_cast(float, w.w << 16), __builtin_bit_cast(float, w.w & 0xffff0000u)}; }
                    const f32x4 v0 = r0 + gv[bj][0] * acc[ai][bj][m][0], v1 = r1 + gv[bj][1] * acc[ai][bj][m][1];
                    u32x4 o; o.x = cvt_pk_bf16(v0[0], v0[1]); o.y = cvt_pk_bf16(v0[2], v0[3]); o.z = cvt_pk_bf16(v1[0], v1[1]); o.w = cvt_pk_bf16(v1[2], v1[3]);
                    *(u32x4*)(out + off + bj * HALF) = o; } }
    }
};
struct EpiF32 {
    static constexpr bool PERM = false, AFTER_DRAIN = false;
    float* O; int ldc;
    __device__ __forceinline__ void operator()(const f32x4 (&acc)[2][2][4][2], const Unit& u, int wr, int wc, int fr, int fq) const {
        const int row0 = u.pm * BM + wr * 64 + fr, col0 = u.pn * BM + wc * 32 + 4 * fq;
#pragma unroll
        for (int ai = 0; ai < 2; ++ai)
#pragma unroll
            for (int m = 0; m < 4; ++m) { float* rowp = O + (size_t)(row0 + ai * HALF + m * 16) * ldc + col0;
#pragma unroll
                for (int bj = 0; bj < 2; ++bj)
#pragma unroll
                    for (int n = 0; n < 2; ++n) *(f32x4*)(rowp + bj * HALF + n * 16) = acc[ai][bj][m][n]; }
    }
};
struct EpiSwiGLU {
    static constexpr bool PERM = true, AFTER_DRAIN = false;
    bf16_t* O; int ldc; int nN;
    __device__ __forceinline__ void operator()(const f32x4 (&acc)[2][2][4][2], const Unit& u, int wr, int wc, int fr, int fq) const {
        const int row0 = u.pm * BM + wr * 64 + fr, col0 = (u.pn % nN) * HALF + wc * 32 + 8 * fq;
#pragma unroll
        for (int ai = 0; ai < 2; ++ai)
#pragma unroll
            for (int m = 0; m < 4; ++m) {
                const f32x4 g0 = acc[ai][0][m][0], g1 = acc[ai][0][m][1], u0 = acc[ai][1][m][0], u1 = acc[ai][1][m][1];
                u32x4 w;
                w.x = cvt_pk_bf16(fast_silu(g0[0]) * u0[0], fast_silu(g0[1]) * u0[1]); w.y = cvt_pk_bf16(fast_silu(g0[2]) * u0[2], fast_silu(g0[3]) * u0[3]);
                w.z = cvt_pk_bf16(fast_silu(g1[0]) * u1[0], fast_silu(g1[1]) * u1[1]); w.w = cvt_pk_bf16(fast_silu(g1[2]) * u1[2], fast_silu(g1[3]) * u1[3]);
                *(u32x4*)(O + (size_t)(row0 + ai * HALF + m * 16) * ldc + col0) = w; }
    }
};
struct EpiQRope {
    static constexpr bool PERM = true, AFTER_DRAIN = false;
    bf16_t* O; const float* ropeR; const float* ropeC; float qs;
    __device__ __forceinline__ void operator()(const f32x4 (&acc)[2][2][4][2], const Unit& u, int wr, int wc, int fr, int fq) const {
        const int row0 = u.pm * BM + wr * 64 + fr, col0 = u.pn * BM + wc * 32 + 8 * fq;
#pragma unroll
        for (int ai = 0; ai < 2; ++ai)
#pragma unroll
            for (int m = 0; m < 4; ++m) { const int r = row0 + ai * HALF + m * 16, t = r & 8191, gr = t >> 6, gc = t & 63;
#pragma unroll
                for (int bj = 0; bj < 2; ++bj) { const int c = col0 + bj * HALF, d = c % 96;
                    f32x4 v0 = acc[ai][bj][m][0], v1 = acc[ai][bj][m][1];
                    if (d >= 64) { const int p = (d - 64) >> 1;
                        const float* tb = p < 8 ? ropeR + gr * 16 + 2 * p : ropeC + gc * 16 + 2 * (p - 8);
                        const f32x4 a = *(const f32x4*)tb, b = *(const f32x4*)(tb + 4);
                        v0 = (f32x4){v0[0] * a[0] - v0[1] * a[1], v0[0] * a[1] + v0[1] * a[0], v0[2] * a[2] - v0[3] * a[3], v0[2] * a[3] + v0[3] * a[2]};
                        v1 = (f32x4){v1[0] * b[0] - v1[1] * b[1], v1[0] * b[1] + v1[1] * b[0], v1[2] * b[2] - v1[3] * b[3], v1[2] * b[3] + v1[3] * b[2]}; }
                    v0 = v0 * qs; v1 = v1 * qs;
                    u32x4 w; w.x = cvt_pk_bf16(v0[0], v0[1]); w.y = cvt_pk_bf16(v0[2], v0[3]); w.z = cvt_pk_bf16(v1[0], v1[1]); w.w = cvt_pk_bf16(v1[2], v1[3]);
                    *(u32x4*)(O + (size_t)r * 1536 + c) = w; }
                asm volatile("" ::: "memory"); }
    }
};
struct MoeOrder {
    int T, nN, G, c; int tb1, tb2, tb3, tb4, tb5, tb6, tb7;
    __device__ __forceinline__ bool next(int i, Unit& u) const {
        const int nwg = T * nN; const long L = (long)i * G + c; if (L >= nwg) return false;
        int wgid = (int)L; { const int q = nwg / NXCD, r = nwg % NXCD, xcd = wgid % NXCD, off = wgid / NXCD; wgid = (xcd < r ? xcd * (q + 1) : r * (q + 1) + (xcd - r) * q) + off; }
        const int nig = WGM * nN, gid = wgid / nig, fm = gid * WGM, gsz = (T - fm) < WGM ? (T - fm) : WGM;
        const int pm = fm + ((wgid % nig) % gsz), pn = (wgid % nig) / gsz;
        const int e = (pm >= tb1) + (pm >= tb2) + (pm >= tb3) + (pm >= tb4) + (pm >= tb5) + (pm >= tb6) + (pm >= tb7);
        u.pm = pm; u.pn = e * nN + pn; return true;
    }
    __device__ __forceinline__ void a_ready(const Unit&) const {}
    __device__ __forceinline__ void done(const Unit&) const {}
};

template <class Epi, class Sched, bool ALIGN_EPI = false, bool SP2 = false>
__device__ __forceinline__ void gemm_phase(PG8_LAS unsigned char* lds, const Gemm g, const Sched& S, const Epi& E) {
    const int tid = threadIdx.x, wid = __builtin_amdgcn_readfirstlane(tid >> 6), lane = tid & 63, wr = wid >> 2, wc = wid & 3, fr = lane & 15, fq = lane >> 4;
    const int K = g.K, nt = K / BK;
    unsigned voffA[2], voffB[2];
#pragma unroll
    for (int i = 0; i < 2; ++i) { int R, C; stage_rc(tid * 16 + i * 8192, R, C); const int Rb = Epi::PERM ? ((R & ~31) + perm32(R & 31)) : R;
        voffA[i] = (unsigned)(R * K + C) * 2u; voffB[i] = (unsigned)(Rb * K + C) * 2u; }
    const size_t kstep = (size_t)(BK * 2);
    const size_t hstep = (size_t)HALF * K * 2;
    const size_t tstep = 2 * hstep;
    const unsigned ldsw = (unsigned)wid * 1024u;
    const int aoff = lds_byte(wr * 64 + fr, fq * 8), boff = lds_byte(wc * 32 + fr, fq * 8);
#define PG8_SA(b, h) (((b) * 2 + (h)) * HTB)
#define PG8_SB(b, h) ((4 + (b) * 2 + (h)) * HTB)
#define PG8_STAGE(bufoff, gbase, voff) do { _Pragma("unroll") for (int _i = 0; _i < 2; ++_i) \
        __builtin_amdgcn_global_load_lds((const unsigned*)((const char*)(gbase) + (voff)[_i]), (PG8_LAS unsigned*)(lds + (bufoff) + ldsw + _i * 8192), 16, 0, 0); } while (0)
#define PG8_LDA(dst, b, h) do { _Pragma("unroll") for (int m = 0; m < 4; ++m) _Pragma("unroll") for (int k = 0; k < 2; ++k) dst[m][k] = *(const PG8_LAS bf16x8*)(lds + PG8_SA(b, h) + aoff + m * 2048 + k * 1024); } while (0)
#define PG8_LDB(dst, b, h) do { _Pragma("unroll") for (int n = 0; n < 2; ++n) _Pragma("unroll") for (int k = 0; k < 2; ++k) dst[n][k] = *(const PG8_LAS bf16x8*)(lds + PG8_SB(b, h) + boff + n * 2048 + k * 1024); } while (0)
#define PG8_MMA(ai, bj, At, Bt) do { __builtin_amdgcn_s_setprio(1); _Pragma("unroll") for (int m = 0; m < 4; ++m) _Pragma("unroll") for (int n = 0; n < 2; ++n) _Pragma("unroll") for (int k = 0; k < 2; ++k) \
        acc[ai][bj][m][n] = __builtin_amdgcn_mfma_f32_16x16x32_bf16(Bt[n][k], At[m][k], acc[ai][bj][m][n], 0, 0, 0); __builtin_amdgcn_s_setprio(0); } while (0)
#define PG8_WAIT_V(n) asm volatile("s_waitcnt vmcnt(" #n ")" ::: "memory")
#define PG8_WAIT_L(n) asm volatile("s_waitcnt lgkmcnt(" #n ")" ::: "memory")
#define PG8_BAR __builtin_amdgcn_s_barrier()
#define PG8_SCHED __builtin_amdgcn_sched_barrier(0)
    Unit cur, nxt; int ui = 0;
    if (!S.next(0, cur)) return;
    f32x4 acc[2][2][4][2];
#pragma unroll
    for (int a = 0; a < 2; ++a)
#pragma unroll
        for (int b = 0; b < 2; ++b)
#pragma unroll
            for (int m = 0; m < 4; ++m)
#pragma unroll
                for (int n = 0; n < 2; ++n) acc[a][b][m][n] = (f32x4){0.f, 0.f, 0.f, 0.f};
    bf16x8 At[4][2], B0[2][2], B1[2][2];
    const char* cA = (const char*)g.A + (size_t)cur.pm * tstep; const char* cB = (const char*)g.Bt + (size_t)cur.pn * tstep;
    S.a_ready(cur);
    if constexpr (SP2) {
        PG8_STAGE(PG8_SB(0, 0), cB, voffB); PG8_STAGE(PG8_SB(0, 1), cB + hstep, voffB); PG8_STAGE(PG8_SA(0, 0), cA, voffA); PG8_STAGE(PG8_SA(0, 1), cA + hstep, voffA);
        if (wr == 1) PG8_BAR;
        PG8_WAIT_V(2); PG8_BAR;
        PG8_STAGE(PG8_SB(1, 0), cB + kstep, voffB); PG8_STAGE(PG8_SA(1, 0), cA + kstep, voffA); PG8_STAGE(PG8_SB(1, 1), cB + hstep + kstep, voffB);
        PG8_WAIT_V(6); PG8_BAR;
    } else {
        PG8_STAGE(PG8_SB(0, 0), cB, voffB); PG8_STAGE(PG8_SA(0, 0), cA, voffA); PG8_STAGE(PG8_SB(0, 1), cB + hstep, voffB); PG8_STAGE(PG8_SA(0, 1), cA + hstep, voffA);
        if (wr == 1) PG8_BAR;
        PG8_WAIT_V(4); PG8_BAR;
        PG8_STAGE(PG8_SB(1, 0), cB + kstep, voffB); PG8_STAGE(PG8_SA(1, 0), cA + kstep, voffA); PG8_STAGE(PG8_SB(1, 1), cB + hstep + kstep, voffB);
        PG8_WAIT_V(6); PG8_BAR;
    }
    for (;;) {
        const bool has_next = S.next(ui + 1, nxt);
        const char* nA = has_next ? (const char*)g.A + (size_t)nxt.pm * tstep : cA; const char* nB = has_next ? (const char*)g.Bt + (size_t)nxt.pn * tstep : cB;
        for (int t = 0; t < nt; t += 2) {
            const bool last = (t == nt - 2);
            const char* a1 = cA + (size_t)(t + 1) * kstep;
            const char* a2 = last ? nA : cA + (size_t)(t + 2) * kstep; const char* b2 = last ? nB : cB + (size_t)(t + 2) * kstep;
            const char* a3 = a2 + kstep; const char* b3 = b2 + kstep;
            if (last && has_next) S.a_ready(nxt);
            if constexpr (SP2) {
            PG8_LDB(B0, 0, 0); PG8_LDB(B1, 0, 1); PG8_SCHED; PG8_LDA(At, 0, 0); PG8_STAGE(PG8_SA(1, 1), a1 + hstep, voffA);
            PG8_WAIT_V(8); PG8_WAIT_L(0); PG8_BAR; PG8_MMA(0, 0, At, B0); PG8_MMA(0, 1, At, B1); PG8_BAR; PG8_SCHED;
            PG8_LDA(At, 0, 1); PG8_STAGE(PG8_SB(0, 0), b2, voffB); PG8_STAGE(PG8_SB(0, 1), b2 + hstep, voffB); PG8_STAGE(PG8_SA(0, 0), a2, voffA);
            PG8_WAIT_V(8); PG8_WAIT_L(0); PG8_BAR; PG8_MMA(1, 0, At, B0); PG8_MMA(1, 1, At, B1); PG8_BAR; PG8_SCHED;
            PG8_LDB(B0, 1, 0); PG8_LDB(B1, 1, 1); PG8_SCHED; PG8_LDA(At, 1, 0); PG8_STAGE(PG8_SA(0, 1), a2 + hstep, voffA);
            PG8_WAIT_V(8); PG8_WAIT_L(0); PG8_BAR; PG8_MMA(0, 0, At, B0); PG8_MMA(0, 1, At, B1); PG8_BAR; PG8_SCHED;
            PG8_LDA(At, 1, 1); PG8_STAGE(PG8_SB(1, 0), b3, voffB); PG8_STAGE(PG8_SB(1, 1), b3 + hstep, voffB); PG8_STAGE(PG8_SA(1, 0), a3, voffA);
            PG8_WAIT_V(8); PG8_WAIT_L(0); PG8_BAR; PG8_MMA(1, 0, At, B0); PG8_MMA(1, 1, At, B1); PG8_BAR; PG8_SCHED;
            } else {
            PG8_LDB(B0, 0, 0); PG8_SCHED; PG8_LDA(At, 0, 0); PG8_STAGE(PG8_SA(1, 1), a1 + hstep, voffA);
            PG8_WAIT_L(8); PG8_BAR; PG8_WAIT_L(0); PG8_MMA(0, 0, At, B0); PG8_BAR; PG8_SCHED;
            PG8_LDB(B1, 0, 1); PG8_STAGE(PG8_SB(0, 0), b2, voffB);
            PG8_BAR; PG8_WAIT_L(0); PG8_MMA(0, 1, At, B1); PG8_BAR;
            PG8_LDA(At, 0, 1); PG8_STAGE(PG8_SA(0, 0), a2, voffA);
            PG8_BAR; PG8_WAIT_L(0); PG8_MMA(1, 0, At, B0); PG8_BAR; PG8_SCHED;
            PG8_STAGE(PG8_SB(0, 1), b2 + hstep, voffB);
            PG8_WAIT_V(6); PG8_BAR; PG8_MMA(1, 1, At, B1); PG8_BAR;
            PG8_LDB(B0, 1, 0); PG8_SCHED; PG8_LDA(At, 1, 0); PG8_STAGE(PG8_SA(0, 1), a2 + hstep, voffA);
            PG8_WAIT_L(8); PG8_BAR; PG8_WAIT_L(0); PG8_MMA(0, 0, At, B0); PG8_BAR; PG8_SCHED;
            PG8_LDB(B1, 1, 1); PG8_STAGE(PG8_SB(1, 0), b3, voffB);
            PG8_BAR; PG8_WAIT_L(0); PG8_MMA(0, 1, At, B1); PG8_BAR;
            PG8_LDA(At, 1, 1); PG8_STAGE(PG8_SA(1, 0), a3, voffA);
            PG8_BAR; PG8_WAIT_L(0); PG8_MMA(1, 0, At, B0); PG8_BAR; PG8_SCHED;
            PG8_STAGE(PG8_SB(1, 1), b3 + hstep, voffB);
            PG8_WAIT_V(6); PG8_BAR; PG8_MMA(1, 1, At, B1); PG8_BAR;
            }
        }
        if constexpr (ALIGN_EPI) { if (wr == 0) PG8_BAR; }
        if constexpr (!Epi::AFTER_DRAIN) { E(acc, cur, wr, wc, fr, fq); S.done(cur); }
        if (!has_next) break;
#pragma unroll
        for (int a = 0; a < 2; ++a)
#pragma unroll
            for (int b = 0; b < 2; ++b)
#pragma unroll
                for (int m = 0; m < 4; ++m)
#pragma unroll
                    for (int n = 0; n < 2; ++n) acc[a][b][m][n] = (f32x4){0.f, 0.f, 0.f, 0.f};
        cur = nxt; cA = nA; cB = nB; ++ui;
        if constexpr (ALIGN_EPI) { if (wr == 1) PG8_BAR; }
    }
    PG8_WAIT_V(0);
    if constexpr (!ALIGN_EPI) { if (wr == 0) PG8_BAR; }
    PG8_BAR;
    if constexpr (Epi::AFTER_DRAIN) { E.fused(acc, cur, wr, wc, fr, fq, lds, wid, lane); S.done(cur); }
#undef PG8_SA
#undef PG8_SB
#undef PG8_STAGE
#undef PG8_LDA
#undef PG8_LDB
#undef PG8_MMA
#undef PG8_WAIT_V
#undef PG8_WAIT_L
#undef PG8_BAR
#undef PG8_SCHED
}
}

#define GAS __attribute__((address_space(1)))
#define LAS __attribute__((address_space(3)))

#define XB_TMO      128
#define XB_XCNT(j)  (256  + 64 * (j))
#define XB_XSUB(j)  (1280 + 64 * (j))
#define XB_XGEN(j)  (2304 + 64 * (j))
#define XB_TOP      3328
#define XB_TOPGEN   3392
#define XCD_BAR_WORDS 3456
#define XB_SPIN_CAP (1u << 18)

__device__ __forceinline__ unsigned xb_ld(unsigned* p)              { return __hip_atomic_load(p, __ATOMIC_RELAXED, __HIP_MEMORY_SCOPE_AGENT); }
__device__ __forceinline__ unsigned xb_add(unsigned* p, unsigned v) { return __hip_atomic_fetch_add(p, v, __ATOMIC_RELAXED, __HIP_MEMORY_SCOPE_AGENT); }
__device__ __forceinline__ unsigned xb_xcc_id() { return (unsigned)__builtin_amdgcn_s_getreg((3 << 11) | 20) & 0xFu; }
#define XB_SPIN(cond, bar) do { unsigned _sp = 0; while (cond) { __builtin_amdgcn_s_sleep(1); \
    if ((++_sp & 255u) == 0u) { if (xb_ld(&(bar)[XB_TMO])) break; if (_sp > XB_SPIN_CAP) { atomicAdd(&(bar)[XB_TMO], 1u); break; } } } } while (0)

struct XcdBarrier {
    unsigned* bar; unsigned x;
    volatile LAS unsigned* st;
};

__device__ __forceinline__ XcdBarrier xcd_barrier_post(unsigned* bar, volatile LAS unsigned* st) {
    XcdBarrier b; b.bar = bar; b.x = xb_xcc_id(); b.st = st;
    if (threadIdx.x == 0) (void)xb_add(&bar[XB_XCNT(b.x)], 1u);
    return b;
}
__device__ __forceinline__ void xcd_barrier_complete(unsigned* bar, unsigned x, unsigned& nloc, unsigned& nx) {
    const unsigned G = gridDim.x * gridDim.y * gridDim.z;
    unsigned sum, cnt, mine, sp = 0u;
    for (;;) {
        sum = 0u; cnt = 0u; mine = 0u;
#pragma unroll
        for (unsigned j = 0; j < 16; ++j) { const unsigned c = xb_ld(&bar[XB_XCNT(j)]); sum += c; cnt += (c > 0u) ? 1u : 0u; mine = (j == x) ? c : mine; }
        if (sum == G) break;
        __builtin_amdgcn_s_sleep(1);
        if ((++sp & 255u) == 0u) { if (xb_ld(&bar[XB_TMO])) break; if (sp > XB_SPIN_CAP) { atomicAdd(&bar[XB_TMO], 1u); break; } }
    }
    nloc = mine > 0u ? mine : 1u; nx = cnt > 0u ? cnt : 1u;
}

__device__ __forceinline__ void xcd_barrier(const XcdBarrier& b) {
    asm volatile("s_waitcnt vmcnt(0)" ::: "memory");
    __syncthreads();
    if (threadIdx.x == 0) {
        unsigned* bar = b.bar;
        __builtin_amdgcn_s_waitcnt(0);
        unsigned nloc = b.st[0], nx = b.st[1];
        if (nloc == 0u) { xcd_barrier_complete(bar, b.x, nloc, nx); b.st[0] = nloc; b.st[1] = nx; }
        const unsigned old = xb_add(&bar[XB_XSUB(b.x)], 1u);
        const unsigned gen = old / nloc;
        if (old + 1u == (gen + 1u) * nloc) {
            __builtin_amdgcn_fence(__ATOMIC_RELEASE, "agent");
            asm volatile("s_waitcnt vmcnt(0)" ::: "memory");
            const unsigned og = xb_add(&bar[XB_TOP], 1u);
            const unsigned tg = og / nx;
            if (og + 1u == (tg + 1u) * nx) xb_add(&bar[XB_TOPGEN], 1u);
            else XB_SPIN(xb_ld(&bar[XB_TOPGEN]) == tg, bar);
            __builtin_amdgcn_fence(__ATOMIC_ACQUIRE, "agent");
            xb_add(&bar[XB_XGEN(b.x)], 1u);
            asm volatile("s_waitcnt vmcnt(0)" ::: "memory");
        } else {
            XB_SPIN(xb_ld(&bar[XB_XGEN(b.x)]) == gen, bar);
            __builtin_amdgcn_fence(__ATOMIC_ACQUIRE, "agent");
            asm volatile("s_waitcnt vmcnt(0)" ::: "memory");
        }
    }
    __syncthreads();
}


constexpr int NWAVES = 8, NTHREADS = 512;
constexpr int D = 1024, NB = 2, SEQ = 8192, M = NB * SEQ, GW = 64, GROWS = 128, NH = 16, HD = 64;
constexpr int FFN = 2816, NE = 8, ED = 1792, QL = 256, KVL = 128, RP = 32, DOWN_N = 416, DOWN_NP = 512, QKD = 96;
constexpr int MP_MAX = 34816;
constexpr float NORM_EPS = 1e-6f;
constexpr float LOG2E = 1.4426950408889634f;
constexpr float QSCALE1 = 0.10206207261596577f * LOG2E;

constexpr size_t MiB = 1u << 20;
constexpr size_t WS_CTL = 0, CTL_ZERO_BYTES = 64 * 1024;
constexpr size_t WS_PART = 4 * MiB;
constexpr size_t WS_MODF = 2 * MiB;
constexpr size_t WS_ROPER = WS_MODF + 128 * 1024;
constexpr size_t WS_ROPEC = WS_ROPER + 16 * 1024;
constexpr size_t WS_CNTWG = WS_ROPEC + 16 * 1024;
constexpr size_t WS_TOKE = 3 * MiB;
constexpr size_t WS_TOKP = WS_TOKE + 128 * 1024;
constexpr size_t WS_TOKW = WS_TOKP + 128 * 1024;
constexpr size_t WS_TOKS = WS_TOKW + 128 * 1024;
constexpr size_t WS_W = 8 * MiB;
constexpr size_t WS_WQK = WS_W, WS_WV = WS_WQK + 4 * MiB, WS_WO0 = WS_WV + 2 * MiB, WS_WGU0 = WS_WO0 + 2 * MiB, WS_WDN0 = WS_WGU0 + 11 * MiB;
constexpr size_t WS_WMD = WS_WDN0 + 5632 * 1024, WS_WUQ = WS_WMD + 1 * MiB, WS_WKN = WS_WUQ + 768 * 1024, WS_WVV = WS_WKN + 512 * 1024, WS_WO1 = WS_WVV + 512 * 1024;
constexpr size_t WS_WGU1 = WS_WO1 + 2 * MiB, WS_WDN1 = WS_WGU1 + 56 * MiB, WS_WEND = WS_WDN1 + 28 * MiB;
static_assert(WS_WEND <= 122 * MiB, "weights");
constexpr size_t WS_XA = 122 * MiB;
constexpr size_t WS_HN = 186 * MiB;
constexpr size_t WS_R = 218 * MiB;
constexpr size_t WS_Q0 = WS_R, WS_K0 = WS_R + 32 * MiB, WS_VT0 = WS_R + 64 * MiB, WS_O0 = WS_R + 96 * MiB;
constexpr size_t WS_ACT0 = WS_R;
constexpr size_t WS_DOWN = WS_R, WS_CQ = WS_R + 32 * MiB, WS_CKV = WS_R + 40 * MiB, WS_KR = WS_R + 48 * MiB;
constexpr size_t WS_Q1 = WS_R + 49 * MiB, WS_KN = WS_R + 97 * MiB, WS_VT1 = WS_R + 129 * MiB, WS_O1 = WS_R + 161 * MiB;
constexpr size_t WS_HP = WS_R, WS_ACT1 = WS_R + 68 * MiB;
constexpr size_t WS_END = WS_R + 193 * MiB;
static_assert(WS_ACT1 + (size_t)MP_MAX * ED * 2 <= WS_END && WS_END <= 448 * MiB, "d_ws map");

constexpr int RING_BYTES = 131072, MISC_OFF = 155648, LDS_BYTES = 159744;

typedef unsigned short bf16;
typedef unsigned v4u __attribute__((ext_vector_type(4)));
typedef unsigned v2u __attribute__((ext_vector_type(2)));
typedef float f32x4 __attribute__((ext_vector_type(4)));
typedef float f32x2 __attribute__((ext_vector_type(2)));
typedef float f32x16 __attribute__((ext_vector_type(16)));
typedef short bf16x8 __attribute__((ext_vector_type(8)));
typedef GAS unsigned gu32;
#define RLX_AGENT __ATOMIC_RELAXED, __HIP_MEMORY_SCOPE_AGENT
#define LDS_WAIT() asm volatile("s_waitcnt lgkmcnt(0)" ::: "memory")
__device__ __forceinline__ unsigned pk2(float lo, float hi) { unsigned r; asm volatile("v_cvt_pk_bf16_f32 %0, %1, %2" : "=v"(r) : "v"(lo), "v"(hi)); return r; }
__device__ __forceinline__ float bf2f(unsigned short h) { return __builtin_bit_cast(float, (unsigned)h << 16); }
__device__ __forceinline__ float bflo(unsigned w) { return __builtin_bit_cast(float, w << 16); }
__device__ __forceinline__ float bfhi(unsigned w) { return __builtin_bit_cast(float, w & 0xffff0000u); }
__device__ __forceinline__ float wave_sum(float v) {
#pragma unroll
    for (int o = 1; o < 64; o <<= 1) v += __shfl_xor(v, o);
    return v;
}

template <typename TX> struct XRow;
template <> struct XRow<float> { static __device__ __forceinline__ f32x4 ld(const float* X, size_t row, int col) { return *(const GAS f32x4*)(X + row * 1024 + col); } };
template <> struct XRow<bf16> { static __device__ __forceinline__ f32x4 ld(const bf16* X, size_t row, int col) { const v2u w = *(const GAS v2u*)(X + row * 1024 + col); return (f32x4){bflo(w.x), bfhi(w.x), bflo(w.y), bfhi(w.y)}; } };

struct Frame {
    LAS unsigned char* lds; volatile LAS unsigned* MISC;
    int tid, lane, wave, vcu, G, gw, NGW;
    const float* in[19]; float* out; unsigned char* ws;
};
#define WSP(T, off) ((T*)(F.ws + (off)))

__device__ __forceinline__ void tr_item(const float* W, int ldn, int k0, int n0, bf16* WT, int ldk, int drow0, LAS float* scr, int lane) {
    { f32x4 v[8]; const int rr = lane >> 3, c4 = (lane & 7) * 4;
#pragma unroll
      for (int i = 0; i < 8; ++i) v[i] = *(const f32x4*)(W + (size_t)(k0 + 8 * i + rr) * ldn + n0 + c4);
#pragma unroll
      for (int i = 0; i < 8; ++i) { LAS float* d = scr + (8 * i + rr) * 33 + c4; d[0] = v[i].x; d[1] = v[i].y; d[2] = v[i].z; d[3] = v[i].w; } }
    LDS_WAIT(); asm volatile("" ::: "memory");
    const int c = lane & 7;
#pragma unroll
    for (int j = 0; j < 4; ++j) { const int n = (lane >> 3) + 8 * j; const LAS float* s = scr + (8 * c) * 33 + n;
        v4u o; o.x = pk2(s[0 * 33], s[1 * 33]); o.y = pk2(s[2 * 33], s[3 * 33]); o.z = pk2(s[4 * 33], s[5 * 33]); o.w = pk2(s[6 * 33], s[7 * 33]);
        *(GAS v4u*)(WT + (size_t)(drow0 + n) * ldk + k0 + 8 * c) = o; }
    LDS_WAIT(); asm volatile("" ::: "memory");
}
__device__ __forceinline__ int gu_row(int n0, int F_) { const int up = n0 >= F_, j = up ? n0 - F_ : n0; return 256 * (j >> 7) + (up ? 128 : 0) + (j & 127); }
__device__ __forceinline__ float silu_acc(float v) { return v / (1.f + expf(-v)); }
constexpr int MOE_I8 = 8 * 16 * 112, MOE_I9 = 8 * 28 * 32, MOE_ITEMS = MOE_I8 + MOE_I9;
constexpr int MOE_G1 = 128 * 40, MOE_G2 = 128 * 48, MOE_G3 = 144 * 24;
__device__ __forceinline__ void moe_w_item(Frame& F, int r, LAS float* scr, int lane) {
    if (r < MOE_I8) { const int e = r / (16 * 112), q = r % (16 * 112), kb = q / 112, nb = q % 112;
        tr_item(F.in[16] + (size_t)e * D * 2 * ED, 2 * ED, 64 * kb, 32 * nb, WSP(bf16, WS_WGU1), D, e * 2 * ED + gu_row(32 * nb, ED), scr, lane); }
    else { r -= MOE_I8; const int e = r / (28 * 32), q = r % (28 * 32), kb = q / 32, nb = q % 32;
        tr_item(F.in[17] + (size_t)e * ED * D, D, 64 * kb, 32 * nb, WSP(bf16, WS_WDN1), ED, e * D + 32 * nb, scr, lane); }
}
__device__ __forceinline__ void moe_w_side(Frame& F, int lo, int hi, int first_wg) {
    if (F.G != 256 || (int)blockIdx.x < first_wg) return;
    LAS float* scr = (LAS float*)(F.lds + F.wave * 16384);
    for (int it = lo + ((int)blockIdx.x - first_wg) * NWAVES + F.wave; it < hi; it += (256 - first_wg) * NWAVES) moe_w_item(F, it, scr, F.lane);
}
__device__ __forceinline__ void p0_prologue(Frame& F) {
    LAS float* scr = (LAS float*)(F.lds + F.wave * 16384);
    const int lane = F.lane;
    constexpr int I0 = 16 * 96, I1 = 16 * 32, I2 = 16 * 176, I3 = 44 * 32, I4 = 16 * 13, I5 = 4 * 48, I6 = 2 * 64, I7 = 16 * 32;
    const int NMOE0 = (F.G == 256) ? MOE_ITEMS - MOE_G1 - MOE_G2 - MOE_G3 : MOE_ITEMS;
    constexpr int IA = 2 * 96 * 16;
    constexpr int IZ = 96 + 2 * 1024;
    const int NITEMS = I0 + I1 + I2 + I3 + I4 + I5 + I6 + I7 + NMOE0 + IA + IZ + 1;
    for (int it = F.gw; it < NITEMS; it += F.NGW) {
        int r = it;
        if (r < NMOE0) { moe_w_item(F, r, scr, lane); continue; } r -= NMOE0;
        if (r < I0) { const int kb = r / 96, nb = r % 96, n0 = 32 * nb;
            if (n0 < 2048) tr_item(F.in[4], 3 * D, 64 * kb, n0, WSP(bf16, WS_WQK), D, n0, scr, lane); else tr_item(F.in[4], 3 * D, 64 * kb, n0, WSP(bf16, WS_WV), D, n0 - 2048, scr, lane);
            continue; } r -= I0;
        if (r < I1) { tr_item(F.in[6], D, 64 * (r / 32), 32 * (r % 32), WSP(bf16, WS_WO0), D, 32 * (r % 32), scr, lane); continue; } r -= I1;
        if (r < I2) { const int kb = r / 176, nb = r % 176; tr_item(F.in[7], 2 * FFN, 64 * kb, 32 * nb, WSP(bf16, WS_WGU0), D, gu_row(32 * nb, FFN), scr, lane); continue; } r -= I2;
        if (r < I3) { tr_item(F.in[8], D, 64 * (r / 32), 32 * (r % 32), WSP(bf16, WS_WDN0), FFN, 32 * (r % 32), scr, lane); continue; } r -= I3;
        if (r < I4) { tr_item(F.in[9], DOWN_N, 64 * (r / 13), 32 * (r % 13), WSP(bf16, WS_WMD), D, 32 * (r % 13), scr, lane); continue; } r -= I4;
        if (r < I5) { tr_item(F.in[11], 1536, 64 * (r / 48), 32 * (r % 48), WSP(bf16, WS_WUQ), QL, 32 * (r % 48), scr, lane); continue; } r -= I5;
        if (r < I6) { const int kb = r / 64, nb = r % 64, h = nb >> 2, q = nb & 3;
            if (q < 2) tr_item(F.in[13], 2048, 64 * kb, 32 * nb, WSP(bf16, WS_WKN), 256, h * 64 + 32 * q, scr, lane); else tr_item(F.in[13], 2048, 64 * kb, 32 * nb, WSP(bf16, WS_WVV), 256, h * 64 + 32 * (q - 2), scr, lane);
            continue; } r -= I6;
        if (r < I7) { tr_item(F.in[14], D, 64 * (r / 32), 32 * (r % 32), WSP(bf16, WS_WO1), D, 32 * (r % 32), scr, lane); continue; } r -= I7;
        if (r < IA) {
            const int l = r / (96 * 16), q = r % (96 * 16), cg = q / 16, kc = q % 16, n = 64 * cg + lane;
            const float* w = F.in[2] + (size_t)l * D * 6 * D + n; const float* c = F.in[1];
            float a0 = 0.f, a1 = 0.f;
#pragma unroll 32
            for (int k = 64 * kc; k < 64 * kc + 64; ++k) { const float wv = w[(size_t)k * 6 * D]; a0 += silu_acc(c[k]) * wv; a1 += silu_acc(c[D + k]) * wv; }
            float* part = WSP(float, WS_PART) + ((size_t)(kc * 2 + l) * 2) * 6 * D + n;
            part[0] = a0; part[6 * D] = a1; continue; } r -= IA;
        if (r < IZ) {
            if (r < 96) { GAS v4u* p = (GAS v4u*)(WSP(bf16, WS_WMD) + (size_t)(DOWN_N + r) * D); p[lane] = (v4u){0u, 0u, 0u, 0u}; p[64 + lane] = (v4u){0u, 0u, 0u, 0u}; }
            else { const int q = r - 96, row = q & 1023; bf16* base = (q < 1024 ? WSP(bf16, WS_WKN) : WSP(bf16, WS_WVV)) + (size_t)row * 256 + 128; ((GAS unsigned*)base)[lane] = 0u; }
            continue; } r -= IZ;
        {
            for (int idx = lane; idx < (128 + 64) * 8; idx += 64) { const int isc = idx >= 1024, q = isc ? idx - 1024 : idx, i = q >> 3, p = q & 7;
                const float inv = powf(10000.f, -(float)p / 8.f), a = (float)i * inv;
                float* t = (isc ? WSP(float, WS_ROPEC) : WSP(float, WS_ROPER)) + i * 16 + 2 * p; t[0] = cosf(a); t[1] = sinf(a); }
        }
    }
}
__device__ __forceinline__ f32x4 mod4_partials(Frame& F, int l, int b, int n) {
    f32x4 a = *(const f32x4*)(F.in[3] + l * 6 * D + n);
#pragma unroll
    for (int kc = 0; kc < 16; ++kc) a += *(const f32x4*)(WSP(float, WS_PART) + ((size_t)((kc * 2 + l) * 2 + b)) * 6 * D + n);
    return a;
}
template <bool FROM_PART, typename TX> __device__ __forceinline__ void modulate_phase(Frame& F, const TX* X, int l, int cs, bf16* HNo) {
    for (int b = 0; b < NB; ++b) {
        f32x4 sh[4], sc[4];
#pragma unroll
        for (int j = 0; j < 4; ++j) { const int n = 4 * F.lane + 256 * j;
            if (FROM_PART) { sh[j] = mod4_partials(F, l, b, cs * D + n); sc[j] = mod4_partials(F, l, b, (cs + 1) * D + n); }
            else { const float* mf = WSP(float, WS_MODF) + (size_t)(l * 2 + b) * 6 * D; sh[j] = *(const f32x4*)(mf + cs * D + n); sc[j] = *(const f32x4*)(mf + (cs + 1) * D + n); }
            sc[j] = sc[j] + 1.f; }
        for (int row = b * SEQ + F.gw; row < (b + 1) * SEQ; row += 4 * F.NGW) {
            f32x4 v[4][4]; float ss[4]; bool ok[4];
#pragma unroll
            for (int q = 0; q < 4; ++q) { ok[q] = row + q * F.NGW < (b + 1) * SEQ; const int rq = ok[q] ? row + q * F.NGW : row;
#pragma unroll
                for (int j = 0; j < 4; ++j) v[q][j] = XRow<TX>::ld(X, (size_t)rq, 4 * F.lane + 256 * j); }
#pragma unroll
            for (int q = 0; q < 4; ++q) { ss[q] = 0.f;
#pragma unroll
                for (int j = 0; j < 4; ++j) ss[q] += (v[q][j].x * v[q][j].x + v[q][j].y * v[q][j].y) + (v[q][j].z * v[q][j].z + v[q][j].w * v[q][j].w); }
#pragma unroll
            for (int o = 1; o < 64; o <<= 1)
#pragma unroll
                for (int q = 0; q < 4; ++q) ss[q] += __shfl_xor(ss[q], o);
#pragma unroll
            for (int q = 0; q < 4; ++q) if (ok[q]) { const float rstd = rsqrtf(ss[q] * (1.f / D) + NORM_EPS); GAS v2u* o8 = (GAS v2u*)(HNo + (size_t)(row + q * F.NGW) * D) + F.lane;
#pragma unroll
                for (int j = 0; j < 4; ++j) { const f32x4 y = v[q][j] * rstd * sc[j] + sh[j]; v2u w; w.x = pk2(y.x, y.y); w.y = pk2(y.z, y.w); o8[64 * j] = w; } }
        }
    }
}
__device__ __forceinline__ void modf_reduce(Frame& F) {
    for (int i = blockIdx.x * NTHREADS + F.tid; i < 2 * 2 * 6 * D; i += F.G * NTHREADS) {
        const int l = i / (2 * 6 * D), q = i % (2 * 6 * D), n = q % (6 * D), b = q / (6 * D);
        float a = F.in[3][l * 6 * D + n];
#pragma unroll
        for (int kc = 0; kc < 16; ++kc) a += WSP(float, WS_PART)[((size_t)((kc * 2 + l) * 2 + b)) * 6 * D + n];
        WSP(float, WS_MODF)[i] = a;
    }
}
__device__ __forceinline__ void mla_mid_phase(Frame& F) {
    const float* DOWN = WSP(float, WS_DOWN); const float* qn = F.in[10]; const float* kvn = F.in[12];
    const f32x4 qn4 = *(const f32x4*)(qn + 4 * F.lane); const f32x2 kn2 = *(const f32x2*)(kvn + 2 * F.lane);
    for (int row = F.gw; row < M; row += F.NGW) {
        const float* dr = DOWN + (size_t)row * DOWN_NP; const int t = row & (SEQ - 1);
        const f32x4 a = *(const f32x4*)(dr + 4 * F.lane); const f32x2 k = *(const f32x2*)(dr + QL + 2 * F.lane);
        const float rq = rsqrtf(wave_sum((a.x * a.x + a.y * a.y) + (a.z * a.z + a.w * a.w)) * (1.f / QL) + NORM_EPS);
        const float rk = rsqrtf(wave_sum(k.x * k.x + k.y * k.y) * (1.f / KVL) + NORM_EPS);
        v2u w; w.x = pk2(a.x * rq * qn4.x, a.y * rq * qn4.y); w.y = pk2(a.z * rq * qn4.z, a.w * rq * qn4.w);
        *((GAS v2u*)(WSP(bf16, WS_CQ) + (size_t)row * QL) + F.lane) = w;
        GAS unsigned* ck = (GAS unsigned*)(WSP(bf16, WS_CKV) + (size_t)row * 256);
        ck[F.lane] = pk2(k.x * rk * kn2.x, k.y * rk * kn2.y); ck[64 + F.lane] = 0u;
        if (F.lane < 16) { const f32x2 x = *(const f32x2*)(dr + QL + KVL + 2 * F.lane);
            const float* tb = F.lane < 8 ? WSP(float, WS_ROPER) + (t >> 6) * 16 + 2 * F.lane : WSP(float, WS_ROPEC) + (t & 63) * 16 + 2 * (F.lane - 8);
            const float cs = tb[0], sn = tb[1];
            ((GAS unsigned*)(WSP(bf16, WS_KR) + (size_t)row * RP))[F.lane] = pk2(x.x * cs - x.y * sn, x.x * sn + x.y * cs); }
    }
}
namespace na {
constexpr int L_K = 0, L_V = 73728, L_B = 147456, L_END = L_B + 15 * 64 * 4;
}
__device__ __forceinline__ void na_phase(Frame& F) {
    const bf16* Q = WSP(bf16, WS_Q0); const bf16* K = WSP(bf16, WS_K0); const bf16* VT = WSP(bf16, WS_VT0); bf16* O = WSP(bf16, WS_O0);
    const int tid = F.tid, lane = F.lane, l16 = lane & 15, g = lane >> 4;
    LAS float* rpbH = (LAS float*)(F.lds + na::L_B);
    const int scol = tid >> 3, sc = tid & 7;
    const unsigned kdst = (unsigned)((scol * 8 + (sc ^ ((scol & 2) ^ ((scol & 8) >> 1)))) * 16), vdst = (unsigned)((scol * 8 + (sc ^ (scol & 6))) * 16);
    const int ri = F.wave >> 2, ct = F.wave & 3;
    const int c0 = 16 * ct, kc0 = ct == 0 ? 0 : (ct == 1 ? 8 : (ct == 2 ? 24 : 32));
    const int c = c0 + l16; int cs = c - 8; cs = cs < 0 ? 0 : (cs > GW - 16 ? GW - 16 : cs);
    const int kcolA = kc0 + 8 * (l16 >> 2) + (l16 & 3), kxv = (kcolA & 2) ^ ((kcolA & 8) >> 1);
    const unsigned kch0 = (unsigned)((kcolA * 8 + (g ^ kxv)) * 16), kch1 = (unsigned)((kcolA * 8 + ((4 + g) ^ kxv)) * 16);
    const unsigned vch = (unsigned)((l16 * 8 + (((kc0 >> 3) + g) ^ (l16 & 6))) * 16);
    const int dc0 = kc0 + 8 * g - c + 15, t0 = kc0 + 8 * g - cs;
    float pen[8];
#pragma unroll
    for (int k = 0; k < 8; ++k) pen[k] = (unsigned)(t0 + k) < 16u ? 0.f : -1e30f;
    for (int w = F.vcu; w < NB * NH * 8; w += F.G) {
        const int bh = w >> 3, b = bh >> 4, h = bh & 15, rp0 = (w & 7) * 8;
        __syncthreads();
        for (int i = tid; i < 15 * 64; i += NTHREADS) { const int dc = (i & 63) - 8; rpbH[i] = (dc >= 0 && dc <= 30) ? F.in[5][(h * 15 + (i >> 6)) * 31 + dc] * LOG2E : 0.f; }
        const bf16* kbase = K + ((size_t)h * M + (size_t)b * SEQ) * HD + scol * HD + sc * 8;
        const bf16* vbase = VT + ((size_t)(b * GROWS) * D + h * HD + scol) * GW + sc * 8;
        bf16x8 kst[9], vst[9];
#define NA_LOAD(rp_) do { int R0_ = 2 * (rp_) - 4; R0_ = R0_ < 0 ? 0 : (R0_ > GROWS - 8 ? GROWS - 8 : R0_); \
        _Pragma("unroll") for (int i_ = 0; i_ < 9; ++i_) { const int row_ = (R0_ + i_) > GROWS - 1 ? GROWS - 1 : (R0_ + i_); \
            kst[i_] = *(const bf16x8*)(kbase + (size_t)row_ * GW * HD); vst[i_] = *(const bf16x8*)(vbase + (size_t)row_ * D * GW); } } while (0)
        NA_LOAD(rp0);
        for (int st = 0; st < 8; ++st) {
            const int rp = rp0 + st;
            __syncthreads();
#pragma unroll
            for (int i = 0; i < 9; ++i) { *(LAS bf16x8*)(F.lds + na::L_K + i * 8192 + kdst) = kst[i]; *(LAS bf16x8*)(F.lds + na::L_V + i * 8192 + vdst) = vst[i]; }
            __syncthreads();
            if (st + 1 < 8) NA_LOAD(rp + 1);
            __builtin_amdgcn_sched_barrier(0);
            const int r = 2 * rp + ri; int rs = r - 4; rs = rs < 0 ? 0 : (rs > GROWS - 8 ? GROWS - 8 : rs);
            int R0 = 2 * rp - 4; R0 = R0 < 0 ? 0 : (R0 > GROWS - 8 ? GROWS - 8 : R0);
            const int roff = rs - R0;
            const size_t tq = (size_t)b * SEQ + r * GW + c;
            bf16x8 qf[2];
#pragma unroll
            for (int ks = 0; ks < 2; ++ks) qf[ks] = *(const bf16x8*)(Q + tq * D + h * HD + 32 * ks + 8 * g);
            const LAS unsigned char* kl = F.lds + na::L_K + roff * 8192; const LAS unsigned char* vl = F.lds + na::L_V + roff * 8192;
            pg8::f32x4 s[8][2];
#pragma unroll
            for (int kr = 0; kr < 8; ++kr)
#pragma unroll
                for (int blk = 0; blk < 2; ++blk) {
                    const bf16x8 k0 = *(const LAS bf16x8*)(kl + kr * 8192 + blk * 512 + kch0), k1 = *(const LAS bf16x8*)(kl + kr * 8192 + blk * 512 + kch1);
                    pg8::f32x4 a = {0.f, 0.f, 0.f, 0.f};
                    a = __builtin_amdgcn_mfma_f32_16x16x32_bf16(k0, qf[0], a, 0, 0, 0);
                    a = __builtin_amdgcn_mfma_f32_16x16x32_bf16(k1, qf[1], a, 0, 0, 0);
                    s[kr][blk] = a; if (blk == 1 && (kr & 1)) __builtin_amdgcn_sched_barrier(0); }
            const LAS float* bp = rpbH + (rs - r + 7) * 64 + dc0 + 8;
            float mx = -1e30f;
#pragma unroll
            for (int kr = 0; kr < 8; ++kr)
#pragma unroll
                for (int blk = 0; blk < 2; ++blk)
#pragma unroll
                    for (int i = 0; i < 4; ++i) { const float v = (s[kr][blk][i] + bp[kr * 64 + 4 * blk + i]) + pen[4 * blk + i]; s[kr][blk][i] = v; mx = fmaxf(mx, v); }
            mx = fmaxf(mx, __shfl_xor(mx, 16)); mx = fmaxf(mx, __shfl_xor(mx, 32));
            float sum = 0.f;
#pragma unroll
            for (int kr = 0; kr < 8; ++kr)
#pragma unroll
                for (int blk = 0; blk < 2; ++blk)
#pragma unroll
                    for (int i = 0; i < 4; ++i) { const float e = __builtin_amdgcn_exp2f(s[kr][blk][i] - mx); s[kr][blk][i] = e; sum += e; }
            sum += __shfl_xor(sum, 16); sum += __shfl_xor(sum, 32);
            const float inv = 1.f / sum;
            pg8::f32x4 o[4];
#pragma unroll
            for (int db = 0; db < 4; ++db) o[db] = (pg8::f32x4){0.f, 0.f, 0.f, 0.f};
#pragma unroll
            for (int kr = 0; kr < 8; ++kr) {
                v4u pw; pw.x = pk2(s[kr][0][0], s[kr][0][1]); pw.y = pk2(s[kr][0][2], s[kr][0][3]); pw.z = pk2(s[kr][1][0], s[kr][1][1]); pw.w = pk2(s[kr][1][2], s[kr][1][3]);
                const bf16x8 pf = __builtin_bit_cast(bf16x8, pw);
#pragma unroll
                for (int db = 0; db < 4; ++db) { const bf16x8 vf = *(const LAS bf16x8*)(vl + kr * 8192 + db * 2048 + vch);
                    o[db] = __builtin_amdgcn_mfma_f32_16x16x32_bf16(vf, pf, o[db], 0, 0, 0); }
                if (kr & 1) __builtin_amdgcn_sched_barrier(0); }
            bf16* op = O + tq * D + h * HD + 4 * g;
#pragma unroll
            for (int db = 0; db < 4; ++db) { v2u wv; wv.x = pk2(o[db][0] * inv, o[db][1] * inv); wv.y = pk2(o[db][2] * inv, o[db][3] * inv); *(GAS v2u*)(op + 16 * db) = wv; }
        }
#undef NA_LOAD
    }
    __syncthreads();
}
namespace mla {
constexpr int NSLOT = 4, KSLOT = 12288, VSLOT = 8192;
constexpr int L_K = 0, L_V = NSLOT * KSLOT, L_WS = L_V + NSLOT * VSLOT, L_OST = L_WS + 2048, L_BYTES = L_OST + 8 * 4096;
constexpr float THR = 8.f;
typedef LAS unsigned char lch;
__device__ __forceinline__ int crow(int r, int hi) { return (r & 3) + 8 * (r >> 2) + 4 * hi; }
__device__ __forceinline__ void glds16(const void* sbase, unsigned voff, unsigned lds_dst) { unsigned keep;
    asm volatile("s_mov_b32 %0, m0\n\ts_mov_b32 m0, %3\n\ts_nop 0\n\tglobal_load_lds_dwordx4 %1, %2\n\ts_mov_b32 m0, %0" : "=&s"(keep) : "v"(voff), "s"(sbase), "s"(lds_dst) : "memory"); }
#define MLA_WAIT_BAR(N) asm volatile("s_waitcnt vmcnt(" #N ") lgkmcnt(0)\n\ts_barrier" ::: "memory")
#define MLA_WAIT_FULL() do { if (wid < 4) { MLA_WAIT_BAR(6); } else { MLA_WAIT_BAR(4); } } while (0)
#define MLA_SBAR() __builtin_amdgcn_sched_barrier(0)
#define MLA_MF(a, b, c) __builtin_amdgcn_mfma_f32_32x32x16_bf16(a, b, c, 0, 0, 0)
#define MLA_PIN(x) asm volatile("" : "+v"(x))
#define MLA_EX(v) __builtin_amdgcn_exp2f(v)
__device__ __forceinline__ void unit(int b, int h, int qb, const bf16* Q1, const bf16* KN, const bf16* KR, const bf16* VT, bf16* O1, lch* lds) {
    const int tid = threadIdx.x, wid = __builtin_amdgcn_readfirstlane(tid >> 6), lane = tid & 63, r32 = lane & 31, hi = lane >> 5;
    const size_t rowbase = (size_t)b * SEQ; const int q0 = qb * 256;
    const unsigned lds0 = (unsigned)(uintptr_t)lds;
    LAS float* wsf = (LAS float*)(lds + L_WS) + wid * 64;
    const bf16* knb = KN + ((size_t)h * M + rowbase + 8 * wid) * HD; const bf16* krb = KR + (rowbase + 16 * (wid & 3)) * RP; const bf16* vb = VT + ((rowbase >> 6) * D + h * HD + 8 * wid) * GW;
    unsigned kno, kro, vo;
    { const int rl = lane >> 3, row = 8 * wid + rl, c = (lane & 7) ^ ((row >> 1) & 7); kno = (unsigned)((rl * HD + c * 8) * 2); }
    { const int rl = lane >> 2, row = 16 * (wid & 3) + rl, c = (lane & 3) ^ ((row >> 2) & 3); kro = (unsigned)((rl * RP + c * 8) * 2); }
    { const int dl = lane >> 3, d = 8 * wid + dl, c = (lane & 7) ^ ((d >> 1) & 7); vo = (unsigned)((dl * GW + c * 8) * 2); }
    const unsigned kndst = lds0 + L_K + wid * 1024, krdst = lds0 + L_K + 8192 + (wid & 3) * 1024, vdst = lds0 + L_V + wid * 1024;
#define DMA_K(t, slot) do { glds16(knb + (size_t)(t) * (64 * HD), kno, (unsigned)__builtin_amdgcn_readfirstlane(kndst + (slot))); if (wid < 4) glds16(krb + (size_t)(t) * (64 * RP), kro, (unsigned)__builtin_amdgcn_readfirstlane(krdst + (slot))); } while (0)
#define DMA_V(t, slot) glds16(vb + (size_t)(t) * (D * GW), vo, (unsigned)__builtin_amdgcn_readfirstlane(vdst + (slot)))
    const int rowA = (r32 & ~0xC) | ((r32 & 4) << 1) | ((r32 & 8) >> 1);
    const lch* kpn0 = lds + L_K + rowA * 128 + (((0 + hi) ^ ((rowA >> 1) & 7)) * 16); const lch* kpn1 = lds + L_K + rowA * 128 + (((2 + hi) ^ ((rowA >> 1) & 7)) * 16);
    const lch* kpn2 = lds + L_K + rowA * 128 + (((4 + hi) ^ ((rowA >> 1) & 7)) * 16); const lch* kpn3 = lds + L_K + rowA * 128 + (((6 + hi) ^ ((rowA >> 1) & 7)) * 16);
    const lch* kpr0 = lds + L_K + 8192 + rowA * 64 + (((0 + hi) ^ ((rowA >> 2) & 3)) * 16); const lch* kpr1 = lds + L_K + 8192 + rowA * 64 + (((2 + hi) ^ ((rowA >> 2) & 3)) * 16);
    const lch* vp0 = lds + L_V + r32 * 128 + (((0 + hi) ^ ((r32 >> 1) & 7)) * 16); const lch* vp1 = lds + L_V + r32 * 128 + (((2 + hi) ^ ((r32 >> 1) & 7)) * 16);
    const lch* vp2 = lds + L_V + r32 * 128 + (((4 + hi) ^ ((r32 >> 1) & 7)) * 16); const lch* vp3 = lds + L_V + r32 * 128 + (((6 + hi) ^ ((r32 >> 1) & 7)) * 16);
#define LDF(p) (*(const LAS bf16x8*)(p))
#define KLOAD_ALL(so) do { kf[0] = LDF(kpn0 + (so)); kf[1] = LDF(kpn0 + (so) + 4096); kf[2] = LDF(kpn1 + (so)); kf[3] = LDF(kpn1 + (so) + 4096); kf[4] = LDF(kpn2 + (so)); kf[5] = LDF(kpn2 + (so) + 4096); \
        kf[6] = LDF(kpn3 + (so)); kf[7] = LDF(kpn3 + (so) + 4096); kf[8] = LDF(kpr0 + (so)); kf[9] = LDF(kpr0 + (so) + 2048); kf[10] = LDF(kpr1 + (so)); kf[11] = LDF(kpr1 + (so) + 2048); } while (0)
    bf16x8 kf[12], qr[6];
    constexpr int NT = SEQ / 64;
    DMA_K(0, 0); DMA_V(0, 0); DMA_K(1, KSLOT);
    { const bf16* Qw = Q1 + (rowbase + q0 + wid * 32 + r32) * 1536 + h * QKD + hi * 8;
#pragma unroll
      for (int d0 = 0; d0 < 6; ++d0) qr[d0] = *(const bf16x8*)(Qw + d0 * 16); }
    DMA_V(1, VSLOT); DMA_K(2, 2 * KSLOT); DMA_K(3, 3 * KSLOT);
    float m_ref = 0.f, l_reg = 0.f; f32x16 o[2]; o[0] = f32x16{}; o[1] = f32x16{}; f32x16 negm;
    f32x16 pA0, pA1, pB0, pB1; bool resc = false;
    if (wid < 4) { MLA_WAIT_BAR(8); } else { MLA_WAIT_BAR(5); }
    KLOAD_ALL(0);
    { const f32x16 z = {};
      pA0 = MLA_MF(kf[0], qr[0], z); pA1 = MLA_MF(kf[1], qr[0], z);
#pragma unroll
      for (int d0 = 1; d0 < 6; ++d0) { pA0 = MLA_MF(kf[2 * d0], qr[d0], pA0); pA1 = MLA_MF(kf[2 * d0 + 1], qr[d0], pA1); } }
    { float rm = pA0[0];
#pragma unroll
      for (int r = 1; r < 16; ++r) rm = fmaxf(rm, pA0[r]);
#pragma unroll
      for (int r = 0; r < 16; ++r) rm = fmaxf(rm, pA1[r]);
      { auto rr = __builtin_amdgcn_permlane32_swap(__float_as_uint(rm), __float_as_uint(rm), false, false); rm = fmaxf(__uint_as_float(rr[0]), __uint_as_float(rr[1])); }
      m_ref = rm;
#pragma unroll
      for (int r = 0; r < 16; ++r) negm[r] = -m_ref;
      MLA_PIN(negm);
#pragma unroll
      for (int r = 0; r < 16; ++r) { pA0[r] = MLA_EX(pA0[r] - m_ref); pA1[r] = pA1[r] - m_ref; } }
    MLA_WAIT_BAR(0);
    DMA_K(4, 0); DMA_V(2, 2 * VSLOT);
    KLOAD_ALL(KSLOT);
    MLA_WAIT_FULL();
    bf16x8 vA0, vA1, vA2, vA3, vB0, vB1, vB2, vB3; v4u pw0, pw1, pw2, pw3;
#define PKW(P, B) pk2(P[B], P[(B) + 1])
#define PAF(k) __builtin_bit_cast(bf16x8, pw##k)
#define GAE(MF, X, B, A0, A1, A2, A3) do { MF; X[B] = MLA_EX(X[B]); X[(B) + 1] = MLA_EX(X[(B) + 1]); X[(B) + 2] = MLA_EX(X[(B) + 2]); X[(B) + 3] = MLA_EX(X[(B) + 3]); MLA_PIN(X); \
        sacc += A0; sacc += A1; sacc += A2; sacc += A3; MLA_PIN(sacc); MLA_SBAR(); } while (0)
#define GAC(MF, A0, A1, A2, A3, W0, W1, PW) do { MF; sacc += A0; sacc += A1; sacc += A2; sacc += A3; MLA_PIN(sacc); W0; W1; MLA_PIN(PW); MLA_SBAR(); } while (0)
#define GAW(MF, W0, W1, W2, W3, PW) do { MF; W0; W1; W2; W3; MLA_PIN(PW); MLA_SBAR(); } while (0)
#define GB(MF, X0, X1, J) do { MF; X0[J] = MLA_EX(X0[J]); X0[(J) + 1] = MLA_EX(X0[(J) + 1]); MLA_PIN(X0); MLA_SBAR(); } while (0)
#define STEP(C0, C1, P0, P1, t, R, GK, GV, GL) do { MLA_SBAR(); \
    constexpr int kc = (R) * KSLOT, kn = (((R) + 1) % 4) * KSLOT, vpv = (((R) + 3) % 4) * VSLOT, vn = (((R) + 2) % 4) * VSLOT; float sacc = 0.f; \
    vA0 = LDF(vp0 + vpv); MLA_SBAR(); GAE(C0 = MLA_MF(kf[0], qr[0], negm), P1, 0, P0[0], P0[1], P0[2], P0[3]); \
    vA1 = LDF(vp1 + vpv); MLA_SBAR(); GAE(C1 = MLA_MF(kf[1], qr[0], negm), P1, 4, P0[4], P0[5], P0[6], P0[7]); \
    vA2 = LDF(vp2 + vpv); MLA_SBAR(); GAE(C0 = MLA_MF(kf[2], qr[1], C0), P1, 8, P0[8], P0[9], P0[10], P0[11]); \
    vA3 = LDF(vp3 + vpv); MLA_SBAR(); GAE(C1 = MLA_MF(kf[3], qr[1], C1), P1, 12, P0[12], P0[13], P0[14], P0[15]); \
    GAC(C0 = MLA_MF(kf[4], qr[2], C0), P1[0], P1[1], P1[2], P1[3], pw0[0] = PKW(P0, 0), pw0[1] = PKW(P0, 2), pw0); \
    GAC(C1 = MLA_MF(kf[5], qr[2], C1), P1[4], P1[5], P1[6], P1[7], pw0[2] = PKW(P0, 4), pw0[3] = PKW(P0, 6), pw0); \
    GAC(C0 = MLA_MF(kf[6], qr[3], C0), P1[8], P1[9], P1[10], P1[11], pw1[0] = PKW(P0, 8), pw1[1] = PKW(P0, 10), pw1); \
    GAC(C1 = MLA_MF(kf[7], qr[3], C1), P1[12], P1[13], P1[14], P1[15], pw1[2] = PKW(P0, 12), pw1[3] = PKW(P0, 14), pw1); \
    GAW(C0 = MLA_MF(kf[8], qr[4], C0), pw2[0] = PKW(P1, 0), pw2[1] = PKW(P1, 2), pw2[2] = PKW(P1, 4), pw2[3] = PKW(P1, 6), pw2); \
    GAW(C1 = MLA_MF(kf[9], qr[4], C1), pw3[0] = PKW(P1, 8), pw3[1] = PKW(P1, 10), pw3[2] = PKW(P1, 12), pw3[3] = PKW(P1, 14), pw3); \
    C0 = MLA_MF(kf[10], qr[5], C0); C1 = MLA_MF(kf[11], qr[5], C1); \
    l_reg += sacc; \
    if (GK) { DMA_K((t) + 4, kc); } if (GV) { DMA_V((t) + 2, vn); } \
    { float a_ = fmaxf(fmaxf(C0[0], C0[1]), C1[0]), b_ = fmaxf(fmaxf(C0[2], C0[3]), C1[1]); a_ = fmaxf(fmaxf(a_, C1[2]), C1[3]); \
      _Pragma("unroll") for (int r = 4; r < 16; r += 4) { a_ = fmaxf(fmaxf(a_, C0[r]), C0[r + 1]); b_ = fmaxf(fmaxf(b_, C0[r + 2]), C0[r + 3]); a_ = fmaxf(fmaxf(a_, C1[r]), C1[r + 1]); b_ = fmaxf(fmaxf(b_, C1[r + 2]), C1[r + 3]); } \
      float rm = fmaxf(a_, b_); { auto rr = __builtin_amdgcn_permlane32_swap(__float_as_uint(rm), __float_as_uint(rm), false, false); rm = fmaxf(__uint_as_float(rr[0]), __uint_as_float(rr[1])); } \
      resc = false; \
      if (__builtin_expect(__any(rm > THR), 0)) { const float dl = fmaxf(rm, 0.f), f = MLA_EX(-dl); m_ref += dl; l_reg *= f; if (hi == 0) wsf[r32] = f; resc = true; \
        _Pragma("unroll") for (int r = 0; r < 16; ++r) { C0[r] -= dl; C1[r] -= dl; } \
        _Pragma("unroll") for (int r = 0; r < 16; ++r) negm[r] = -m_ref; MLA_PIN(negm); } } \
    MLA_SBAR(); \
    vB0 = LDF(vp0 + vpv + 4096); if (GL) { kf[0] = LDF(kpn0 + kn); } MLA_SBAR(); GB(o[0] = MLA_MF(PAF(0), vA0, o[0]), C0, C1, 0); \
    vB1 = LDF(vp1 + vpv + 4096); if (GL) { kf[1] = LDF(kpn0 + kn + 4096); } MLA_SBAR(); GB(o[0] = MLA_MF(PAF(1), vA1, o[0]), C0, C1, 2); \
    vB2 = LDF(vp2 + vpv + 4096); if (GL) { kf[2] = LDF(kpn1 + kn); kf[3] = LDF(kpn1 + kn + 4096); } MLA_SBAR(); GB(o[0] = MLA_MF(PAF(2), vA2, o[0]), C0, C1, 4); \
    vB3 = LDF(vp3 + vpv + 4096); if (GL) { kf[4] = LDF(kpn2 + kn); kf[5] = LDF(kpn2 + kn + 4096); } MLA_SBAR(); GB(o[0] = MLA_MF(PAF(3), vA3, o[0]), C0, C1, 6); \
    if (GL) { kf[6] = LDF(kpn3 + kn); kf[7] = LDF(kpn3 + kn + 4096); } MLA_SBAR(); GB(o[1] = MLA_MF(PAF(0), vB0, o[1]), C0, C1, 8); \
    if (GL) { kf[8] = LDF(kpr0 + kn); kf[9] = LDF(kpr0 + kn + 2048); } MLA_SBAR(); GB(o[1] = MLA_MF(PAF(1), vB1, o[1]), C0, C1, 10); \
    if (GL) { kf[10] = LDF(kpr1 + kn); kf[11] = LDF(kpr1 + kn + 2048); } MLA_SBAR(); GB(o[1] = MLA_MF(PAF(2), vB2, o[1]), C0, C1, 12); \
    GB(o[1] = MLA_MF(PAF(3), vB3, o[1]), C0, C1, 14); \
    } while (0)
#define RESC() do { if (resc) { LDS_WAIT(); \
    _Pragma("unroll") for (int d_ = 0; d_ < 2; ++d_) _Pragma("unroll") for (int r_ = 0; r_ < 16; ++r_) o[d_][r_] *= wsf[crow(r_, hi)]; } } while (0)
    static_assert(NT == 128, "the step program below is written for 128 tiles");
    for (int t = 1; t < 121; t += 4) {
        STEP(pB0, pB1, pA0, pA1, t,     1, true, true, true); MLA_WAIT_FULL(); RESC();
        STEP(pA0, pA1, pB0, pB1, t + 1, 2, true, true, true); MLA_WAIT_FULL(); RESC();
        STEP(pB0, pB1, pA0, pA1, t + 2, 3, true, true, true); MLA_WAIT_FULL(); RESC();
        STEP(pA0, pA1, pB0, pB1, t + 3, 0, true, true, true); MLA_WAIT_FULL(); RESC();
    }
    STEP(pB0, pB1, pA0, pA1, 121, 1, true, true, true);    MLA_WAIT_FULL(); RESC();
    STEP(pA0, pA1, pB0, pB1, 122, 2, true, true, true);    MLA_WAIT_FULL(); RESC();
    STEP(pB0, pB1, pA0, pA1, 123, 3, true, true, true);    MLA_WAIT_FULL(); RESC();
    STEP(pA0, pA1, pB0, pB1, 124, 0, false, true, true);   if (wid < 4) { MLA_WAIT_BAR(4); } else { MLA_WAIT_BAR(3); } RESC();
    STEP(pB0, pB1, pA0, pA1, 125, 1, false, true, true);   MLA_WAIT_BAR(2); RESC();
    STEP(pA0, pA1, pB0, pB1, 126, 2, false, false, true);  MLA_WAIT_BAR(0); RESC();
    STEP(pB0, pB1, pA0, pA1, 127, 3, false, false, false); RESC();
    constexpr int vc = 3 * VSLOT;
    {
#pragma unroll
      for (int r = 0; r < 16; ++r) pB1[r] = MLA_EX(pB1[r]);
      float sacc = 0.f;
#pragma unroll
      for (int r = 0; r < 16; ++r) sacc += pB0[r];
#pragma unroll
      for (int r = 0; r < 16; ++r) sacc += pB1[r];
      l_reg += sacc;
      pw0 = (v4u){PKW(pB0, 0), PKW(pB0, 2), PKW(pB0, 4), PKW(pB0, 6)}; pw1 = (v4u){PKW(pB0, 8), PKW(pB0, 10), PKW(pB0, 12), PKW(pB0, 14)};
      pw2 = (v4u){PKW(pB1, 0), PKW(pB1, 2), PKW(pB1, 4), PKW(pB1, 6)}; pw3 = (v4u){PKW(pB1, 8), PKW(pB1, 10), PKW(pB1, 12), PKW(pB1, 14)};
      MLA_SBAR();
#pragma unroll
      for (int dh = 0; dh < 2; ++dh) { const bf16x8 w0 = LDF(vp0 + vc + dh * 4096), w1 = LDF(vp1 + vc + dh * 4096), w2 = LDF(vp2 + vc + dh * 4096), w3 = LDF(vp3 + vc + dh * 4096);
          o[dh] = MLA_MF(PAF(0), w0, o[dh]); o[dh] = MLA_MF(PAF(1), w1, o[dh]); o[dh] = MLA_MF(PAF(2), w2, o[dh]); o[dh] = MLA_MF(PAF(3), w3, o[dh]); } }
    { auto rr = __builtin_amdgcn_permlane32_swap(__float_as_uint(l_reg), __float_as_uint(l_reg), false, false); l_reg = __uint_as_float(rr[0]) + __uint_as_float(rr[1]); }
    if (hi == 0) wsf[32 + r32] = l_reg; LDS_WAIT();
    { LAS bf16* stg = (LAS bf16*)(lds + L_OST) + wid * 2048;
#pragma unroll
      for (int r = 0; r < 16; ++r) { const int orow = crow(r, hi); const float rl = __builtin_amdgcn_rcpf(wsf[32 + orow]);
#pragma unroll
          for (int dh = 0; dh < 2; ++dh) stg[orow * 64 + dh * 32 + r32] = (bf16)(pk2(o[dh][r] * rl, 0.f) & 0xffffu); }
      LDS_WAIT();
      bf16* Ow = O1 + (rowbase + q0 + wid * 32) * 1024 + h * HD;
#pragma unroll
      for (int i = 0; i < 4; ++i) { const int row = i * 8 + (lane >> 3), ch = lane & 7; const v4u v = *(const LAS v4u*)(stg + row * 64 + ch * 8); *(GAS v4u*)(Ow + (size_t)row * 1024 + ch * 8) = v; } }
    asm volatile("s_waitcnt lgkmcnt(0)\n\ts_barrier" ::: "memory");
#undef DMA_K
#undef DMA_V
#undef LDF
#undef KLOAD_ALL
#undef PKW
#undef PAF
#undef GAE
#undef GAC
#undef GAW
#undef GB
#undef STEP
#undef RESC
}
#undef MLA_WAIT_BAR
#undef MLA_WAIT_FULL
#undef MLA_SBAR
#undef MLA_MF
#undef MLA_PIN
#undef MLA_EX
}

#ifndef MK_CHECK
#define MK_CHECK 0
#endif
#ifndef MK_PHASED
#define MK_PHASED 0
#endif
#ifndef MK_DBL
#define MK_DBL 0u
#endif
#define REP(k) ((((unsigned)MK_DBL >> (k)) & 1u) ? 2 : 1)

#if MK_CHECK
__global__ void __launch_bounds__(256) chk_na(const bf16* Q, const bf16* K, const bf16* VT, const bf16* O, const float* rpb, float* accum) {
    __shared__ float qs[4][64], ps[4][128];
    const int w = threadIdx.x >> 6, lane = threadIdx.x & 63;
    const int unit = blockIdx.x * 4 + w, tok = unit / NH, h = unit % NH;
    const int b = tok / SEQ, t = tok % SEQ, r = t / GW, c = t % GW;
    int rs = r - 4; rs = rs < 0 ? 0 : (rs > GROWS - 8 ? GROWS - 8 : rs);
    int cs = c - 8; cs = cs < 0 ? 0 : (cs > GW - 16 ? GW - 16 : cs);
    qs[w][lane] = bf2f(Q[(size_t)tok * D + h * HD + lane]) * (1.f / LOG2E);
    __syncthreads();
    float sc[2];
#pragma unroll
    for (int u = 0; u < 2; ++u) {
        const int kk = lane + 64 * u, i = kk >> 4, j = kk & 15;
        const size_t kt = (size_t)b * SEQ + (rs + i) * GW + cs + j;
        const bf16* kp = K + ((size_t)h * M + kt) * HD;
        float a = 0.f;
        for (int d = 0; d < HD; ++d) a += qs[w][d] * bf2f(kp[d]);
        sc[u] = a + rpb[(h * 15 + (rs + i - r + 7)) * 31 + (cs + j - c + 15)];
    }
    float mx = fmaxf(sc[0], sc[1]);
    for (int o = 1; o < 64; o <<= 1) mx = fmaxf(mx, __shfl_xor(mx, o));
    const float e0 = expf(sc[0] - mx), e1 = expf(sc[1] - mx);
    const float inv = 1.f / wave_sum(e0 + e1);
    ps[w][lane] = e0 * inv; ps[w][lane + 64] = e1 * inv;
    __syncthreads();
    float acc = 0.f;
    for (int kk = 0; kk < 128; ++kk) { const int i = kk >> 4, j = kk & 15; const size_t kt = (size_t)b * SEQ + (rs + i) * GW + cs + j;
        acc += ps[w][kk] * bf2f(VT[((kt >> 6) * D + h * HD + lane) * GW + (kt & 63)]); }
    const float got = bf2f(O[(size_t)tok * D + h * HD + lane]);
    const float e2 = wave_sum((got - acc) * (got - acc)), r2 = wave_sum(acc * acc);
    if (lane == 0) { atomicAdd(accum, e2); atomicAdd(accum + 1, r2); }
}
__global__ void __launch_bounds__(64) chk_mla(const bf16* Q1, const bf16* KN, const bf16* KR, const bf16* VT, const bf16* O1, float* accum) {
    __shared__ float sc[SEQ]; __shared__ float qv[96];
    const int lane = threadIdx.x, i = blockIdx.x >> 4, h = blockIdx.x & 15;
    const int tok = i * 32 + ((i * 7) & 31), b = tok / SEQ;
    for (int d = lane; d < 96; d += 64) qv[d] = bf2f(Q1[(size_t)tok * 1536 + h * 96 + d]);
    __syncthreads();
    float mx = -1e30f;
    for (int key = lane; key < SEQ; key += 64) { const size_t kt = (size_t)b * SEQ + key; float a = 0.f;
        for (int d = 0; d < 64; ++d) a += qv[d] * bf2f(KN[((size_t)h * M + kt) * 64 + d]);
        for (int d = 0; d < 32; ++d) a += qv[64 + d] * bf2f(KR[kt * 32 + d]);
        sc[key] = a; mx = fmaxf(mx, a); }
    for (int o = 1; o < 64; o <<= 1) mx = fmaxf(mx, __shfl_xor(mx, o));
    float sm = 0.f;
    for (int key = lane; key < SEQ; key += 64) { const float e = exp2f(sc[key] - mx); sc[key] = e; sm += e; }
    sm = wave_sum(sm);
    __syncthreads();
    float acc = 0.f;
    for (int key = 0; key < SEQ; ++key) { const size_t kt = (size_t)b * SEQ + key; acc += sc[key] * bf2f(VT[((kt >> 6) * D + h * 64 + lane) * GW + (kt & 63)]); }
    acc /= sm;
    const float got = bf2f(O1[(size_t)tok * 1024 + h * 64 + lane]);
    const float e2 = wave_sum((got - acc) * (got - acc)), r2 = wave_sum(acc * acc);
    if (lane == 0) { atomicAdd(accum, e2); atomicAdd(accum + 1, r2); }
}
__global__ void chk_tweak(float* out, const float* accum, float amp) {
    const float s = sqrtf(amp * accum[0] / fmaxf(accum[1], 1e-30f));
    const size_t i = (size_t)blockIdx.x * 256 + threadIdx.x; out[i] *= (1.f + s);
}

__global__ void __launch_bounds__(256) chk_proj(const float* DOWN, const float* qn, const float* kvn, const float* w_uq, const float* w_ukv,
                                                const bf16* Q1, const bf16* KR, const bf16* KN, const bf16* VT, float* accum) {
    __shared__ float cq[256], ckv[128], qv[1536], red[8];
    const int tid = threadIdx.x, i = blockIdx.x, row = i * 64 + ((i * 11) & 63), t = row & (SEQ - 1), gr = t >> 6, gc = t & 63;
    const float* dr = DOWN + (size_t)row * 512;
    float ss = dr[tid] * dr[tid], ssk = tid < 128 ? dr[256 + tid] * dr[256 + tid] : 0.f;
    ss = wave_sum(ss); ssk = wave_sum(ssk);
    if ((tid & 63) == 0) { red[tid >> 6] = ss; red[4 + (tid >> 6)] = ssk; }
    __syncthreads();
    const float rq = rsqrtf((red[0] + red[1] + red[2] + red[3]) / 256.f + 1e-6f), rk = rsqrtf((red[4] + red[5] + red[6] + red[7]) / 128.f + 1e-6f);
    cq[tid] = dr[tid] * rq * qn[tid]; if (tid < 128) ckv[tid] = dr[256 + tid] * rk * kvn[tid];
    __syncthreads();
    for (int c = tid; c < 1536; c += 256) { float a = 0.f; for (int k = 0; k < 256; ++k) a += cq[k] * w_uq[(size_t)k * 1536 + c]; qv[c] = a; }
    __syncthreads();
    float e[4] = {0.f, 0.f, 0.f, 0.f}, r[4] = {0.f, 0.f, 0.f, 0.f};
    for (int c = tid; c < 1536; c += 256) { const int d = c % 96; float v = qv[c];
        if (d >= 64) { const int pr = (d - 64) >> 1; const float inv = powf(10000.f, -(float)(pr & 7) / 8.f), ang = (pr < 8 ? (float)gr : (float)gc) * inv, cs = cosf(ang), sn = sinf(ang);
            const float x1 = qv[c & ~1], x2 = qv[c | 1]; v = (c & 1) ? x1 * sn + x2 * cs : x1 * cs - x2 * sn; }
        v *= QSCALE1; const float g = bf2f(Q1[(size_t)row * 1536 + c]); e[0] += (g - v) * (g - v); r[0] += v * v; }
    if (tid < 32) { const int pr = tid >> 1; const float inv = powf(10000.f, -(float)(pr & 7) / 8.f), ang = (pr < 8 ? (float)gr : (float)gc) * inv, cs = cosf(ang), sn = sinf(ang);
        const float x1 = dr[384 + (tid & ~1)], x2 = dr[384 + (tid | 1)]; const float v = (tid & 1) ? x1 * sn + x2 * cs : x1 * cs - x2 * sn;
        const float g = bf2f(KR[(size_t)row * 32 + tid]); e[1] += (g - v) * (g - v); r[1] += v * v; }
    for (int c = tid; c < 2048; c += 256) { float a = 0.f; for (int k = 0; k < 128; ++k) a += ckv[k] * w_ukv[(size_t)k * 2048 + c];
        const int h = c >> 7, d = c & 127;
        if (d < 64) { const float g = bf2f(KN[((size_t)h * M + row) * 64 + d]); e[2] += (g - a) * (g - a); r[2] += a * a; }
        else { const float g = bf2f(VT[((size_t)(row >> 6) * D + h * 64 + d - 64) * GW + (row & 63)]); e[3] += (g - a) * (g - a); r[3] += a * a; } }
#pragma unroll
    for (int q = 0; q < 4; ++q) { const float es = wave_sum(e[q]), rs = wave_sum(r[q]); if ((tid & 63) == 0) { atomicAdd(accum + 2 * q, es); atomicAdd(accum + 2 * q + 1, rs); } }
}
__global__ void chk_tweak4(float* out, const float* accum, float amp) {
    float s2 = 0.f;
    for (int q = 0; q < 4; ++q) s2 += accum[2 * q] / fmaxf(accum[2 * q + 1], 1e-30f);
    const float s = sqrtf(amp * s2);
    const size_t i = (size_t)blockIdx.x * 256 + threadIdx.x; out[i] *= (1.f + s);
}
#endif


__device__ __forceinline__ int moe_count_prefix(Frame& F, int nblk, LAS int* red) {
    typedef int i32x4 __attribute__((ext_vector_type(4)));
    i32x4 a = {0, 0, 0, 0}, b = {0, 0, 0, 0};
    if (F.tid < nblk) { const i32x4* p = (const i32x4*)(WSP(int, WS_CNTWG) + F.tid * 8); a = p[0]; b = p[1]; }
    int c[8] = {a.x, a.y, a.z, a.w, b.x, b.y, b.z, b.w};
#pragma unroll
    for (int o = 1; o < 64; o <<= 1)
#pragma unroll
        for (int e = 0; e < 8; ++e) c[e] += __shfl_xor(c[e], o);
    if (F.lane == 0 && F.wave < 4) {
#pragma unroll
        for (int e = 0; e < 8; ++e) red[F.wave * 8 + e] = c[e]; }
    __syncthreads();
    int r = 0;
    if (F.tid < 8) r = (red[F.tid] + red[8 + F.tid]) + (red[16 + F.tid] + red[24 + F.tid]);
    __syncthreads();
    return r;
}
__device__ __forceinline__ void moe_tables(Frame& F) {
    LAS int* red = (LAS int*)(F.lds + 65536);
    const int tot = moe_count_prefix(F, 256, red);
    if (F.tid < 8) F.MISC[16 + F.tid] = (unsigned)tot;
    __syncthreads();
    if (F.tid == 0) { int tb = 0;
        for (int e = 0; e < 8; ++e) { F.MISC[24 + e] = (unsigned)tb; F.MISC[33 + e] = (unsigned)(tb * 256); tb += ((int)F.MISC[16 + e] + 255) >> 8; }
        F.MISC[32] = (unsigned)tb; F.MISC[41] = (unsigned)(tb * 256); }
    __syncthreads();
}
template <typename TX> __device__ __forceinline__ void router_phase(Frame& F, const TX* X, int l, int cs) {
    LAS float* wr_l = (LAS float*)(F.lds);
    LAS int* rowE = (LAS int*)(F.lds + 32768);
    LAS float* rowW = (LAS float*)(F.lds + 32768 + 512);
    LAS int* rowP = (LAS int*)(F.lds + 32768 + 1024);
    LAS int* lcnt = (LAS int*)(F.lds + 32768 + 1536);
    for (int i = F.tid; i < D * NE / 4; i += NTHREADS) ((LAS f32x4*)wr_l)[i] = ((const f32x4*)F.in[15])[i];
    __syncthreads();
    const float* mf = WSP(float, WS_MODF);
    for (int blk = blockIdx.x; blk < M / 64; blk += F.G) {
        const int b = (blk * 64) >> 13;
        f32x4 sh[4], sc[4];
#pragma unroll
        for (int j = 0; j < 4; ++j) { const int n = 4 * F.lane + 256 * j; sh[j] = *(const f32x4*)(mf + (size_t)(l * 2 + b) * 6 * D + cs * D + n); sc[j] = *(const f32x4*)(mf + (size_t)(l * 2 + b) * 6 * D + (cs + 1) * D + n) + 1.f; }
        for (int rr0 = 0; rr0 < 8; rr0 += 4) {
            f32x4 v[4][4]; float ss[4];
#pragma unroll
            for (int q = 0; q < 4; ++q) {
#pragma unroll
                for (int j = 0; j < 4; ++j) v[q][j] = XRow<TX>::ld(X, (size_t)(blk * 64 + F.wave * 8 + rr0 + q), 4 * F.lane + 256 * j); }
#pragma unroll
            for (int q = 0; q < 4; ++q) { ss[q] = 0.f;
#pragma unroll
                for (int j = 0; j < 4; ++j) ss[q] += (v[q][j].x * v[q][j].x + v[q][j].y * v[q][j].y) + (v[q][j].z * v[q][j].z + v[q][j].w * v[q][j].w); }
#pragma unroll
            for (int o = 1; o < 64; o <<= 1)
#pragma unroll
                for (int q = 0; q < 4; ++q) ss[q] += __shfl_xor(ss[q], o);
            float lg[4][8];
#pragma unroll
            for (int q = 0; q < 4; ++q) { const float rstd = rsqrtf(ss[q] * (1.f / D) + NORM_EPS);
#pragma unroll
                for (int e = 0; e < 8; ++e) lg[q][e] = 0.f;
                GAS v2u* o8 = (GAS v2u*)(WSP(bf16, WS_HN) + (size_t)(blk * 64 + F.wave * 8 + rr0 + q) * D) + F.lane;
#pragma unroll
                for (int j = 0; j < 4; ++j) { v[q][j] = v[q][j] * rstd * sc[j] + sh[j]; { v2u w; w.x = pk2(v[q][j].x, v[q][j].y); w.y = pk2(v[q][j].z, v[q][j].w); o8[64 * j] = w; } } }
#pragma unroll
            for (int j = 0; j < 4; ++j)
#pragma unroll
                for (int c = 0; c < 4; ++c) { const LAS f32x4* wp = (const LAS f32x4*)(wr_l + (4 * F.lane + 256 * j + c) * 8); const f32x4 w0 = wp[0], w1 = wp[1];
#pragma unroll
                    for (int q = 0; q < 4; ++q) { const float yq = v[q][j][c];
                        lg[q][0] += yq * w0.x; lg[q][1] += yq * w0.y; lg[q][2] += yq * w0.z; lg[q][3] += yq * w0.w; lg[q][4] += yq * w1.x; lg[q][5] += yq * w1.y; lg[q][6] += yq * w1.z; lg[q][7] += yq * w1.w; } }
#pragma unroll
            for (int o = 1; o < 64; o <<= 1)
#pragma unroll
                for (int q = 0; q < 4; ++q)
#pragma unroll
                    for (int e = 0; e < 8; ++e) lg[q][e] += __shfl_xor(lg[q][e], o);
#pragma unroll
            for (int q = 0; q < 4; ++q) { const int rl = F.wave * 8 + rr0 + q;
                float mx = lg[q][0];
#pragma unroll
                for (int e = 1; e < 8; ++e) mx = fmaxf(mx, lg[q][e]);
                float p[8], sm = 0.f;
#pragma unroll
                for (int e = 0; e < 8; ++e) { p[e] = expf(lg[q][e] - mx); sm += p[e]; }
                int i0 = 0; float v0 = -1.f;
#pragma unroll
                for (int e = 0; e < 8; ++e) { p[e] = p[e] / sm; if (p[e] > v0) { v0 = p[e]; i0 = e; } }
                int i1 = 0; float v1 = -1.f;
#pragma unroll
                for (int e = 0; e < 8; ++e) if (e != i0 && p[e] > v1) { v1 = p[e]; i1 = e; }
                if (F.lane == 0) { const float s2 = v0 + v1; rowE[rl * 2] = i0; rowE[rl * 2 + 1] = i1; rowW[rl * 2] = v0 / s2; rowW[rl * 2 + 1] = v1 / s2; } }
        }
        __syncthreads();
        if (F.tid < 8) lcnt[F.tid] = 0;
        __syncthreads();
        if (F.tid == 0) { for (int a = 0; a < 128; ++a) { const int e = rowE[a]; rowP[a] = lcnt[e]; lcnt[e] = lcnt[e] + 1; } }
        __syncthreads();
        if (F.tid < 128) { const size_t g = (size_t)blk * 128 + F.tid; WSP(int, WS_TOKE)[g] = rowE[F.tid]; WSP(int, WS_TOKP)[g] = rowP[F.tid]; WSP(float, WS_TOKW)[g] = rowW[F.tid]; }
        if (F.tid < 8) WSP(int, WS_CNTWG)[blk * 8 + F.tid] = lcnt[F.tid];
        __syncthreads();
    }
}
__device__ __forceinline__ void gather_phase(Frame& F) {
    LAS int* boff = (LAS int*)(F.lds);
    for (int blk = blockIdx.x; blk < M / 64; blk += F.G) {
        { const int mine = moe_count_prefix(F, blk, (LAS int*)(F.lds + 65536)); if (F.tid < 8) boff[F.tid] = mine + (int)F.MISC[33 + F.tid]; }
        __syncthreads();
        for (int a = F.wave; a < 128; a += NWAVES) {
            const size_t g = (size_t)blk * 128 + a; const int e = WSP(int, WS_TOKE)[g], slot = boff[e] + WSP(int, WS_TOKP)[g];
            if (F.lane == 0) WSP(int, WS_TOKS)[g] = slot;
            const GAS v4u* src = (const GAS v4u*)(WSP(bf16, WS_HN) + (size_t)(blk * 64 + (a >> 1)) * D); GAS v4u* dst = (GAS v4u*)(WSP(bf16, WS_HP) + (size_t)slot * D);
            dst[F.lane] = src[F.lane]; dst[64 + F.lane] = src[64 + F.lane];
        }
        __syncthreads();
    }
    for (int e = 0; e < 8; ++e) { const int r0 = (int)F.MISC[33 + e] + (int)F.MISC[16 + e], r1 = (int)F.MISC[34 + e];
        for (int r = r0 + F.gw; r < r1; r += F.NGW) { GAS v4u* dst = (GAS v4u*)(WSP(bf16, WS_HP) + (size_t)r * D); dst[F.lane] = (v4u){0u, 0u, 0u, 0u}; dst[64 + F.lane] = (v4u){0u, 0u, 0u, 0u}; } }
}
template <typename TX> __device__ __forceinline__ void final_phase(Frame& F, const TX* X, int l) {
    const bf16* Y = WSP(bf16, WS_HP); const float* mf = WSP(float, WS_MODF);
    f32x4 fn[4];
#pragma unroll
    for (int j = 0; j < 4; ++j) fn[j] = *(const f32x4*)(F.in[18] + 4 * F.lane + 256 * j);
    for (int b = 0; b < NB; ++b) {
        f32x4 gf[4];
#pragma unroll
        for (int j = 0; j < 4; ++j) gf[j] = *(const f32x4*)(mf + (size_t)(l * 2 + b) * 6 * D + 5 * D + 4 * F.lane + 256 * j);
        for (int row = b * SEQ + F.gw; row < (b + 1) * SEQ; row += 2 * F.NGW) {
            f32x4 v[2][4]; float ss[2]; bool ok[2];
#pragma unroll
            for (int q = 0; q < 2; ++q) { ok[q] = row + q * F.NGW < (b + 1) * SEQ; const int rq = ok[q] ? row + q * F.NGW : row;
                const int s0 = WSP(int, WS_TOKS)[rq * 2], s1 = WSP(int, WS_TOKS)[rq * 2 + 1]; const float w0 = WSP(float, WS_TOKW)[rq * 2], w1 = WSP(float, WS_TOKW)[rq * 2 + 1];
                const GAS v2u* y0 = (const GAS v2u*)(Y + (size_t)s0 * D) + F.lane; const GAS v2u* y1 = (const GAS v2u*)(Y + (size_t)s1 * D) + F.lane;
                f32x4 xv[4]; v2u a[4], c[4];
#pragma unroll
                for (int j = 0; j < 4; ++j) { xv[j] = XRow<TX>::ld(X, (size_t)rq, 4 * F.lane + 256 * j); a[j] = y0[64 * j]; c[j] = y1[64 * j]; }
                ss[q] = 0.f;
#pragma unroll
                for (int j = 0; j < 4; ++j) { const f32x4 ya = {bflo(a[j].x), bfhi(a[j].x), bflo(a[j].y), bfhi(a[j].y)}, yc = {bflo(c[j].x), bfhi(c[j].x), bflo(c[j].y), bfhi(c[j].y)};
                    v[q][j] = xv[j] + gf[j] * (ya * w0 + yc * w1); ss[q] += (v[q][j].x * v[q][j].x + v[q][j].y * v[q][j].y) + (v[q][j].z * v[q][j].z + v[q][j].w * v[q][j].w); } }
#pragma unroll
            for (int o = 1; o < 64; o <<= 1) { ss[0] += __shfl_xor(ss[0], o); ss[1] += __shfl_xor(ss[1], o); }
#pragma unroll
            for (int q = 0; q < 2; ++q) if (ok[q]) { const float rstd = rsqrtf(ss[q] * (1.f / D) + NORM_EPS); GAS f32x4* o = (GAS f32x4*)(F.out + (size_t)(row + q * F.NGW) * D) + F.lane;
#pragma unroll
                for (int j = 0; j < 4; ++j) o[64 * j] = v[q][j] * rstd * fn[j]; }
        }
    }
}

constexpr int N_PHASES = 19;
struct Args { const float* in[19]; float* out; unsigned char* ws; int ph_lo, ph_hi; };
__global__ void __launch_bounds__(NTHREADS, 2) mk_fwd(Args args) {
    extern __shared__ __attribute__((aligned(16))) unsigned char lds[];
    Frame F;
    F.lds = (LAS unsigned char*)lds; F.MISC = (volatile LAS unsigned*)(F.lds + MISC_OFF);
    F.tid = threadIdx.x; F.lane = F.tid & 63; F.wave = __builtin_amdgcn_readfirstlane(F.tid >> 6);
    F.G = gridDim.x; { const int bx = blockIdx.x; F.vcu = (F.G % 8 == 0) ? (bx % 8) * (F.G / 8) + bx / 8 : bx; }
    F.gw = F.vcu * NWAVES + F.wave; F.NGW = F.G * NWAVES;
#pragma unroll
    for (int i = 0; i < 19; ++i) F.in[i] = args.in[i];
    F.out = args.out; F.ws = args.ws;
    for (int u = F.tid; u < (LDS_BYTES - MISC_OFF) / 4; u += NTHREADS) ((LAS unsigned*)(F.lds + MISC_OFF))[u] = 0u;
    __syncthreads();
    XcdBarrier bar; bar.bar = WSP(unsigned, WS_CTL) + 1024; bar.x = 0; bar.st = nullptr;
    if (!MK_PHASED) bar = xcd_barrier_post(WSP(unsigned, WS_CTL) + 1024, F.MISC + 8);
    const int lo = args.ph_lo, hi = args.ph_hi;
#ifdef MK_ONLY
#define IN(k) ((k) == MK_ONLY && lo <= (k) && (k) < hi)
#else
#define IN(k) (lo <= (k) && (k) < hi)
#endif
#define REFRESH() do { int t_ = threadIdx.x; asm volatile("" : "+v"(t_)); F.tid = t_; F.lane = t_ & 63; } while (0)
#define SEAM(k) do { if (IN(k) && IN((k) + 1)) xcd_barrier(bar); } while (0)
    bf16* XA = WSP(bf16, WS_XA); bf16* XB = (bf16*)F.out; const float* MODF = WSP(float, WS_MODF);
    bf16* HN = WSP(bf16, WS_HN);
    LAS unsigned char* ring = F.lds;

    if (IN(0)) for (int rep_ = 0; rep_ < REP(0); ++rep_) { REFRESH(); p0_prologue(F); } SEAM(0);
    if (IN(1)) for (int rep_ = 0; rep_ < REP(1); ++rep_) { REFRESH(); modulate_phase<true, float>(F, F.in[0], 0, 0, HN); modf_reduce(F); } SEAM(1);
    if (IN(2)) for (int rep_ = 0; rep_ < REP(2); ++rep_) { REFRESH();
        { pg8::Gemm g{HN, WSP(bf16, WS_WQK), M, 2048, D}; pg8::StaticOrder S; S.init(M, 2048, F.G, (int)blockIdx.x);
          pg8::EpiBf16P E{WSP(bf16, WS_Q0), D, 8, 4, (size_t)(WS_K0 - WS_Q0) / 2, 0.125f * LOG2E, 0, 1};
          pg8::gemm_phase<pg8::EpiBf16P, pg8::StaticOrder, true, true>(ring, g, S, E); }
        { pg8::Gemm g{WSP(bf16, WS_WV), HN, D, M, D}; pg8::StaticOrder S; S.init(D, M, F.G, (int)blockIdx.x);
          pg8::EpiBf16P E{WSP(bf16, WS_VT0), M, 64, 0, 0, 1.f, 2, 2};
          pg8::gemm_phase<pg8::EpiBf16P, pg8::StaticOrder, true, true>(ring, g, S, E); }
    } SEAM(2);
    if (IN(3)) for (int rep_ = 0; rep_ < REP(3); ++rep_) { REFRESH(); na_phase(F); } SEAM(3);
    if (IN(4)) for (int rep_ = 0; rep_ < REP(4); ++rep_) { REFRESH(); pg8::Gemm g{WSP(bf16, WS_O0), WSP(bf16, WS_WO0), M, D, D}; pg8::StaticOrder S; S.init(M, D, F.G, (int)blockIdx.x);
        pg8::EpiResGateB<true> E{F.in[0], XA, MODF + 0 * 12 * D + 2 * D};
        pg8::gemm_phase<pg8::EpiResGateB<true>, pg8::StaticOrder, true, true>(ring, g, S, E); } SEAM(4);
    if (IN(5)) for (int rep_ = 0; rep_ < REP(5); ++rep_) { REFRESH(); modulate_phase<false, bf16>(F, XA, 0, 3, HN); } SEAM(5);
    if (IN(6)) for (int rep_ = 0; rep_ < REP(6); ++rep_) { REFRESH(); pg8::Gemm g{HN, WSP(bf16, WS_WGU0), M, 2 * FFN, D}; pg8::StaticOrder S; S.init(M, 2 * FFN, F.G, (int)blockIdx.x);
        pg8::EpiSwiGLU E{WSP(bf16, WS_ACT0), FFN, 22};
        pg8::gemm_phase<pg8::EpiSwiGLU, pg8::StaticOrder, true, true>(ring, g, S, E);
        moe_w_side(F, MOE_ITEMS - MOE_G1 - MOE_G2 - MOE_G3, MOE_ITEMS - MOE_G2 - MOE_G3, 128); } SEAM(6);
    if (IN(7)) for (int rep_ = 0; rep_ < REP(7); ++rep_) { REFRESH(); pg8::Gemm g{WSP(bf16, WS_ACT0), WSP(bf16, WS_WDN0), M, D, FFN}; pg8::StaticOrder S; S.init(M, D, F.G, (int)blockIdx.x);
        pg8::EpiResGateB<false> E{XA, XB, MODF + 0 * 12 * D + 5 * D};
        pg8::gemm_phase<pg8::EpiResGateB<false>, pg8::StaticOrder, true, true>(ring, g, S, E); } SEAM(7);
    if (IN(8)) for (int rep_ = 0; rep_ < REP(8); ++rep_) { REFRESH(); modulate_phase<false, bf16>(F, XB, 1, 0, HN); } SEAM(8);
    if (IN(9)) for (int rep_ = 0; rep_ < REP(9); ++rep_) { REFRESH(); pg8::Gemm g{HN, WSP(bf16, WS_WMD), M, DOWN_NP, D}; pg8::StaticOrder S; S.init(M, DOWN_NP, F.G, (int)blockIdx.x);
        pg8::EpiF32 E{WSP(float, WS_DOWN), DOWN_NP};
        pg8::gemm_phase<pg8::EpiF32, pg8::StaticOrder, true, true>(ring, g, S, E);
        moe_w_side(F, MOE_ITEMS - MOE_G2 - MOE_G3, MOE_ITEMS - MOE_G3, 128); } SEAM(9);
    if (IN(10)) for (int rep_ = 0; rep_ < REP(10); ++rep_) { REFRESH(); mla_mid_phase(F); } SEAM(10);
    if (IN(11)) for (int rep_ = 0; rep_ < REP(11); ++rep_) { REFRESH(); int kq = 256; asm volatile("" : "+s"(kq));
        { pg8::Gemm g{WSP(bf16, WS_CQ), WSP(bf16, WS_WUQ), M, 1536, kq}; pg8::StaticOrder S; S.init(M, 1536, F.G, (int)blockIdx.x);
          pg8::EpiQRope E{WSP(bf16, WS_Q1), WSP(float, WS_ROPER), WSP(float, WS_ROPEC), QSCALE1};
          pg8::gemm_phase<pg8::EpiQRope, pg8::StaticOrder, true, true>(ring, g, S, E); }
        { pg8::Gemm g{WSP(bf16, WS_CKV), WSP(bf16, WS_WKN), M, D, kq}; pg8::StaticOrder S; S.init(M, D, F.G, (int)blockIdx.x);
          pg8::EpiBf16P E{WSP(bf16, WS_KN), D, 4, 0, 0, 1.f, 1, 1};
          pg8::gemm_phase<pg8::EpiBf16P, pg8::StaticOrder, true, true>(ring, g, S, E); }
        { pg8::Gemm g{WSP(bf16, WS_WVV), WSP(bf16, WS_CKV), D, M, kq}; pg8::StaticOrder S; S.init(D, M, F.G, (int)blockIdx.x);
          pg8::EpiBf16P E{WSP(bf16, WS_VT1), M, 64, 0, 0, 1.f, 2, 2};
          pg8::gemm_phase<pg8::EpiBf16P, pg8::StaticOrder, true, true>(ring, g, S, E); }
    } SEAM(11);
    if (IN(12)) for (int rep_ = 0; rep_ < REP(12); ++rep_) { REFRESH();
        for (int u = F.vcu; u < NB * NH * (SEQ / 256); u += F.G) { const int a = u >> 8, r = u & 255, bh = r >> 3, qb = (r & 7) * 4 + a;
            mla::unit(bh >> 4, bh & 15, qb, WSP(bf16, WS_Q1), WSP(bf16, WS_KN), WSP(bf16, WS_KR), WSP(bf16, WS_VT1), WSP(bf16, WS_O1), ring); }
    } SEAM(12);
    if (IN(13)) for (int rep_ = 0; rep_ < REP(13); ++rep_) { REFRESH(); pg8::Gemm g{WSP(bf16, WS_O1), WSP(bf16, WS_WO1), M, D, D}; pg8::StaticOrder S; S.init(M, D, F.G, (int)blockIdx.x);
        pg8::EpiResGateB<false> E{XB, XA, MODF + 1 * 12 * D + 2 * D};
        pg8::gemm_phase<pg8::EpiResGateB<false>, pg8::StaticOrder, true, true>(ring, g, S, E); } SEAM(13);
    if (IN(14)) for (int rep_ = 0; rep_ < REP(14); ++rep_) { REFRESH(); router_phase<bf16>(F, XA, 1, 3); } SEAM(14);
    if (IN(15)) for (int rep_ = 0; rep_ < REP(15); ++rep_) { REFRESH(); moe_tables(F); gather_phase(F); } SEAM(15);
    if (IN(16)) for (int rep_ = 0; rep_ < REP(16); ++rep_) { REFRESH(); moe_tables(F);
        pg8::MoeOrder S{(int)F.MISC[32], 14, F.G, (int)blockIdx.x, (int)F.MISC[25], (int)F.MISC[26], (int)F.MISC[27], (int)F.MISC[28], (int)F.MISC[29], (int)F.MISC[30], (int)F.MISC[31]};
        pg8::Gemm g{WSP(bf16, WS_HP), WSP(bf16, WS_WGU1), MP_MAX, NE * 2 * ED, D};
        pg8::EpiSwiGLU E{WSP(bf16, WS_ACT1), ED, 14};
        pg8::gemm_phase<pg8::EpiSwiGLU, pg8::MoeOrder, true, true>(ring, g, S, E);
        moe_w_side(F, MOE_ITEMS - MOE_G3, MOE_ITEMS, 112); } SEAM(16);
    if (IN(17)) for (int rep_ = 0; rep_ < REP(17); ++rep_) { REFRESH(); moe_tables(F);
        pg8::MoeOrder S{(int)F.MISC[32], 4, F.G, (int)blockIdx.x, (int)F.MISC[25], (int)F.MISC[26], (int)F.MISC[27], (int)F.MISC[28], (int)F.MISC[29], (int)F.MISC[30], (int)F.MISC[31]};
        pg8::Gemm g{WSP(bf16, WS_ACT1), WSP(bf16, WS_WDN1), MP_MAX, NE * D, ED};
        pg8::EpiBf16P E{WSP(bf16, WS_HP), D, 4, 0, 0, 1.f, 0, 0};
        pg8::gemm_phase<pg8::EpiBf16P, pg8::MoeOrder, true, true>(ring, g, S, E); } SEAM(17);
    if (IN(18)) for (int rep_ = 0; rep_ < REP(18); ++rep_) { REFRESH(); final_phase<bf16>(F, XA, 1); }
#undef IN
#undef SEAM
}

extern "C" void kernel_launch(void* const* d_in, const int* in_sizes, int n_in, void* d_out, int out_size, void* d_ws, size_t ws_size, hipStream_t stream) {
    static int grid = 0;
    if (grid == 0) {
        if (n_in != 19 || in_sizes[0] != M * D || out_size != M * D || ws_size < WS_END) { fprintf(stderr, "kernel_launch: shape mismatch (n_in %d, ws %zu)\n", n_in, ws_size); grid = -1; return; }
        int dev = 0, cus = 0, per_cu = 0;
        if (hipGetDevice(&dev) != hipSuccess || hipDeviceGetAttribute(&cus, hipDeviceAttributeMultiprocessorCount, dev) != hipSuccess) { grid = -1; return; }
        if (hipFuncSetAttribute((const void*)mk_fwd, hipFuncAttributeMaxDynamicSharedMemorySize, LDS_BYTES) != hipSuccess) { fprintf(stderr, "kernel_launch: hipFuncSetAttribute failed\n"); grid = -1; return; }
        if (hipOccupancyMaxActiveBlocksPerMultiprocessor(&per_cu, (const void*)mk_fwd, NTHREADS, LDS_BYTES) != hipSuccess || per_cu < 1) fprintf(stderr, "kernel_launch: occupancy query says %d\n", per_cu);
        (void)hipGetLastError();
        grid = cus;
    }
    if (grid < 0) return;
    (void)hipMemsetAsync((char*)d_ws + WS_CTL, 0, CTL_ZERO_BYTES, stream);
    Args a{};
    for (int i = 0; i < 19; ++i) a.in[i] = (const float*)d_in[i];
    a.out = (float*)d_out; a.ws = (unsigned char*)d_ws;
#if MK_PHASED
    for (int p = 0; p < N_PHASES; ++p) { a.ph_lo = p; a.ph_hi = p + 1; hipLaunchKernelGGL(mk_fwd, dim3(grid), dim3(NTHREADS), LDS_BYTES, stream, a);
#if MK_CHECK == 1
        if (p == 3) hipLaunchKernelGGL(chk_na, dim3(M * NH / 4), dim3(256), 0, stream, (const bf16*)(a.ws + WS_Q0), (const bf16*)(a.ws + WS_K0), (const bf16*)(a.ws + WS_VT0), (const bf16*)(a.ws + WS_O0), a.in[5], (float*)(a.ws + WS_CTL + 32768));
#elif MK_CHECK == 2
        if (p == 12) hipLaunchKernelGGL(chk_mla, dim3(512 * 16), dim3(64), 0, stream, (const bf16*)(a.ws + WS_Q1), (const bf16*)(a.ws + WS_KN), (const bf16*)(a.ws + WS_KR), (const bf16*)(a.ws + WS_VT1), (const bf16*)(a.ws + WS_O1), (float*)(a.ws + WS_CTL + 32768));
#elif MK_CHECK == 3
        if (p == 11) hipLaunchKernelGGL(chk_proj, dim3(256), dim3(256), 0, stream, (const float*)(a.ws + WS_DOWN), a.in[10], a.in[12], a.in[11], a.in[13], (const bf16*)(a.ws + WS_Q1), (const bf16*)(a.ws + WS_KR), (const bf16*)(a.ws + WS_KN), (const bf16*)(a.ws + WS_VT1), (float*)(a.ws + WS_CTL + 32768));
#endif
    }
#if MK_CHECK == 3
    hipLaunchKernelGGL(chk_tweak4, dim3(M * D / 256), dim3(256), 0, stream, a.out, (const float*)(a.ws + WS_CTL + 32768), 1000.f);
#elif MK_CHECK
    hipLaunchKernelGGL(chk_tweak, dim3(M * D / 256), dim3(256), 0, stream, a.out, (const float*)(a.ws + WS_CTL + 32768), 1000.f);
#endif
#else
    a.ph_lo = 0; a.ph_hi = N_PHASES; hipLaunchKernelGGL(mk_fwd, dim3(grid), dim3(NTHREADS), LDS_BYTES, stream, a);
#endif
}
```

```cpp
#include <hip/hip_runtime.h>
#include <cstdio>
#include <cstdint>
namespace pg8 {
#define PG8_LAS __attribute__((address_space(3)))
typedef unsigned short bf16_t;
typedef short bf16x8 __attribute__((ext_vector_type(8)));
typedef float f32x4 __attribute__((ext_vector_type(4)));
typedef unsigned u32x4 __attribute__((ext_vector_type(4)));
constexpr int BM = 256, BK = 64, HALF = 128, HTB = HALF * BK * 2  , STAGE_BYTES = 8 * HTB, NXCD = 8, WGM = 8;

__host__ __device__ __forceinline__ int lds_byte(int r, int c) { const int st = (r >> 4) * 2 + (c >> 5), rr = r & 15, cc = c & 31, ob = rr * 64 + cc * 2; return st * 1024 + (ob ^ (((ob >> 9) & 1) << 5)); }
__host__ __device__ __forceinline__ void stage_rc(int b, int& R, int& C) { const int st = b / 1024, sb = b % 1024, swz = sb ^ (((sb >> 9) & 1) << 5); R = (st >> 1) * 16 + swz / 64; C = (st & 1) * 32 + (swz % 64) / 2; }
__host__ __device__ __forceinline__ int perm32(int rho) { const int n = rho >> 4, i = rho & 15; return 8 * (i >> 2) + 4 * n + (i & 3); }

struct Unit { int pm, pn; };
struct Gemm { const bf16_t* A; const bf16_t* Bt; int M, N, K; };

struct StaticOrder {
    int nM, nN, nwg, G, c;
    __host__ __device__ void init(int M, int N, int G_, int c_) { nM = M / BM; nN = N / BM; nwg = nM * nN; G = G_; c = c_; }
    __host__ __device__ bool next(int i, Unit& u) const {
        const long L = (long)i * G + c; if (L >= nwg) return false;
        int wgid = (int)L; { const int q = nwg / NXCD, r = nwg % NXCD, xcd = wgid % NXCD, off = wgid / NXCD; wgid = (xcd < r ? xcd * (q + 1) : r * (q + 1) + (xcd - r) * q) + off; }
        const int nig = WGM * nN, gid = wgid / nig, fm = gid * WGM, gsz = (nM - fm) < WGM ? (nM - fm) : WGM;
        u.pm = fm + ((wgid % nig) % gsz); u.pn = (wgid % nig) / gsz; return true;
    }
    __device__ __forceinline__ void a_ready(const Unit&) const {}
    __device__ __forceinline__ void done(const Unit&) const {}
};

__device__ __forceinline__ unsigned cvt_pk_bf16(float lo, float hi) { unsigned r; asm volatile("v_cvt_pk_bf16_f32 %0, %1, %2" : "=v"(r) : "v"(lo), "v"(hi)); return r; }

__device__ __forceinline__ float fast_silu(float g) { return g * __builtin_amdgcn_rcpf(1.f + __builtin_amdgcn_exp2f(-1.4426950408889634f * g)); }
struct EpiBf16P {
    static constexpr bool PERM = true, AFTER_DRAIN = false;
    bf16_t* O; int ldc; int nct; int st; size_t sstride; float scale0; int mode0, mode1;
    __device__ __forceinline__ void operator()(const f32x4 (&acc)[2][2][4][2], const Unit& u, int wr, int wc, int fr, int fq) const {
        int ct = u.pn % nct; bf16_t* base = O; float sc = 1.f; int mode = mode0;
        if (st) { const int t = ct / st; base += (size_t)t * sstride; ct -= t * st; if (t == 0) sc = scale0; else mode = mode1; }
        const int row0 = u.pm * BM + wr * 64 + fr, col0 = ct * BM + wc * 32 + 8 * fq;
#pragma unroll
        for (int ai = 0; ai < 2; ++ai)
#pragma unroll
            for (int m = 0; m < 4; ++m) { const int row = row0 + ai * HALF + m * 16;
#pragma unroll
                for (int bj = 0; bj < 2; ++bj) { const f32x4 v0 = acc[ai][bj][m][0] * sc, v1 = acc[ai][bj][m][1] * sc; const int col = col0 + bj * HALF;
                    u32x4 w; w.x = cvt_pk_bf16(v0[0], v0[1]); w.y = cvt_pk_bf16(v0[2], v0[3]); w.z = cvt_pk_bf16(v1[0], v1[1]); w.w = cvt_pk_bf16(v1[2], v1[3]);
                    bf16_t* p = mode == 0 ? base + (size_t)row * ldc + col : base + ((size_t)(col >> 6) * (mode == 1 ? 16384 : 1024) + row) * 64 + (col & 63);
                    *(u32x4*)p = w; } }
    }
};
struct EpiResGate {
    static constexpr bool PERM = false, AFTER_DRAIN = false;
    const float* res; float* out; const float* gate;
    __device__ __forceinline__ void operator()(const f32x4 (&acc)[2][2][4][2], const Unit& u, int wr, int wc, int fr, int fq) const {
        const int row0 = u.pm * BM + wr * 64 + fr, col0 = u.pn * BM + wc * 32 + 4 * fq;
        const float* gp = gate + (size_t)((u.pm * BM) >> 13) * 6144 + col0;
        f32x4 gv[2][2];
#pragma unroll
        for (int bj = 0; bj < 2; ++bj)
#pragma unroll
            for (int n = 0; n < 2; ++n) gv[bj][n] = *(const f32x4*)(gp + bj * HALF + n * 16);
#pragma unroll
        for (int ai = 0; ai < 2; ++ai)
#pragma unroll
            for (int m = 0; m < 4; ++m) { const size_t off = (size_t)(row0 + ai * HALF + m * 16) * 1024 + col0;
#pragma unroll
                for (int bj = 0; bj < 2; ++bj)
#pragma unroll
                    for (int n = 0; n < 2; ++n) { const f32x4 rs = *(const f32x4*)(res + off + bj * HALF + n * 16);
                        *(f32x4*)(out + off + bj * HALF + n * 16) = rs + gv[bj][n] * acc[ai][bj][m][n]; } }
    }
};
template <bool RES_F32> struct EpiResGateB {
    static constexpr bool PERM = true, AFTER_DRAIN = false;
    const void* res; bf16_t* out; const float* gate;
    __device__ __forceinline__ void operator()(const f32x4 (&acc)[2][2][4][2], const Unit& u, int wr, int wc, int fr, int fq) const {
        const int row0 = u.pm * BM + wr * 64 + fr, col0 = u.pn * BM + wc * 32 + 8 * fq;
        const float* gp = gate + (size_t)((u.pm * BM) >> 13) * 6144 + col0;
        f32x4 gv[2][2];
#pragma unroll
        for (int bj = 0; bj < 2; ++bj)
#pragma unroll
            for (int n = 0; n < 2; ++n) gv[bj][n] = *(const f32x4*)(gp + bj * HALF + 4 * n);
#pragma unroll
        for (int ai = 0; ai < 2; ++ai)
#pragma unroll
            for (int m = 0; m < 4; ++m) { const size_t off = (size_t)(row0 + ai * HALF + m * 16) * 1024 + col0;
#pragma unroll
                for (int bj = 0; bj < 2; ++bj) { f32x4 r0, r1;
                    if (RES_F32) { const float* rp = (const float*)res + off + bj * HALF; r0 = *(const f32x4*)rp; r1 = *(const f32x4*)(rp + 4); }
                    else { const u32x4 w = *(const u32x4*)((const bf16_t*)res + off + bj * HALF);
                        r0 = (f32x4){__builtin_bit_cast(float, w.x << 16), __builtin_bit_cast(float, w.x & 0xffff0000u), __builtin_bit_cast(float, w.y << 16), __builtin_bit_cast(float, w.y & 0xffff0000u)};
                        r1 = (f32x4){__builtin_bit_cast(float, w.z << 16), __builtin_bit_cast(float, w.z & 0xffff0000u), __builtin_bit_cast(float, w.w << 16), __builtin_bit_cast(float, w.w & 0xffff0000u)}; }
                    const f32x4 v0 = r0 + gv[bj][0] * acc[ai][bj][m][0], v1 = r1 + gv[bj][1] * acc[ai][bj][m][1];
                    u32x4 o; o.x = cvt_pk_bf16(v0[0], v0[1]); o.y = cvt_pk_bf16(v0[2], v0[3]); o.z = cvt_pk_bf16(v1[0], v1[1]); o.w = cvt_pk_bf16(v1[2], v1[3]);
                    *(u32x4*)(out + off + bj * HALF) = o; } }
    }
};
struct EpiF32 {
    static constexpr bool PERM = false, AFTER_DRAIN = false;
    float* O; int ldc;
    __device__ __forceinline__ void operator()(const f32x4 (&acc)[2][2][4][2], const Unit& u, int wr, int wc, int fr, int fq) const {
        const int row0 = u.pm * BM + wr * 64 + fr, col0 = u.pn * BM + wc * 32 + 4 * fq;
#pragma unroll
        for (int ai = 0; ai < 2; ++ai)
#pragma unroll
            for (int m = 0; m < 4; ++m) { float* rowp = O + (size_t)(row0 + ai * HALF + m * 16) * ldc + col0;
#pragma unroll
                for (int bj = 0; bj < 2; ++bj)
#pragma unroll
                    for (int n = 0; n < 2; ++n) *(f32x4*)(rowp + bj * HALF + n * 16) = acc[ai][bj][m][n]; }
    }
};
struct EpiSwiGLU {
    static constexpr bool PERM = true, AFTER_DRAIN = false;
    bf16_t* O; int ldc; int nN;
    __device__ __forceinline__ void operator()(const f32x4 (&acc)[2][2][4][2], const Unit& u, int wr, int wc, int fr, int fq) const {
        const int row0 = u.pm * BM + wr * 64 + fr, col0 = (u.pn % nN) * HALF + wc * 32 + 8 * fq;
#pragma unroll
        for (int ai = 0; ai < 2; ++ai)
#pragma unroll
            for (int m = 0; m < 4; ++m) {
                const f32x4 g0 = acc[ai][0][m][0], g1 = acc[ai][0][m][1], u0 = acc[ai][1][m][0], u1 = acc[ai][1][m][1];
                u32x4 w;
                w.x = cvt_pk_bf16(fast_silu(g0[0]) * u0[0], fast_silu(g0[1]) * u0[1]); w.y = cvt_pk_bf16(fast_silu(g0[2]) * u0[2], fast_silu(g0[3]) * u0[3]);
                w.z = cvt_pk_bf16(fast_silu(g1[0]) * u1[0], fast_silu(g1[1]) * u1[1]); w.w = cvt_pk_bf16(fast_silu(g1[2]) * u1[2], fast_silu(g1[3]) * u1[3]);
                *(u32x4*)(O + (size_t)(row0 + ai * HALF + m * 16) * ldc + col0) = w; }
    }
};
struct EpiQRope {
    static constexpr bool PERM = true, AFTER_DRAIN = false;
    bf16_t* O; const float* ropeR; const float* ropeC; float qs;
    __device__ __forceinline__ void operator()(const f32x4 (&acc)[2][2][4][2], const Unit& u, int wr, int wc, int fr, int fq) const {
        const int row0 = u.pm * BM + wr * 64 + fr, col0 = u.pn * BM + wc * 32 + 8 * fq;
#pragma unroll
        for (int ai = 0; ai < 2; ++ai)
#pragma unroll
            for (int m = 0; m < 4; ++m) { const int r = row0 + ai * HALF + m * 16, t = r & 8191, gr = t >> 6, gc = t & 63;
#pragma unroll
                for (int bj = 0; bj < 2; ++bj) { const int c = col0 + bj * HALF, d = c % 96;
                    f32x4 v0 = acc[ai][bj][m][0], v1 = acc[ai][bj][m][1];
                    if (d >= 64) { const int p = (d - 64) >> 1;
                        const float* tb = p < 8 ? ropeR + gr * 16 + 2 * p : ropeC + gc * 16 + 2 * (p - 8);
                        const f32x4 a = *(const f32x4*)tb, b = *(const f32x4*)(tb + 4);
                        v0 = (f32x4){v0[0] * a[0] - v0[1] * a[1], v0[0] * a[1] + v0[1] * a[0], v0[2] * a[2] - v0[3] * a[3], v0[2] * a[3] + v0[3] * a[2]};
                        v1 = (f32x4){v1[0] * b[0] - v1[1] * b[1], v1[0] * b[1] + v1[1] * b[0], v1[2] * b[2] - v1[3] * b[3], v1[2] * b[3] + v1[3] * b[2]}; }
                    v0 = v0 * qs; v1 = v1 * qs;
                    u32x4 w; w.x = cvt_pk_bf16(v0[0], v0[1]); w.y = cvt_pk_bf16(v0[2], v0[3]); w.z = cvt_pk_bf16(v1[0], v1[1]); w.w = cvt_pk_bf16(v1[2], v1[3]);
                    *(u32x4*)(O + (size_t)r * 1536 + c) = w; }
                asm volatile("" ::: "memory"); }
    }
};
struct MoeOrder {
    int T, nN, G, c; int tb1, tb2, tb3, tb4, tb5, tb6, tb7;
    __device__ __forceinline__ bool next(int i, Unit& u) const {
        const int nwg = T * nN; const long L = (long)i * G + c; if (L >= nwg) return false;
        int wgid = (int)L; { const int q = nwg / NXCD, r = nwg % NXCD, xcd = wgid % NXCD, off = wgid / NXCD; wgid = (xcd < r ? xcd * (q + 1) : r * (q + 1) + (xcd - r) * q) + off; }
        const int nig = WGM * nN, gid = wgid / nig, fm = gid * WGM, gsz = (T - fm) < WGM ? (T - fm) : WGM;
        const int pm = fm + ((wgid % nig) % gsz), pn = (wgid % nig) / gsz;
        const int e = (pm >= tb1) + (pm >= tb2) + (pm >= tb3) + (pm >= tb4) + (pm >= tb5) + (pm >= tb6) + (pm >= tb7);
        u.pm = pm; u.pn = e * nN + pn; return true;
    }
    __device__ __forceinline__ void a_ready(const Unit&) const {}
    __device__ __forceinline__ void done(const Unit&) const {}
};

template <class Epi, class Sched, bool ALIGN_EPI = false, bool SP2 = false>
__device__ __forceinline__ void gemm_phase(PG8_LAS unsigned char* lds, const Gemm g, const Sched& S, const Epi& E) {
    const int tid = threadIdx.x, wid = __builtin_amdgcn_readfirstlane(tid >> 6), lane = tid & 63, wr = wid >> 2, wc = wid & 3, fr = lane & 15, fq = lane >> 4;
    const int K = g.K, nt = K / BK;
    unsigned voffA[2], voffB[2];
#pragma unroll
    for (int i = 0; i < 2; ++i) { int R, C; stage_rc(tid * 16 + i * 8192, R, C); const int Rb = Epi::PERM ? ((R & ~31) + perm32(R & 31)) : R;
        voffA[i] = (unsigned)(R * K + C) * 2u; voffB[i] = (unsigned)(Rb * K + C) * 2u; }
    const size_t kstep = (size_t)(BK * 2);
    const size_t hstep = (size_t)HALF * K * 2;
    const size_t tstep = 2 * hstep;
    const unsigned ldsw = (unsigned)wid * 1024u;
    const int aoff = lds_byte(wr * 64 + fr, fq * 8), boff = lds_byte(wc * 32 + fr, fq * 8);
#define PG8_SA(b, h) (((b) * 2 + (h)) * HTB)
#define PG8_SB(b, h) ((4 + (b) * 2 + (h)) * HTB)
#define PG8_STAGE(bufoff, gbase, voff) do { _Pragma("unroll") for (int _i = 0; _i < 2; ++_i) \
        __builtin_amdgcn_global_load_lds((const unsigned*)((const char*)(gbase) + (voff)[_i]), (PG8_LAS unsigned*)(lds + (bufoff) + ldsw + _i * 8192), 16, 0, 0); } while (0)
#define PG8_LDA(dst, b, h) do { _Pragma("unroll") for (int m = 0; m < 4; ++m) _Pragma("unroll") for (int k = 0; k < 2; ++k) dst[m][k] = *(const PG8_LAS bf16x8*)(lds + PG8_SA(b, h) + aoff + m * 2048 + k * 1024); } while (0)
#define PG8_LDB(dst, b, h) do { _Pragma("unroll") for (int n = 0; n < 2; ++n) _Pragma("unroll") for (int k = 0; k < 2; ++k) dst[n][k] = *(const PG8_LAS bf16x8*)(lds + PG8_SB(b, h) + boff + n * 2048 + k * 1024); } while (0)
#define PG8_MMA(ai, bj, At, Bt) do { __builtin_amdgcn_s_setprio(1); _Pragma("unroll") for (int m = 0; m < 4; ++m) _Pragma("unroll") for (int n = 0; n < 2; ++n) _Pragma("unroll") for (int k = 0; k < 2; ++k) \
        acc[ai][bj][m][n] = __builtin_amdgcn_mfma_f32_16x16x32_bf16(Bt[n][k], At[m][k], acc[ai][bj][m][n], 0, 0, 0); __builtin_amdgcn_s_setprio(0); } while (0)
#define PG8_WAIT_V(n) asm volatile("s_waitcnt vmcnt(" #n ")" ::: "memory")
#define PG8_WAIT_L(n) asm volatile("s_waitcnt lgkmcnt(" #n ")" ::: "memory")
#define PG8_BAR __builtin_amdgcn_s_barrier()
#define PG8_SCHED __builtin_amdgcn_sched_barrier(0)
    Unit cur, nxt; int ui = 0;
    if (!S.next(0, cur)) return;
    f32x4 acc[2][2][4][2];
#pragma unroll
    for (int a = 0; a < 2; ++a)
#pragma unroll
        for (int b = 0; b < 2; ++b)
#pragma unroll
            for (int m = 0; m < 4; ++m)
#pragma unroll
                for (int n = 0; n < 2; ++n) acc[a][b][m][n] = (f32x4){0.f, 0.f, 0.f, 0.f};
    bf16x8 At[4][2], B0[2][2], B1[2][2];
    const char* cA = (const char*)g.A + (size_t)cur.pm * tstep; const char* cB = (const char*)g.Bt + (size_t)cur.pn * tstep;
    S.a_ready(cur);
    if constexpr (SP2) {
        PG8_STAGE(PG8_SB(0, 0), cB, voffB); PG8_STAGE(PG8_SB(0, 1), cB + hstep, voffB); PG8_STAGE(PG8_SA(0, 0), cA, voffA); PG8_STAGE(PG8_SA(0, 1), cA + hstep, voffA);
        if (wr == 1) PG8_BAR;
        PG8_WAIT_V(2); PG8_BAR;
        PG8_STAGE(PG8_SB(1, 0), cB + kstep, voffB); PG8_STAGE(PG8_SA(1, 0), cA + kstep, voffA); PG8_STAGE(PG8_SB(1, 1), cB + hstep + kstep, voffB);
        PG8_WAIT_V(6); PG8_BAR;
    } else {
        PG8_STAGE(PG8_SB(0, 0), cB, voffB); PG8_STAGE(PG8_SA(0, 0), cA, voffA); PG8_STAGE(PG8_SB(0, 1), cB + hstep, voffB); PG8_STAGE(PG8_SA(0, 1), cA + hstep, voffA);
        if (wr == 1) PG8_BAR;
        PG8_WAIT_V(4); PG8_BAR;
        PG8_STAGE(PG8_SB(1, 0), cB + kstep, voffB); PG8_STAGE(PG8_SA(1, 0), cA + kstep, voffA); PG8_STAGE(PG8_SB(1, 1), cB + hstep + kstep, voffB);
        PG8_WAIT_V(6); PG8_BAR;
    }
    for (;;) {
        const bool has_next = S.next(ui + 1, nxt);
        const char* nA = has_next ? (const char*)g.A + (size_t)nxt.pm * tstep : cA; const char* nB = has_next ? (const char*)g.Bt + (size_t)nxt.pn * tstep : cB;
        for (int t = 0; t < nt; t += 2) {
            const bool last = (t == nt - 2);
            const char* a1 = cA + (size_t)(t + 1) * kstep;
            const char* a2 = last ? nA : cA + (size_t)(t + 2) * kstep; const char* b2 = last ? nB : cB + (size_t)(t + 2) * kstep;
            const char* a3 = a2 + kstep; const char* b3 = b2 + kstep;
            if (last && has_next) S.a_ready(nxt);
            if constexpr (SP2) {
            PG8_LDB(B0, 0, 0); PG8_LDB(B1, 0, 1); PG8_SCHED; PG8_LDA(At, 0, 0); PG8_STAGE(PG8_SA(1, 1), a1 + hstep, voffA);
            PG8_WAIT_V(8); PG8_WAIT_L(0); PG8_BAR; PG8_MMA(0, 0, At, B0); PG8_MMA(0, 1, At, B1); PG8_BAR; PG8_SCHED;
            PG8_LDA(At, 0, 1); PG8_STAGE(PG8_SB(0, 0), b2, voffB); PG8_STAGE(PG8_SB(0, 1), b2 + hstep, voffB); PG8_STAGE(PG8_SA(0, 0), a2, voffA);
            PG8_WAIT_V(8); PG8_WAIT_L(0); PG8_BAR; PG8_MMA(1, 0, At, B0); PG8_MMA(1, 1, At, B1); PG8_BAR; PG8_SCHED;
            PG8_LDB(B0, 1, 0); PG8_LDB(B1, 1, 1); PG8_SCHED; PG8_LDA(At, 1, 0); PG8_STAGE(PG8_SA(0, 1), a2 + hstep, voffA);
            PG8_WAIT_V(8); PG8_WAIT_L(0); PG8_BAR; PG8_MMA(0, 0, At, B0); PG8_MMA(0, 1, At, B1); PG8_BAR; PG8_SCHED;
            PG8_LDA(At, 1, 1); PG8_STAGE(PG8_SB(1, 0), b3, voffB); PG8_STAGE(PG8_SB(1, 1), b3 + hstep, voffB); PG8_STAGE(PG8_SA(1, 0), a3, voffA);
            PG8_WAIT_V(8); PG8_WAIT_L(0); PG8_BAR; PG8_MMA(1, 0, At, B0); PG8_MMA(1, 1, At, B1); PG8_BAR; PG8_SCHED;
            } else {
            PG8_LDB(B0, 0, 0); PG8_SCHED; PG8_LDA(At, 0, 0); PG8_STAGE(PG8_SA(1, 1), a1 + hstep, voffA);
            PG8_WAIT_L(8); PG8_BAR; PG8_WAIT_L(0); PG8_MMA(0, 0, At, B0); PG8_BAR; PG8_SCHED;
            PG8_LDB(B1, 0, 1); PG8_STAGE(PG8_SB(0, 0), b2, voffB);
            PG8_BAR; PG8_WAIT_L(0); PG8_MMA(0, 1, At, B1); PG8_BAR;
            PG8_LDA(At, 0, 1); PG8_STAGE(PG8_SA(0, 0), a2, voffA);
            PG8_BAR; PG8_WAIT_L(0); PG8_MMA(1, 0, At, B0); PG8_BAR; PG8_SCHED;
            PG8_STAGE(PG8_SB(0, 1), b2 + hstep, voffB);
            PG8_WAIT_V(6); PG8_BAR; PG8_MMA(1, 1, At, B1); PG8_BAR;
            PG8_LDB(B0, 1, 0); PG8_SCHED; PG8_LDA(At, 1, 0); PG8_STAGE(PG8_SA(0, 1), a2 + hstep, voffA);
            PG8_WAIT_L(8); PG8_BAR; PG8_WAIT_L(0); PG8_MMA(0, 0, At, B0); PG8_BAR; PG8_SCHED;
            PG8_LDB(B1, 1, 1); PG8_STAGE(PG8_SB(1, 0), b3, voffB);
            PG8_BAR; PG8_WAIT_L(0); PG8_MMA(0, 1, At, B1); PG8_BAR;
            PG8_LDA(At, 1, 1); PG8_STAGE(PG8_SA(1, 0), a3, voffA);
            PG8_BAR; PG8_WAIT_L(0); PG8_MMA(1, 0, At, B0); PG8_BAR; PG8_SCHED;
            PG8_STAGE(PG8_SB(1, 1), b3 + hstep, voffB);
            PG8_WAIT_V(6); PG8_BAR; PG8_MMA(1, 1, At, B1); PG8_BAR;
            }
        }
        if constexpr (ALIGN_EPI) { if (wr == 0) PG8_BAR; }
        if constexpr (!Epi::AFTER_DRAIN) { E(acc, cur, wr, wc, fr, fq); S.done(cur); }
        if (!has_next) break;
#pragma unroll
        for (int a = 0; a < 2; ++a)
#pragma unroll
            for (int b = 0; b < 2; ++b)
#pragma unroll
                for (int m = 0; m < 4; ++m)
#pragma unroll
                    for (int n = 0; n < 2; ++n) acc[a][b][m][n] = (f32x4){0.f, 0.f, 0.f, 0.f};
        cur = nxt; cA = nA; cB = nB; ++ui;
        if constexpr (ALIGN_EPI) { if (wr == 1) PG8_BAR; }
    }
    PG8_WAIT_V(0);
    if constexpr (!ALIGN_EPI) { if (wr == 0) PG8_BAR; }
    PG8_BAR;
    if constexpr (Epi::AFTER_DRAIN) { E.fused(acc, cur, wr, wc, fr, fq, lds, wid, lane); S.done(cur); }
#undef PG8_SA
#undef PG8_SB
#undef PG8_STAGE
#undef PG8_LDA
#undef PG8_LDB
#undef PG8_MMA
#undef PG8_WAIT_V
#undef PG8_WAIT_L
#undef PG8_BAR
#undef PG8_SCHED
}
}

#define GAS __attribute__((address_space(1)))
#define LAS __attribute__((address_space(3)))

#define XB_TMO      128
#define XB_XCNT(j)  (256  + 64 * (j))
#define XB_XSUB(j)  (1280 + 64 * (j))
#define XB_XGEN(j)  (2304 + 64 * (j))
#define XB_TOP      3328
#define XB_TOPGEN   3392
#define XCD_BAR_WORDS 3456
#define XB_SPIN_CAP (1u << 18)

__device__ __forceinline__ unsigned xb_ld(unsigned* p)              { return __hip_atomic_load(p, __ATOMIC_RELAXED, __HIP_MEMORY_SCOPE_AGENT); }
__device__ __forceinline__ unsigned xb_add(unsigned* p, unsigned v) { return __hip_atomic_fetch_add(p, v, __ATOMIC_RELAXED, __HIP_MEMORY_SCOPE_AGENT); }
__device__ __forceinline__ unsigned xb_xcc_id() { return (unsigned)__builtin_amdgcn_s_getreg((3 << 11) | 20) & 0xFu; }
#define XB_SPIN(cond, bar) do { unsigned _sp = 0; while (cond) { __builtin_amdgcn_s_sleep(1); \
    if ((++_sp & 255u) == 0u) { if (xb_ld(&(bar)[XB_TMO])) break; if (_sp > XB_SPIN_CAP) { atomicAdd(&(bar)[XB_TMO], 1u); break; } } } } while (0)

struct XcdBarrier {
    unsigned* bar; unsigned x;
    volatile LAS unsigned* st;
};

__device__ __forceinline__ XcdBarrier xcd_barrier_post(unsigned* bar, volatile LAS unsigned* st) {
    XcdBarrier b; b.bar = bar; b.x = xb_xcc_id(); b.st = st;
    if (threadIdx.x == 0) (void)xb_add(&bar[XB_XCNT(b.x)], 1u);
    return b;
}
__device__ __forceinline__ void xcd_barrier_complete(unsigned* bar, unsigned x, unsigned& nloc, unsigned& nx) {
    const unsigned G = gridDim.x * gridDim.y * gridDim.z;
    unsigned sum, cnt, mine, sp = 0u;
    for (;;) {
        sum = 0u; cnt = 0u; mine = 0u;
#pragma unroll
        for (unsigned j = 0; j < 16; ++j) { const unsigned c = xb_ld(&bar[XB_XCNT(j)]); sum += c; cnt += (c > 0u) ? 1u : 0u; mine = (j == x) ? c : mine; }
        if (sum == G) break;
        __builtin_amdgcn_s_sleep(1);
        if ((++sp & 255u) == 0u) { if (xb_ld(&bar[XB_TMO])) break; if (sp > XB_SPIN_CAP) { atomicAdd(&bar[XB_TMO], 1u); break; } }
    }
    nloc = mine > 0u ? mine : 1u; nx = cnt > 0u ? cnt : 1u;
}

__device__ __forceinline__ void xcd_barrier(const XcdBarrier& b) {
    asm volatile("s_waitcnt vmcnt(0)" ::: "memory");
    __syncthreads();
    if (threadIdx.x == 0) {
        unsigned* bar = b.bar;
        __builtin_amdgcn_s_waitcnt(0);
        unsigned nloc = b.st[0], nx = b.st[1];
        if (nloc == 0u) { xcd_barrier_complete(bar, b.x, nloc, nx); b.st[0] = nloc; b.st[1] = nx; }
        const unsigned old = xb_add(&bar[XB_XSUB(b.x)], 1u);
        const unsigned gen = old / nloc;
        if (old + 1u == (gen + 1u) * nloc) {
            __builtin_amdgcn_fence(__ATOMIC_RELEASE, "agent");
            asm volatile("s_waitcnt vmcnt(0)" ::: "memory");
            const unsigned og = xb_add(&bar[XB_TOP], 1u);
            const unsigned tg = og / nx;
            if (og + 1u == (tg + 1u) * nx) xb_add(&bar[XB_TOPGEN], 1u);
            else XB_SPIN(xb_ld(&bar[XB_TOPGEN]) == tg, bar);
            __builtin_amdgcn_fence(__ATOMIC_ACQUIRE, "agent");
            xb_add(&bar[XB_XGEN(b.x)], 1u);
            asm volatile("s_waitcnt vmcnt(0)" ::: "memory");
        } else {
            XB_SPIN(xb_ld(&bar[XB_XGEN(b.x)]) == gen, bar);
            __builtin_amdgcn_fence(__ATOMIC_ACQUIRE, "agent");
            asm volatile("s_waitcnt vmcnt(0)" ::: "memory");
        }
    }
    __syncthreads();
}


constexpr int NWAVES = 8, NTHREADS = 512;
constexpr int D = 1024, NB = 2, SEQ = 8192, M = NB * SEQ, GW = 64, GROWS = 128, NH = 16, HD = 64;
constexpr int FFN = 2816, NE = 8, ED = 1792, QL = 256, KVL = 128, RP = 32, DOWN_N = 416, DOWN_NP = 512, QKD = 96;
constexpr int MP_MAX = 34816;
constexpr float NORM_EPS = 1e-6f;
constexpr float LOG2E = 1.4426950408889634f;
constexpr float QSCALE1 = 0.10206207261596577f * LOG2E;

constexpr size_t MiB = 1u << 20;
constexpr size_t WS_CTL = 0, CTL_ZERO_BYTES = 64 * 1024;
constexpr size_t WS_PART = 4 * MiB;
constexpr size_t WS_MODF = 2 * MiB;
constexpr size_t WS_ROPER = WS_MODF + 128 * 1024;
constexpr size_t WS_ROPEC = WS_ROPER + 16 * 1024;
constexpr size_t WS_CNTWG = WS_ROPEC + 16 * 1024;
constexpr size_t WS_TOKE = 3 * MiB;
constexpr size_t WS_TOKP = WS_TOKE + 128 * 1024;
constexpr size_t WS_TOKW = WS_TOKP + 128 * 1024;
constexpr size_t WS_TOKS = WS_TOKW + 128 * 1024;
constexpr size_t WS_W = 8 * MiB;
constexpr size_t WS_WQK = WS_W, WS_WV = WS_WQK + 4 * MiB, WS_WO0 = WS_WV + 2 * MiB, WS_WGU0 = WS_WO0 + 2 * MiB, WS_WDN0 = WS_WGU0 + 11 * MiB;
constexpr size_t WS_WMD = WS_WDN0 + 5632 * 1024, WS_WUQ = WS_WMD + 1 * MiB, WS_WKN = WS_WUQ + 768 * 1024, WS_WVV = WS_WKN + 512 * 1024, WS_WO1 = WS_WVV + 512 * 1024;
constexpr size_t WS_WGU1 = WS_WO1 + 2 * MiB, WS_WDN1 = WS_WGU1 + 56 * MiB, WS_WEND = WS_WDN1 + 28 * MiB;
static_assert(WS_WEND <= 122 * MiB, "weights");
constexpr size_t WS_XA = 122 * MiB;
constexpr size_t WS_HN = 186 * MiB;
constexpr size_t WS_R = 218 * MiB;
constexpr size_t WS_Q0 = WS_R, WS_K0 = WS_R + 32 * MiB, WS_VT0 = WS_R + 64 * MiB, WS_O0 = WS_R + 96 * MiB;
constexpr size_t WS_ACT0 = WS_R;
constexpr size_t WS_DOWN = WS_R, WS_CQ = WS_R + 32 * MiB, WS_CKV = WS_R + 40 * MiB, WS_KR = WS_R + 48 * MiB;
constexpr size_t WS_Q1 = WS_R + 49 * MiB, WS_KN = WS_R + 97 * MiB, WS_VT1 = WS_R + 129 * MiB, WS_O1 = WS_R + 161 * MiB;
constexpr size_t WS_HP = WS_R, WS_ACT1 = WS_R + 68 * MiB;
constexpr size_t WS_END = WS_R + 193 * MiB;
static_assert(WS_ACT1 + (size_t)MP_MAX * ED * 2 <= WS_END && WS_END <= 448 * MiB, "d_ws map");

constexpr int RING_BYTES = 131072, MISC_OFF = 155648, LDS_BYTES = 159744;

typedef unsigned short bf16;
typedef unsigned v4u __attribute__((ext_vector_type(4)));
typedef unsigned v2u __attribute__((ext_vector_type(2)));
typedef float f32x4 __attribute__((ext_vector_type(4)));
typedef float f32x2 __attribute__((ext_vector_type(2)));
typedef float f32x16 __attribute__((ext_vector_type(16)));
typedef short bf16x8 __attribute__((ext_vector_type(8)));
typedef GAS unsigned gu32;
#define RLX_AGENT __ATOMIC_RELAXED, __HIP_MEMORY_SCOPE_AGENT
#define LDS_WAIT() asm volatile("s_waitcnt lgkmcnt(0)" ::: "memory")
__device__ __forceinline__ unsigned pk2(float lo, float hi) { unsigned r; asm volatile("v_cvt_pk_bf16_f32 %0, %1, %2" : "=v"(r) : "v"(lo), "v"(hi)); return r; }
__device__ __forceinline__ float bf2f(unsigned short h) { return __builtin_bit_cast(float, (unsigned)h << 16); }
__device__ __forceinline__ float bflo(unsigned w) { return __builtin_bit_cast(float, w << 16); }
__device__ __forceinline__ float bfhi(unsigned w) { return __builtin_bit_cast(float, w & 0xffff0000u); }
__device__ __forceinline__ float wave_sum(float v) {
#pragma unroll
    for (int o = 1; o < 64; o <<= 1) v += __shfl_xor(v, o);
    return v;
}

template <typename TX> struct XRow;
template <> struct XRow<float> { static __device__ __forceinline__ f32x4 ld(const float* X, size_t row, int col) { return *(const GAS f32x4*)(X + row * 1024 + col); } };
template <> struct XRow<bf16> { static __device__ __forceinline__ f32x4 ld(const bf16* X, size_t row, int col) { const v2u w = *(const GAS v2u*)(X + row * 1024 + col); return (f32x4){bflo(w.x), bfhi(w.x), bflo(w.y), bfhi(w.y)}; } };

struct Frame {
    LAS unsigned char* lds; volatile LAS unsigned* MISC;
    int tid, lane, wave, vcu, G, gw, NGW;
    const float* in[19]; float* out; unsigned char* ws;
};
#define WSP(T, off) ((T*)(F.ws + (off)))

__device__ __forceinline__ void tr_item(const float* W, int ldn, int k0, int n0, bf16* WT, int ldk, int drow0, LAS float* scr, int lane) {
    { f32x4 v[8]; const int rr = lane >> 3, c4 = (lane & 7) * 4;
#pragma unroll
      for (int i = 0; i < 8; ++i) v[i] = *(const f32x4*)(W + (size_t)(k0 + 8 * i + rr) * ldn + n0 + c4);
#pragma unroll
      for (int i = 0; i < 8; ++i) { LAS float* d = scr + (8 * i + rr) * 33 + c4; d[0] = v[i].x; d[1] = v[i].y; d[2] = v[i].z; d[3] = v[i].w; } }
    LDS_WAIT(); asm volatile("" ::: "memory");
    const int c = lane & 7;
#pragma unroll
    for (int j = 0; j < 4; ++j) { const int n = (lane >> 3) + 8 * j; const LAS float* s = scr + (8 * c) * 33 + n;
        v4u o; o.x = pk2(s[0 * 33], s[1 * 33]); o.y = pk2(s[2 * 33], s[3 * 33]); o.z = pk2(s[4 * 33], s[5 * 33]); o.w = pk2(s[6 * 33], s[7 * 33]);
        *(GAS v4u*)(WT + (size_t)(drow0 + n) * ldk + k0 + 8 * c) = o; }
    LDS_WAIT(); asm volatile("" ::: "memory");
}
__device__ __forceinline__ int gu_row(int n0, int F_) { const int up = n0 >= F_, j = up ? n0 - F_ : n0; return 256 * (j >> 7) + (up ? 128 : 0) + (j & 127); }
__device__ __forceinline__ float silu_acc(float v) { return v / (1.f + expf(-v)); }
constexpr int MOE_I8 = 8 * 16 * 112, MOE_I9 = 8 * 28 * 32, MOE_ITEMS = MOE_I8 + MOE_I9;
constexpr int MOE_G1 = 128 * 40, MOE_G2 = 128 * 48, MOE_G3 = 144 * 24;
__device__ __forceinline__ void moe_w_item(Frame& F, int r, LAS float* scr, int lane) {
    if (r < MOE_I8) { const int e = r / (16 * 112), q = r % (16 * 112), kb = q / 112, nb = q % 112;
        tr_item(F.in[16] + (size_t)e * D * 2 * ED, 2 * ED, 64 * kb, 32 * nb, WSP(bf16, WS_WGU1), D, e * 2 * ED + gu_row(32 * nb, ED), scr, lane); }
    else { r -= MOE_I8; const int e = r / (28 * 32), q = r % (28 * 32), kb = q / 32, nb = q % 32;
        tr_item(F.in[17] + (size_t)e * ED * D, D, 64 * kb, 32 * nb, WSP(bf16, WS_WDN1), ED, e * D + 32 * nb, scr, lane); }
}
__device__ __forceinline__ void moe_w_side(Frame& F, int lo, int hi, int first_wg) {
    if (F.G != 256 || (int)blockIdx.x < first_wg) return;
    LAS float* scr = (LAS float*)(F.lds + F.wave * 16384);
    for (int it = lo + ((int)blockIdx.x - first_wg) * NWAVES + F.wave; it < hi; it += (256 - first_wg) * NWAVES) moe_w_item(F, it, scr, F.lane);
}
__device__ __forceinline__ void p0_prologue(Frame& F) {
    LAS float* scr = (LAS float*)(F.lds + F.wave * 16384);
    const int lane = F.lane;
    constexpr int I0 = 16 * 96, I1 = 16 * 32, I2 = 16 * 176, I3 = 44 * 32, I4 = 16 * 13, I5 = 4 * 48, I6 = 2 * 64, I7 = 16 * 32;
    const int NMOE0 = (F.G == 256) ? MOE_ITEMS - MOE_G1 - MOE_G2 - MOE_G3 : MOE_ITEMS;
    constexpr int IA = 2 * 96 * 16;
    constexpr int IZ = 96 + 2 * 1024;
    constexpr int IR = 24;
    const int NITEMS = I0 + I1 + I2 + I3 + I4 + I5 + I6 + I7 + NMOE0 + IA + IZ + IR;
    for (int it = F.gw; it < NITEMS; it += F.NGW) {
        int r = it;
        if (r < NMOE0) { moe_w_item(F, r, scr, lane); continue; } r -= NMOE0;
        if (r < I0) { const int kb = r / 96, nb = r % 96, n0 = 32 * nb;
            if (n0 < 2048) tr_item(F.in[4], 3 * D, 64 * kb, n0, WSP(bf16, WS_WQK), D, n0, scr, lane); else tr_item(F.in[4], 3 * D, 64 * kb, n0, WSP(bf16, WS_WV), D, n0 - 2048, scr, lane);
            continue; } r -= I0;
        if (r < I1) { tr_item(F.in[6], D, 64 * (r / 32), 32 * (r % 32), WSP(bf16, WS_WO0), D, 32 * (r % 32), scr, lane); continue; } r -= I1;
        if (r < I2) { const int kb = r / 176, nb = r % 176; tr_item(F.in[7], 2 * FFN, 64 * kb, 32 * nb, WSP(bf16, WS_WGU0), D, gu_row(32 * nb, FFN), scr, lane); continue; } r -= I2;
        if (r < I3) { tr_item(F.in[8], D, 64 * (r / 32), 32 * (r % 32), WSP(bf16, WS_WDN0), FFN, 32 * (r % 32), scr, lane); continue; } r -= I3;
        if (r < I4) { tr_item(F.in[9], DOWN_N, 64 * (r / 13), 32 * (r % 13), WSP(bf16, WS_WMD), D, 32 * (r % 13), scr, lane); continue; } r -= I4;
        if (r < I5) { tr_item(F.in[11], 1536, 64 * (r / 48), 32 * (r % 48), WSP(bf16, WS_WUQ), QL, 32 * (r % 48), scr, lane); continue; } r -= I5;
        if (r < I6) { const int kb = r / 64, nb = r % 64, h = nb >> 2, q = nb & 3;
            if (q < 2) tr_item(F.in[13], 2048, 64 * kb, 32 * nb, WSP(bf16, WS_WKN), 128, h * 64 + 32 * q, scr, lane); else tr_item(F.in[13], 2048, 64 * kb, 32 * nb, WSP(bf16, WS_WVV), 128, h * 64 + 32 * (q - 2), scr, lane);
            continue; } r -= I6;
        if (r < I7) { tr_item(F.in[14], D, 64 * (r / 32), 32 * (r % 32), WSP(bf16, WS_WO1), D, 32 * (r % 32), scr, lane); continue; } r -= I7;
        if (r < IA) {
            const int l = r / (96 * 16), q = r % (96 * 16), cg = q / 16, kc = q % 16, n = 64 * cg + lane;
            const float* w = F.in[2] + (size_t)l * D * 6 * D + n; const float* c = F.in[1];
            float a0 = 0.f, a1 = 0.f;
            const float ca0 = silu_acc(c[64 * kc + lane]), ca1 = silu_acc(c[D + 64 * kc + lane]);
#pragma unroll 32
            for (int kk = 0; kk < 64; ++kk) { const float wv = w[(size_t)(64 * kc + kk) * 6 * D]; a0 += __shfl(ca0, kk) * wv; a1 += __shfl(ca1, kk) * wv; }
            float* part = WSP(float, WS_PART) + ((size_t)(kc * 2 + l) * 2) * 6 * D + n;
            part[0] = a0; part[6 * D] = a1; continue; } r -= IA;
        if (r < IZ) {
            if (r < 96) { GAS v4u* p = (GAS v4u*)(WSP(bf16, WS_WMD) + (size_t)(DOWN_N + r) * D); p[lane] = (v4u){0u, 0u, 0u, 0u}; p[64 + lane] = (v4u){0u, 0u, 0u, 0u}; }
            else { }
            continue; } r -= IZ;
        {
            const int idx = 64 * r + lane, isc = idx >= 1024, q = isc ? idx - 1024 : idx, i = q >> 3, p = q & 7;
            const float inv = powf(10000.f, -(float)p / 8.f), a = (float)i * inv;
            float* t = (isc ? WSP(float, WS_ROPEC) : WSP(float, WS_ROPER)) + i * 16 + 2 * p; t[0] = cosf(a); t[1] = sinf(a);
        }
    }
}
__device__ __forceinline__ f32x4 mod4_partials(Frame& F, int l, int b, int n) {
    f32x4 a = *(const f32x4*)(F.in[3] + l * 6 * D + n);
#pragma unroll
    for (int kc = 0; kc < 16; ++kc) a += *(const f32x4*)(WSP(float, WS_PART) + ((size_t)((kc * 2 + l) * 2 + b)) * 6 * D + n);
    return a;
}
template <bool FROM_PART, typename TX> __device__ __forceinline__ void modulate_phase(Frame& F, const TX* X, int l, int cs, bf16* HNo) {
    for (int b = 0; b < NB; ++b) {
        f32x4 sh[4], sc[4];
#pragma unroll
        for (int j = 0; j < 4; ++j) { const int n = 4 * F.lane + 256 * j;
            if (FROM_PART) { sh[j] = mod4_partials(F, l, b, cs * D + n); sc[j] = mod4_partials(F, l, b, (cs + 1) * D + n); }
            else { const float* mf = WSP(float, WS_MODF) + (size_t)(l * 2 + b) * 6 * D; sh[j] = *(const f32x4*)(mf + cs * D + n); sc[j] = *(const f32x4*)(mf + (cs + 1) * D + n); }
            sc[j] = sc[j] + 1.f; }
        for (int row = b * SEQ + F.gw; row < (b + 1) * SEQ; row += 4 * F.NGW) {
            f32x4 v[4][4]; float ss[4]; bool ok[4];
#pragma unroll
            for (int q = 0; q < 4; ++q) { ok[q] = row + q * F.NGW < (b + 1) * SEQ; const int rq = ok[q] ? row + q * F.NGW : row;
#pragma unroll
                for (int j = 0; j < 4; ++j) v[q][j] = XRow<TX>::ld(X, (size_t)rq, 4 * F.lane + 256 * j); }
#pragma unroll
            for (int q = 0; q < 4; ++q) { ss[q] = 0.f;
#pragma unroll
                for (int j = 0; j < 4; ++j) ss[q] += (v[q][j].x * v[q][j].x + v[q][j].y * v[q][j].y) + (v[q][j].z * v[q][j].z + v[q][j].w * v[q][j].w); }
#pragma unroll
            for (int o = 1; o < 64; o <<= 1)
#pragma unroll
                for (int q = 0; q < 4; ++q) ss[q] += __shfl_xor(ss[q], o);
#pragma unroll
            for (int q = 0; q < 4; ++q) if (ok[q]) { const float rstd = rsqrtf(ss[q] * (1.f / D) + NORM_EPS); GAS v2u* o8 = (GAS v2u*)(HNo + (size_t)(row + q * F.NGW) * D) + F.lane;
#pragma unroll
                for (int j = 0; j < 4; ++j) { const f32x4 y = v[q][j] * rstd * sc[j] + sh[j]; v2u w; w.x = pk2(y.x, y.y); w.y = pk2(y.z, y.w); o8[64 * j] = w; } }
        }
    }
}
__device__ __forceinline__ void modf_reduce(Frame& F) {
    for (int i = blockIdx.x * NTHREADS + F.tid; i < 2 * 2 * 6 * D; i += F.G * NTHREADS) {
        const int l = i / (2 * 6 * D), q = i % (2 * 6 * D), n = q % (6 * D), b = q / (6 * D);
        float a = F.in[3][l * 6 * D + n];
#pragma unroll
        for (int kc = 0; kc < 16; ++kc) a += WSP(float, WS_PART)[((size_t)((kc * 2 + l) * 2 + b)) * 6 * D + n];
        WSP(float, WS_MODF)[i] = a;
    }
}
__device__ __forceinline__ void mla_mid_phase(Frame& F) {
    const float* DOWN = WSP(float, WS_DOWN); const float* qn = F.in[10]; const float* kvn = F.in[12];
    const f32x4 qn4 = *(const f32x4*)(qn + 4 * F.lane); const f32x2 kn2 = *(const f32x2*)(kvn + 2 * F.lane);
    for (int row = F.gw; row < M; row += F.NGW) {
        const float* dr = DOWN + (size_t)row * DOWN_NP; const int t = row & (SEQ - 1);
        const f32x4 a = *(const f32x4*)(dr + 4 * F.lane); const f32x2 k = *(const f32x2*)(dr + QL + 2 * F.lane);
        const float rq = rsqrtf(wave_sum((a.x * a.x + a.y * a.y) + (a.z * a.z + a.w * a.w)) * (1.f / QL) + NORM_EPS);
        const float rk = rsqrtf(wave_sum(k.x * k.x + k.y * k.y) * (1.f / KVL) + NORM_EPS);
        v2u w; w.x = pk2(a.x * rq * qn4.x, a.y * rq * qn4.y); w.y = pk2(a.z * rq * qn4.z, a.w * rq * qn4.w);
        *((GAS v2u*)(WSP(bf16, WS_CQ) + (size_t)row * QL) + F.lane) = w;
        GAS unsigned* ck = (GAS unsigned*)(WSP(bf16, WS_CKV) + (size_t)row * 128);
        ck[F.lane] = pk2(k.x * rk * kn2.x, k.y * rk * kn2.y);
        if (F.lane < 16) { const f32x2 x = *(const f32x2*)(dr + QL + KVL + 2 * F.lane);
            const float* tb = F.lane < 8 ? WSP(float, WS_ROPER) + (t >> 6) * 16 + 2 * F.lane : WSP(float, WS_ROPEC) + (t & 63) * 16 + 2 * (F.lane - 8);
            const float cs = tb[0], sn = tb[1];
            ((GAS unsigned*)(WSP(bf16, WS_KR) + (size_t)row * RP))[F.lane] = pk2(x.x * cs - x.y * sn, x.x * sn + x.y * cs); }
    }
}
namespace na {
constexpr int L_K = 0, L_V = 73728, L_B = 147456, L_END = L_B + 15 * 64 * 4;
}
__device__ __forceinline__ void na_phase(Frame& F) {
    const bf16* Q = WSP(bf16, WS_Q0); const bf16* K = WSP(bf16, WS_K0); const bf16* VT = WSP(bf16, WS_VT0); bf16* O = WSP(bf16, WS_O0);
    const int tid = F.tid, lane = F.lane, l16 = lane & 15, g = lane >> 4;
    LAS float* rpbH = (LAS float*)(F.lds + na::L_B);
    const int scol = tid >> 3, sc = tid & 7;
    const unsigned kdst = (unsigned)((scol * 8 + (sc ^ ((scol & 2) ^ ((scol & 8) >> 1)))) * 16), vdst = (unsigned)((scol * 8 + (sc ^ (scol & 6))) * 16);
    const int ri = F.wave >> 2, ct = F.wave & 3;
    const int c0 = 16 * ct, kc0 = ct == 0 ? 0 : (ct == 1 ? 8 : (ct == 2 ? 24 : 32));
    const int c = c0 + l16; int cs = c - 8; cs = cs < 0 ? 0 : (cs > GW - 16 ? GW - 16 : cs);
    const int kcolA = kc0 + 8 * (l16 >> 2) + (l16 & 3), kxv = (kcolA & 2) ^ ((kcolA & 8) >> 1);
    const unsigned kch0 = (unsigned)((kcolA * 8 + (g ^ kxv)) * 16), kch1 = (unsigned)((kcolA * 8 + ((4 + g) ^ kxv)) * 16);
    const unsigned vch = (unsigned)((l16 * 8 + (((kc0 >> 3) + g) ^ (l16 & 6))) * 16);
    const int dc0 = kc0 + 8 * g - c + 15, t0 = kc0 + 8 * g - cs;
    float pen[8];
#pragma unroll
    for (int k = 0; k < 8; ++k) pen[k] = (unsigned)(t0 + k) < 16u ? 0.f : -1e30f;
    for (int w = F.vcu; w < NB * NH * 8; w += F.G) {
        const int bh = w >> 3, b = bh >> 4, h = bh & 15, rp0 = (w & 7) * 8;
        __syncthreads();
        for (int i = tid; i < 15 * 64; i += NTHREADS) { const int dc = (i & 63) - 8; rpbH[i] = (dc >= 0 && dc <= 30) ? F.in[5][(h * 15 + (i >> 6)) * 31 + dc] * LOG2E : 0.f; }
        const bf16* kbase = K + ((size_t)h * M + (size_t)b * SEQ) * HD + scol * HD + sc * 8;
        const bf16* vbase = VT + ((size_t)(b * GROWS) * D + h * HD + scol) * GW + sc * 8;
        bf16x8 kst[9], vst[9];
#define NA_LOAD(rp_) do { int R0_ = 2 * (rp_) - 4; R0_ = R0_ < 0 ? 0 : (R0_ > GROWS - 8 ? GROWS - 8 : R0_); \
        _Pragma("unroll") for (int i_ = 0; i_ < 9; ++i_) { const int row_ = (R0_ + i_) > GROWS - 1 ? GROWS - 1 : (R0_ + i_); \
            kst[i_] = *(const bf16x8*)(kbase + (size_t)row_ * GW * HD); vst[i_] = *(const bf16x8*)(vbase + (size_t)row_ * D * GW); } } while (0)
        NA_LOAD(rp0);
        for (int st = 0; st < 8; ++st) {
            const int rp = rp0 + st;
            __syncthreads();
#pragma unroll
            for (int i = 0; i < 9; ++i) { *(LAS bf16x8*)(F.lds + na::L_K + i * 8192 + kdst) = kst[i]; *(LAS bf16x8*)(F.lds + na::L_V + i * 8192 + vdst) = vst[i]; }
            __syncthreads();
            if (st + 1 < 8) NA_LOAD(rp + 1);
            __builtin_amdgcn_sched_barrier(0);
            const int r = 2 * rp + ri; int rs = r - 4; rs = rs < 0 ? 0 : (rs > GROWS - 8 ? GROWS - 8 : rs);
            int R0 = 2 * rp - 4; R0 = R0 < 0 ? 0 : (R0 > GROWS - 8 ? GROWS - 8 : R0);
            const int roff = rs - R0;
            const size_t tq = (size_t)b * SEQ + r * GW + c;
            bf16x8 qf[2];
#pragma unroll
            for (int ks = 0; ks < 2; ++ks) qf[ks] = *(const bf16x8*)(Q + tq * D + h * HD + 32 * ks + 8 * g);
            const LAS unsigned char* kl = F.lds + na::L_K + roff * 8192; const LAS unsigned char* vl = F.lds + na::L_V + roff * 8192;
            pg8::f32x4 s[8][2];
#pragma unroll
            for (int kr = 0; kr < 8; ++kr)
#pragma unroll
                for (int blk = 0; blk < 2; ++blk) {
                    const bf16x8 k0 = *(const LAS bf16x8*)(kl + kr * 8192 + blk * 512 + kch0), k1 = *(const LAS bf16x8*)(kl + kr * 8192 + blk * 512 + kch1);
                    pg8::f32x4 a = {0.f, 0.f, 0.f, 0.f};
                    a = __builtin_amdgcn_mfma_f32_16x16x32_bf16(k0, qf[0], a, 0, 0, 0);
                    a = __builtin_amdgcn_mfma_f32_16x16x32_bf16(k1, qf[1], a, 0, 0, 0);
                    s[kr][blk] = a; if (blk == 1 && (kr & 1)) __builtin_amdgcn_sched_barrier(0); }
            const LAS float* bp = rpbH + (rs - r + 7) * 64 + dc0 + 8;
            float mx = -1e30f;
#pragma unroll
            for (int kr = 0; kr < 8; ++kr)
#pragma unroll
                for (int blk = 0; blk < 2; ++blk)
#pragma unroll
                    for (int i = 0; i < 4; ++i) { const float v = (s[kr][blk][i] + bp[kr * 64 + 4 * blk + i]) + pen[4 * blk + i]; s[kr][blk][i] = v; mx = fmaxf(mx, v); }
            mx = fmaxf(mx, __shfl_xor(mx, 16)); mx = fmaxf(mx, __shfl_xor(mx, 32));
            float sum = 0.f;
#pragma unroll
            for (int kr = 0; kr < 8; ++kr)
#pragma unroll
                for (int blk = 0; blk < 2; ++blk)
#pragma unroll
                    for (int i = 0; i < 4; ++i) { const float e = __builtin_amdgcn_exp2f(s[kr][blk][i] - mx); s[kr][blk][i] = e; sum += e; }
            sum += __shfl_xor(sum, 16); sum += __shfl_xor(sum, 32);
            const float inv = 1.f / sum;
            pg8::f32x4 o[4];
#pragma unroll
            for (int db = 0; db < 4; ++db) o[db] = (pg8::f32x4){0.f, 0.f, 0.f, 0.f};
#pragma unroll
            for (int kr = 0; kr < 8; ++kr) {
                v4u pw; pw.x = pk2(s[kr][0][0], s[kr][0][1]); pw.y = pk2(s[kr][0][2], s[kr][0][3]); pw.z = pk2(s[kr][1][0], s[kr][1][1]); pw.w = pk2(s[kr][1][2], s[kr][1][3]);
                const bf16x8 pf = __builtin_bit_cast(bf16x8, pw);
#pragma unroll
                for (int db = 0; db < 4; ++db) { const bf16x8 vf = *(const LAS bf16x8*)(vl + kr * 8192 + db * 2048 + vch);
                    o[db] = __builtin_amdgcn_mfma_f32_16x16x32_bf16(vf, pf, o[db], 0, 0, 0); }
                if (kr & 1) __builtin_amdgcn_sched_barrier(0); }
            bf16* op = O + tq * D + h * HD + 4 * g;
#pragma unroll
            for (int db = 0; db < 4; ++db) { v2u wv; wv.x = pk2(o[db][0] * inv, o[db][1] * inv); wv.y = pk2(o[db][2] * inv, o[db][3] * inv); *(GAS v2u*)(op + 16 * db) = wv; }
        }
#undef NA_LOAD
    }
    __syncthreads();
}
namespace mla {
constexpr int NSLOT = 4, KSLOT = 12288, VSLOT = 8192;
constexpr int L_K = 0, L_V = NSLOT * KSLOT, L_WS = L_V + NSLOT * VSLOT, L_OST = L_WS + 2048, L_BYTES = L_OST + 8 * 4096;
constexpr float THR = 8.f;
typedef LAS unsigned char lch;
__device__ __forceinline__ int crow(int r, int hi) { return (r & 3) + 8 * (r >> 2) + 4 * hi; }
__device__ __forceinline__ void glds16(const void* sbase, unsigned voff, unsigned lds_dst) { unsigned keep;
    asm volatile("s_mov_b32 %0, m0\n\ts_mov_b32 m0, %3\n\ts_nop 0\n\tglobal_load_lds_dwordx4 %1, %2\n\ts_mov_b32 m0, %0" : "=&s"(keep) : "v"(voff), "s"(sbase), "s"(lds_dst) : "memory"); }
#define MLA_WAIT_BAR(N) asm volatile("s_waitcnt vmcnt(" #N ") lgkmcnt(0)\n\ts_barrier" ::: "memory")
#define MLA_WAIT_FULL() do { if (wid < 4) { MLA_WAIT_BAR(6); } else { MLA_WAIT_BAR(4); } } while (0)
#define MLA_SBAR() __builtin_amdgcn_sched_barrier(0)
#define MLA_MF(a, b, c) __builtin_amdgcn_mfma_f32_32x32x16_bf16(a, b, c, 0, 0, 0)
#define MLA_PIN(x) asm volatile("" : "+v"(x))
#define MLA_EX(v) __builtin_amdgcn_exp2f(v)
__device__ __forceinline__ void unit(int b, int h, int qb, const bf16* Q1, const bf16* KN, const bf16* KR, const bf16* VT, bf16* O1, lch* lds) {
    const int tid = threadIdx.x, wid = __builtin_amdgcn_readfirstlane(tid >> 6), lane = tid & 63, r32 = lane & 31, hi = lane >> 5;
    const size_t rowbase = (size_t)b * SEQ; const int q0 = qb * 256;
    const unsigned lds0 = (unsigned)(uintptr_t)lds;
    LAS float* wsf = (LAS float*)(lds + L_WS) + wid * 64;
    const bf16* knb = KN + ((size_t)h * M + rowbase + 8 * wid) * HD; const bf16* krb = KR + (rowbase + 16 * (wid & 3)) * RP; const bf16* vb = VT + ((rowbase >> 6) * D + h * HD + 8 * wid) * GW;
    unsigned kno, kro, vo;
    { const int rl = lane >> 3, row = 8 * wid + rl, c = (lane & 7) ^ ((row >> 1) & 7); kno = (unsigned)((rl * HD + c * 8) * 2); }
    { const int rl = lane >> 2, row = 16 * (wid & 3) + rl, c = (lane & 3) ^ ((row >> 2) & 3); kro = (unsigned)((rl * RP + c * 8) * 2); }
    { const int dl = lane >> 3, d = 8 * wid + dl, c = (lane & 7) ^ ((d >> 1) & 7); vo = (unsigned)((dl * GW + c * 8) * 2); }
    const unsigned kndst = lds0 + L_K + wid * 1024, krdst = lds0 + L_K + 8192 + (wid & 3) * 1024, vdst = lds0 + L_V + wid * 1024;
#define DMA_K(t, slot) do { glds16(knb + (size_t)(t) * (64 * HD), kno, (unsigned)__builtin_amdgcn_readfirstlane(kndst + (slot))); if (wid < 4) glds16(krb + (size_t)(t) * (64 * RP), kro, (unsigned)__builtin_amdgcn_readfirstlane(krdst + (slot))); } while (0)
#define DMA_V(t, slot) glds16(vb + (size_t)(t) * (D * GW), vo, (unsigned)__builtin_amdgcn_readfirstlane(vdst + (slot)))
    const int rowA = (r32 & ~0xC) | ((r32 & 4) << 1) | ((r32 & 8) >> 1);
    const lch* kpn0 = lds + L_K + rowA * 128 + (((0 + hi) ^ ((rowA >> 1) & 7)) * 16); const lch* kpn1 = lds + L_K + rowA * 128 + (((2 + hi) ^ ((rowA >> 1) & 7)) * 16);
    const lch* kpn2 = lds + L_K + rowA * 128 + (((4 + hi) ^ ((rowA >> 1) & 7)) * 16); const lch* kpn3 = lds + L_K + rowA * 128 + (((6 + hi) ^ ((rowA >> 1) & 7)) * 16);
    const lch* kpr0 = lds + L_K + 8192 + rowA * 64 + (((0 + hi) ^ ((rowA >> 2) & 3)) * 16); const lch* kpr1 = lds + L_K + 8192 + rowA * 64 + (((2 + hi) ^ ((rowA >> 2) & 3)) * 16);
    const lch* vp0 = lds + L_V + r32 * 128 + (((0 + hi) ^ ((r32 >> 1) & 7)) * 16); const lch* vp1 = lds + L_V + r32 * 128 + (((2 + hi) ^ ((r32 >> 1) & 7)) * 16);
    const lch* vp2 = lds + L_V + r32 * 128 + (((4 + hi) ^ ((r32 >> 1) & 7)) * 16); const lch* vp3 = lds + L_V + r32 * 128 + (((6 + hi) ^ ((r32 >> 1) & 7)) * 16);
#define LDF(p) (*(const LAS bf16x8*)(p))
#define KLOAD_ALL(so) do { kf[0] = LDF(kpn0 + (so)); kf[1] = LDF(kpn0 + (so) + 4096); kf[2] = LDF(kpn1 + (so)); kf[3] = LDF(kpn1 + (so) + 4096); kf[4] = LDF(kpn2 + (so)); kf[5] = LDF(kpn2 + (so) + 4096); \
        kf[6] = LDF(kpn3 + (so)); kf[7] = LDF(kpn3 + (so) + 4096); kf[8] = LDF(kpr0 + (so)); kf[9] = LDF(kpr0 + (so) + 2048); kf[10] = LDF(kpr1 + (so)); kf[11] = LDF(kpr1 + (so) + 2048); } while (0)
    bf16x8 kf[12], qr[6];
    constexpr int NT = SEQ / 64;
    DMA_K(0, 0); DMA_V(0, 0); DMA_K(1, KSLOT);
    { const bf16* Qw = Q1 + (rowbase + q0 + wid * 32 + r32) * 1536 + h * QKD + hi * 8;
#pragma unroll
      for (int d0 = 0; d0 < 6; ++d0) qr[d0] = *(const bf16x8*)(Qw + d0 * 16); }
    DMA_V(1, VSLOT); DMA_K(2, 2 * KSLOT); DMA_K(3, 3 * KSLOT);
    float m_ref = 0.f, l_reg = 0.f; f32x16 o[2]; o[0] = f32x16{}; o[1] = f32x16{}; f32x16 negm;
    f32x16 pA0, pA1, pB0, pB1; bool resc = false;
    if (wid < 4) { MLA_WAIT_BAR(8); } else { MLA_WAIT_BAR(5); }
    KLOAD_ALL(0);
    { const f32x16 z = {};
      pA0 = MLA_MF(kf[0], qr[0], z); pA1 = MLA_MF(kf[1], qr[0], z);
#pragma unroll
      for (int d0 = 1; d0 < 6; ++d0) { pA0 = MLA_MF(kf[2 * d0], qr[d0], pA0); pA1 = MLA_MF(kf[2 * d0 + 1], qr[d0], pA1); } }
    { float rm = pA0[0];
#pragma unroll
      for (int r = 1; r < 16; ++r) rm = fmaxf(rm, pA0[r]);
#pragma unroll
      for (int r = 0; r < 16; ++r) rm = fmaxf(rm, pA1[r]);
      { auto rr = __builtin_amdgcn_permlane32_swap(__float_as_uint(rm), __float_as_uint(rm), false, false); rm = fmaxf(__uint_as_float(rr[0]), __uint_as_float(rr[1])); }
      m_ref = rm;
#pragma unroll
      for (int r = 0; r < 16; ++r) negm[r] = -m_ref;
      MLA_PIN(negm);
#pragma unroll
      for (int r = 0; r < 16; ++r) { pA0[r] = MLA_EX(pA0[r] - m_ref); pA1[r] = pA1[r] - m_ref; } }
    MLA_WAIT_BAR(0);
    DMA_K(4, 0); DMA_V(2, 2 * VSLOT);
    KLOAD_ALL(KSLOT);
    MLA_WAIT_FULL();
    bf16x8 vA0, vA1, vA2, vA3, vB0, vB1, vB2, vB3; v4u pw0, pw1, pw2, pw3;
#define PKW(P, B) pk2(P[B], P[(B) + 1])
#define PAF(k) __builtin_bit_cast(bf16x8, pw##k)
#define GAE(MF, X, B, A0, A1, A2, A3) do { MF; X[B] = MLA_EX(X[B]); X[(B) + 1] = MLA_EX(X[(B) + 1]); X[(B) + 2] = MLA_EX(X[(B) + 2]); X[(B) + 3] = MLA_EX(X[(B) + 3]); MLA_PIN(X); \
        sacc += A0; sacc += A1; sacc += A2; sacc += A3; MLA_PIN(sacc); MLA_SBAR(); } while (0)
#define GAC(MF, A0, A1, A2, A3, W0, W1, PW) do { MF; sacc += A0; sacc += A1; sacc += A2; sacc += A3; MLA_PIN(sacc); W0; W1; MLA_PIN(PW); MLA_SBAR(); } while (0)
#define GAW(MF, W0, W1, W2, W3, PW) do { MF; W0; W1; W2; W3; MLA_PIN(PW); MLA_SBAR(); } while (0)
#define GB(MF, X0, X1, J) do { MF; X0[J] = MLA_EX(X0[J]); X0[(J) + 1] = MLA_EX(X0[(J) + 1]); MLA_PIN(X0); MLA_SBAR(); } while (0)
#define STEP(C0, C1, P0, P1, t, R, GK, GV, GL) do { MLA_SBAR(); \
    constexpr int kc = (R) * KSLOT, kn = (((R) + 1) % 4) * KSLOT, vpv = (((R) + 3) % 4) * VSLOT, vn = (((R) + 2) % 4) * VSLOT; float sacc = 0.f; \
    vA0 = LDF(vp0 + vpv); MLA_SBAR(); GAE(C0 = MLA_MF(kf[0], qr[0], negm), P1, 0, P0[0], P0[1], P0[2], P0[3]); \
    vA1 = LDF(vp1 + vpv); MLA_SBAR(); GAE(C1 = MLA_MF(kf[1], qr[0], negm), P1, 4, P0[4], P0[5], P0[6], P0[7]); \
    vA2 = LDF(vp2 + vpv); MLA_SBAR(); GAE(C0 = MLA_MF(kf[2], qr[1], C0), P1, 8, P0[8], P0[9], P0[10], P0[11]); \
    vA3 = LDF(vp3 + vpv); MLA_SBAR(); GAE(C1 = MLA_MF(kf[3], qr[1], C1), P1, 12, P0[12], P0[13], P0[14], P0[15]); \
    GAC(C0 = MLA_MF(kf[4], qr[2], C0), P1[0], P1[1], P1[2], P1[3], pw0[0] = PKW(P0, 0), pw0[1] = PKW(P0, 2), pw0); \
    GAC(C1 = MLA_MF(kf[5], qr[2], C1), P1[4], P1[5], P1[6], P1[7], pw0[2] = PKW(P0, 4), pw0[3] = PKW(P0, 6), pw0); \
    GAC(C0 = MLA_MF(kf[6], qr[3], C0), P1[8], P1[9], P1[10], P1[11], pw1[0] = PKW(P0, 8), pw1[1] = PKW(P0, 10), pw1); \
    GAC(C1 = MLA_MF(kf[7], qr[3], C1), P1[12], P1[13], P1[14], P1[15], pw1[2] = PKW(P0, 12), pw1[3] = PKW(P0, 14), pw1); \
    GAW(C0 = MLA_MF(kf[8], qr[4], C0), pw2[0] = PKW(P1, 0), pw2[1] = PKW(P1, 2), pw2[2] = PKW(P1, 4), pw2[3] = PKW(P1, 6), pw2); \
    GAW(C1 = MLA_MF(kf[9], qr[4], C1), pw3[0] = PKW(P1, 8), pw3[1] = PKW(P1, 10), pw3[2] = PKW(P1, 12), pw3[3] = PKW(P1, 14), pw3); \
    C0 = MLA_MF(kf[10], qr[5], C0); C1 = MLA_MF(kf[11], qr[5], C1); \
    l_reg += sacc; \
    if (GK) { DMA_K((t) + 4, kc); } if (GV) { DMA_V((t) + 2, vn); } \
    { float a_ = fmaxf(fmaxf(C0[0], C0[1]), C1[0]), b_ = fmaxf(fmaxf(C0[2], C0[3]), C1[1]); a_ = fmaxf(fmaxf(a_, C1[2]), C1[3]); \
      _Pragma("unroll") for (int r = 4; r < 16; r += 4) { a_ = fmaxf(fmaxf(a_, C0[r]), C0[r + 1]); b_ = fmaxf(fmaxf(b_, C0[r + 2]), C0[r + 3]); a_ = fmaxf(fmaxf(a_, C1[r]), C1[r + 1]); b_ = fmaxf(fmaxf(b_, C1[r + 2]), C1[r + 3]); } \
      float rm = fmaxf(a_, b_); { auto rr = __builtin_amdgcn_permlane32_swap(__float_as_uint(rm), __float_as_uint(rm), false, false); rm = fmaxf(__uint_as_float(rr[0]), __uint_as_float(rr[1])); } \
      resc = false; \
      if (__builtin_expect(__any(rm > THR), 0)) { const float dl = fmaxf(rm, 0.f), f = MLA_EX(-dl); m_ref += dl; l_reg *= f; if (hi == 0) wsf[r32] = f; resc = true; \
        _Pragma("unroll") for (int r = 0; r < 16; ++r) { C0[r] -= dl; C1[r] -= dl; } \
        _Pragma("unroll") for (int r = 0; r < 16; ++r) negm[r] = -m_ref; MLA_PIN(negm); } } \
    MLA_SBAR(); \
    vB0 = LDF(vp0 + vpv + 4096); if (GL) { kf[0] = LDF(kpn0 + kn); } MLA_SBAR(); GB(o[0] = MLA_MF(PAF(0), vA0, o[0]), C0, C1, 0); \
    vB1 = LDF(vp1 + vpv + 4096); if (GL) { kf[1] = LDF(kpn0 + kn + 4096); } MLA_SBAR(); GB(o[0] = MLA_MF(PAF(1), vA1, o[0]), C0, C1, 2); \
    vB2 = LDF(vp2 + vpv + 4096); if (GL) { kf[2] = LDF(kpn1 + kn); kf[3] = LDF(kpn1 + kn + 4096); } MLA_SBAR(); GB(o[0] = MLA_MF(PAF(2), vA2, o[0]), C0, C1, 4); \
    vB3 = LDF(vp3 + vpv + 4096); if (GL) { kf[4] = LDF(kpn2 + kn); kf[5] = LDF(kpn2 + kn + 4096); } MLA_SBAR(); GB(o[0] = MLA_MF(PAF(3), vA3, o[0]), C0, C1, 6); \
    if (GL) { kf[6] = LDF(kpn3 + kn); kf[7] = LDF(kpn3 + kn + 4096); } MLA_SBAR(); GB(o[1] = MLA_MF(PAF(0), vB0, o[1]), C0, C1, 8); \
    if (GL) { kf[8] = LDF(kpr0 + kn); kf[9] = LDF(kpr0 + kn + 2048); } MLA_SBAR(); GB(o[1] = MLA_MF(PAF(1), vB1, o[1]), C0, C1, 10); \
    if (GL) { kf[10] = LDF(kpr1 + kn); kf[11] = LDF(kpr1 + kn + 2048); } MLA_SBAR(); GB(o[1] = MLA_MF(PAF(2), vB2, o[1]), C0, C1, 12); \
    GB(o[1] = MLA_MF(PAF(3), vB3, o[1]), C0, C1, 14); \
    } while (0)
#define RESC() do { if (resc) { LDS_WAIT(); \
    _Pragma("unroll") for (int d_ = 0; d_ < 2; ++d_) _Pragma("unroll") for (int r_ = 0; r_ < 16; ++r_) o[d_][r_] *= wsf[crow(r_, hi)]; } } while (0)
    static_assert(NT == 128, "the step program below is written for 128 tiles");
    for (int t = 1; t < 121; t += 4) {
        STEP(pB0, pB1, pA0, pA1, t,     1, true, true, true); MLA_WAIT_FULL(); RESC();
        STEP(pA0, pA1, pB0, pB1, t + 1, 2, true, true, true); MLA_WAIT_FULL(); RESC();
        STEP(pB0, pB1, pA0, pA1, t + 2, 3, true, true, true); MLA_WAIT_FULL(); RESC();
        STEP(pA0, pA1, pB0, pB1, t + 3, 0, true, true, true); MLA_WAIT_FULL(); RESC();
    }
    STEP(pB0, pB1, pA0, pA1, 121, 1, true, true, true);    MLA_WAIT_FULL(); RESC();
    STEP(pA0, pA1, pB0, pB1, 122, 2, true, true, true);    MLA_WAIT_FULL(); RESC();
    STEP(pB0, pB1, pA0, pA1, 123, 3, true, true, true);    MLA_WAIT_FULL(); RESC();
    STEP(pA0, pA1, pB0, pB1, 124, 0, false, true, true);   if (wid < 4) { MLA_WAIT_BAR(4); } else { MLA_WAIT_BAR(3); } RESC();
    STEP(pB0, pB1, pA0, pA1, 125, 1, false, true, true);   MLA_WAIT_BAR(2); RESC();
    STEP(pA0, pA1, pB0, pB1, 126, 2, false, false, true);  MLA_WAIT_BAR(0); RESC();
    STEP(pB0, pB1, pA0, pA1, 127, 3, false, false, false); RESC();
    constexpr int vc = 3 * VSLOT;
    {
#pragma unroll
      for (int r = 0; r < 16; ++r) pB1[r] = MLA_EX(pB1[r]);
      float sacc = 0.f;
#pragma unroll
      for (int r = 0; r < 16; ++r) sacc += pB0[r];
#pragma unroll
      for (int r = 0; r < 16; ++r) sacc += pB1[r];
      l_reg += sacc;
      pw0 = (v4u){PKW(pB0, 0), PKW(pB0, 2), PKW(pB0, 4), PKW(pB0, 6)}; pw1 = (v4u){PKW(pB0, 8), PKW(pB0, 10), PKW(pB0, 12), PKW(pB0, 14)};
      pw2 = (v4u){PKW(pB1, 0), PKW(pB1, 2), PKW(pB1, 4), PKW(pB1, 6)}; pw3 = (v4u){PKW(pB1, 8), PKW(pB1, 10), PKW(pB1, 12), PKW(pB1, 14)};
      MLA_SBAR();
#pragma unroll
      for (int dh = 0; dh < 2; ++dh) { const bf16x8 w0 = LDF(vp0 + vc + dh * 4096), w1 = LDF(vp1 + vc + dh * 4096), w2 = LDF(vp2 + vc + dh * 4096), w3 = LDF(vp3 + vc + dh * 4096);
          o[dh] = MLA_MF(PAF(0), w0, o[dh]); o[dh] = MLA_MF(PAF(1), w1, o[dh]); o[dh] = MLA_MF(PAF(2), w2, o[dh]); o[dh] = MLA_MF(PAF(3), w3, o[dh]); } }
    { auto rr = __builtin_amdgcn_permlane32_swap(__float_as_uint(l_reg), __float_as_uint(l_reg), false, false); l_reg = __uint_as_float(rr[0]) + __uint_as_float(rr[1]); }
    if (hi == 0) wsf[32 + r32] = l_reg; LDS_WAIT();
    { LAS bf16* stg = (LAS bf16*)(lds + L_OST) + wid * 2048;
#pragma unroll
      for (int r = 0; r < 16; ++r) { const int orow = crow(r, hi); const float rl = __builtin_amdgcn_rcpf(wsf[32 + orow]);
#pragma unroll
          for (int dh = 0; dh < 2; ++dh) stg[orow * 64 + dh * 32 + r32] = (bf16)(pk2(o[dh][r] * rl, 0.f) & 0xffffu); }
      LDS_WAIT();
      bf16* Ow = O1 + (rowbase + q0 + wid * 32) * 1024 + h * HD;
#pragma unroll
      for (int i = 0; i < 4; ++i) { const int row = i * 8 + (lane >> 3), ch = lane & 7; const v4u v = *(const LAS v4u*)(stg + row * 64 + ch * 8); *(GAS v4u*)(Ow + (size_t)row * 1024 + ch * 8) = v; } }
    asm volatile("s_waitcnt lgkmcnt(0)\n\ts_barrier" ::: "memory");
#undef DMA_K
#undef DMA_V
#undef LDF
#undef KLOAD_ALL
#undef PKW
#undef PAF
#undef GAE
#undef GAC
#undef GAW
#undef GB
#undef STEP
#undef RESC
}
#undef MLA_WAIT_BAR
#undef MLA_WAIT_FULL
#undef MLA_SBAR
#undef MLA_MF
#undef MLA_PIN
#undef MLA_EX
}

#ifndef MK_CHECK
#define MK_CHECK 0
#endif
#ifndef MK_PHASED
#define MK_PHASED 0
#endif
#ifndef MK_DBL
#define MK_DBL 0u
#endif
#define REP(k) ((((unsigned)MK_DBL >> (k)) & 1u) ? 2 : 1)

#if MK_CHECK
__global__ void __launch_bounds__(256) chk_na(const bf16* Q, const bf16* K, const bf16* VT, const bf16* O, const float* rpb, float* accum) {
    __shared__ float qs[4][64], ps[4][128];
    const int w = threadIdx.x >> 6, lane = threadIdx.x & 63;
    const int unit = blockIdx.x * 4 + w, tok = unit / NH, h = unit % NH;
    const int b = tok / SEQ, t = tok % SEQ, r = t / GW, c = t % GW;
    int rs = r - 4; rs = rs < 0 ? 0 : (rs > GROWS - 8 ? GROWS - 8 : rs);
    int cs = c - 8; cs = cs < 0 ? 0 : (cs > GW - 16 ? GW - 16 : cs);
    qs[w][lane] = bf2f(Q[(size_t)tok * D + h * HD + lane]) * (1.f / LOG2E);
    __syncthreads();
    float sc[2];
#pragma unroll
    for (int u = 0; u < 2; ++u) {
        const int kk = lane + 64 * u, i = kk >> 4, j = kk & 15;
        const size_t kt = (size_t)b * SEQ + (rs + i) * GW + cs + j;
        const bf16* kp = K + ((size_t)h * M + kt) * HD;
        float a = 0.f;
        for (int d = 0; d < HD; ++d) a += qs[w][d] * bf2f(kp[d]);
        sc[u] = a + rpb[(h * 15 + (rs + i - r + 7)) * 31 + (cs + j - c + 15)];
    }
    float mx = fmaxf(sc[0], sc[1]);
    for (int o = 1; o < 64; o <<= 1) mx = fmaxf(mx, __shfl_xor(mx, o));
    const float e0 = expf(sc[0] - mx), e1 = expf(sc[1] - mx);
    const float inv = 1.f / wave_sum(e0 + e1);
    ps[w][lane] = e0 * inv; ps[w][lane + 64] = e1 * inv;
    __syncthreads();
    float acc = 0.f;
    for (int kk = 0; kk < 128; ++kk) { const int i = kk >> 4, j = kk & 15; const size_t kt = (size_t)b * SEQ + (rs + i) * GW + cs + j;
        acc += ps[w][kk] * bf2f(VT[((kt >> 6) * D + h * HD + lane) * GW + (kt & 63)]); }
    const float got = bf2f(O[(size_t)tok * D + h * HD + lane]);
    const float e2 = wave_sum((got - acc) * (got - acc)), r2 = wave_sum(acc * acc);
    if (lane == 0) { atomicAdd(accum, e2); atomicAdd(accum + 1, r2); }
}
__global__ void __launch_bounds__(64) chk_mla(const bf16* Q1, const bf16* KN, const bf16* KR, const bf16* VT, const bf16* O1, float* accum) {
    __shared__ float sc[SEQ]; __shared__ float qv[96];
    const int lane = threadIdx.x, i = blockIdx.x >> 4, h = blockIdx.x & 15;
    const int tok = i * 32 + ((i * 7) & 31), b = tok / SEQ;
    for (int d = lane; d < 96; d += 64) qv[d] = bf2f(Q1[(size_t)tok * 1536 + h * 96 + d]);
    __syncthreads();
    float mx = -1e30f;
    for (int key = lane; key < SEQ; key += 64) { const size_t kt = (size_t)b * SEQ + key; float a = 0.f;
        for (int d = 0; d < 64; ++d) a += qv[d] * bf2f(KN[((size_t)h * M + kt) * 64 + d]);
        for (int d = 0; d < 32; ++d) a += qv[64 + d] * bf2f(KR[kt * 32 + d]);
        sc[key] = a; mx = fmaxf(mx, a); }
    for (int o = 1; o < 64; o <<= 1) mx = fmaxf(mx, __shfl_xor(mx, o));
    float sm = 0.f;
    for (int key = lane; key < SEQ; key += 64) { const float e = exp2f(sc[key] - mx); sc[key] = e; sm += e; }
    sm = wave_sum(sm);
    __syncthreads();
    float acc = 0.f;
    for (int key = 0; key < SEQ; ++key) { const size_t kt = (size_t)b * SEQ + key; acc += sc[key] * bf2f(VT[((kt >> 6) * D + h * 64 + lane) * GW + (kt & 63)]); }
    acc /= sm;
    const float got = bf2f(O1[(size_t)tok * 1024 + h * 64 + lane]);
    const float e2 = wave_sum((got - acc) * (got - acc)), r2 = wave_sum(acc * acc);
    if (lane == 0) { atomicAdd(accum, e2); atomicAdd(accum + 1, r2); }
}
__global__ void chk_tweak(float* out, const float* accum, float amp) {
    const float s = sqrtf(amp * accum[0] / fmaxf(accum[1], 1e-30f));
    const size_t i = (size_t)blockIdx.x * 256 + threadIdx.x; out[i] *= (1.f + s);
}

__global__ void __launch_bounds__(256) chk_proj(const float* DOWN, const float* qn, const float* kvn, const float* w_uq, const float* w_ukv,
                                                const bf16* Q1, const bf16* KR, const bf16* KN, const bf16* VT, float* accum) {
    __shared__ float cq[256], ckv[128], qv[1536], red[8];
    const int tid = threadIdx.x, i = blockIdx.x, row = i * 64 + ((i * 11) & 63), t = row & (SEQ - 1), gr = t >> 6, gc = t & 63;
    const float* dr = DOWN + (size_t)row * 512;
    float ss = dr[tid] * dr[tid], ssk = tid < 128 ? dr[256 + tid] * dr[256 + tid] : 0.f;
    ss = wave_sum(ss); ssk = wave_sum(ssk);
    if ((tid & 63) == 0) { red[tid >> 6] = ss; red[4 + (tid >> 6)] = ssk; }
    __syncthreads();
    const float rq = rsqrtf((red[0] + red[1] + red[2] + red[3]) / 256.f + 1e-6f), rk = rsqrtf((red[4] + red[5] + red[6] + red[7]) / 128.f + 1e-6f);
    cq[tid] = dr[tid] * rq * qn[tid]; if (tid < 128) ckv[tid] = dr[256 + tid] * rk * kvn[tid];
    __syncthreads();
    for (int c = tid; c < 1536; c += 256) { float a = 0.f; for (int k = 0; k < 256; ++k) a += cq[k] * w_uq[(size_t)k * 1536 + c]; qv[c] = a; }
    __syncthreads();
    float e[4] = {0.f, 0.f, 0.f, 0.f}, r[4] = {0.f, 0.f, 0.f, 0.f};
    for (int c = tid; c < 1536; c += 256) { const int d = c % 96; float v = qv[c];
        if (d >= 64) { const int pr = (d - 64) >> 1; const float inv = powf(10000.f, -(float)(pr & 7) / 8.f), ang = (pr < 8 ? (float)gr : (float)gc) * inv, cs = cosf(ang), sn = sinf(ang);
            const float x1 = qv[c & ~1], x2 = qv[c | 1]; v = (c & 1) ? x1 * sn + x2 * cs : x1 * cs - x2 * sn; }
        v *= QSCALE1; const float g = bf2f(Q1[(size_t)row * 1536 + c]); e[0] += (g - v) * (g - v); r[0] += v * v; }
    if (tid < 32) { const int pr = tid >> 1; const float inv = powf(10000.f, -(float)(pr & 7) / 8.f), ang = (pr < 8 ? (float)gr : (float)gc) * inv, cs = cosf(ang), sn = sinf(ang);
        const float x1 = dr[384 + (tid & ~1)], x2 = dr[384 + (tid | 1)]; const float v = (tid & 1) ? x1 * sn + x2 * cs : x1 * cs - x2 * sn;
        const float g = bf2f(KR[(size_t)row * 32 + tid]); e[1] += (g - v) * (g - v); r[1] += v * v; }
    for (int c = tid; c < 2048; c += 256) { float a = 0.f; for (int k = 0; k < 128; ++k) a += ckv[k] * w_ukv[(size_t)k * 2048 + c];
        const int h = c >> 7, d = c & 127;
        if (d < 64) { const float g = bf2f(KN[((size_t)h * M + row) * 64 + d]); e[2] += (g - a) * (g - a); r[2] += a * a; }
        else { const float g = bf2f(VT[((size_t)(row >> 6) * D + h * 64 + d - 64) * GW + (row & 63)]); e[3] += (g - a) * (g - a); r[3] += a * a; } }
#pragma unroll
    for (int q = 0; q < 4; ++q) { const float es = wave_sum(e[q]), rs = wave_sum(r[q]); if ((tid & 63) == 0) { atomicAdd(accum + 2 * q, es); atomicAdd(accum + 2 * q + 1, rs); } }
}
__global__ void chk_tweak4(float* out, const float* accum, float amp) {
    float s2 = 0.f;
    for (int q = 0; q < 4; ++q) s2 += accum[2 * q] / fmaxf(accum[2 * q + 1], 1e-30f);
    const float s = sqrtf(amp * s2);
    const size_t i = (size_t)blockIdx.x * 256 + threadIdx.x; out[i] *= (1.f + s);
}
#endif


__device__ __forceinline__ int moe_count_prefix(Frame& F, int nblk, LAS int* red) {
    typedef int i32x4 __attribute__((ext_vector_type(4)));
    i32x4 a = {0, 0, 0, 0}, b = {0, 0, 0, 0};
    if (F.tid < nblk) { const i32x4* p = (const i32x4*)(WSP(int, WS_CNTWG) + F.tid * 8); a = p[0]; b = p[1]; }
    int c[8] = {a.x, a.y, a.z, a.w, b.x, b.y, b.z, b.w};
#pragma unroll
    for (int o = 1; o < 64; o <<= 1)
#pragma unroll
        for (int e = 0; e < 8; ++e) c[e] += __shfl_xor(c[e], o);
    if (F.lane == 0 && F.wave < 4) {
#pragma unroll
        for (int e = 0; e < 8; ++e) red[F.wave * 8 + e] = c[e]; }
    __syncthreads();
    int r = 0;
    if (F.tid < 8) r = (red[F.tid] + red[8 + F.tid]) + (red[16 + F.tid] + red[24 + F.tid]);
    __syncthreads();
    return r;
}
__device__ __forceinline__ void moe_tables(Frame& F) {
    LAS int* red = (LAS int*)(F.lds + 65536);
    const int tot = moe_count_prefix(F, 256, red);
    if (F.tid < 8) F.MISC[16 + F.tid] = (unsigned)tot;
    __syncthreads();
    if (F.tid == 0) { int tb = 0;
        for (int e = 0; e < 8; ++e) { F.MISC[24 + e] = (unsigned)tb; F.MISC[33 + e] = (unsigned)(tb * 256); tb += ((int)F.MISC[16 + e] + 255) >> 8; }
        F.MISC[32] = (unsigned)tb; F.MISC[41] = (unsigned)(tb * 256); }
    __syncthreads();
}
template <typename TX> __device__ __forceinline__ void router_phase(Frame& F, const TX* X, int l, int cs) {
    LAS float* wr_l = (LAS float*)(F.lds);
    LAS int* rowE = (LAS int*)(F.lds + 32768);
    LAS float* rowW = (LAS float*)(F.lds + 32768 + 512);
    LAS int* rowP = (LAS int*)(F.lds + 32768 + 1024);
    LAS int* lcnt = (LAS int*)(F.lds + 32768 + 1536);
    for (int i = F.tid; i < D * NE / 4; i += NTHREADS) ((LAS f32x4*)wr_l)[i] = ((const f32x4*)F.in[15])[i];
    __syncthreads();
    const float* mf = WSP(float, WS_MODF);
    for (int blk = blockIdx.x; blk < M / 64; blk += F.G) {
        const int b = (blk * 64) >> 13;
        f32x4 sh[4], sc[4];
#pragma unroll
        for (int j = 0; j < 4; ++j) { const int n = 4 * F.lane + 256 * j; sh[j] = *(const f32x4*)(mf + (size_t)(l * 2 + b) * 6 * D + cs * D + n); sc[j] = *(const f32x4*)(mf + (size_t)(l * 2 + b) * 6 * D + (cs + 1) * D + n) + 1.f; }
        for (int rr0 = 0; rr0 < 8; rr0 += 4) {
            f32x4 v[4][4]; float ss[4];
#pragma unroll
            for (int q = 0; q < 4; ++q) {
#pragma unroll
                for (int j = 0; j < 4; ++j) v[q][j] = XRow<TX>::ld(X, (size_t)(blk * 64 + F.wave * 8 + rr0 + q), 4 * F.lane + 256 * j); }
#pragma unroll
            for (int q = 0; q < 4; ++q) { ss[q] = 0.f;
#pragma unroll
                for (int j = 0; j < 4; ++j) ss[q] += (v[q][j].x * v[q][j].x + v[q][j].y * v[q][j].y) + (v[q][j].z * v[q][j].z + v[q][j].w * v[q][j].w); }
#pragma unroll
            for (int o = 1; o < 64; o <<= 1)
#pragma unroll
                for (int q = 0; q < 4; ++q) ss[q] += __shfl_xor(ss[q], o);
            float lg[4][8];
#pragma unroll
            for (int q = 0; q < 4; ++q) { const float rstd = rsqrtf(ss[q] * (1.f / D) + NORM_EPS);
#pragma unroll
                for (int e = 0; e < 8; ++e) lg[q][e] = 0.f;
                GAS v2u* o8 = (GAS v2u*)(WSP(bf16, WS_HN) + (size_t)(blk * 64 + F.wave * 8 + rr0 + q) * D) + F.lane;
#pragma unroll
                for (int j = 0; j < 4; ++j) { v[q][j] = v[q][j] * rstd * sc[j] + sh[j]; { v2u w; w.x = pk2(v[q][j].x, v[q][j].y); w.y = pk2(v[q][j].z, v[q][j].w); o8[64 * j] = w; } } }
#pragma unroll
            for (int j = 0; j < 4; ++j)
#pragma unroll
                for (int c = 0; c < 4; ++c) { const LAS f32x4* wp = (const LAS f32x4*)(wr_l + (4 * F.lane + 256 * j + c) * 8); const f32x4 w0 = wp[0], w1 = wp[1];
#pragma unroll
                    for (int q = 0; q < 4; ++q) { const float yq = v[q][j][c];
                        lg[q][0] += yq * w0.x; lg[q][1] += yq * w0.y; lg[q][2] += yq * w0.z; lg[q][3] += yq * w0.w; lg[q][4] += yq * w1.x; lg[q][5] += yq * w1.y; lg[q][6] += yq * w1.z; lg[q][7] += yq * w1.w; } }
#pragma unroll
            for (int o = 1; o < 64; o <<= 1)
#pragma unroll
                for (int q = 0; q < 4; ++q)
#pragma unroll
                    for (int e = 0; e < 8; ++e) lg[q][e] += __shfl_xor(lg[q][e], o);
#pragma unroll
            for (int q = 0; q < 4; ++q) { const int rl = F.wave * 8 + rr0 + q;
                float mx = lg[q][0];
#pragma unroll
                for (int e = 1; e < 8; ++e) mx = fmaxf(mx, lg[q][e]);
                float p[8], sm = 0.f;
#pragma unroll
                for (int e = 0; e < 8; ++e) { p[e] = expf(lg[q][e] - mx); sm += p[e]; }
                int i0 = 0; float v0 = -1.f;
#pragma unroll
                for (int e = 0; e < 8; ++e) { p[e] = p[e] / sm; if (p[e] > v0) { v0 = p[e]; i0 = e; } }
                int i1 = 0; float v1 = -1.f;
#pragma unroll
                for (int e = 0; e < 8; ++e) if (e != i0 && p[e] > v1) { v1 = p[e]; i1 = e; }
                if (F.lane == 0) { const float s2 = v0 + v1; rowE[rl * 2] = i0; rowE[rl * 2 + 1] = i1; rowW[rl * 2] = v0 / s2; rowW[rl * 2 + 1] = v1 / s2; } }
        }
        __syncthreads();
        if (F.wave == 0) {
            int cnt[8];
#pragma unroll
            for (int e = 0; e < 8; ++e) cnt[e] = 0;
#pragma unroll
            for (int ch = 0; ch < 2; ++ch) { const int a = ch * 64 + F.lane, ea = rowE[a]; int pos = 0;
#pragma unroll
                for (int e = 0; e < 8; ++e) { const unsigned long long mk = __ballot(ea == e); if (ea == e) pos = cnt[e] + __popcll(mk & ((1ull << F.lane) - 1ull)); cnt[e] += __popcll(mk); }
                rowP[a] = pos; }
            if (F.lane == 0) {
#pragma unroll
                for (int e = 0; e < 8; ++e) lcnt[e] = cnt[e]; } }
        __syncthreads();
        if (F.tid < 128) { const size_t g = (size_t)blk * 128 + F.tid; WSP(int, WS_TOKE)[g] = rowE[F.tid]; WSP(int, WS_TOKP)[g] = rowP[F.tid]; WSP(float, WS_TOKW)[g] = rowW[F.tid]; }
        if (F.tid < 8) WSP(int, WS_CNTWG)[blk * 8 + F.tid] = lcnt[F.tid];
        __syncthreads();
    }
}
__device__ __forceinline__ void gather_phase(Frame& F) {
    LAS int* boff = (LAS int*)(F.lds);
    for (int blk = blockIdx.x; blk < M / 64; blk += F.G) {
        { const int mine = moe_count_prefix(F, blk, (LAS int*)(F.lds + 65536)); if (F.tid < 8) boff[F.tid] = mine + (int)F.MISC[33 + F.tid]; }
        __syncthreads();
        {
            int slot = 0;
            if (F.lane < 16) { const size_t g = (size_t)blk * 128 + F.wave * 16 + F.lane; slot = boff[WSP(int, WS_TOKE)[g]] + WSP(int, WS_TOKP)[g]; WSP(int, WS_TOKS)[g] = slot; }
            v4u r0[8], r1[8];
#pragma unroll
            for (int tk = 0; tk < 8; ++tk) { const GAS v4u* src = (const GAS v4u*)(WSP(bf16, WS_HN) + (size_t)(blk * 64 + F.wave * 8 + tk) * D); r0[tk] = src[F.lane]; r1[tk] = src[64 + F.lane]; }
#pragma unroll
            for (int tk = 0; tk < 8; ++tk) {
#pragma unroll
                for (int k = 0; k < 2; ++k) { const int s = __shfl(slot, 2 * tk + k); GAS v4u* dst = (GAS v4u*)(WSP(bf16, WS_HP) + (size_t)s * D); dst[F.lane] = r0[tk]; dst[64 + F.lane] = r1[tk]; } }
        }
        __syncthreads();
    }
    for (int e = 0; e < 8; ++e) { const int r0 = (int)F.MISC[33 + e] + (int)F.MISC[16 + e], r1 = (int)F.MISC[34 + e];
        for (int r = r0 + F.gw; r < r1; r += F.NGW) { GAS v4u* dst = (GAS v4u*)(WSP(bf16, WS_HP) + (size_t)r * D); dst[F.lane] = (v4u){0u, 0u, 0u, 0u}; dst[64 + F.lane] = (v4u){0u, 0u, 0u, 0u}; } }
}
template <typename TX> __device__ __forceinline__ void final_phase(Frame& F, const TX* X, int l) {
    const bf16* Y = WSP(bf16, WS_HP); const float* mf = WSP(float, WS_MODF);
    f32x4 fn[4];
#pragma unroll
    for (int j = 0; j < 4; ++j) fn[j] = *(const f32x4*)(F.in[18] + 4 * F.lane + 256 * j);
    for (int b = 0; b < NB; ++b) {
        f32x4 gf[4];
#pragma unroll
        for (int j = 0; j < 4; ++j) gf[j] = *(const f32x4*)(mf + (size_t)(l * 2 + b) * 6 * D + 5 * D + 4 * F.lane + 256 * j);
        for (int row = b * SEQ + F.gw; row < (b + 1) * SEQ; row += 4 * F.NGW) {
            int s0[4], s1[4]; float w0[4], w1[4]; bool ok[4]; int rq[4];
#pragma unroll
            for (int q = 0; q < 4; ++q) { ok[q] = row + q * F.NGW < (b + 1) * SEQ; rq[q] = ok[q] ? row + q * F.NGW : row;
                s0[q] = WSP(int, WS_TOKS)[rq[q] * 2]; s1[q] = WSP(int, WS_TOKS)[rq[q] * 2 + 1]; w0[q] = WSP(float, WS_TOKW)[rq[q] * 2]; w1[q] = WSP(float, WS_TOKW)[rq[q] * 2 + 1]; }
            f32x4 xv[4][4]; v2u ya[4][4], yc[4][4];
#pragma unroll
            for (int q = 0; q < 4; ++q) { const GAS v2u* y0 = (const GAS v2u*)(Y + (size_t)s0[q] * D) + F.lane; const GAS v2u* y1 = (const GAS v2u*)(Y + (size_t)s1[q] * D) + F.lane;
#pragma unroll
                for (int j = 0; j < 4; ++j) { xv[q][j] = XRow<TX>::ld(X, (size_t)rq[q], 4 * F.lane + 256 * j); ya[q][j] = y0[64 * j]; yc[q][j] = y1[64 * j]; } }
            float ss[4];
#pragma unroll
            for (int q = 0; q < 4; ++q) { ss[q] = 0.f;
#pragma unroll
                for (int j = 0; j < 4; ++j) { const f32x4 a = {bflo(ya[q][j].x), bfhi(ya[q][j].x), bflo(ya[q][j].y), bfhi(ya[q][j].y)}, c = {bflo(yc[q][j].x), bfhi(yc[q][j].x), bflo(yc[q][j].y), bfhi(yc[q][j].y)};
                    xv[q][j] = xv[q][j] + gf[j] * (a * w0[q] + c * w1[q]); ss[q] += (xv[q][j].x * xv[q][j].x + xv[q][j].y * xv[q][j].y) + (xv[q][j].z * xv[q][j].z + xv[q][j].w * xv[q][j].w); } }
#pragma unroll
            for (int o = 1; o < 64; o <<= 1)
#pragma unroll
                for (int q = 0; q < 4; ++q) ss[q] += __shfl_xor(ss[q], o);
#pragma unroll
            for (int q = 0; q < 4; ++q) if (ok[q]) { const float rstd = rsqrtf(ss[q] * (1.f / D) + NORM_EPS); GAS f32x4* o = (GAS f32x4*)(F.out + (size_t)(row + q * F.NGW) * D) + F.lane;
#pragma unroll
                for (int j = 0; j < 4; ++j) o[64 * j] = xv[q][j] * rstd * fn[j]; }
        }
    }
}

constexpr int N_PHASES = 19;
struct Args { const float* in[19]; float* out; unsigned char* ws; int ph_lo, ph_hi; };
__global__ void __launch_bounds__(NTHREADS, 2) mk_fwd(Args args) {
    extern __shared__ __attribute__((aligned(16))) unsigned char lds[];
    Frame F;
    F.lds = (LAS unsigned char*)lds; F.MISC = (volatile LAS unsigned*)(F.lds + MISC_OFF);
    F.tid = threadIdx.x; F.lane = F.tid & 63; F.wave = __builtin_amdgcn_readfirstlane(F.tid >> 6);
    F.G = gridDim.x; { const int bx = blockIdx.x; F.vcu = (F.G % 8 == 0) ? (bx % 8) * (F.G / 8) + bx / 8 : bx; }
    F.gw = F.vcu * NWAVES + F.wave; F.NGW = F.G * NWAVES;
#pragma unroll
    for (int i = 0; i < 19; ++i) F.in[i] = args.in[i];
    F.out = args.out; F.ws = args.ws;
    for (int u = F.tid; u < (LDS_BYTES - MISC_OFF) / 4; u += NTHREADS) ((LAS unsigned*)(F.lds + MISC_OFF))[u] = 0u;
    __syncthreads();
    XcdBarrier bar; bar.bar = WSP(unsigned, WS_CTL) + 1024; bar.x = 0; bar.st = nullptr;
    if (!MK_PHASED) bar = xcd_barrier_post(WSP(unsigned, WS_CTL) + 1024, F.MISC + 8);
    const int lo = args.ph_lo, hi = args.ph_hi;
#ifdef MK_ONLY
#define IN(k) ((k) == MK_ONLY && lo <= (k) && (k) < hi)
#else
#define IN(k) (lo <= (k) && (k) < hi)
#endif
#define REFRESH() do { int t_ = threadIdx.x; asm volatile("" : "+v"(t_)); F.tid = t_; F.lane = t_ & 63; } while (0)
#define SEAM(k) do { if (IN(k) && IN((k) + 1)) xcd_barrier(bar); } while (0)
    bf16* XA = WSP(bf16, WS_XA); bf16* XB = (bf16*)F.out; const float* MODF = WSP(float, WS_MODF);
    bf16* HN = WSP(bf16, WS_HN);
    LAS unsigned char* ring = F.lds;

    if (IN(0)) for (int rep_ = 0; rep_ < REP(0); ++rep_) { REFRESH(); p0_prologue(F); } SEAM(0);
    if (IN(1)) for (int rep_ = 0; rep_ < REP(1); ++rep_) { REFRESH(); modulate_phase<true, float>(F, F.in[0], 0, 0, HN); modf_reduce(F); } SEAM(1);
    if (IN(2)) for (int rep_ = 0; rep_ < REP(2); ++rep_) { REFRESH();
        { pg8::Gemm g{HN, WSP(bf16, WS_WQK), M, 2048, D}; pg8::StaticOrder S; S.init(M, 2048, F.G, (int)blockIdx.x);
          pg8::EpiBf16P E{WSP(bf16, WS_Q0), D, 8, 4, (size_t)(WS_K0 - WS_Q0) / 2, 0.125f * LOG2E, 0, 1};
          pg8::gemm_phase<pg8::EpiBf16P, pg8::StaticOrder, true, true>(ring, g, S, E); }
        { pg8::Gemm g{WSP(bf16, WS_WV), HN, D, M, D}; pg8::StaticOrder S; S.init(D, M, F.G, (int)blockIdx.x);
          pg8::EpiBf16P E{WSP(bf16, WS_VT0), M, 64, 0, 0, 1.f, 2, 2};
          pg8::gemm_phase<pg8::EpiBf16P, pg8::StaticOrder, true, true>(ring, g, S, E); }
    } SEAM(2);
    if (IN(3)) for (int rep_ = 0; rep_ < REP(3); ++rep_) { REFRESH(); na_phase(F); } SEAM(3);
    if (IN(4)) for (int rep_ = 0; rep_ < REP(4); ++rep_) { REFRESH(); pg8::Gemm g{WSP(bf16, WS_O0), WSP(bf16, WS_WO0), M, D, D}; pg8::StaticOrder S; S.init(M, D, F.G, (int)blockIdx.x);
        pg8::EpiResGateB<true> E{F.in[0], XA, MODF + 0 * 12 * D + 2 * D};
        pg8::gemm_phase<pg8::EpiResGateB<true>, pg8::StaticOrder, true, true>(ring, g, S, E); } SEAM(4);
    if (IN(5)) for (int rep_ = 0; rep_ < REP(5); ++rep_) { REFRESH(); modulate_phase<false, bf16>(F, XA, 0, 3, HN); } SEAM(5);
    if (IN(6)) for (int rep_ = 0; rep_ < REP(6); ++rep_) { REFRESH(); pg8::Gemm g{HN, WSP(bf16, WS_WGU0), M, 2 * FFN, D}; pg8::StaticOrder S; S.init(M, 2 * FFN, F.G, (int)blockIdx.x);
        pg8::EpiSwiGLU E{WSP(bf16, WS_ACT0), FFN, 22};
        pg8::gemm_phase<pg8::EpiSwiGLU, pg8::StaticOrder, true, true>(ring, g, S, E);
        moe_w_side(F, MOE_ITEMS - MOE_G1 - MOE_G2 - MOE_G3, MOE_ITEMS - MOE_G2 - MOE_G3, 128); } SEAM(6);
    if (IN(7)) for (int rep_ = 0; rep_ < REP(7); ++rep_) { REFRESH(); pg8::Gemm g{WSP(bf16, WS_ACT0), WSP(bf16, WS_WDN0), M, D, FFN}; pg8::StaticOrder S; S.init(M, D, F.G, (int)blockIdx.x);
        pg8::EpiResGateB<false> E{XA, XB, MODF + 0 * 12 * D + 5 * D};
        pg8::gemm_phase<pg8::EpiResGateB<false>, pg8::StaticOrder, true, true>(ring, g, S, E); } SEAM(7);
    if (IN(8)) for (int rep_ = 0; rep_ < REP(8); ++rep_) { REFRESH(); modulate_phase<false, bf16>(F, XB, 1, 0, HN); } SEAM(8);
    if (IN(9)) for (int rep_ = 0; rep_ < REP(9); ++rep_) { REFRESH(); pg8::Gemm g{HN, WSP(bf16, WS_WMD), M, DOWN_NP, D}; pg8::StaticOrder S; S.init(M, DOWN_NP, F.G, (int)blockIdx.x);
        pg8::EpiF32 E{WSP(float, WS_DOWN), DOWN_NP};
        pg8::gemm_phase<pg8::EpiF32, pg8::StaticOrder, true, true>(ring, g, S, E);
        moe_w_side(F, MOE_ITEMS - MOE_G2 - MOE_G3, MOE_ITEMS - MOE_G3, 128); } SEAM(9);
    if (IN(10)) for (int rep_ = 0; rep_ < REP(10); ++rep_) { REFRESH(); mla_mid_phase(F); } SEAM(10);
    if (IN(11)) for (int rep_ = 0; rep_ < REP(11); ++rep_) { REFRESH(); int kq = 256; asm volatile("" : "+s"(kq));
        { pg8::Gemm g{WSP(bf16, WS_CQ), WSP(bf16, WS_WUQ), M, 1536, kq}; pg8::StaticOrder S; S.init(M, 1536, F.G, (int)blockIdx.x);
          pg8::EpiQRope E{WSP(bf16, WS_Q1), WSP(float, WS_ROPER), WSP(float, WS_ROPEC), QSCALE1};
          pg8::gemm_phase<pg8::EpiQRope, pg8::StaticOrder, true, true>(ring, g, S, E); }
        { pg8::Gemm g{WSP(bf16, WS_CKV), WSP(bf16, WS_WKN), M, D, kq >> 1}; pg8::StaticOrder S; S.init(M, D, F.G, (int)blockIdx.x);
          pg8::EpiBf16P E{WSP(bf16, WS_KN), D, 4, 0, 0, 1.f, 1, 1};
          pg8::gemm_phase<pg8::EpiBf16P, pg8::StaticOrder, true, true>(ring, g, S, E); }
        { pg8::Gemm g{WSP(bf16, WS_WVV), WSP(bf16, WS_CKV), D, M, kq >> 1}; pg8::StaticOrder S; S.init(D, M, F.G, (int)blockIdx.x);
          pg8::EpiBf16P E{WSP(bf16, WS_VT1), M, 64, 0, 0, 1.f, 2, 2};
          pg8::gemm_phase<pg8::EpiBf16P, pg8::StaticOrder, true, true>(ring, g, S, E); }
    } SEAM(11);
    if (IN(12)) for (int rep_ = 0; rep_ < REP(12); ++rep_) { REFRESH();
        for (int u = F.vcu; u < NB * NH * (SEQ / 256); u += F.G) { const int a = u >> 8, r = u & 255, bh = r >> 3, qb = (r & 7) * 4 + a;
            mla::unit(bh >> 4, bh & 15, qb, WSP(bf16, WS_Q1), WSP(bf16, WS_KN), WSP(bf16, WS_KR), WSP(bf16, WS_VT1), WSP(bf16, WS_O1), ring); }
    } SEAM(12);
    if (IN(13)) for (int rep_ = 0; rep_ < REP(13); ++rep_) { REFRESH(); pg8::Gemm g{WSP(bf16, WS_O1), WSP(bf16, WS_WO1), M, D, D}; pg8::StaticOrder S; S.init(M, D, F.G, (int)blockIdx.x);
        pg8::EpiResGateB<false> E{XB, XA, MODF + 1 * 12 * D + 2 * D};
        pg8::gemm_phase<pg8::EpiResGateB<false>, pg8::StaticOrder, true, true>(ring, g, S, E); } SEAM(13);
    if (IN(14)) for (int rep_ = 0; rep_ < REP(14); ++rep_) { REFRESH(); router_phase<bf16>(F, XA, 1, 3); } SEAM(14);
    if (IN(15)) for (int rep_ = 0; rep_ < REP(15); ++rep_) { REFRESH(); moe_tables(F); gather_phase(F); } SEAM(15);
    if (IN(16)) for (int rep_ = 0; rep_ < REP(16); ++rep_) { REFRESH(); moe_tables(F);
        pg8::MoeOrder S{(int)F.MISC[32], 14, F.G, (int)blockIdx.x, (int)F.MISC[25], (int)F.MISC[26], (int)F.MISC[27], (int)F.MISC[28], (int)F.MISC[29], (int)F.MISC[30], (int)F.MISC[31]};
        pg8::Gemm g{WSP(bf16, WS_HP), WSP(bf16, WS_WGU1), MP_MAX, NE * 2 * ED, D};
        pg8::EpiSwiGLU E{WSP(bf16, WS_ACT1), ED, 14};
        pg8::gemm_phase<pg8::EpiSwiGLU, pg8::MoeOrder, true, true>(ring, g, S, E);
        moe_w_side(F, MOE_ITEMS - MOE_G3, MOE_ITEMS, 112); } SEAM(16);
    if (IN(17)) for (int rep_ = 0; rep_ < REP(17); ++rep_) { REFRESH(); moe_tables(F);
        pg8::MoeOrder S{(int)F.MISC[32], 4, F.G, (int)blockIdx.x, (int)F.MISC[25], (int)F.MISC[26], (int)F.MISC[27], (int)F.MISC[28], (int)F.MISC[29], (int)F.MISC[30], (int)F.MISC[31]};
        pg8::Gemm g{WSP(bf16, WS_ACT1), WSP(bf16, WS_WDN1), MP_MAX, NE * D, ED};
        pg8::EpiBf16P E{WSP(bf16, WS_HP), D, 4, 0, 0, 1.f, 0, 0};
        pg8::gemm_phase<pg8::EpiBf16P, pg8::MoeOrder, true, true>(ring, g, S, E); } SEAM(17);
    if (IN(18)) for (int rep_ = 0; rep_ < REP(18); ++rep_) { REFRESH(); final_phase<bf16>(F, XA, 1); }
#undef IN
#undef SEAM
}

extern "C" void kernel_launch(void* const* d_in, const int* in_sizes, int n_in, void* d_out, int out_size, void* d_ws, size_t ws_size, hipStream_t stream) {
    static int grid = 0;
    if (grid == 0) {
        if (n_in != 19 || in_sizes[0] != M * D || out_size != M * D || ws_size < WS_END) { fprintf(stderr, "kernel_launch: shape mismatch (n_in %d, ws %zu)\n", n_in, ws_size); grid = -1; return; }
        int dev = 0, cus = 0, per_cu = 0;
        if (hipGetDevice(&dev) != hipSuccess || hipDeviceGetAttribute(&cus, hipDeviceAttributeMultiprocessorCount, dev) != hipSuccess) { grid = -1; return; }
        if (hipFuncSetAttribute((const void*)mk_fwd, hipFuncAttributeMaxDynamicSharedMemorySize, LDS_BYTES) != hipSuccess) { fprintf(stderr, "kernel_launch: hipFuncSetAttribute failed\n"); grid = -1; return; }
        if (hipOccupancyMaxActiveBlocksPerMultiprocessor(&per_cu, (const void*)mk_fwd, NTHREADS, LDS_BYTES) != hipSuccess || per_cu < 1) fprintf(stderr, "kernel_launch: occupancy query says %d\n", per_cu);
        (void)hipGetLastError();
        grid = cus;
    }
    if (grid < 0) return;
    (void)hipMemsetAsync((char*)d_ws + WS_CTL, 0, CTL_ZERO_BYTES, stream);
    Args a{};
    for (int i = 0; i < 19; ++i) a.in[i] = (const float*)d_in[i];
    a.out = (float*)d_out; a.ws = (unsigned char*)d_ws;
#if MK_PHASED
    for (int p = 0; p < N_PHASES; ++p) { a.ph_lo = p; a.ph_hi = p + 1; hipLaunchKernelGGL(mk_fwd, dim3(grid), dim3(NTHREADS), LDS_BYTES, stream, a);
#if MK_CHECK == 1
        if (p == 3) hipLaunchKernelGGL(chk_na, dim3(M * NH / 4), dim3(256), 0, stream, (const bf16*)(a.ws + WS_Q0), (const bf16*)(a.ws + WS_K0), (const bf16*)(a.ws + WS_VT0), (const bf16*)(a.ws + WS_O0), a.in[5], (float*)(a.ws + WS_CTL + 32768));
#elif MK_CHECK == 2
        if (p == 12) hipLaunchKernelGGL(chk_mla, dim3(512 * 16), dim3(64), 0, stream, (const bf16*)(a.ws + WS_Q1), (const bf16*)(a.ws + WS_KN), (const bf16*)(a.ws + WS_KR), (const bf16*)(a.ws + WS_VT1), (const bf16*)(a.ws + WS_O1), (float*)(a.ws + WS_CTL + 32768));
#elif MK_CHECK == 3
        if (p == 11) hipLaunchKernelGGL(chk_proj, dim3(256), dim3(256), 0, stream, (const float*)(a.ws + WS_DOWN), a.in[10], a.in[12], a.in[11], a.in[13], (const bf16*)(a.ws + WS_Q1), (const bf16*)(a.ws + WS_KR), (const bf16*)(a.ws + WS_KN), (const bf16*)(a.ws + WS_VT1), (float*)(a.ws + WS_CTL + 32768));
#endif
    }
#if MK_CHECK == 3
    hipLaunchKernelGGL(chk_tweak4, dim3(M * D / 256), dim3(256), 0, stream, a.out, (const float*)(a.ws + WS_CTL + 32768), 1000.f);
#elif MK_CHECK
    hipLaunchKernelGGL(chk_tweak, dim3(M * D / 256), dim3(256), 0, stream, a.out, (const float*)(a.ws + WS_CTL + 32768), 1000.f);
#endif
#else
    a.ph_lo = 0; a.ph_hi = N_PHASES; hipLaunchKernelGGL(mk_fwd, dim3(grid), dim3(NTHREADS), LDS_BYTES, stream, a);
#endif
}
```

```cpp
#include <hip/hip_runtime.h>
#include <cstdio>
#include <cstdint>
namespace pg8 {
#define PG8_LAS __attribute__((address_space(3)))
typedef unsigned short bf16_t;
typedef short bf16x8 __attribute__((ext_vector_type(8)));
typedef float f32x4 __attribute__((ext_vector_type(4)));
typedef unsigned u32x4 __attribute__((ext_vector_type(4)));
constexpr int BM = 256, BK = 64, HALF = 128, HTB = HALF * BK * 2  , STAGE_BYTES = 8 * HTB, NXCD = 8, WGM = 8;

__host__ __device__ __forceinline__ int lds_byte(int r, int c) { const int st = (r >> 4) * 2 + (c >> 5), rr = r & 15, cc = c & 31, ob = rr * 64 + cc * 2; return st * 1024 + (ob ^ (((ob >> 9) & 1) << 5)); }
__host__ __device__ __forceinline__ void stage_rc(int b, int& R, int& C) { const int st = b / 1024, sb = b % 1024, swz = sb ^ (((sb >> 9) & 1) << 5); R = (st >> 1) * 16 + swz / 64; C = (st & 1) * 32 + (swz % 64) / 2; }
__host__ __device__ __forceinline__ int perm32(int rho) { const int n = rho >> 4, i = rho & 15; return 8 * (i >> 2) + 4 * n + (i & 3); }

struct Unit { int pm, pn; };
struct Gemm { const bf16_t* A; const bf16_t* Bt; int M, N, K; };

struct StaticOrder {
    int nM, nN, nwg, G, c;
    __host__ __device__ void init(int M, int N, int G_, int c_) { nM = M / BM; nN = N / BM; nwg = nM * nN; G = G_; c = c_; }
    __host__ __device__ bool next(int i, Unit& u) const {
        const long L = (long)i * G + c; if (L >= nwg) return false;
        int wgid = (int)L; { const int q = nwg / NXCD, r = nwg % NXCD, xcd = wgid % NXCD, off = wgid / NXCD; wgid = (xcd < r ? xcd * (q + 1) : r * (q + 1) + (xcd - r) * q) + off; }
        const int nig = WGM * nN, gid = wgid / nig, fm = gid * WGM, gsz = (nM - fm) < WGM ? (nM - fm) : WGM;
        u.pm = fm + ((wgid % nig) % gsz); u.pn = (wgid % nig) / gsz; return true;
    }
    __device__ __forceinline__ void a_ready(const Unit&) const {}
    __device__ __forceinline__ void done(const Unit&) const {}
};

__device__ __forceinline__ unsigned cvt_pk_bf16(float lo, float hi) { unsigned r; asm volatile("v_cvt_pk_bf16_f32 %0, %1, %2" : "=v"(r) : "v"(lo), "v"(hi)); return r; }

__device__ __forceinline__ float fast_silu(float g) { return g * __builtin_amdgcn_rcpf(1.f + __builtin_amdgcn_exp2f(-1.4426950408889634f * g)); }
struct EpiBf16P {
    static constexpr bool PERM = true, AFTER_DRAIN = false;
    bf16_t* O; int ldc; int nct; int st; size_t sstride; float scale0; int mode0, mode1;
    __device__ __forceinline__ void operator()(const f32x4 (&acc)[2][2][4][2], const Unit& u, int wr, int wc, int fr, int fq) const {
        int ct = u.pn % nct; bf16_t* base = O; float sc = 1.f; int mode = mode0;
        if (st) { const int t = ct / st; base += (size_t)t * sstride; ct -= t * st; if (t == 0) sc = scale0; else mode = mode1; }
        const int row0 = u.pm * BM + wr * 64 + fr, col0 = ct * BM + wc * 32 + 8 * fq;
#pragma unroll
        for (int ai = 0; ai < 2; ++ai)
#pragma unroll
            for (int m = 0; m < 4; ++m) { const int row = row0 + ai * HALF + m * 16;
#pragma unroll
                for (int bj = 0; bj < 2; ++bj) { const f32x4 v0 = acc[ai][bj][m][0] * sc, v1 = acc[ai][bj][m][1] * sc; const int col = col0 + bj * HALF;
                    u32x4 w; w.x = cvt_pk_bf16(v0[0], v0[1]); w.y = cvt_pk_bf16(v0[2], v0[3]); w.z = cvt_pk_bf16(v1[0], v1[1]); w.w = cvt_pk_bf16(v1[2], v1[3]);
                    bf16_t* p = mode == 0 ? base + (size_t)row * ldc + col : base + ((size_t)(col >> 6) * (mode == 1 ? 16384 : 1024) + row) * 64 + (col & 63);
                    *(u32x4*)p = w; } }
    }
};
struct EpiResGate {
    static constexpr bool PERM = false, AFTER_DRAIN = false;
    const float* res; float* out; const float* gate;
    __device__ __forceinline__ void operator()(const f32x4 (&acc)[2][2][4][2], const Unit& u, int wr, int wc, int fr, int fq) const {
        const int row0 = u.pm * BM + wr * 64 + fr, col0 = u.pn * BM + wc * 32 + 4 * fq;
        const float* gp = gate + (size_t)((u.pm * BM) >> 13) * 6144 + col0;
        f32x4 gv[2][2];
#pragma unroll
        for (int bj = 0; bj < 2; ++bj)
#pragma unroll
            for (int n = 0; n < 2; ++n) gv[bj][n] = *(const f32x4*)(gp + bj * HALF + n * 16);
#pragma unroll
        for (int ai = 0; ai < 2; ++ai)
#pragma unroll
            for (int m = 0; m < 4; ++m) { const size_t off = (size_t)(row0 + ai * HALF + m * 16) * 1024 + col0;
#pragma unroll
                for (int bj = 0; bj < 2; ++bj)
#pragma unroll
                    for (int n = 0; n < 2; ++n) { const f32x4 rs = *(const f32x4*)(res + off + bj * HALF + n * 16);
                        *(f32x4*)(out + off + bj * HALF + n * 16) = rs + gv[bj][n] * acc[ai][bj][m][n]; } }
    }
};
template <bool RES_F32> struct EpiResGateB {
    static constexpr bool PERM = true, AFTER_DRAIN = false;
    const void* res; bf16_t* out; const float* gate;
    __device__ __forceinline__ void operator()(const f32x4 (&acc)[2][2][4][2], const Unit& u, int wr, int wc, int fr, int fq) const {
        const int row0 = u.pm * BM + wr * 64 + fr, col0 = u.pn * BM + wc * 32 + 8 * fq;
        const float* gp = gate + (size_t)((u.pm * BM) >> 13) * 6144 + col0;
        f32x4 gv[2][2];
#pragma unroll
        for (int bj = 0; bj < 2; ++bj)
#pragma unroll
            for (int n = 0; n < 2; ++n) gv[bj][n] = *(const f32x4*)(gp + bj * HALF + 4 * n);
#pragma unroll
        for (int ai = 0; ai < 2; ++ai)
#pragma unroll
            for (int m = 0; m < 4; ++m) { const size_t off = (size_t)(row0 + ai * HALF + m * 16) * 1024 + col0;
#pragma unroll
                for (int bj = 0; bj < 2; ++bj) { f32x4 r0, r1;
                    if (RES_F32) { const float* rp = (const float*)res + off + bj * HALF; r0 = *(const f32x4*)rp; r1 = *(const f32x4*)(rp + 4); }
                    else { const u32x4 w = *(const u32x4*)((const bf16_t*)res + off + bj * HALF);
                        r0 = (f32x4){__builtin_bit_cast(float, w.x << 16), __builtin_bit_cast(float, w.x & 0xffff0000u), __builtin_bit_cast(float, w.y << 16), __builtin_bit_cast(float, w.y & 0xffff0000u)};
                        r1 = (f32x4){__builtin_bit_cast(float, w.z << 16), __builtin_bit_cast(float, w.z & 0xffff0000u), __builtin_bit_cast(float, w.w << 16), __builtin_bit_cast(float, w.w & 0xffff0000u)}; }
                    const f32x4 v0 = r0 + gv[bj][0] * acc[ai][bj][m][0], v1 = r1 + gv[bj][1] * acc[ai][bj][m][1];
                    u32x4 o; o.x = cvt_pk_bf16(v0[0], v0[1]); o.y = cvt_pk_bf16(v0[2], v0[3]); o.z = cvt_pk_bf16(v1[0], v1[1]); o.w = cvt_pk_bf16(v1[2], v1[3]);
                    *(u32x4*)(out + off + bj * HALF) = o; } }
    }
};
struct EpiF32 {
    static constexpr bool PERM = false, AFTER_DRAIN = false;
    float* O; int ldc;
    __device__ __forceinline__ void operator()(const f32x4 (&acc)[2][2][4][2], const Unit& u, int wr, int wc, int fr, int fq) const {
        const int row0 = u.pm * BM + wr * 64 + fr, col0 = u.pn * BM + wc * 32 + 4 * fq;
#pragma unroll
        for (int ai = 0; ai < 2; ++ai)
#pragma unroll
            for (int m = 0; m < 4; ++m) { float* rowp = O + (size_t)(row0 + ai * HALF + m * 16) * ldc + col0;
#pragma unroll
                for (int bj = 0; bj < 2; ++bj)
#pragma unroll
                    for (int n = 0; n < 2; ++n) *(f32x4*)(rowp + bj * HALF + n * 16) = acc[ai][bj][m][n]; }
    }
};
struct EpiSwiGLU {
    static constexpr bool PERM = true, AFTER_DRAIN = false;
    bf16_t* O; int ldc; int nN;
    __device__ __forceinline__ void operator()(const f32x4 (&acc)[2][2][4][2], const Unit& u, int wr, int wc, int fr, int fq) const {
        const int row0 = u.pm * BM + wr * 64 + fr, col0 = (u.pn % nN) * HALF + wc * 32 + 8 * fq;
#pragma unroll
        for (int ai = 0; ai < 2; ++ai)
#pragma unroll
            for (int m = 0; m < 4; ++m) {
                const f32x4 g0 = acc[ai][0][m][0], g1 = acc[ai][0][m][1], u0 = acc[ai][1][m][0], u1 = acc[ai][1][m][1];
                u32x4 w;
                w.x = cvt_pk_bf16(fast_silu(g0[0]) * u0[0], fast_silu(g0[1]) * u0[1]); w.y = cvt_pk_bf16(fast_silu(g0[2]) * u0[2], fast_silu(g0[3]) * u0[3]);
                w.z = cvt_pk_bf16(fast_silu(g1[0]) * u1[0], fast_silu(g1[1]) * u1[1]); w.w = cvt_pk_bf16(fast_silu(g1[2]) * u1[2], fast_silu(g1[3]) * u1[3]);
                *(u32x4*)(O + (size_t)(row0 + ai * HALF + m * 16) * ldc + col0) = w; }
    }
};
struct EpiQRope {
    static constexpr bool PERM = true, AFTER_DRAIN = false;
    bf16_t* O; const float* ropeR; const float* ropeC; float qs;
    __device__ __forceinline__ void operator()(const f32x4 (&acc)[2][2][4][2], const Unit& u, int wr, int wc, int fr, int fq) const {
        const int row0 = u.pm * BM + wr * 64 + fr, col0 = u.pn * BM + wc * 32 + 8 * fq;
#pragma unroll
        for (int ai = 0; ai < 2; ++ai)
#pragma unroll
            for (int m = 0; m < 4; ++m) { const int r = row0 + ai * HALF + m * 16, t = r & 8191, gr = t >> 6, gc = t & 63;
#pragma unroll
                for (int bj = 0; bj < 2; ++bj) { const int c = col0 + bj * HALF, d = c % 96;
                    f32x4 v0 = acc[ai][bj][m][0], v1 = acc[ai][bj][m][1];
                    if (d >= 64) { const int p = (d - 64) >> 1;
                        const float* tb = p < 8 ? ropeR + gr * 16 + 2 * p : ropeC + gc * 16 + 2 * (p - 8);
                        const f32x4 a = *(const f32x4*)tb, b = *(const f32x4*)(tb + 4);
                        v0 = (f32x4){v0[0] * a[0] - v0[1] * a[1], v0[0] * a[1] + v0[1] * a[0], v0[2] * a[2] - v0[3] * a[3], v0[2] * a[3] + v0[3] * a[2]};
                        v1 = (f32x4){v1[0] * b[0] - v1[1] * b[1], v1[0] * b[1] + v1[1] * b[0], v1[2] * b[2] - v1[3] * b[3], v1[2] * b[3] + v1[3] * b[2]}; }
                    v0 = v0 * qs; v1 = v1 * qs;
                    u32x4 w; w.x = cvt_pk_bf16(v0[0], v0[1]); w.y = cvt_pk_bf16(v0[2], v0[3]); w.z = cvt_pk_bf16(v1[0], v1[1]); w.w = cvt_pk_bf16(v1[2], v1[3]);
                    *(u32x4*)(O + (size_t)r * 1536 + c) = w; }
                asm volatile("" ::: "memory"); }
    }
};
struct MoeOrder {
    int T, nN, G, c; int tb1, tb2, tb3, tb4, tb5, tb6, tb7;
    __device__ __forceinline__ bool next(int i, Unit& u) const {
        const int nwg = T * nN; const long L = (long)i * G + c; if (L >= nwg) return false;
        int wgid = (int)L; { const int q = nwg / NXCD, r = nwg % NXCD, xcd = wgid % NXCD, off = wgid / NXCD; wgid = (xcd < r ? xcd * (q + 1) : r * (q + 1) + (xcd - r) * q) + off; }
        const int nig = WGM * nN, gid = wgid / nig, fm = gid * WGM, gsz = (T - fm) < WGM ? (T - fm) : WGM;
        const int pm = fm + ((wgid % nig) % gsz), pn = (wgid % nig) / gsz;
        const int e = (pm >= tb1) + (pm >= tb2) + (pm >= tb3) + (pm >= tb4) + (pm >= tb5) + (pm >= tb6) + (pm >= tb7);
        u.pm = pm; u.pn = e * nN + pn; return true;
    }
    __device__ __forceinline__ void a_ready(const Unit&) const {}
    __device__ __forceinline__ void done(const Unit&) const {}
};

template <class Epi, class Sched, bool ALIGN_EPI = false, bool SP2 = false>
__device__ __forceinline__ void gemm_phase(PG8_LAS unsigned char* lds, const Gemm g, const Sched& S, const Epi& E) {
    const int tid = threadIdx.x, wid = __builtin_amdgcn_readfirstlane(tid >> 6), lane = tid & 63, wr = wid >> 2, wc = wid & 3, fr = lane & 15, fq = lane >> 4;
    const int K = g.K, nt = K / BK;
    unsigned voffA[2], voffB[2];
#pragma unroll
    for (int i = 0; i < 2; ++i) { int R, C; stage_rc(tid * 16 + i * 8192, R, C); const int Rb = Epi::PERM ? ((R & ~31) + perm32(R & 31)) : R;
        voffA[i] = (unsigned)(R * K + C) * 2u; voffB[i] = (unsigned)(Rb * K + C) * 2u; }
    const size_t kstep = (size_t)(BK * 2);
    const size_t hstep = (size_t)HALF * K * 2;
    const size_t tstep = 2 * hstep;
    const unsigned ldsw = (unsigned)wid * 1024u;
    const int aoff = lds_byte(wr * 64 + fr, fq * 8), boff = lds_byte(wc * 32 + fr, fq * 8);
#define PG8_SA(b, h) (((b) * 2 + (h)) * HTB)
#define PG8_SB(b, h) ((4 + (b) * 2 + (h)) * HTB)
#define PG8_STAGE(bufoff, gbase, voff) do { _Pragma("unroll") for (int _i = 0; _i < 2; ++_i) \
        __builtin_amdgcn_global_load_lds((const unsigned*)((const char*)(gbase) + (voff)[_i]), (PG8_LAS unsigned*)(lds + (bufoff) + ldsw + _i * 8192), 16, 0, 0); } while (0)
#define PG8_LDA(dst, b, h) do { _Pragma("unroll") for (int m = 0; m < 4; ++m) _Pragma("unroll") for (int k = 0; k < 2; ++k) dst[m][k] = *(const PG8_LAS bf16x8*)(lds + PG8_SA(b, h) + aoff + m * 2048 + k * 1024); } while (0)
#define PG8_LDB(dst, b, h) do { _Pragma("unroll") for (int n = 0; n < 2; ++n) _Pragma("unroll") for (int k = 0; k < 2; ++k) dst[n][k] = *(const PG8_LAS bf16x8*)(lds + PG8_SB(b, h) + boff + n * 2048 + k * 1024); } while (0)
#define PG8_MMA(ai, bj, At, Bt) do { __builtin_amdgcn_s_setprio(1); _Pragma("unroll") for (int m = 0; m < 4; ++m) _Pragma("unroll") for (int n = 0; n < 2; ++n) _Pragma("unroll") for (int k = 0; k < 2; ++k) \
        acc[ai][bj][m][n] = __builtin_amdgcn_mfma_f32_16x16x32_bf16(Bt[n][k], At[m][k], acc[ai][bj][m][n], 0, 0, 0); __builtin_amdgcn_s_setprio(0); } while (0)
#define PG8_WAIT_V(n) asm volatile("s_waitcnt vmcnt(" #n ")" ::: "memory")
#define PG8_WAIT_L(n) asm volatile("s_waitcnt lgkmcnt(" #n ")" ::: "memory")
#define PG8_BAR __builtin_amdgcn_s_barrier()
#define PG8_SCHED __builtin_amdgcn_sched_barrier(0)
    Unit cur, nxt; int ui = 0;
    if (!S.next(0, cur)) return;
    f32x4 acc[2][2][4][2];
#pragma unroll
    for (int a = 0; a < 2; ++a)
#pragma unroll
        for (int b = 0; b < 2; ++b)
#pragma unroll
            for (int m = 0; m < 4; ++m)
#pragma unroll
                for (int n = 0; n < 2; ++n) acc[a][b][m][n] = (f32x4){0.f, 0.f, 0.f, 0.f};
    bf16x8 At[4][2], B0[2][2], B1[2][2];
    const char* cA = (const char*)g.A + (size_t)cur.pm * tstep; const char* cB = (const char*)g.Bt + (size_t)cur.pn * tstep;
    S.a_ready(cur);
    if constexpr (SP2) {
        PG8_STAGE(PG8_SB(0, 0), cB, voffB); PG8_STAGE(PG8_SB(0, 1), cB + hstep, voffB); PG8_STAGE(PG8_SA(0, 0), cA, voffA); PG8_STAGE(PG8_SA(0, 1), cA + hstep, voffA);
        if (wr == 1) PG8_BAR;
        PG8_WAIT_V(2); PG8_BAR;
        PG8_STAGE(PG8_SB(1, 0), cB + kstep, voffB); PG8_STAGE(PG8_SA(1, 0), cA + kstep, voffA); PG8_STAGE(PG8_SB(1, 1), cB + hstep + kstep, voffB);
        PG8_WAIT_V(6); PG8_BAR;
    } else {
        PG8_STAGE(PG8_SB(0, 0), cB, voffB); PG8_STAGE(PG8_SA(0, 0), cA, voffA); PG8_STAGE(PG8_SB(0, 1), cB + hstep, voffB); PG8_STAGE(PG8_SA(0, 1), cA + hstep, voffA);
        if (wr == 1) PG8_BAR;
        PG8_WAIT_V(4); PG8_BAR;
        PG8_STAGE(PG8_SB(1, 0), cB + kstep, voffB); PG8_STAGE(PG8_SA(1, 0), cA + kstep, voffA); PG8_STAGE(PG8_SB(1, 1), cB + hstep + kstep, voffB);
        PG8_WAIT_V(6); PG8_BAR;
    }
    for (;;) {
        const bool has_next = S.next(ui + 1, nxt);
        const char* nA = has_next ? (const char*)g.A + (size_t)nxt.pm * tstep : cA; const char* nB = has_next ? (const char*)g.Bt + (size_t)nxt.pn * tstep : cB;
        for (int t = 0; t < nt; t += 2) {
            const bool last = (t == nt - 2);
            const char* a1 = cA + (size_t)(t + 1) * kstep;
            const char* a2 = last ? nA : cA + (size_t)(t + 2) * kstep; const char* b2 = last ? nB : cB + (size_t)(t + 2) * kstep;
            const char* a3 = a2 + kstep; const char* b3 = b2 + kstep;
            if (last && has_next) S.a_ready(nxt);
            if constexpr (SP2) {
            PG8_LDB(B0, 0, 0); PG8_LDB(B1, 0, 1); PG8_SCHED; PG8_LDA(At, 0, 0); PG8_STAGE(PG8_SA(1, 1), a1 + hstep, voffA);
            PG8_WAIT_V(8); PG8_WAIT_L(0); PG8_BAR; PG8_MMA(0, 0, At, B0); PG8_MMA(0, 1, At, B1); PG8_BAR; PG8_SCHED;
            PG8_LDA(At, 0, 1); PG8_STAGE(PG8_SB(0, 0), b2, voffB); PG8_STAGE(PG8_SB(0, 1), b2 + hstep, voffB); PG8_STAGE(PG8_SA(0, 0), a2, voffA);
            PG8_WAIT_V(8); PG8_WAIT_L(0); PG8_BAR; PG8_MMA(1, 0, At, B0); PG8_MMA(1, 1, At, B1); PG8_BAR; PG8_SCHED;
            PG8_LDB(B0, 1, 0); PG8_LDB(B1, 1, 1); PG8_SCHED; PG8_LDA(At, 1, 0); PG8_STAGE(PG8_SA(0, 1), a2 + hstep, voffA);
            PG8_WAIT_V(8); PG8_WAIT_L(0); PG8_BAR; PG8_MMA(0, 0, At, B0); PG8_MMA(0, 1, At, B1); PG8_BAR; PG8_SCHED;
            PG8_LDA(At, 1, 1); PG8_STAGE(PG8_SB(1, 0), b3, voffB); PG8_STAGE(PG8_SB(1, 1), b3 + hstep, voffB); PG8_STAGE(PG8_SA(1, 0), a3, voffA);
            PG8_WAIT_V(8); PG8_WAIT_L(0); PG8_BAR; PG8_MMA(1, 0, At, B0); PG8_MMA(1, 1, At, B1); PG8_BAR; PG8_SCHED;
            } else {
            PG8_LDB(B0, 0, 0); PG8_SCHED; PG8_LDA(At, 0, 0); PG8_STAGE(PG8_SA(1, 1), a1 + hstep, voffA);
            PG8_WAIT_L(8); PG8_BAR; PG8_WAIT_L(0); PG8_MMA(0, 0, At, B0); PG8_BAR; PG8_SCHED;
            PG8_LDB(B1, 0, 1); PG8_STAGE(PG8_SB(0, 0), b2, voffB);
            PG8_BAR; PG8_WAIT_L(0); PG8_MMA(0, 1, At, B1); PG8_BAR;
            PG8_LDA(At, 0, 1); PG8_STAGE(PG8_SA(0, 0), a2, voffA);
            PG8_BAR; PG8_WAIT_L(0); PG8_MMA(1, 0, At, B0); PG8_BAR; PG8_SCHED;
            PG8_STAGE(PG8_SB(0, 1), b2 + hstep, voffB);
            PG8_WAIT_V(6); PG8_BAR; PG8_MMA(1, 1, At, B1); PG8_BAR;
            PG8_LDB(B0, 1, 0); PG8_SCHED; PG8_LDA(At, 1, 0); PG8_STAGE(PG8_SA(0, 1), a2 + hstep, voffA);
            PG8_WAIT_L(8); PG8_BAR; PG8_WAIT_L(0); PG8_MMA(0, 0, At, B0); PG8_BAR; PG8_SCHED;
            PG8_LDB(B1, 1, 1); PG8_STAGE(PG8_SB(1, 0), b3, voffB);
            PG8_BAR; PG8_WAIT_L(0); PG8_MMA(0, 1, At, B1); PG8_BAR;
            PG8_LDA(At, 1, 1); PG8_STAGE(PG8_SA(1, 0), a3, voffA);
            PG8_BAR; PG8_WAIT_L(0); PG8_MMA(1, 0, At, B0); PG8_BAR; PG8_SCHED;
            PG8_STAGE(PG8_SB(1, 1), b3 + hstep, voffB);
            PG8_WAIT_V(6); PG8_BAR; PG8_MMA(1, 1, At, B1); PG8_BAR;
            }
        }
        if constexpr (ALIGN_EPI) { if (wr == 0) PG8_BAR; }
        if constexpr (!Epi::AFTER_DRAIN) { E(acc, cur, wr, wc, fr, fq); S.done(cur); }
        if (!has_next) break;
#pragma unroll
        for (int a = 0; a < 2; ++a)
#pragma unroll
            for (int b = 0; b < 2; ++b)
#pragma unroll
                for (int m = 0; m < 4; ++m)
#pragma unroll
                    for (int n = 0; n < 2; ++n) acc[a][b][m][n] = (f32x4){0.f, 0.f, 0.f, 0.f};
        cur = nxt; cA = nA; cB = nB; ++ui;
        if constexpr (ALIGN_EPI) { if (wr == 1) PG8_BAR; }
    }
    PG8_WAIT_V(0);
    if constexpr (!ALIGN_EPI) { if (wr == 0) PG8_BAR; }
    PG8_BAR;
    if constexpr (Epi::AFTER_DRAIN) { E.fused(acc, cur, wr, wc, fr, fq, lds, wid, lane); S.done(cur); }
#undef PG8_SA
#undef PG8_SB
#undef PG8_STAGE
#undef PG8_LDA
#undef PG8_LDB
#undef PG8_MMA
#undef PG8_WAIT_V
#undef PG8_WAIT_L
#undef PG8_BAR
#undef PG8_SCHED
}
}

#define GAS __attribute__((address_space(1)))
#define LAS __attribute__((address_space(3)))

#define XB_TMO      128
#define XB_XCNT(j)  (256  + 64 * (j))
#define XB_XSUB(j)  (1280 + 64 * (j))
#define XB_XGEN(j)  (2304 + 64 * (j))
#define XB_TOP      3328
#define XB_TOPGEN   3392
#define XCD_BAR_WORDS 3456
#define XB_SPIN_CAP (1u << 18)

__device__ __forceinline__ unsigned xb_ld(unsigned* p)              { return __hip_atomic_load(p, __ATOMIC_RELAXED, __HIP_MEMORY_SCOPE_AGENT); }
__device__ __forceinline__ unsigned xb_add(unsigned* p, unsigned v) { return __hip_atomic_fetch_add(p, v, __ATOMIC_RELAXED, __HIP_MEMORY_SCOPE_AGENT); }
__device__ __forceinline__ unsigned xb_xcc_id() { return (unsigned)__builtin_amdgcn_s_getreg((3 << 11) | 20) & 0xFu; }
#define XB_SPIN(cond, bar) do { unsigned _sp = 0; while (cond) { __builtin_amdgcn_s_sleep(1); \
    if ((++_sp & 255u) == 0u) { if (xb_ld(&(bar)[XB_TMO])) break; if (_sp > XB_SPIN_CAP) { atomicAdd(&(bar)[XB_TMO], 1u); break; } } } } while (0)

struct XcdBarrier {
    unsigned* bar; unsigned x;
    volatile LAS unsigned* st;
};

__device__ __forceinline__ XcdBarrier xcd_barrier_post(unsigned* bar, volatile LAS unsigned* st) {
    XcdBarrier b; b.bar = bar; b.x = xb_xcc_id(); b.st = st;
    if (threadIdx.x == 0) (void)xb_add(&bar[XB_XCNT(b.x)], 1u);
    return b;
}
__device__ __forceinline__ void xcd_barrier_complete(unsigned* bar, unsigned x, unsigned& nloc, unsigned& nx) {
    const unsigned G = gridDim.x * gridDim.y * gridDim.z;
    unsigned sum, cnt, mine, sp = 0u;
    for (;;) {
        sum = 0u; cnt = 0u; mine = 0u;
#pragma unroll
        for (unsigned j = 0; j < 16; ++j) { const unsigned c = xb_ld(&bar[XB_XCNT(j)]); sum += c; cnt += (c > 0u) ? 1u : 0u; mine = (j == x) ? c : mine; }
        if (sum == G) break;
        __builtin_amdgcn_s_sleep(1);
        if ((++sp & 255u) == 0u) { if (xb_ld(&bar[XB_TMO])) break; if (sp > XB_SPIN_CAP) { atomicAdd(&bar[XB_TMO], 1u); break; } }
    }
    nloc = mine > 0u ? mine : 1u; nx = cnt > 0u ? cnt : 1u;
}

__device__ __forceinline__ void xcd_barrier(const XcdBarrier& b) {
    asm volatile("s_waitcnt vmcnt(0)" ::: "memory");
    __syncthreads();
    if (threadIdx.x == 0) {
        unsigned* bar = b.bar;
        __builtin_amdgcn_s_waitcnt(0);
        unsigned nloc = b.st[0], nx = b.st[1];
        if (nloc == 0u) { xcd_barrier_complete(bar, b.x, nloc, nx); b.st[0] = nloc; b.st[1] = nx; }
        const unsigned old = xb_add(&bar[XB_XSUB(b.x)], 1u);
        const unsigned gen = old / nloc;
        if (old + 1u == (gen + 1u) * nloc) {
            __builtin_amdgcn_fence(__ATOMIC_RELEASE, "agent");
            asm volatile("s_waitcnt vmcnt(0)" ::: "memory");
            const unsigned og = xb_add(&bar[XB_TOP], 1u);
            const unsigned tg = og / nx;
            if (og + 1u == (tg + 1u) * nx) xb_add(&bar[XB_TOPGEN], 1u);
            else XB_SPIN(xb_ld(&bar[XB_TOPGEN]) == tg, bar);
            __builtin_amdgcn_fence(__ATOMIC_ACQUIRE, "agent");
            xb_add(&bar[XB_XGEN(b.x)], 1u);
            asm volatile("s_waitcnt vmcnt(0)" ::: "memory");
        } else {
            XB_SPIN(xb_ld(&bar[XB_XGEN(b.x)]) == gen, bar);
            __builtin_amdgcn_fence(__ATOMIC_ACQUIRE, "agent");
            asm volatile("s_waitcnt vmcnt(0)" ::: "memory");
        }
    }
    __syncthreads();
}


constexpr int NWAVES = 8, NTHREADS = 512;
constexpr int D = 1024, NB = 2, SEQ = 8192, M = NB * SEQ, GW = 64, GROWS = 128, NH = 16, HD = 64;
constexpr int FFN = 2816, NE = 8, ED = 1792, QL = 256, KVL = 128, RP = 32, DOWN_N = 416, DOWN_NP = 512, QKD = 96;
constexpr int MP_MAX = 34816;
constexpr float NORM_EPS = 1e-6f;
constexpr float LOG2E = 1.4426950408889634f;
constexpr float QSCALE1 = 0.10206207261596577f * LOG2E;

constexpr size_t MiB = 1u << 20;
constexpr size_t WS_CTL = 0, CTL_ZERO_BYTES = 64 * 1024;
constexpr size_t WS_PART = 4 * MiB;
constexpr size_t WS_MODF = 2 * MiB;
constexpr size_t WS_ROPER = WS_MODF + 128 * 1024;
constexpr size_t WS_ROPEC = WS_ROPER + 16 * 1024;
constexpr size_t WS_CNTWG = WS_ROPEC + 16 * 1024;
constexpr size_t WS_TOKE = 3 * MiB;
constexpr size_t WS_TOKP = WS_TOKE + 128 * 1024;
constexpr size_t WS_TOKW = WS_TOKP + 128 * 1024;
constexpr size_t WS_TOKS = WS_TOKW + 128 * 1024;
constexpr size_t WS_W = 8 * MiB;
constexpr size_t WS_WQK = WS_W, WS_WV = WS_WQK + 4 * MiB, WS_WO0 = WS_WV + 2 * MiB, WS_WGU0 = WS_WO0 + 2 * MiB, WS_WDN0 = WS_WGU0 + 11 * MiB;
constexpr size_t WS_WMD = WS_WDN0 + 5632 * 1024, WS_WUQ = WS_WMD + 1 * MiB, WS_WKN = WS_WUQ + 768 * 1024, WS_WVV = WS_WKN + 512 * 1024, WS_WO1 = WS_WVV + 512 * 1024;
constexpr size_t WS_WGU1 = WS_WO1 + 2 * MiB, WS_WDN1 = WS_WGU1 + 56 * MiB, WS_WEND = WS_WDN1 + 28 * MiB;
static_assert(WS_WEND <= 122 * MiB, "weights");
constexpr size_t WS_XA = 122 * MiB;
constexpr size_t WS_HN = 186 * MiB;
constexpr size_t WS_R = 218 * MiB;
constexpr size_t WS_Q0 = WS_R, WS_K0 = WS_R + 32 * MiB, WS_VT0 = WS_R + 64 * MiB, WS_O0 = WS_R + 96 * MiB;
constexpr size_t WS_ACT0 = WS_R;
constexpr size_t WS_DOWN = WS_R, WS_CQ = WS_R + 32 * MiB, WS_CKV = WS_R + 40 * MiB, WS_KR = WS_R + 48 * MiB;
constexpr size_t WS_Q1 = WS_R + 49 * MiB, WS_KN = WS_R + 97 * MiB, WS_VT1 = WS_R + 129 * MiB, WS_O1 = WS_R + 161 * MiB;
constexpr size_t WS_HP = WS_R, WS_ACT1 = WS_R + 68 * MiB;
constexpr size_t WS_END = WS_R + 193 * MiB;
static_assert(WS_ACT1 + (size_t)MP_MAX * ED * 2 <= WS_END && WS_END <= 448 * MiB, "d_ws map");

constexpr int RING_BYTES = 131072, MISC_OFF = 155648, LDS_BYTES = 159744;

typedef unsigned short bf16;
typedef unsigned v4u __attribute__((ext_vector_type(4)));
typedef unsigned v2u __attribute__((ext_vector_type(2)));
typedef float f32x4 __attribute__((ext_vector_type(4)));
typedef float f32x2 __attribute__((ext_vector_type(2)));
typedef float f32x16 __attribute__((ext_vector_type(16)));
typedef short bf16x8 __attribute__((ext_vector_type(8)));
typedef GAS unsigned gu32;
#define RLX_AGENT __ATOMIC_RELAXED, __HIP_MEMORY_SCOPE_AGENT
#define LDS_WAIT() asm volatile("s_waitcnt lgkmcnt(0)" ::: "memory")
__device__ __forceinline__ unsigned pk2(float lo, float hi) { unsigned r; asm volatile("v_cvt_pk_bf16_f32 %0, %1, %2" : "=v"(r) : "v"(lo), "v"(hi)); return r; }
__device__ __forceinline__ float bf2f(unsigned short h) { return __builtin_bit_cast(float, (unsigned)h << 16); }
__device__ __forceinline__ float bflo(unsigned w) { return __builtin_bit_cast(float, w << 16); }
__device__ __forceinline__ float bfhi(unsigned w) { return __builtin_bit_cast(float, w & 0xffff0000u); }
__device__ __forceinline__ float wave_sum(float v) {
#pragma unroll
    for (int o = 1; o < 64; o <<= 1) v += __shfl_xor(v, o);
    return v;
}

template <typename TX> struct XRow;
template <> struct XRow<float> { static __device__ __forceinline__ f32x4 ld(const float* X, size_t row, int col) { return *(const GAS f32x4*)(X + row * 1024 + col); } };
template <> struct XRow<bf16> { static __device__ __forceinline__ f32x4 ld(const bf16* X, size_t row, int col) { const v2u w = *(const GAS v2u*)(X + row * 1024 + col); return (f32x4){bflo(w.x), bfhi(w.x), bflo(w.y), bfhi(w.y)}; } };

struct Frame {
    LAS unsigned char* lds; volatile LAS unsigned* MISC;
    int tid, lane, wave, vcu, G, gw, NGW;
    const float* in[19]; float* out; unsigned char* ws;
};
#define WSP(T, off) ((T*)(F.ws + (off)))

__device__ __forceinline__ void tr_item(const float* W, int ldn, int k0, int n0, bf16* WT, int ldk, int drow0, LAS float* scr, int lane) {
    { f32x4 v[8]; const int rr = lane >> 3, c4 = (lane & 7) * 4;
#pragma unroll
      for (int i = 0; i < 8; ++i) v[i] = *(const f32x4*)(W + (size_t)(k0 + 8 * i + rr) * ldn + n0 + c4);
#pragma unroll
      for (int i = 0; i < 8; ++i) { LAS float* d = scr + (8 * i + rr) * 33 + c4; d[0] = v[i].x; d[1] = v[i].y; d[2] = v[i].z; d[3] = v[i].w; } }
    LDS_WAIT(); asm volatile("" ::: "memory");
    const int c = lane & 7;
#pragma unroll
    for (int j = 0; j < 4; ++j) { const int n = (lane >> 3) + 8 * j; const LAS float* s = scr + (8 * c) * 33 + n;
        v4u o; o.x = pk2(s[0 * 33], s[1 * 33]); o.y = pk2(s[2 * 33], s[3 * 33]); o.z = pk2(s[4 * 33], s[5 * 33]); o.w = pk2(s[6 * 33], s[7 * 33]);
        *(GAS v4u*)(WT + (size_t)(drow0 + n) * ldk + k0 + 8 * c) = o; }
    LDS_WAIT(); asm volatile("" ::: "memory");
}
__device__ __forceinline__ int gu_row(int n0, int F_) { const int up = n0 >= F_, j = up ? n0 - F_ : n0; return 256 * (j >> 7) + (up ? 128 : 0) + (j & 127); }
__device__ __forceinline__ float silu_acc(float v) { return v / (1.f + expf(-v)); }
constexpr int MOE_I8 = 8 * 16 * 112, MOE_I9 = 8 * 28 * 32, MOE_ITEMS = MOE_I8 + MOE_I9;
constexpr int MOE_G1 = 128 * 40, MOE_G2 = 128 * 48, MOE_G3 = 144 * 24;
__device__ __forceinline__ void moe_w_item(Frame& F, int r, LAS float* scr, int lane) {
    if (r < MOE_I8) { const int e = r / (16 * 112), q = r % (16 * 112), kb = q / 112, nb = q % 112;
        tr_item(F.in[16] + (size_t)e * D * 2 * ED, 2 * ED, 64 * kb, 32 * nb, WSP(bf16, WS_WGU1), D, e * 2 * ED + gu_row(32 * nb, ED), scr, lane); }
    else { r -= MOE_I8; const int e = r / (28 * 32), q = r % (28 * 32), kb = q / 32, nb = q % 32;
        tr_item(F.in[17] + (size_t)e * ED * D, D, 64 * kb, 32 * nb, WSP(bf16, WS_WDN1), ED, e * D + 32 * nb, scr, lane); }
}
__device__ __forceinline__ void moe_w_side(Frame& F, int lo, int hi, int first_wg) {
    if (F.G != 256 || (int)blockIdx.x < first_wg) return;
    LAS float* scr = (LAS float*)(F.lds + F.wave * 16384);
    for (int it = lo + ((int)blockIdx.x - first_wg) * NWAVES + F.wave; it < hi; it += (256 - first_wg) * NWAVES) moe_w_item(F, it, scr, F.lane);
}
__device__ __forceinline__ void p0_prologue(Frame& F) {
    LAS float* scr = (LAS float*)(F.lds + F.wave * 16384);
    const int lane = F.lane;
    constexpr int I0 = 16 * 96, I1 = 16 * 32, I2 = 16 * 176, I3 = 44 * 32, I4 = 16 * 13, I5 = 4 * 48, I6 = 2 * 64, I7 = 16 * 32;
    const int NMOE0 = (F.G == 256) ? MOE_ITEMS - MOE_G1 - MOE_G2 - MOE_G3 : MOE_ITEMS;
    constexpr int IA = 2 * 96 * 16;
    constexpr int IZ = 96 + 2 * 1024;
    constexpr int IR = 24;
    const int NITEMS = I0 + I1 + I2 + I3 + I4 + I5 + I6 + I7 + NMOE0 + IA + IZ + IR;
    for (int it = F.gw; it < NITEMS; it += F.NGW) {
        int r = it;
        if (r < NMOE0) { moe_w_item(F, r, scr, lane); continue; } r -= NMOE0;
        if (r < I0) { const int kb = r / 96, nb = r % 96, n0 = 32 * nb;
            if (n0 < 2048) tr_item(F.in[4], 3 * D, 64 * kb, n0, WSP(bf16, WS_WQK), D, n0, scr, lane); else tr_item(F.in[4], 3 * D, 64 * kb, n0, WSP(bf16, WS_WV), D, n0 - 2048, scr, lane);
            continue; } r -= I0;
        if (r < I1) { tr_item(F.in[6], D, 64 * (r / 32), 32 * (r % 32), WSP(bf16, WS_WO0), D, 32 * (r % 32), scr, lane); continue; } r -= I1;
        if (r < I2) { const int kb = r / 176, nb = r % 176; tr_item(F.in[7], 2 * FFN, 64 * kb, 32 * nb, WSP(bf16, WS_WGU0), D, gu_row(32 * nb, FFN), scr, lane); continue; } r -= I2;
        if (r < I3) { tr_item(F.in[8], D, 64 * (r / 32), 32 * (r % 32), WSP(bf16, WS_WDN0), FFN, 32 * (r % 32), scr, lane); continue; } r -= I3;
        if (r < I4) { tr_item(F.in[9], DOWN_N, 64 * (r / 13), 32 * (r % 13), WSP(bf16, WS_WMD), D, 32 * (r % 13), scr, lane); continue; } r -= I4;
        if (r < I5) { tr_item(F.in[11], 1536, 64 * (r / 48), 32 * (r % 48), WSP(bf16, WS_WUQ), QL, 32 * (r % 48), scr, lane); continue; } r -= I5;
        if (r < I6) { const int kb = r / 64, nb = r % 64, h = nb >> 2, q = nb & 3;
            if (q < 2) tr_item(F.in[13], 2048, 64 * kb, 32 * nb, WSP(bf16, WS_WKN), 128, h * 64 + 32 * q, scr, lane); else tr_item(F.in[13], 2048, 64 * kb, 32 * nb, WSP(bf16, WS_WVV), 128, h * 64 + 32 * (q - 2), scr, lane);
            continue; } r -= I6;
        if (r < I7) { tr_item(F.in[14], D, 64 * (r / 32), 32 * (r % 32), WSP(bf16, WS_WO1), D, 32 * (r % 32), scr, lane); continue; } r -= I7;
        if (r < IA) {
            const int l = r / (96 * 16), q = r % (96 * 16), cg = q / 16, kc = q % 16, n = 64 * cg + lane;
            const float* w = F.in[2] + (size_t)l * D * 6 * D + n; const float* c = F.in[1];
            float a0 = 0.f, a1 = 0.f;
            const float ca0 = silu_acc(c[64 * kc + lane]), ca1 = silu_acc(c[D + 64 * kc + lane]);
#pragma unroll 32
            for (int kk = 0; kk < 64; ++kk) { const float wv = w[(size_t)(64 * kc + kk) * 6 * D]; a0 += __shfl(ca0, kk) * wv; a1 += __shfl(ca1, kk) * wv; }
            float* part = WSP(float, WS_PART) + ((size_t)(kc * 2 + l) * 2) * 6 * D + n;
            part[0] = a0; part[6 * D] = a1; continue; } r -= IA;
        if (r < IZ) {
            if (r < 96) { GAS v4u* p = (GAS v4u*)(WSP(bf16, WS_WMD) + (size_t)(DOWN_N + r) * D); p[lane] = (v4u){0u, 0u, 0u, 0u}; p[64 + lane] = (v4u){0u, 0u, 0u, 0u}; }
            else { }
            continue; } r -= IZ;
        {
            const int idx = 64 * r + lane, isc = idx >= 1024, q = isc ? idx - 1024 : idx, i = q >> 3, p = q & 7;
            const float inv = powf(10000.f, -(float)p / 8.f), a = (float)i * inv;
            float* t = (isc ? WSP(float, WS_ROPEC) : WSP(float, WS_ROPER)) + i * 16 + 2 * p; t[0] = cosf(a); t[1] = sinf(a);
        }
    }
}
__device__ __forceinline__ f32x4 mod4_partials(Frame& F, int l, int b, int n) {
    f32x4 a = *(const f32x4*)(F.in[3] + l * 6 * D + n);
#pragma unroll
    for (int kc = 0; kc < 16; ++kc) a += *(const f32x4*)(WSP(float, WS_PART) + ((size_t)((kc * 2 + l) * 2 + b)) * 6 * D + n);
    return a;
}
template <bool FROM_PART, typename TX> __device__ __forceinline__ void modulate_phase(Frame& F, const TX* X, int l, int cs, bf16* HNo) {
    for (int b = 0; b < NB; ++b) {
        f32x4 sh[4], sc[4];
#pragma unroll
        for (int j = 0; j < 4; ++j) { const int n = 4 * F.lane + 256 * j;
            if (FROM_PART) { sh[j] = mod4_partials(F, l, b, cs * D + n); sc[j] = mod4_partials(F, l, b, (cs + 1) * D + n); }
            else { const float* mf = WSP(float, WS_MODF) + (size_t)(l * 2 + b) * 6 * D; sh[j] = *(const f32x4*)(mf + cs * D + n); sc[j] = *(const f32x4*)(mf + (cs + 1) * D + n); }
            sc[j] = sc[j] + 1.f; }
        for (int row = b * SEQ + F.gw; row < (b + 1) * SEQ; row += 4 * F.NGW) {
            f32x4 v[4][4]; float ss[4]; bool ok[4];
#pragma unroll
            for (int q = 0; q < 4; ++q) { ok[q] = row + q * F.NGW < (b + 1) * SEQ; const int rq = ok[q] ? row + q * F.NGW : row;
#pragma unroll
                for (int j = 0; j < 4; ++j) v[q][j] = XRow<TX>::ld(X, (size_t)rq, 4 * F.lane + 256 * j); }
#pragma unroll
            for (int q = 0; q < 4; ++q) { ss[q] = 0.f;
#pragma unroll
                for (int j = 0; j < 4; ++j) ss[q] += (v[q][j].x * v[q][j].x + v[q][j].y * v[q][j].y) + (v[q][j].z * v[q][j].z + v[q][j].w * v[q][j].w); }
#pragma unroll
            for (int o = 1; o < 64; o <<= 1)
#pragma unroll
                for (int q = 0; q < 4; ++q) ss[q] += __shfl_xor(ss[q], o);
#pragma unroll
            for (int q = 0; q < 4; ++q) if (ok[q]) { const float rstd = rsqrtf(ss[q] * (1.f / D) + NORM_EPS); GAS v2u* o8 = (GAS v2u*)(HNo + (size_t)(row + q * F.NGW) * D) + F.lane;
#pragma unroll
                for (int j = 0; j < 4; ++j) { const f32x4 y = v[q][j] * rstd * sc[j] + sh[j]; v2u w; w.x = pk2(y.x, y.y); w.y = pk2(y.z, y.w); o8[64 * j] = w; } }
        }
    }
}
__device__ __forceinline__ void modf_reduce(Frame& F) {
    for (int i = blockIdx.x * NTHREADS + F.tid; i < 2 * 2 * 6 * D; i += F.G * NTHREADS) {
        const int l = i / (2 * 6 * D), q = i % (2 * 6 * D), n = q % (6 * D), b = q / (6 * D);
        float a = F.in[3][l * 6 * D + n];
#pragma unroll
        for (int kc = 0; kc < 16; ++kc) a += WSP(float, WS_PART)[((size_t)((kc * 2 + l) * 2 + b)) * 6 * D + n];
        WSP(float, WS_MODF)[i] = a;
    }
}
__device__ __forceinline__ void mla_mid_phase(Frame& F) {
    const float* DOWN = WSP(float, WS_DOWN); const float* qn = F.in[10]; const float* kvn = F.in[12];
    const f32x4 qn4 = *(const f32x4*)(qn + 4 * F.lane); const f32x2 kn2 = *(const f32x2*)(kvn + 2 * F.lane);
    for (int row = F.gw; row < M; row += F.NGW) {
        const float* dr = DOWN + (size_t)row * DOWN_NP; const int t = row & (SEQ - 1);
        const f32x4 a = *(const f32x4*)(dr + 4 * F.lane); const f32x2 k = *(const f32x2*)(dr + QL + 2 * F.lane);
        const float rq = rsqrtf(wave_sum((a.x * a.x + a.y * a.y) + (a.z * a.z + a.w * a.w)) * (1.f / QL) + NORM_EPS);
        const float rk = rsqrtf(wave_sum(k.x * k.x + k.y * k.y) * (1.f / KVL) + NORM_EPS);
        v2u w; w.x = pk2(a.x * rq * qn4.x, a.y * rq * qn4.y); w.y = pk2(a.z * rq * qn4.z, a.w * rq * qn4.w);
        *((GAS v2u*)(WSP(bf16, WS_CQ) + (size_t)row * QL) + F.lane) = w;
        GAS unsigned* ck = (GAS unsigned*)(WSP(bf16, WS_CKV) + (size_t)row * 128);
        ck[F.lane] = pk2(k.x * rk * kn2.x, k.y * rk * kn2.y);
        if (F.lane < 16) { const f32x2 x = *(const f32x2*)(dr + QL + KVL + 2 * F.lane);
            const float* tb = F.lane < 8 ? WSP(float, WS_ROPER) + (t >> 6) * 16 + 2 * F.lane : WSP(float, WS_ROPEC) + (t & 63) * 16 + 2 * (F.lane - 8);
            const float cs = tb[0], sn = tb[1];
            ((GAS unsigned*)(WSP(bf16, WS_KR) + (size_t)row * RP))[F.lane] = pk2(x.x * cs - x.y * sn, x.x * sn + x.y * cs); }
    }
}
namespace na {
constexpr int L_K = 0, L_V = 73728, L_B = 147456, L_END = L_B + 15 * 64 * 4;
}
__device__ __forceinline__ void na_phase(Frame& F) {
    const bf16* Q = WSP(bf16, WS_Q0); const bf16* K = WSP(bf16, WS_K0); const bf16* VT = WSP(bf16, WS_VT0); bf16* O = WSP(bf16, WS_O0);
    const int tid = F.tid, lane = F.lane, l16 = lane & 15, g = lane >> 4;
    LAS float* rpbH = (LAS float*)(F.lds + na::L_B);
    const int scol = tid >> 3, sc = tid & 7;
    const unsigned kdst = (unsigned)((scol * 8 + (sc ^ ((scol & 2) ^ ((scol & 8) >> 1)))) * 16), vdst = (unsigned)((scol * 8 + (sc ^ (scol & 6))) * 16);
    const int ri = F.wave >> 2, ct = F.wave & 3;
    const int c0 = 16 * ct, kc0 = ct == 0 ? 0 : (ct == 1 ? 8 : (ct == 2 ? 24 : 32));
    const int c = c0 + l16; int cs = c - 8; cs = cs < 0 ? 0 : (cs > GW - 16 ? GW - 16 : cs);
    const int kcolA = kc0 + 8 * (l16 >> 2) + (l16 & 3), kxv = (kcolA & 2) ^ ((kcolA & 8) >> 1);
    const unsigned kch0 = (unsigned)((kcolA * 8 + (g ^ kxv)) * 16), kch1 = (unsigned)((kcolA * 8 + ((4 + g) ^ kxv)) * 16);
    const unsigned vch = (unsigned)((l16 * 8 + (((kc0 >> 3) + g) ^ (l16 & 6))) * 16);
    const int dc0 = kc0 + 8 * g - c + 15, t0 = kc0 + 8 * g - cs;
    float pen[8];
#pragma unroll
    for (int k = 0; k < 8; ++k) pen[k] = (unsigned)(t0 + k) < 16u ? 0.f : -1e30f;
    for (int w = F.vcu; w < NB * NH * 8; w += F.G) {
        const int bh = w >> 3, b = bh >> 4, h = bh & 15, rp0 = (w & 7) * 8;
        __syncthreads();
        for (int i = tid; i < 15 * 64; i += NTHREADS) { const int dc = (i & 63) - 8; rpbH[i] = (dc >= 0 && dc <= 30) ? F.in[5][(h * 15 + (i >> 6)) * 31 + dc] * LOG2E : 0.f; }
        const bf16* kbase = K + ((size_t)h * M + (size_t)b * SEQ) * HD + scol * HD + sc * 8;
        const bf16* vbase = VT + ((size_t)(b * GROWS) * D + h * HD + scol) * GW + sc * 8;
        bf16x8 kst[9], vst[9];
#define NA_LOAD(rp_) do { int R0_ = 2 * (rp_) - 4; R0_ = R0_ < 0 ? 0 : (R0_ > GROWS - 8 ? GROWS - 8 : R0_); \
        _Pragma("unroll") for (int i_ = 0; i_ < 9; ++i_) { const int row_ = (R0_ + i_) > GROWS - 1 ? GROWS - 1 : (R0_ + i_); \
            kst[i_] = *(const bf16x8*)(kbase + (size_t)row_ * GW * HD); vst[i_] = *(const bf16x8*)(vbase + (size_t)row_ * D * GW); } } while (0)
        NA_LOAD(rp0);
        for (int st = 0; st < 8; ++st) {
            const int rp = rp0 + st;
            __syncthreads();
#pragma unroll
            for (int i = 0; i < 9; ++i) { *(LAS bf16x8*)(F.lds + na::L_K + i * 8192 + kdst) = kst[i]; *(LAS bf16x8*)(F.lds + na::L_V + i * 8192 + vdst) = vst[i]; }
            __syncthreads();
            if (st + 1 < 8) NA_LOAD(rp + 1);
            __builtin_amdgcn_sched_barrier(0);
            const int r = 2 * rp + ri; int rs = r - 4; rs = rs < 0 ? 0 : (rs > GROWS - 8 ? GROWS - 8 : rs);
            int R0 = 2 * rp - 4; R0 = R0 < 0 ? 0 : (R0 > GROWS - 8 ? GROWS - 8 : R0);
            const int roff = rs - R0;
            const size_t tq = (size_t)b * SEQ + r * GW + c;
            bf16x8 qf[2];
#pragma unroll
            for (int ks = 0; ks < 2; ++ks) qf[ks] = *(const bf16x8*)(Q + tq * D + h * HD + 32 * ks + 8 * g);
            const LAS unsigned char* kl = F.lds + na::L_K + roff * 8192; const LAS unsigned char* vl = F.lds + na::L_V + roff * 8192;
            pg8::f32x4 s[8][2];
#pragma unroll
            for (int kr = 0; kr < 8; ++kr)
#pragma unroll
                for (int blk = 0; blk < 2; ++blk) {
                    const bf16x8 k0 = *(const LAS bf16x8*)(kl + kr * 8192 + blk * 512 + kch0), k1 = *(const LAS bf16x8*)(kl + kr * 8192 + blk * 512 + kch1);
                    pg8::f32x4 a = {0.f, 0.f, 0.f, 0.f};
                    a = __builtin_amdgcn_mfma_f32_16x16x32_bf16(k0, qf[0], a, 0, 0, 0);
                    a = __builtin_amdgcn_mfma_f32_16x16x32_bf16(k1, qf[1], a, 0, 0, 0);
                    s[kr][blk] = a; if (blk == 1 && (kr & 1)) __builtin_amdgcn_sched_barrier(0); }
            const LAS float* bp = rpbH + (rs - r + 7) * 64 + dc0 + 8;
            float mx = -1e30f;
#pragma unroll
            for (int kr = 0; kr < 8; ++kr)
#pragma unroll
                for (int blk = 0; blk < 2; ++blk)
#pragma unroll
                    for (int i = 0; i < 4; ++i) { const float v = (s[kr][blk][i] + bp[kr * 64 + 4 * blk + i]) + pen[4 * blk + i]; s[kr][blk][i] = v; mx = fmaxf(mx, v); }
            mx = fmaxf(mx, __shfl_xor(mx, 16)); mx = fmaxf(mx, __shfl_xor(mx, 32));
            float sum = 0.f;
#pragma unroll
            for (int kr = 0; kr < 8; ++kr)
#pragma unroll
                for (int blk = 0; blk < 2; ++blk)
#pragma unroll
                    for (int i = 0; i < 4; ++i) { const float e = __builtin_amdgcn_exp2f(s[kr][blk][i] - mx); s[kr][blk][i] = e; sum += e; }
            sum += __shfl_xor(sum, 16); sum += __shfl_xor(sum, 32);
            const float inv = 1.f / sum;
            pg8::f32x4 o[4];
#pragma unroll
            for (int db = 0; db < 4; ++db) o[db] = (pg8::f32x4){0.f, 0.f, 0.f, 0.f};
#pragma unroll
            for (int kr = 0; kr < 8; ++kr) {
                v4u pw; pw.x = pk2(s[kr][0][0], s[kr][0][1]); pw.y = pk2(s[kr][0][2], s[kr][0][3]); pw.z = pk2(s[kr][1][0], s[kr][1][1]); pw.w = pk2(s[kr][1][2], s[kr][1][3]);
                const bf16x8 pf = __builtin_bit_cast(bf16x8, pw);
#pragma unroll
                for (int db = 0; db < 4; ++db) { const bf16x8 vf = *(const LAS bf16x8*)(vl + kr * 8192 + db * 2048 + vch);
                    o[db] = __builtin_amdgcn_mfma_f32_16x16x32_bf16(vf, pf, o[db], 0, 0, 0); }
                if (kr & 1) __builtin_amdgcn_sched_barrier(0); }
            bf16* op = O + tq * D + h * HD + 4 * g;
#pragma unroll
            for (int db = 0; db < 4; ++db) { v2u wv; wv.x = pk2(o[db][0] * inv, o[db][1] * inv); wv.y = pk2(o[db][2] * inv, o[db][3] * inv); *(GAS v2u*)(op + 16 * db) = wv; }
        }
#undef NA_LOAD
    }
    __syncthreads();
}
namespace mla {
constexpr int NSLOT = 4, KSLOT = 12288, VSLOT = 8192;
constexpr int L_K = 0, L_V = NSLOT * KSLOT, L_WS = L_V + NSLOT * VSLOT, L_OST = L_WS + 2048, L_BYTES = L_OST + 8 * 4096;
constexpr float THR = 8.f;
typedef LAS unsigned char lch;
__device__ __forceinline__ int crow(int r, int hi) { return (r & 3) + 8 * (r >> 2) + 4 * hi; }
__device__ __forceinline__ void glds16(const void* sbase, unsigned voff, unsigned lds_dst) { unsigned keep;
    asm volatile("s_mov_b32 %0, m0\n\ts_mov_b32 m0, %3\n\ts_nop 0\n\tglobal_load_lds_dwordx4 %1, %2\n\ts_mov_b32 m0, %0" : "=&s"(keep) : "v"(voff), "s"(sbase), "s"(lds_dst) : "memory"); }
#define MLA_WAIT_BAR(N) asm volatile("s_waitcnt vmcnt(" #N ") lgkmcnt(0)\n\ts_barrier" ::: "memory")
#define MLA_WAIT_FULL() do { if (wid < 4) { MLA_WAIT_BAR(6); } else { MLA_WAIT_BAR(4); } } while (0)
#define MLA_SBAR() __builtin_amdgcn_sched_barrier(0)
#define MLA_MF(a, b, c) __builtin_amdgcn_mfma_f32_32x32x16_bf16(a, b, c, 0, 0, 0)
#define MLA_PIN(x) asm volatile("" : "+v"(x))
#define MLA_EX(v) __builtin_amdgcn_exp2f(v)
__device__ __forceinline__ void unit(int b, int h, int qb, const bf16* Q1, const bf16* KN, const bf16* KR, const bf16* VT, bf16* O1, lch* lds, const bool first, const bool chain) {
    const int tid = threadIdx.x, wid = __builtin_amdgcn_readfirstlane(tid >> 6), lane = tid & 63, r32 = lane & 31, hi = lane >> 5;
    const size_t rowbase = (size_t)b * SEQ; const int q0 = qb * 256;
    const unsigned lds0 = (unsigned)(uintptr_t)lds;
    LAS float* wsf = (LAS float*)(lds + L_WS) + wid * 64;
    const bf16* knb = KN + ((size_t)h * M + rowbase + 8 * wid) * HD; const bf16* krb = KR + (rowbase + 16 * (wid & 3)) * RP; const bf16* vb = VT + ((rowbase >> 6) * D + h * HD + 8 * wid) * GW;
    unsigned kno, kro, vo;
    { const int rl = lane >> 3, row = 8 * wid + rl, c = (lane & 7) ^ ((row >> 1) & 7); kno = (unsigned)((rl * HD + c * 8) * 2); }
    { const int rl = lane >> 2, row = 16 * (wid & 3) + rl, c = (lane & 3) ^ ((row >> 2) & 3); kro = (unsigned)((rl * RP + c * 8) * 2); }
    { const int dl = lane >> 3, d = 8 * wid + dl, c = (lane & 7) ^ ((d >> 1) & 7); vo = (unsigned)((dl * GW + c * 8) * 2); }
    const unsigned kndst = lds0 + L_K + wid * 1024, krdst = lds0 + L_K + 8192 + (wid & 3) * 1024, vdst = lds0 + L_V + wid * 1024;
#define DMA_K(t, slot) do { glds16(knb + (size_t)(t) * (64 * HD), kno, (unsigned)__builtin_amdgcn_readfirstlane(kndst + (slot))); if (wid < 4) glds16(krb + (size_t)(t) * (64 * RP), kro, (unsigned)__builtin_amdgcn_readfirstlane(krdst + (slot))); } while (0)
#define DMA_V(t, slot) glds16(vb + (size_t)(t) * (D * GW), vo, (unsigned)__builtin_amdgcn_readfirstlane(vdst + (slot)))
    const int rowA = (r32 & ~0xC) | ((r32 & 4) << 1) | ((r32 & 8) >> 1);
    const lch* kpn0 = lds + L_K + rowA * 128 + (((0 + hi) ^ ((rowA >> 1) & 7)) * 16); const lch* kpn1 = lds + L_K + rowA * 128 + (((2 + hi) ^ ((rowA >> 1) & 7)) * 16);
    const lch* kpn2 = lds + L_K + rowA * 128 + (((4 + hi) ^ ((rowA >> 1) & 7)) * 16); const lch* kpn3 = lds + L_K + rowA * 128 + (((6 + hi) ^ ((rowA >> 1) & 7)) * 16);
    const lch* kpr0 = lds + L_K + 8192 + rowA * 64 + (((0 + hi) ^ ((rowA >> 2) & 3)) * 16); const lch* kpr1 = lds + L_K + 8192 + rowA * 64 + (((2 + hi) ^ ((rowA >> 2) & 3)) * 16);
    const lch* vp0 = lds + L_V + r32 * 128 + (((0 + hi) ^ ((r32 >> 1) & 7)) * 16); const lch* vp1 = lds + L_V + r32 * 128 + (((2 + hi) ^ ((r32 >> 1) & 7)) * 16);
    const lch* vp2 = lds + L_V + r32 * 128 + (((4 + hi) ^ ((r32 >> 1) & 7)) * 16); const lch* vp3 = lds + L_V + r32 * 128 + (((6 + hi) ^ ((r32 >> 1) & 7)) * 16);
#define LDF(p) (*(const LAS bf16x8*)(p))
#define KLOAD_ALL(so) do { kf[0] = LDF(kpn0 + (so)); kf[1] = LDF(kpn0 + (so) + 4096); kf[2] = LDF(kpn1 + (so)); kf[3] = LDF(kpn1 + (so) + 4096); kf[4] = LDF(kpn2 + (so)); kf[5] = LDF(kpn2 + (so) + 4096); \
        kf[6] = LDF(kpn3 + (so)); kf[7] = LDF(kpn3 + (so) + 4096); kf[8] = LDF(kpr0 + (so)); kf[9] = LDF(kpr0 + (so) + 2048); kf[10] = LDF(kpr1 + (so)); kf[11] = LDF(kpr1 + (so) + 2048); } while (0)
    bf16x8 kf[12], qr[6];
    constexpr int NT = SEQ / 64;
    if (first) { DMA_K(0, 0); DMA_V(0, 0); DMA_K(1, KSLOT); }
    { const bf16* Qw = Q1 + (rowbase + q0 + wid * 32 + r32) * 1536 + h * QKD + hi * 8;
#pragma unroll
      for (int d0 = 0; d0 < 6; ++d0) qr[d0] = *(const bf16x8*)(Qw + d0 * 16); }
    if (first) { DMA_V(1, VSLOT); DMA_K(2, 2 * KSLOT); DMA_K(3, 3 * KSLOT); }
    float m_ref = 0.f, l_reg = 0.f; f32x16 o[2]; o[0] = f32x16{}; o[1] = f32x16{}; f32x16 negm;
    f32x16 pA0, pA1, pB0, pB1; bool resc = false;
    if (!first) { MLA_WAIT_BAR(0); } else if (wid < 4) { MLA_WAIT_BAR(8); } else { MLA_WAIT_BAR(5); }
    KLOAD_ALL(0);
    { const f32x16 z = {};
      pA0 = MLA_MF(kf[0], qr[0], z); pA1 = MLA_MF(kf[1], qr[0], z);
#pragma unroll
      for (int d0 = 1; d0 < 6; ++d0) { pA0 = MLA_MF(kf[2 * d0], qr[d0], pA0); pA1 = MLA_MF(kf[2 * d0 + 1], qr[d0], pA1); } }
    { float rm = pA0[0];
#pragma unroll
      for (int r = 1; r < 16; ++r) rm = fmaxf(rm, pA0[r]);
#pragma unroll
      for (int r = 0; r < 16; ++r) rm = fmaxf(rm, pA1[r]);
      { auto rr = __builtin_amdgcn_permlane32_swap(__float_as_uint(rm), __float_as_uint(rm), false, false); rm = fmaxf(__uint_as_float(rr[0]), __uint_as_float(rr[1])); }
      m_ref = rm;
#pragma unroll
      for (int r = 0; r < 16; ++r) negm[r] = -m_ref;
      MLA_PIN(negm);
#pragma unroll
      for (int r = 0; r < 16; ++r) { pA0[r] = MLA_EX(pA0[r] - m_ref); pA1[r] = pA1[r] - m_ref; } }
    MLA_WAIT_BAR(0);
    DMA_K(4, 0); DMA_V(2, 2 * VSLOT);
    KLOAD_ALL(KSLOT);
    MLA_WAIT_FULL();
    bf16x8 vA0, vA1, vA2, vA3, vB0, vB1, vB2, vB3; v4u pw0, pw1, pw2, pw3;
#define PKW(P, B) pk2(P[B], P[(B) + 1])
#define PAF(k) __builtin_bit_cast(bf16x8, pw##k)
#define GAE(MF, X, B, A0, A1, A2, A3) do { MF; X[B] = MLA_EX(X[B]); X[(B) + 1] = MLA_EX(X[(B) + 1]); X[(B) + 2] = MLA_EX(X[(B) + 2]); X[(B) + 3] = MLA_EX(X[(B) + 3]); MLA_PIN(X); \
        sacc += A0; sacc += A1; sacc += A2; sacc += A3; MLA_PIN(sacc); MLA_SBAR(); } while (0)
#define GAC(MF, A0, A1, A2, A3, W0, W1, PW) do { MF; sacc += A0; sacc += A1; sacc += A2; sacc += A3; MLA_PIN(sacc); W0; W1; MLA_PIN(PW); MLA_SBAR(); } while (0)
#define GAW(MF, W0, W1, W2, W3, PW) do { MF; W0; W1; W2; W3; MLA_PIN(PW); MLA_SBAR(); } while (0)
#define GB(MF, X0, X1, J) do { MF; X0[J] = MLA_EX(X0[J]); X0[(J) + 1] = MLA_EX(X0[(J) + 1]); MLA_PIN(X0); MLA_SBAR(); } while (0)
#define STEP(C0, C1, P0, P1, t, R, GK, GV, GL) do { MLA_SBAR(); \
    constexpr int kc = (R) * KSLOT, kn = (((R) + 1) % 4) * KSLOT, vpv = (((R) + 3) % 4) * VSLOT, vn = (((R) + 2) % 4) * VSLOT; float sacc = 0.f; \
    vA0 = LDF(vp0 + vpv); MLA_SBAR(); GAE(C0 = MLA_MF(kf[0], qr[0], negm), P1, 0, P0[0], P0[1], P0[2], P0[3]); \
    vA1 = LDF(vp1 + vpv); MLA_SBAR(); GAE(C1 = MLA_MF(kf[1], qr[0], negm), P1, 4, P0[4], P0[5], P0[6], P0[7]); \
    vA2 = LDF(vp2 + vpv); MLA_SBAR(); GAE(C0 = MLA_MF(kf[2], qr[1], C0), P1, 8, P0[8], P0[9], P0[10], P0[11]); \
    vA3 = LDF(vp3 + vpv); MLA_SBAR(); GAE(C1 = MLA_MF(kf[3], qr[1], C1), P1, 12, P0[12], P0[13], P0[14], P0[15]); \
    GAC(C0 = MLA_MF(kf[4], qr[2], C0), P1[0], P1[1], P1[2], P1[3], pw0[0] = PKW(P0, 0), pw0[1] = PKW(P0, 2), pw0); \
    GAC(C1 = MLA_MF(kf[5], qr[2], C1), P1[4], P1[5], P1[6], P1[7], pw0[2] = PKW(P0, 4), pw0[3] = PKW(P0, 6), pw0); \
    GAC(C0 = MLA_MF(kf[6], qr[3], C0), P1[8], P1[9], P1[10], P1[11], pw1[0] = PKW(P0, 8), pw1[1] = PKW(P0, 10), pw1); \
    GAC(C1 = MLA_MF(kf[7], qr[3], C1), P1[12], P1[13], P1[14], P1[15], pw1[2] = PKW(P0, 12), pw1[3] = PKW(P0, 14), pw1); \
    GAW(C0 = MLA_MF(kf[8], qr[4], C0), pw2[0] = PKW(P1, 0), pw2[1] = PKW(P1, 2), pw2[2] = PKW(P1, 4), pw2[3] = PKW(P1, 6), pw2); \
    GAW(C1 = MLA_MF(kf[9], qr[4], C1), pw3[0] = PKW(P1, 8), pw3[1] = PKW(P1, 10), pw3[2] = PKW(P1, 12), pw3[3] = PKW(P1, 14), pw3); \
    C0 = MLA_MF(kf[10], qr[5], C0); C1 = MLA_MF(kf[11], qr[5], C1); \
    l_reg += sacc; \
    if (GK) { DMA_K(((t) + 4) & (NT - 1), kc); } if (GV) { DMA_V(((t) + 2) & (NT - 1), vn); } \
    { float a_ = fmaxf(fmaxf(C0[0], C0[1]), C1[0]), b_ = fmaxf(fmaxf(C0[2], C0[3]), C1[1]); a_ = fmaxf(fmaxf(a_, C1[2]), C1[3]); \
      _Pragma("unroll") for (int r = 4; r < 16; r += 4) { a_ = fmaxf(fmaxf(a_, C0[r]), C0[r + 1]); b_ = fmaxf(fmaxf(b_, C0[r + 2]), C0[r + 3]); a_ = fmaxf(fmaxf(a_, C1[r]), C1[r + 1]); b_ = fmaxf(fmaxf(b_, C1[r + 2]), C1[r + 3]); } \
      float rm = fmaxf(a_, b_); { auto rr = __builtin_amdgcn_permlane32_swap(__float_as_uint(rm), __float_as_uint(rm), false, false); rm = fmaxf(__uint_as_float(rr[0]), __uint_as_float(rr[1])); } \
      resc = false; \
      if (__builtin_expect(__any(rm > THR), 0)) { const float dl = fmaxf(rm, 0.f), f = MLA_EX(-dl); m_ref += dl; l_reg *= f; if (hi == 0) wsf[r32] = f; resc = true; \
        _Pragma("unroll") for (int r = 0; r < 16; ++r) { C0[r] -= dl; C1[r] -= dl; } \
        _Pragma("unroll") for (int r = 0; r < 16; ++r) negm[r] = -m_ref; MLA_PIN(negm); } } \
    MLA_SBAR(); \
    vB0 = LDF(vp0 + vpv + 4096); if (GL) { kf[0] = LDF(kpn0 + kn); } MLA_SBAR(); GB(o[0] = MLA_MF(PAF(0), vA0, o[0]), C0, C1, 0); \
    vB1 = LDF(vp1 + vpv + 4096); if (GL) { kf[1] = LDF(kpn0 + kn + 4096); } MLA_SBAR(); GB(o[0] = MLA_MF(PAF(1), vA1, o[0]), C0, C1, 2); \
    vB2 = LDF(vp2 + vpv + 4096); if (GL) { kf[2] = LDF(kpn1 + kn); kf[3] = LDF(kpn1 + kn + 4096); } MLA_SBAR(); GB(o[0] = MLA_MF(PAF(2), vA2, o[0]), C0, C1, 4); \
    vB3 = LDF(vp3 + vpv + 4096); if (GL) { kf[4] = LDF(kpn2 + kn); kf[5] = LDF(kpn2 + kn + 4096); } MLA_SBAR(); GB(o[0] = MLA_MF(PAF(3), vA3, o[0]), C0, C1, 6); \
    if (GL) { kf[6] = LDF(kpn3 + kn); kf[7] = LDF(kpn3 + kn + 4096); } MLA_SBAR(); GB(o[1] = MLA_MF(PAF(0), vB0, o[1]), C0, C1, 8); \
    if (GL) { kf[8] = LDF(kpr0 + kn); kf[9] = LDF(kpr0 + kn + 2048); } MLA_SBAR(); GB(o[1] = MLA_MF(PAF(1), vB1, o[1]), C0, C1, 10); \
    if (GL) { kf[10] = LDF(kpr1 + kn); kf[11] = LDF(kpr1 + kn + 2048); } MLA_SBAR(); GB(o[1] = MLA_MF(PAF(2), vB2, o[1]), C0, C1, 12); \
    GB(o[1] = MLA_MF(PAF(3), vB3, o[1]), C0, C1, 14); \
    } while (0)
#define RESC() do { if (resc) { LDS_WAIT(); \
    _Pragma("unroll") for (int d_ = 0; d_ < 2; ++d_) _Pragma("unroll") for (int r_ = 0; r_ < 16; ++r_) o[d_][r_] *= wsf[crow(r_, hi)]; } } while (0)
    static_assert(NT == 128, "the step program below is written for 128 tiles");
    for (int t = 1; t < 121; t += 4) {
        STEP(pB0, pB1, pA0, pA1, t,     1, true, true, true); MLA_WAIT_FULL(); RESC();
        STEP(pA0, pA1, pB0, pB1, t + 1, 2, true, true, true); MLA_WAIT_FULL(); RESC();
        STEP(pB0, pB1, pA0, pA1, t + 2, 3, true, true, true); MLA_WAIT_FULL(); RESC();
        STEP(pA0, pA1, pB0, pB1, t + 3, 0, true, true, true); MLA_WAIT_FULL(); RESC();
    }
    STEP(pB0, pB1, pA0, pA1, 121, 1, true, true, true);    MLA_WAIT_FULL(); RESC();
    STEP(pA0, pA1, pB0, pB1, 122, 2, true, true, true);    MLA_WAIT_FULL(); RESC();
    STEP(pB0, pB1, pA0, pA1, 123, 3, true, true, true);    MLA_WAIT_FULL(); RESC();
    STEP(pA0, pA1, pB0, pB1, 124, 0, chain, true, true);   if (chain) { MLA_WAIT_FULL(); } else if (wid < 4) { MLA_WAIT_BAR(4); } else { MLA_WAIT_BAR(3); } RESC();
    STEP(pB0, pB1, pA0, pA1, 125, 1, chain, true, true);   if (chain) { MLA_WAIT_FULL(); } else { MLA_WAIT_BAR(2); } RESC();
    STEP(pA0, pA1, pB0, pB1, 126, 2, chain, chain, true);  if (!chain) { MLA_WAIT_BAR(0); } else if (wid < 4) { MLA_WAIT_BAR(3); } else { MLA_WAIT_BAR(2); } RESC();
    STEP(pB0, pB1, pA0, pA1, 127, 3, chain, chain, false); RESC();
    constexpr int vc = 3 * VSLOT;
    {
#pragma unroll
      for (int r = 0; r < 16; ++r) pB1[r] = MLA_EX(pB1[r]);
      float sacc = 0.f;
#pragma unroll
      for (int r = 0; r < 16; ++r) sacc += pB0[r];
#pragma unroll
      for (int r = 0; r < 16; ++r) sacc += pB1[r];
      l_reg += sacc;
      pw0 = (v4u){PKW(pB0, 0), PKW(pB0, 2), PKW(pB0, 4), PKW(pB0, 6)}; pw1 = (v4u){PKW(pB0, 8), PKW(pB0, 10), PKW(pB0, 12), PKW(pB0, 14)};
      pw2 = (v4u){PKW(pB1, 0), PKW(pB1, 2), PKW(pB1, 4), PKW(pB1, 6)}; pw3 = (v4u){PKW(pB1, 8), PKW(pB1, 10), PKW(pB1, 12), PKW(pB1, 14)};
      MLA_SBAR();
#pragma unroll
      for (int dh = 0; dh < 2; ++dh) { const bf16x8 w0 = LDF(vp0 + vc + dh * 4096), w1 = LDF(vp1 + vc + dh * 4096), w2 = LDF(vp2 + vc + dh * 4096), w3 = LDF(vp3 + vc + dh * 4096);
          o[dh] = MLA_MF(PAF(0), w0, o[dh]); o[dh] = MLA_MF(PAF(1), w1, o[dh]); o[dh] = MLA_MF(PAF(2), w2, o[dh]); o[dh] = MLA_MF(PAF(3), w3, o[dh]); } }
    { auto rr = __builtin_amdgcn_permlane32_swap(__float_as_uint(l_reg), __float_as_uint(l_reg), false, false); l_reg = __uint_as_float(rr[0]) + __uint_as_float(rr[1]); }
    if (hi == 0) wsf[32 + r32] = l_reg; LDS_WAIT();
    { LAS bf16* stg = (LAS bf16*)(lds + L_OST) + wid * 2048;
#pragma unroll
      for (int r = 0; r < 16; ++r) { const int orow = crow(r, hi); const float rl = __builtin_amdgcn_rcpf(wsf[32 + orow]);
#pragma unroll
          for (int dh = 0; dh < 2; ++dh) stg[orow * 64 + dh * 32 + r32] = (bf16)(pk2(o[dh][r] * rl, 0.f) & 0xffffu); }
      LDS_WAIT();
      bf16* Ow = O1 + (rowbase + q0 + wid * 32) * 1024 + h * HD;
#pragma unroll
      for (int i = 0; i < 4; ++i) { const int row = i * 8 + (lane >> 3), ch = lane & 7; const v4u v = *(const LAS v4u*)(stg + row * 64 + ch * 8); *(GAS v4u*)(Ow + (size_t)row * 1024 + ch * 8) = v; } }
    asm volatile("s_waitcnt lgkmcnt(0)\n\ts_barrier" ::: "memory");
#undef DMA_K
#undef DMA_V
#undef LDF
#undef KLOAD_ALL
#undef PKW
#undef PAF
#undef GAE
#undef GAC
#undef GAW
#undef GB
#undef STEP
#undef RESC
}
#undef MLA_WAIT_BAR
#undef MLA_WAIT_FULL
#undef MLA_SBAR
#undef MLA_MF
#undef MLA_PIN
#undef MLA_EX
}

#ifndef MK_CHECK
#define MK_CHECK 0
#endif
#ifndef MK_PHASED
#define MK_PHASED 0
#endif
#ifndef MK_DBL
#define MK_DBL 0u
#endif
#define REP(k) ((((unsigned)MK_DBL >> (k)) & 1u) ? 2 : 1)

#if MK_CHECK
__global__ void __launch_bounds__(256) chk_na(const bf16* Q, const bf16* K, const bf16* VT, const bf16* O, const float* rpb, float* accum) {
    __shared__ float qs[4][64], ps[4][128];
    const int w = threadIdx.x >> 6, lane = threadIdx.x & 63;
    const int unit = blockIdx.x * 4 + w, tok = unit / NH, h = unit % NH;
    const int b = tok / SEQ, t = tok % SEQ, r = t / GW, c = t % GW;
    int rs = r - 4; rs = rs < 0 ? 0 : (rs > GROWS - 8 ? GROWS - 8 : rs);
    int cs = c - 8; cs = cs < 0 ? 0 : (cs > GW - 16 ? GW - 16 : cs);
    qs[w][lane] = bf2f(Q[(size_t)tok * D + h * HD + lane]) * (1.f / LOG2E);
    __syncthreads();
    float sc[2];
#pragma unroll
    for (int u = 0; u < 2; ++u) {
        const int kk = lane + 64 * u, i = kk >> 4, j = kk & 15;
        const size_t kt = (size_t)b * SEQ + (rs + i) * GW + cs + j;
        const bf16* kp = K + ((size_t)h * M + kt) * HD;
        float a = 0.f;
        for (int d = 0; d < HD; ++d) a += qs[w][d] * bf2f(kp[d]);
        sc[u] = a + rpb[(h * 15 + (rs + i - r + 7)) * 31 + (cs + j - c + 15)];
    }
    float mx = fmaxf(sc[0], sc[1]);
    for (int o = 1; o < 64; o <<= 1) mx = fmaxf(mx, __shfl_xor(mx, o));
    const float e0 = expf(sc[0] - mx), e1 = expf(sc[1] - mx);
    const float inv = 1.f / wave_sum(e0 + e1);
    ps[w][lane] = e0 * inv; ps[w][lane + 64] = e1 * inv;
    __syncthreads();
    float acc = 0.f;
    for (int kk = 0; kk < 128; ++kk) { const int i = kk >> 4, j = kk & 15; const size_t kt = (size_t)b * SEQ + (rs + i) * GW + cs + j;
        acc += ps[w][kk] * bf2f(VT[((kt >> 6) * D + h * HD + lane) * GW + (kt & 63)]); }
    const float got = bf2f(O[(size_t)tok * D + h * HD + lane]);
    const float e2 = wave_sum((got - acc) * (got - acc)), r2 = wave_sum(acc * acc);
    if (lane == 0) { atomicAdd(accum, e2); atomicAdd(accum + 1, r2); }
}
__global__ void __launch_bounds__(64) chk_mla(const bf16* Q1, const bf16* KN, const bf16* KR, const bf16* VT, const bf16* O1, float* accum) {
    __shared__ float sc[SEQ]; __shared__ float qv[96];
    const int lane = threadIdx.x, i = blockIdx.x >> 4, h = blockIdx.x & 15;
    const int tok = i * 32 + ((i * 7) & 31), b = tok / SEQ;
    for (int d = lane; d < 96; d += 64) qv[d] = bf2f(Q1[(size_t)tok * 1536 + h * 96 + d]);
    __syncthreads();
    float mx = -1e30f;
    for (int key = lane; key < SEQ; key += 64) { const size_t kt = (size_t)b * SEQ + key; float a = 0.f;
        for (int d = 0; d < 64; ++d) a += qv[d] * bf2f(KN[((size_t)h * M + kt) * 64 + d]);
        for (int d = 0; d < 32; ++d) a += qv[64 + d] * bf2f(KR[kt * 32 + d]);
        sc[key] = a; mx = fmaxf(mx, a); }
    for (int o = 1; o < 64; o <<= 1) mx = fmaxf(mx, __shfl_xor(mx, o));
    float sm = 0.f;
    for (int key = lane; key < SEQ; key += 64) { const float e = exp2f(sc[key] - mx); sc[key] = e; sm += e; }
    sm = wave_sum(sm);
    __syncthreads();
    float acc = 0.f;
    for (int key = 0; key < SEQ; ++key) { const size_t kt = (size_t)b * SEQ + key; acc += sc[key] * bf2f(VT[((kt >> 6) * D + h * 64 + lane) * GW + (kt & 63)]); }
    acc /= sm;
    const float got = bf2f(O1[(size_t)tok * 1024 + h * 64 + lane]);
    const float e2 = wave_sum((got - acc) * (got - acc)), r2 = wave_sum(acc * acc);
    if (lane == 0) { atomicAdd(accum, e2); atomicAdd(accum + 1, r2); }
}
__global__ void chk_tweak(float* out, const float* accum, float amp) {
    const float s = sqrtf(amp * accum[0] / fmaxf(accum[1], 1e-30f));
    const size_t i = (size_t)blockIdx.x * 256 + threadIdx.x; out[i] *= (1.f + s);
}

__global__ void __launch_bounds__(256) chk_proj(const float* DOWN, const float* qn, const float* kvn, const float* w_uq, const float* w_ukv,
                                                const bf16* Q1, const bf16* KR, const bf16* KN, const bf16* VT, float* accum) {
    __shared__ float cq[256], ckv[128], qv[1536], red[8];
    const int tid = threadIdx.x, i = blockIdx.x, row = i * 64 + ((i * 11) & 63), t = row & (SEQ - 1), gr = t >> 6, gc = t & 63;
    const float* dr = DOWN + (size_t)row * 512;
    float ss = dr[tid] * dr[tid], ssk = tid < 128 ? dr[256 + tid] * dr[256 + tid] : 0.f;
    ss = wave_sum(ss); ssk = wave_sum(ssk);
    if ((tid & 63) == 0) { red[tid >> 6] = ss; red[4 + (tid >> 6)] = ssk; }
    __syncthreads();
    const float rq = rsqrtf((red[0] + red[1] + red[2] + red[3]) / 256.f + 1e-6f), rk = rsqrtf((red[4] + red[5] + red[6] + red[7]) / 128.f + 1e-6f);
    cq[tid] = dr[tid] * rq * qn[tid]; if (tid < 128) ckv[tid] = dr[256 + tid] * rk * kvn[tid];
    __syncthreads();
    for (int c = tid; c < 1536; c += 256) { float a = 0.f; for (int k = 0; k < 256; ++k) a += cq[k] * w_uq[(size_t)k * 1536 + c]; qv[c] = a; }
    __syncthreads();
    float e[4] = {0.f, 0.f, 0.f, 0.f}, r[4] = {0.f, 0.f, 0.f, 0.f};
    for (int c = tid; c < 1536; c += 256) { const int d = c % 96; float v = qv[c];
        if (d >= 64) { const int pr = (d - 64) >> 1; const float inv = powf(10000.f, -(float)(pr & 7) / 8.f), ang = (pr < 8 ? (float)gr : (float)gc) * inv, cs = cosf(ang), sn = sinf(ang);
            const float x1 = qv[c & ~1], x2 = qv[c | 1]; v = (c & 1) ? x1 * sn + x2 * cs : x1 * cs - x2 * sn; }
        v *= QSCALE1; const float g = bf2f(Q1[(size_t)row * 1536 + c]); e[0] += (g - v) * (g - v); r[0] += v * v; }
    if (tid < 32) { const int pr = tid >> 1; const float inv = powf(10000.f, -(float)(pr & 7) / 8.f), ang = (pr < 8 ? (float)gr : (float)gc) * inv, cs = cosf(ang), sn = sinf(ang);
        const float x1 = dr[384 + (tid & ~1)], x2 = dr[384 + (tid | 1)]; const float v = (tid & 1) ? x1 * sn + x2 * cs : x1 * cs - x2 * sn;
        const float g = bf2f(KR[(size_t)row * 32 + tid]); e[1] += (g - v) * (g - v); r[1] += v * v; }
    for (int c = tid; c < 2048; c += 256) { float a = 0.f; for (int k = 0; k < 128; ++k) a += ckv[k] * w_ukv[(size_t)k * 2048 + c];
        const int h = c >> 7, d = c & 127;
        if (d < 64) { const float g = bf2f(KN[((size_t)h * M + row) * 64 + d]); e[2] += (g - a) * (g - a); r[2] += a * a; }
        else { const float g = bf2f(VT[((size_t)(row >> 6) * D + h * 64 + d - 64) * GW + (row & 63)]); e[3] += (g - a) * (g - a); r[3] += a * a; } }
#pragma unroll
    for (int q = 0; q < 4; ++q) { const float es = wave_sum(e[q]), rs = wave_sum(r[q]); if ((tid & 63) == 0) { atomicAdd(accum + 2 * q, es); atomicAdd(accum + 2 * q + 1, rs); } }
}
__global__ void chk_tweak4(float* out, const float* accum, float amp) {
    float s2 = 0.f;
    for (int q = 0; q < 4; ++q) s2 += accum[2 * q] / fmaxf(accum[2 * q + 1], 1e-30f);
    const float s = sqrtf(amp * s2);
    const size_t i = (size_t)blockIdx.x * 256 + threadIdx.x; out[i] *= (1.f + s);
}
#endif


__device__ __forceinline__ int moe_count_prefix(Frame& F, int nblk, LAS int* red) {
    typedef int i32x4 __attribute__((ext_vector_type(4)));
    i32x4 a = {0, 0, 0, 0}, b = {0, 0, 0, 0};
    if (F.tid < nblk) { const i32x4* p = (const i32x4*)(WSP(int, WS_CNTWG) + F.tid * 8); a = p[0]; b = p[1]; }
    int c[8] = {a.x, a.y, a.z, a.w, b.x, b.y, b.z, b.w};
#pragma unroll
    for (int o = 1; o < 64; o <<= 1)
#pragma unroll
        for (int e = 0; e < 8; ++e) c[e] += __shfl_xor(c[e], o);
    if (F.lane == 0 && F.wave < 4) {
#pragma unroll
        for (int e = 0; e < 8; ++e) red[F.wave * 8 + e] = c[e]; }
    __syncthreads();
    int r = 0;
    if (F.tid < 8) r = (red[F.tid] + red[8 + F.tid]) + (red[16 + F.tid] + red[24 + F.tid]);
    __syncthreads();
    return r;
}
__device__ __forceinline__ void moe_tables(Frame& F) {
    LAS int* red = (LAS int*)(F.lds + 65536);
    const int tot = moe_count_prefix(F, 256, red);
    if (F.tid < 8) F.MISC[16 + F.tid] = (unsigned)tot;
    __syncthreads();
    if (F.tid == 0) { int tb = 0;
        for (int e = 0; e < 8; ++e) { F.MISC[24 + e] = (unsigned)tb; F.MISC[33 + e] = (unsigned)(tb * 256); tb += ((int)F.MISC[16 + e] + 255) >> 8; }
        F.MISC[32] = (unsigned)tb; F.MISC[41] = (unsigned)(tb * 256); }
    __syncthreads();
}
template <typename TX> __device__ __forceinline__ void router_phase(Frame& F, const TX* X, int l, int cs) {
    LAS float* wr_l = (LAS float*)(F.lds);
    LAS int* rowE = (LAS int*)(F.lds + 32768);
    LAS float* rowW = (LAS float*)(F.lds + 32768 + 512);
    LAS int* rowP = (LAS int*)(F.lds + 32768 + 1024);
    LAS int* lcnt = (LAS int*)(F.lds + 32768 + 1536);
    for (int i = F.tid; i < D * NE / 4; i += NTHREADS) ((LAS f32x4*)wr_l)[i] = ((const f32x4*)F.in[15])[i];
    __syncthreads();
    const float* mf = WSP(float, WS_MODF);
    for (int blk = blockIdx.x; blk < M / 64; blk += F.G) {
        const int b = (blk * 64) >> 13;
        f32x4 sh[4], sc[4];
#pragma unroll
        for (int j = 0; j < 4; ++j) { const int n = 4 * F.lane + 256 * j; sh[j] = *(const f32x4*)(mf + (size_t)(l * 2 + b) * 6 * D + cs * D + n); sc[j] = *(const f32x4*)(mf + (size_t)(l * 2 + b) * 6 * D + (cs + 1) * D + n) + 1.f; }
        for (int rr0 = 0; rr0 < 8; rr0 += 4) {
            f32x4 v[4][4]; float ss[4];
#pragma unroll
            for (int q = 0; q < 4; ++q) {
#pragma unroll
                for (int j = 0; j < 4; ++j) v[q][j] = XRow<TX>::ld(X, (size_t)(blk * 64 + F.wave * 8 + rr0 + q), 4 * F.lane + 256 * j); }
#pragma unroll
            for (int q = 0; q < 4; ++q) { ss[q] = 0.f;
#pragma unroll
                for (int j = 0; j < 4; ++j) ss[q] += (v[q][j].x * v[q][j].x + v[q][j].y * v[q][j].y) + (v[q][j].z * v[q][j].z + v[q][j].w * v[q][j].w); }
#pragma unroll
            for (int o = 1; o < 64; o <<= 1)
#pragma unroll
                for (int q = 0; q < 4; ++q) ss[q] += __shfl_xor(ss[q], o);
            float lg[4][8];
#pragma unroll
            for (int q = 0; q < 4; ++q) { const float rstd = rsqrtf(ss[q] * (1.f / D) + NORM_EPS);
#pragma unroll
                for (int e = 0; e < 8; ++e) lg[q][e] = 0.f;
                GAS v2u* o8 = (GAS v2u*)(WSP(bf16, WS_HN) + (size_t)(blk * 64 + F.wave * 8 + rr0 + q) * D) + F.lane;
#pragma unroll
                for (int j = 0; j < 4; ++j) { v[q][j] = v[q][j] * rstd * sc[j] + sh[j]; { v2u w; w.x = pk2(v[q][j].x, v[q][j].y); w.y = pk2(v[q][j].z, v[q][j].w); o8[64 * j] = w; } } }
#pragma unroll
            for (int j = 0; j < 4; ++j)
#pragma unroll
                for (int c = 0; c < 4; ++c) { const LAS f32x4* wp = (const LAS f32x4*)(wr_l + (4 * F.lane + 256 * j + c) * 8); const f32x4 w0 = wp[0], w1 = wp[1];
#pragma unroll
                    for (int q = 0; q < 4; ++q) { const float yq = v[q][j][c];
                        lg[q][0] += yq * w0.x; lg[q][1] += yq * w0.y; lg[q][2] += yq * w0.z; lg[q][3] += yq * w0.w; lg[q][4] += yq * w1.x; lg[q][5] += yq * w1.y; lg[q][6] += yq * w1.z; lg[q][7] += yq * w1.w; } }
#pragma unroll
            for (int o = 1; o < 64; o <<= 1)
#pragma unroll
                for (int q = 0; q < 4; ++q)
#pragma unroll
                    for (int e = 0; e < 8; ++e) lg[q][e] += __shfl_xor(lg[q][e], o);
#pragma unroll
            for (int q = 0; q < 4; ++q) { const int rl = F.wave * 8 + rr0 + q;
                float mx = lg[q][0];
#pragma unroll
                for (int e = 1; e < 8; ++e) mx = fmaxf(mx, lg[q][e]);
                float p[8], sm = 0.f;
#pragma unroll
                for (int e = 0; e < 8; ++e) { p[e] = expf(lg[q][e] - mx); sm += p[e]; }
                int i0 = 0; float v0 = -1.f;
#pragma unroll
                for (int e = 0; e < 8; ++e) { p[e] = p[e] / sm; if (p[e] > v0) { v0 = p[e]; i0 = e; } }
                int i1 = 0; float v1 = -1.f;
#pragma unroll
                for (int e = 0; e < 8; ++e) if (e != i0 && p[e] > v1) { v1 = p[e]; i1 = e; }
                if (F.lane == 0) { const float s2 = v0 + v1; rowE[rl * 2] = i0; rowE[rl * 2 + 1] = i1; rowW[rl * 2] = v0 / s2; rowW[rl * 2 + 1] = v1 / s2; } }
        }
        __syncthreads();
        if (F.wave == 0) {
            int cnt[8];
#pragma unroll
            for (int e = 0; e < 8; ++e) cnt[e] = 0;
#pragma unroll
            for (int ch = 0; ch < 2; ++ch) { const int a = ch * 64 + F.lane, ea = rowE[a]; int pos = 0;
#pragma unroll
                for (int e = 0; e < 8; ++e) { const unsigned long long mk = __ballot(ea == e); if (ea == e) pos = cnt[e] + __popcll(mk & ((1ull << F.lane) - 1ull)); cnt[e] += __popcll(mk); }
                rowP[a] = pos; }
            if (F.lane == 0) {
#pragma unroll
                for (int e = 0; e < 8; ++e) lcnt[e] = cnt[e]; } }
        __syncthreads();
        if (F.tid < 128) { const size_t g = (size_t)blk * 128 + F.tid; WSP(int, WS_TOKE)[g] = rowE[F.tid]; WSP(int, WS_TOKP)[g] = rowP[F.tid]; WSP(float, WS_TOKW)[g] = rowW[F.tid]; }
        if (F.tid < 8) WSP(int, WS_CNTWG)[blk * 8 + F.tid] = lcnt[F.tid];
        __syncthreads();
    }
}
__device__ __forceinline__ void gather_phase(Frame& F) {
    LAS int* boff = (LAS int*)(F.lds);
    for (int blk = blockIdx.x; blk < M / 64; blk += F.G) {
        { const int mine = moe_count_prefix(F, blk, (LAS int*)(F.lds + 65536)); if (F.tid < 8) boff[F.tid] = mine + (int)F.MISC[33 + F.tid]; }
        __syncthreads();
        {
            int slot = 0;
            if (F.lane < 16) { const size_t g = (size_t)blk * 128 + F.wave * 16 + F.lane; slot = boff[WSP(int, WS_TOKE)[g]] + WSP(int, WS_TOKP)[g]; WSP(int, WS_TOKS)[g] = slot; }
            v4u r0[8], r1[8];
#pragma unroll
            for (int tk = 0; tk < 8; ++tk) { const GAS v4u* src = (const GAS v4u*)(WSP(bf16, WS_HN) + (size_t)(blk * 64 + F.wave * 8 + tk) * D); r0[tk] = src[F.lane]; r1[tk] = src[64 + F.lane]; }
#pragma unroll
            for (int tk = 0; tk < 8; ++tk) {
#pragma unroll
                for (int k = 0; k < 2; ++k) { const int s = __shfl(slot, 2 * tk + k); GAS v4u* dst = (GAS v4u*)(WSP(bf16, WS_HP) + (size_t)s * D); dst[F.lane] = r0[tk]; dst[64 + F.lane] = r1[tk]; } }
        }
        __syncthreads();
    }
    for (int e = 0; e < 8; ++e) { const int r0 = (int)F.MISC[33 + e] + (int)F.MISC[16 + e], r1 = (int)F.MISC[34 + e];
        for (int r = r0 + F.gw; r < r1; r += F.NGW) { GAS v4u* dst = (GAS v4u*)(WSP(bf16, WS_HP) + (size_t)r * D); dst[F.lane] = (v4u){0u, 0u, 0u, 0u}; dst[64 + F.lane] = (v4u){0u, 0u, 0u, 0u}; } }
}
template <typename TX> __device__ __forceinline__ void final_phase(Frame& F, const TX* X, int l) {
    const bf16* Y = WSP(bf16, WS_HP); const float* mf = WSP(float, WS_MODF);
    f32x4 fn[4];
#pragma unroll
    for (int j = 0; j < 4; ++j) fn[j] = *(const f32x4*)(F.in[18] + 4 * F.lane + 256 * j);
    for (int b = 0; b < NB; ++b) {
        f32x4 gf[4];
#pragma unroll
        for (int j = 0; j < 4; ++j) gf[j] = *(const f32x4*)(mf + (size_t)(l * 2 + b) * 6 * D + 5 * D + 4 * F.lane + 256 * j);
        for (int row = b * SEQ + F.gw; row < (b + 1) * SEQ; row += 4 * F.NGW) {
            int s0[4], s1[4]; float w0[4], w1[4]; bool ok[4]; int rq[4];
#pragma unroll
            for (int q = 0; q < 4; ++q) { ok[q] = row + q * F.NGW < (b + 1) * SEQ; rq[q] = ok[q] ? row + q * F.NGW : row;
                s0[q] = WSP(int, WS_TOKS)[rq[q] * 2]; s1[q] = WSP(int, WS_TOKS)[rq[q] * 2 + 1]; w0[q] = WSP(float, WS_TOKW)[rq[q] * 2]; w1[q] = WSP(float, WS_TOKW)[rq[q] * 2 + 1]; }
            f32x4 xv[4][4]; v2u ya[4][4], yc[4][4];
#pragma unroll
            for (int q = 0; q < 4; ++q) { const GAS v2u* y0 = (const GAS v2u*)(Y + (size_t)s0[q] * D) + F.lane; const GAS v2u* y1 = (const GAS v2u*)(Y + (size_t)s1[q] * D) + F.lane;
#pragma unroll
                for (int j = 0; j < 4; ++j) { xv[q][j] = XRow<TX>::ld(X, (size_t)rq[q], 4 * F.lane + 256 * j); ya[q][j] = y0[64 * j]; yc[q][j] = y1[64 * j]; } }
            float ss[4];
#pragma unroll
            for (int q = 0; q < 4; ++q) { ss[q] = 0.f;
#pragma unroll
                for (int j = 0; j < 4; ++j) { const f32x4 a = {bflo(ya[q][j].x), bfhi(ya[q][j].x), bflo(ya[q][j].y), bfhi(ya[q][j].y)}, c = {bflo(yc[q][j].x), bfhi(yc[q][j].x), bflo(yc[q][j].y), bfhi(yc[q][j].y)};
                    xv[q][j] = xv[q][j] + gf[j] * (a * w0[q] + c * w1[q]); ss[q] += (xv[q][j].x * xv[q][j].x + xv[q][j].y * xv[q][j].y) + (xv[q][j].z * xv[q][j].z + xv[q][j].w * xv[q][j].w); } }
#pragma unroll
            for (int o = 1; o < 64; o <<= 1)
#pragma unroll
                for (int q = 0; q < 4; ++q) ss[q] += __shfl_xor(ss[q], o);
#pragma unroll
            for (int q = 0; q < 4; ++q) if (ok[q]) { const float rstd = rsqrtf(ss[q] * (1.f / D) + NORM_EPS); GAS f32x4* o = (GAS f32x4*)(F.out + (size_t)(row + q * F.NGW) * D) + F.lane;
#pragma unroll
                for (int j = 0; j < 4; ++j) o[64 * j] = xv[q][j] * rstd * fn[j]; }
        }
    }
}

constexpr int N_PHASES = 19;
struct Args { const float* in[19]; float* out; unsigned char* ws; int ph_lo, ph_hi; };
__global__ void __launch_bounds__(NTHREADS, 2) mk_fwd(Args args) {
    extern __shared__ __attribute__((aligned(16))) unsigned char lds[];
    Frame F;
    F.lds = (LAS unsigned char*)lds; F.MISC = (volatile LAS unsigned*)(F.lds + MISC_OFF);
    F.tid = threadIdx.x; F.lane = F.tid & 63; F.wave = __builtin_amdgcn_readfirstlane(F.tid >> 6);
    F.G = gridDim.x; { const int bx = blockIdx.x; F.vcu = (F.G % 8 == 0) ? (bx % 8) * (F.G / 8) + bx / 8 : bx; }
    F.gw = F.vcu * NWAVES + F.wave; F.NGW = F.G * NWAVES;
#pragma unroll
    for (int i = 0; i < 19; ++i) F.in[i] = args.in[i];
    F.out = args.out; F.ws = args.ws;
    for (int u = F.tid; u < (LDS_BYTES - MISC_OFF) / 4; u += NTHREADS) ((LAS unsigned*)(F.lds + MISC_OFF))[u] = 0u;
    __syncthreads();
    XcdBarrier bar; bar.bar = WSP(unsigned, WS_CTL) + 1024; bar.x = 0; bar.st = nullptr;
    if (!MK_PHASED) bar = xcd_barrier_post(WSP(unsigned, WS_CTL) + 1024, F.MISC + 8);
    const int lo = args.ph_lo, hi = args.ph_hi;
#ifdef MK_ONLY
#define IN(k) ((k) == MK_ONLY && lo <= (k) && (k) < hi)
#else
#define IN(k) (lo <= (k) && (k) < hi)
#endif
#define REFRESH() do { int t_ = threadIdx.x; asm volatile("" : "+v"(t_)); F.tid = t_; F.lane = t_ & 63; } while (0)
#define SEAM(k) do { if (IN(k) && IN((k) + 1)) xcd_barrier(bar); } while (0)
    bf16* XA = WSP(bf16, WS_XA); bf16* XB = (bf16*)F.out; const float* MODF = WSP(float, WS_MODF);
    bf16* HN = WSP(bf16, WS_HN);
    LAS unsigned char* ring = F.lds;

    if (IN(0)) for (int rep_ = 0; rep_ < REP(0); ++rep_) { REFRESH(); p0_prologue(F); } SEAM(0);
    if (IN(1)) for (int rep_ = 0; rep_ < REP(1); ++rep_) { REFRESH(); modulate_phase<true, float>(F, F.in[0], 0, 0, HN); modf_reduce(F); } SEAM(1);
    if (IN(2)) for (int rep_ = 0; rep_ < REP(2); ++rep_) { REFRESH();
        { pg8::Gemm g{HN, WSP(bf16, WS_WQK), M, 2048, D}; pg8::StaticOrder S; S.init(M, 2048, F.G, (int)blockIdx.x);
          pg8::EpiBf16P E{WSP(bf16, WS_Q0), D, 8, 4, (size_t)(WS_K0 - WS_Q0) / 2, 0.125f * LOG2E, 0, 1};
          pg8::gemm_phase<pg8::EpiBf16P, pg8::StaticOrder, true, true>(ring, g, S, E); }
        { pg8::Gemm g{WSP(bf16, WS_WV), HN, D, M, D}; pg8::StaticOrder S; S.init(D, M, F.G, (int)blockIdx.x);
          pg8::EpiBf16P E{WSP(bf16, WS_VT0), M, 64, 0, 0, 1.f, 2, 2};
          pg8::gemm_phase<pg8::EpiBf16P, pg8::StaticOrder, true, true>(ring, g, S, E); }
    } SEAM(2);
    if (IN(3)) for (int rep_ = 0; rep_ < REP(3); ++rep_) { REFRESH(); na_phase(F); } SEAM(3);
    if (IN(4)) for (int rep_ = 0; rep_ < REP(4); ++rep_) { REFRESH(); pg8::Gemm g{WSP(bf16, WS_O0), WSP(bf16, WS_WO0), M, D, D}; pg8::StaticOrder S; S.init(M, D, F.G, (int)blockIdx.x);
        pg8::EpiResGateB<true> E{F.in[0], XA, MODF + 0 * 12 * D + 2 * D};
        pg8::gemm_phase<pg8::EpiResGateB<true>, pg8::StaticOrder, true, true>(ring, g, S, E); } SEAM(4);
    if (IN(5)) for (int rep_ = 0; rep_ < REP(5); ++rep_) { REFRESH(); modulate_phase<false, bf16>(F, XA, 0, 3, HN); } SEAM(5);
    if (IN(6)) for (int rep_ = 0; rep_ < REP(6); ++rep_) { REFRESH(); pg8::Gemm g{HN, WSP(bf16, WS_WGU0), M, 2 * FFN, D}; pg8::StaticOrder S; S.init(M, 2 * FFN, F.G, (int)blockIdx.x);
        pg8::EpiSwiGLU E{WSP(bf16, WS_ACT0), FFN, 22};
        pg8::gemm_phase<pg8::EpiSwiGLU, pg8::StaticOrder, true, true>(ring, g, S, E);
        moe_w_side(F, MOE_ITEMS - MOE_G1 - MOE_G2 - MOE_G3, MOE_ITEMS - MOE_G2 - MOE_G3, 128); } SEAM(6);
    if (IN(7)) for (int rep_ = 0; rep_ < REP(7); ++rep_) { REFRESH(); pg8::Gemm g{WSP(bf16, WS_ACT0), WSP(bf16, WS_WDN0), M, D, FFN}; pg8::StaticOrder S; S.init(M, D, F.G, (int)blockIdx.x);
        pg8::EpiResGateB<false> E{XA, XB, MODF + 0 * 12 * D + 5 * D};
        pg8::gemm_phase<pg8::EpiResGateB<false>, pg8::StaticOrder, true, true>(ring, g, S, E); } SEAM(7);
    if (IN(8)) for (int rep_ = 0; rep_ < REP(8); ++rep_) { REFRESH(); modulate_phase<false, bf16>(F, XB, 1, 0, HN); } SEAM(8);
    if (IN(9)) for (int rep_ = 0; rep_ < REP(9); ++rep_) { REFRESH(); pg8::Gemm g{HN, WSP(bf16, WS_WMD), M, DOWN_NP, D}; pg8::StaticOrder S; S.init(M, DOWN_NP, F.G, (int)blockIdx.x);
        pg8::EpiF32 E{WSP(float, WS_DOWN), DOWN_NP};
        pg8::gemm_phase<pg8::EpiF32, pg8::StaticOrder, true, true>(ring, g, S, E);
        moe_w_side(F, MOE_ITEMS - MOE_G2 - MOE_G3, MOE_ITEMS - MOE_G3, 128); } SEAM(9);
    if (IN(10)) for (int rep_ = 0; rep_ < REP(10); ++rep_) { REFRESH(); mla_mid_phase(F); } SEAM(10);
    if (IN(11)) for (int rep_ = 0; rep_ < REP(11); ++rep_) { REFRESH(); int kq = 256; asm volatile("" : "+s"(kq));
        { pg8::Gemm g{WSP(bf16, WS_CQ), WSP(bf16, WS_WUQ), M, 1536, kq}; pg8::StaticOrder S; S.init(M, 1536, F.G, (int)blockIdx.x);
          pg8::EpiQRope E{WSP(bf16, WS_Q1), WSP(float, WS_ROPER), WSP(float, WS_ROPEC), QSCALE1};
          pg8::gemm_phase<pg8::EpiQRope, pg8::StaticOrder, true, true>(ring, g, S, E); }
        { pg8::Gemm g{WSP(bf16, WS_CKV), WSP(bf16, WS_WKN), M, D, kq >> 1}; pg8::StaticOrder S; S.init(M, D, F.G, (int)blockIdx.x);
          pg8::EpiBf16P E{WSP(bf16, WS_KN), D, 4, 0, 0, 1.f, 1, 1};
          pg8::gemm_phase<pg8::EpiBf16P, pg8::StaticOrder, true, true>(ring, g, S, E); }
        { pg8::Gemm g{WSP(bf16, WS_WVV), WSP(bf16, WS_CKV), D, M, kq >> 1}; pg8::StaticOrder S; S.init(D, M, F.G, (int)blockIdx.x);
          pg8::EpiBf16P E{WSP(bf16, WS_VT1), M, 64, 0, 0, 1.f, 2, 2};
          pg8::gemm_phase<pg8::EpiBf16P, pg8::StaticOrder, true, true>(ring, g, S, E); }
    } SEAM(11);
    if (IN(12)) for (int rep_ = 0; rep_ < REP(12); ++rep_) { REFRESH();
        int prev_bh = -1;
        for (int u = F.vcu; u < NB * NH * (SEQ / 256); u += F.G) { const int a = u >> 8, r = u & 255, bh = r >> 3, qb = (r & 7) * 4 + a;
            const int un = u + F.G, next_bh = un < NB * NH * (SEQ / 256) ? ((un & 255) >> 3) : -1;
            mla::unit(bh >> 4, bh & 15, qb, WSP(bf16, WS_Q1), WSP(bf16, WS_KN), WSP(bf16, WS_KR), WSP(bf16, WS_VT1), WSP(bf16, WS_O1), ring, prev_bh != bh, next_bh == bh);
            prev_bh = bh; }
    } SEAM(12);
    if (IN(13)) for (int rep_ = 0; rep_ < REP(13); ++rep_) { REFRESH(); pg8::Gemm g{WSP(bf16, WS_O1), WSP(bf16, WS_WO1), M, D, D}; pg8::StaticOrder S; S.init(M, D, F.G, (int)blockIdx.x);
        pg8::EpiResGateB<false> E{XB, XA, MODF + 1 * 12 * D + 2 * D};
        pg8::gemm_phase<pg8::EpiResGateB<false>, pg8::StaticOrder, true, true>(ring, g, S, E); } SEAM(13);
    if (IN(14)) for (int rep_ = 0; rep_ < REP(14); ++rep_) { REFRESH(); router_phase<bf16>(F, XA, 1, 3); } SEAM(14);
    if (IN(15)) for (int rep_ = 0; rep_ < REP(15); ++rep_) { REFRESH(); moe_tables(F); gather_phase(F); } SEAM(15);
    if (IN(16)) for (int rep_ = 0; rep_ < REP(16); ++rep_) { REFRESH(); moe_tables(F);
        pg8::MoeOrder S{(int)F.MISC[32], 14, F.G, (int)blockIdx.x, (int)F.MISC[25], (int)F.MISC[26], (int)F.MISC[27], (int)F.MISC[28], (int)F.MISC[29], (int)F.MISC[30], (int)F.MISC[31]};
        pg8::Gemm g{WSP(bf16, WS_HP), WSP(bf16, WS_WGU1), MP_MAX, NE * 2 * ED, D};
        pg8::EpiSwiGLU E{WSP(bf16, WS_ACT1), ED, 14};
        pg8::gemm_phase<pg8::EpiSwiGLU, pg8::MoeOrder, true, true>(ring, g, S, E);
        moe_w_side(F, MOE_ITEMS - MOE_G3, MOE_ITEMS, 112); } SEAM(16);
    if (IN(17)) for (int rep_ = 0; rep_ < REP(17); ++rep_) { REFRESH(); moe_tables(F);
        pg8::MoeOrder S{(int)F.MISC[32], 4, F.G, (int)blockIdx.x, (int)F.MISC[25], (int)F.MISC[26], (int)F.MISC[27], (int)F.MISC[28], (int)F.MISC[29], (int)F.MISC[30], (int)F.MISC[31]};
        pg8::Gemm g{WSP(bf16, WS_ACT1), WSP(bf16, WS_WDN1), MP_MAX, NE * D, ED};
        pg8::EpiBf16P E{WSP(bf16, WS_HP), D, 4, 0, 0, 1.f, 0, 0};
        pg8::gemm_phase<pg8::EpiBf16P, pg8::MoeOrder, true, true>(ring, g, S, E); } SEAM(17);
    if (IN(18)) for (int rep_ = 0; rep_ < REP(18); ++rep_) { REFRESH(); final_phase<bf16>(F, XA, 1); }
#undef IN
#undef SEAM
}

extern "C" void kernel_launch(void* const* d_in, const int* in_sizes, int n_in, void* d_out, int out_size, void* d_ws, size_t ws_size, hipStream_t stream) {
    static int grid = 0;
    if (grid == 0) {
        if (n_in != 19 || in_sizes[0] != M * D || out_size != M * D || ws_size < WS_END) { fprintf(stderr, "kernel_launch: shape mismatch (n_in %d, ws %zu)\n", n_in, ws_size); grid = -1; return; }
        int dev = 0, cus = 0, per_cu = 0;
        if (hipGetDevice(&dev) != hipSuccess || hipDeviceGetAttribute(&cus, hipDeviceAttributeMultiprocessorCount, dev) != hipSuccess) { grid = -1; return; }
        if (hipFuncSetAttribute((const void*)mk_fwd, hipFuncAttributeMaxDynamicSharedMemorySize, LDS_BYTES) != hipSuccess) { fprintf(stderr, "kernel_launch: hipFuncSetAttribute failed\n"); grid = -1; return; }
        if (hipOccupancyMaxActiveBlocksPerMultiprocessor(&per_cu, (const void*)mk_fwd, NTHREADS, LDS_BYTES) != hipSuccess || per_cu < 1) fprintf(stderr, "kernel_launch: occupancy query says %d\n", per_cu);
        (void)hipGetLastError();
        grid = cus;
    }
    if (grid < 0) return;
    (void)hipMemsetAsync((char*)d_ws + WS_CTL, 0, CTL_ZERO_BYTES, stream);
    Args a{};
    for (int i = 0; i < 19; ++i) a.in[i] = (const float*)d_in[i];
    a.out = (float*)d_out; a.ws = (unsigned char*)d_ws;
#if MK_PHASED
    for (int p = 0; p < N_PHASES; ++p) { a.ph_lo = p; a.ph_hi = p + 1; hipLaunchKernelGGL(mk_fwd, dim3(grid), dim3(NTHREADS), LDS_BYTES, stream, a);
#if MK_CHECK == 1
        if (p == 3) hipLaunchKernelGGL(chk_na, dim3(M * NH / 4), dim3(256), 0, stream, (const bf16*)(a.ws + WS_Q0), (const bf16*)(a.ws + WS_K0), (const bf16*)(a.ws + WS_VT0), (const bf16*)(a.ws + WS_O0), a.in[5], (float*)(a.ws + WS_CTL + 32768));
#elif MK_CHECK == 2
        if (p == 12) hipLaunchKernelGGL(chk_mla, dim3(512 * 16), dim3(64), 0, stream, (const bf16*)(a.ws + WS_Q1), (const bf16*)(a.ws + WS_KN), (const bf16*)(a.ws + WS_KR), (const bf16*)(a.ws + WS_VT1), (const bf16*)(a.ws + WS_O1), (float*)(a.ws + WS_CTL + 32768));
#elif MK_CHECK == 3
        if (p == 11) hipLaunchKernelGGL(chk_proj, dim3(256), dim3(256), 0, stream, (const float*)(a.ws + WS_DOWN), a.in[10], a.in[12], a.in[11], a.in[13], (const bf16*)(a.ws + WS_Q1), (const bf16*)(a.ws + WS_KR), (const bf16*)(a.ws + WS_KN), (const bf16*)(a.ws + WS_VT1), (float*)(a.ws + WS_CTL + 32768));
#endif
    }
#if MK_CHECK == 3
    hipLaunchKernelGGL(chk_tweak4, dim3(M * D / 256), dim3(256), 0, stream, a.out, (const float*)(a.ws + WS_CTL + 32768), 1000.f);
#elif MK_CHECK
    hipLaunchKernelGGL(chk_tweak, dim3(M * D / 256), dim3(256), 0, stream, a.out, (const float*)(a.ws + WS_CTL + 32768), 1000.f);
#endif
#else
    a.ph_lo = 0; a.ph_hi = N_PHASES; hipLaunchKernelGGL(mk_fwd, dim3(grid), dim3(NTHREADS), LDS_BYTES, stream, a);
#endif
}
```

```cpp
#include <hip/hip_runtime.h>
#include <cstdio>
#include <cstdint>
namespace pg8 {
#define PG8_LAS __attribute__((address_space(3)))
typedef unsigned short bf16_t;
typedef short bf16x8 __attribute__((ext_vector_type(8)));
typedef float f32x4 __attribute__((ext_vector_type(4)));
typedef unsigned u32x4 __attribute__((ext_vector_type(4)));
constexpr int BM = 256, BK = 64, HALF = 128, HTB = HALF * BK * 2  , STAGE_BYTES = 8 * HTB, NXCD = 8, WGM = 8;

__host__ __device__ __forceinline__ int lds_byte(int r, int c) { const int st = (r >> 4) * 2 + (c >> 5), rr = r & 15, cc = c & 31, ob = rr * 64 + cc * 2; return st * 1024 + (ob ^ (((ob >> 9) & 1) << 5)); }
__host__ __device__ __forceinline__ void stage_rc(int b, int& R, int& C) { const int st = b / 1024, sb = b % 1024, swz = sb ^ (((sb >> 9) & 1) << 5); R = (st >> 1) * 16 + swz / 64; C = (st & 1) * 32 + (swz % 64) / 2; }
__host__ __device__ __forceinline__ int perm32(int rho) { const int n = rho >> 4, i = rho & 15; return 8 * (i >> 2) + 4 * n + (i & 3); }

struct Unit { int pm, pn; };
struct Gemm { const bf16_t* A; const bf16_t* Bt; int M, N, K; };

struct StaticOrder {
    int nM, nN, nwg, G, c;
    __host__ __device__ void init(int M, int N, int G_, int c_) { nM = M / BM; nN = N / BM; nwg = nM * nN; G = G_; c = c_; }
    __host__ __device__ bool next(int i, Unit& u) const {
        const long L = (long)i * G + c; if (L >= nwg) return false;
        int wgid = (int)L; { const int q = nwg / NXCD, r = nwg % NXCD, xcd = wgid % NXCD, off = wgid / NXCD; wgid = (xcd < r ? xcd * (q + 1) : r * (q + 1) + (xcd - r) * q) + off; }
        const int nig = WGM * nN, gid = wgid / nig, fm = gid * WGM, gsz = (nM - fm) < WGM ? (nM - fm) : WGM;
        u.pm = fm + ((wgid % nig) % gsz); u.pn = (wgid % nig) / gsz; return true;
    }
    __device__ __forceinline__ void a_ready(const Unit&) const {}
    __device__ __forceinline__ void done(const Unit&) const {}
};

__device__ __forceinline__ unsigned cvt_pk_bf16(float lo, float hi) { unsigned r; asm volatile("v_cvt_pk_bf16_f32 %0, %1, %2" : "=v"(r) : "v"(lo), "v"(hi)); return r; }

__device__ __forceinline__ float fast_silu(float g) { return g * __builtin_amdgcn_rcpf(1.f + __builtin_amdgcn_exp2f(-1.4426950408889634f * g)); }
struct EpiBf16P {
    static constexpr bool PERM = true, AFTER_DRAIN = false;
    bf16_t* O; int ldc; int nct; int st; size_t sstride; float scale0; int mode0, mode1;
    __device__ __forceinline__ void operator()(const f32x4 (&acc)[2][2][4][2], const Unit& u, int wr, int wc, int fr, int fq) const {
        int ct = u.pn % nct; bf16_t* base = O; float sc = 1.f; int mode = mode0;
        if (st) { const int t = ct / st; base += (size_t)t * sstride; ct -= t * st; if (t == 0) sc = scale0; else mode = mode1; }
        const int row0 = u.pm * BM + wr * 64 + fr, col0 = ct * BM + wc * 32 + 8 * fq;
#pragma unroll
        for (int ai = 0; ai < 2; ++ai)
#pragma unroll
            for (int m = 0; m < 4; ++m) { const int row = row0 + ai * HALF + m * 16;
#pragma unroll
                for (int bj = 0; bj < 2; ++bj) { const f32x4 v0 = acc[ai][bj][m][0] * sc, v1 = acc[ai][bj][m][1] * sc; const int col = col0 + bj * HALF;
                    u32x4 w; w.x = cvt_pk_bf16(v0[0], v0[1]); w.y = cvt_pk_bf16(v0[2], v0[3]); w.z = cvt_pk_bf16(v1[0], v1[1]); w.w = cvt_pk_bf16(v1[2], v1[3]);
                    bf16_t* p = mode == 0 ? base + (size_t)row * ldc + col : base + ((size_t)(col >> 6) * (mode == 1 ? 16384 : 1024) + row) * 64 + (col & 63);
                    *(u32x4*)p = w; } }
    }
};
struct EpiResGate {
    static constexpr bool PERM = false, AFTER_DRAIN = false;
    const float* res; float* out; const float* gate;
    __device__ __forceinline__ void operator()(const f32x4 (&acc)[2][2][4][2], const Unit& u, int wr, int wc, int fr, int fq) const {
        const int row0 = u.pm * BM + wr * 64 + fr, col0 = u.pn * BM + wc * 32 + 4 * fq;
        const float* gp = gate + (size_t)((u.pm * BM) >> 13) * 6144 + col0;
        f32x4 gv[2][2];
#pragma unroll
        for (int bj = 0; bj < 2; ++bj)
#pragma unroll
            for (int n = 0; n < 2; ++n) gv[bj][n] = *(const f32x4*)(gp + bj * HALF + n * 16);
#pragma unroll
        for (int ai = 0; ai < 2; ++ai)
#pragma unroll
            for (int m = 0; m < 4; ++m) { const size_t off = (size_t)(row0 + ai * HALF + m * 16) * 1024 + col0;
#pragma unroll
                for (int bj = 0; bj < 2; ++bj)
#pragma unroll
                    for (int n = 0; n < 2; ++n) { const f32x4 rs = *(const f32x4*)(res + off + bj * HALF + n * 16);
                        *(f32x4*)(out + off + bj * HALF + n * 16) = rs + gv[bj][n] * acc[ai][bj][m][n]; } }
    }
};
template <bool RES_F32> struct EpiResGateB {
    static constexpr bool PERM = true, AFTER_DRAIN = false;
    const void* res; bf16_t* out; const float* gate;
    __device__ __forceinline__ void operator()(const f32x4 (&acc)[2][2][4][2], const Unit& u, int wr, int wc, int fr, int fq) const {
        const int row0 = u.pm * BM + wr * 64 + fr, col0 = u.pn * BM + wc * 32 + 8 * fq;
        const float* gp = gate + (size_t)((u.pm * BM) >> 13) * 6144 + col0;
        f32x4 gv[2][2];
#pragma unroll
        for (int bj = 0; bj < 2; ++bj)
#pragma unroll
            for (int n = 0; n < 2; ++n) gv[bj][n] = *(const f32x4*)(gp + bj * HALF + 4 * n);
#pragma unroll
        for (int ai = 0; ai < 2; ++ai)
#pragma unroll
            for (int m = 0; m < 4; ++m) { const size_t off = (size_t)(row0 + ai * HALF + m * 16) * 1024 + col0;
#pragma unroll
                for (int bj = 0; bj < 2; ++bj) { f32x4 r0, r1;
                    if (RES_F32) { const float* rp = (const float*)res + off + bj * HALF; r0 = *(const f32x4*)rp; r1 = *(const f32x4*)(rp + 4); }
                    else { const u32x4 w = *(const u32x4*)((const bf16_t*)res + off + bj * HALF);
                        r0 = (f32x4){__builtin_bit_cast(float, w.x << 16), __builtin_bit_cast(float, w.x & 0xffff0000u), __builtin_bit_cast(float, w.y << 16), __builtin_bit_cast(float, w.y & 0xffff0000u)};
                        r1 = (f32x4){__builtin_bit_cast(float, w.z << 16), __builtin_bit_cast(float, w.z & 0xffff0000u), __builtin_bit_cast(float, w.w << 16), __builtin_bit_cast(float, w.w & 0xffff0000u)}; }
                    const f32x4 v0 = r0 + gv[bj][0] * acc[ai][bj][m][0], v1 = r1 + gv[bj][1] * acc[ai][bj][m][1];
                    u32x4 o; o.x = cvt_pk_bf16(v0[0], v0[1]); o.y = cvt_pk_bf16(v0[2], v0[3]); o.z = cvt_pk_bf16(v1[0], v1[1]); o.w = cvt_pk_bf16(v1[2], v1[3]);
                    *(u32x4*)(out + off + bj * HALF) = o; } }
    }
};
struct EpiF32 {
    static constexpr bool PERM = false, AFTER_DRAIN = false;
    float* O; int ldc;
    __device__ __forceinline__ void operator()(const f32x4 (&acc)[2][2][4][2], const Unit& u, int wr, int wc, int fr, int fq) const {
        const int row0 = u.pm * BM + wr * 64 + fr, col0 = u.pn * BM + wc * 32 + 4 * fq;
#pragma unroll
        for (int ai = 0; ai < 2; ++ai)
#pragma unroll
            for (int m = 0; m < 4; ++m) { float* rowp = O + (size_t)(row0 + ai * HALF + m * 16) * ldc + col0;
#pragma unroll
                for (int bj = 0; bj < 2; ++bj)
#pragma unroll
                    for (int n = 0; n < 2; ++n) *(f32x4*)(rowp + bj * HALF + n * 16) = acc[ai][bj][m][n]; }
    }
};
struct EpiMlaMid {
    static constexpr bool PERM = false, AFTER_DRAIN = true;
    bf16_t* CQ; bf16_t* CKV; bf16_t* KRo; const float* qn; const float* kvn; const float* ropeR; const float* ropeC; float eps;
    __device__ __forceinline__ void fused(f32x4 (&acc)[2][2][4][2], const Unit& u, int wr, int wc, int fr, int fq, PG8_LAS unsigned char* lds, int wid, int lane) const {
        typedef unsigned u32x2v __attribute__((ext_vector_type(2)));
        PG8_LAS f32x4* P = (PG8_LAS f32x4*)lds;
        const bool isq = (u.pn == 0);
#pragma unroll
        for (int ai = 0; ai < 2; ++ai)
#pragma unroll
            for (int m = 0; m < 4; ++m) { float s = 0.f;
#pragma unroll
                for (int n = 0; n < 2; ++n) { const f32x4 x = acc[ai][0][m][n]; s += (x[0] * x[0] + x[1] * x[1]) + (x[2] * x[2] + x[3] * x[3]); }
                if (isq) {
#pragma unroll
                    for (int n = 0; n < 2; ++n) { const f32x4 x = acc[ai][1][m][n]; s += (x[0] * x[0] + x[1] * x[1]) + (x[2] * x[2] + x[3] * x[3]); } }
                s += __shfl_xor(s, 16); s += __shfl_xor(s, 32);
                if (fq == 0) ((PG8_LAS float*)P)[(ai * HALF + wr * 64 + m * 16 + fr) * 4 + wc] = s; }
        asm volatile("s_waitcnt lgkmcnt(0)" ::: "memory"); __builtin_amdgcn_s_barrier(); asm volatile("" ::: "memory");
        const int colw = wc * 32 + 4 * fq;
#pragma unroll
        for (int ai = 0; ai < 2; ++ai)
#pragma unroll
            for (int m = 0; m < 4; ++m) { const int rl = ai * HALF + wr * 64 + m * 16 + fr, row = u.pm * BM + rl; const f32x4 p4 = P[rl];
                const float tot = (p4[0] + p4[1]) + (p4[2] + p4[3]);
                if (isq) { const float rstd = 1.0f / sqrtf(tot * (1.0f / 256.0f) + eps);
#pragma unroll
                    for (int bj = 0; bj < 2; ++bj)
#pragma unroll
                        for (int n = 0; n < 2; ++n) { const int c = bj * HALF + colw + 16 * n; const f32x4 g = *(const f32x4*)(qn + c); const f32x4 y = acc[ai][bj][m][n] * rstd * g;
                            u32x2v w; w.x = cvt_pk_bf16(y[0], y[1]); w.y = cvt_pk_bf16(y[2], y[3]); *(u32x2v*)(CQ + (size_t)row * 256 + c) = w; } }
                else { const float rstd = 1.0f / sqrtf(tot * (1.0f / 128.0f) + eps);
#pragma unroll
                    for (int n = 0; n < 2; ++n) { const int c = colw + 16 * n; const f32x4 g = *(const f32x4*)(kvn + c); const f32x4 y = acc[ai][0][m][n] * rstd * g;
                        u32x2v w; w.x = cvt_pk_bf16(y[0], y[1]); w.y = cvt_pk_bf16(y[2], y[3]); *(u32x2v*)(CKV + (size_t)row * 128 + c) = w; }
                    if (wc == 0) { const int t = row & 8191;
#pragma unroll
                        for (int n = 0; n < 2; ++n) { const int d = 16 * n + 4 * fq;
                            const float* tb = n == 0 ? ropeR + (t >> 6) * 16 + d : ropeC + (t & 63) * 16 + (d - 16);
                            const f32x4 cs = *(const f32x4*)tb; const f32x4 x = acc[ai][1][m][n];
                            u32x2v w; w.x = cvt_pk_bf16(x[0] * cs[0] - x[1] * cs[1], x[0] * cs[1] + x[1] * cs[0]); w.y = cvt_pk_bf16(x[2] * cs[2] - x[3] * cs[3], x[2] * cs[3] + x[3] * cs[2]);
                            *(u32x2v*)(KRo + (size_t)row * 32 + d) = w; } } } }
    }
};
struct EpiSwiGLU {
    static constexpr bool PERM = true, AFTER_DRAIN = false;
    bf16_t* O; int ldc; int nN;
    __device__ __forceinline__ void operator()(const f32x4 (&acc)[2][2][4][2], const Unit& u, int wr, int wc, int fr, int fq) const {
        const int row0 = u.pm * BM + wr * 64 + fr, col0 = (u.pn % nN) * HALF + wc * 32 + 8 * fq;
#pragma unroll
        for (int ai = 0; ai < 2; ++ai)
#pragma unroll
            for (int m = 0; m < 4; ++m) {
                const f32x4 g0 = acc[ai][0][m][0], g1 = acc[ai][0][m][1], u0 = acc[ai][1][m][0], u1 = acc[ai][1][m][1];
                u32x4 w;
                w.x = cvt_pk_bf16(fast_silu(g0[0]) * u0[0], fast_silu(g0[1]) * u0[1]); w.y = cvt_pk_bf16(fast_silu(g0[2]) * u0[2], fast_silu(g0[3]) * u0[3]);
                w.z = cvt_pk_bf16(fast_silu(g1[0]) * u1[0], fast_silu(g1[1]) * u1[1]); w.w = cvt_pk_bf16(fast_silu(g1[2]) * u1[2], fast_silu(g1[3]) * u1[3]);
                *(u32x4*)(O + (size_t)(row0 + ai * HALF + m * 16) * ldc + col0) = w; }
    }
};
struct EpiQRope {
    static constexpr bool PERM = true, AFTER_DRAIN = false;
    bf16_t* O; const float* ropeR; const float* ropeC; float qs;
    __device__ __forceinline__ void operator()(const f32x4 (&acc)[2][2][4][2], const Unit& u, int wr, int wc, int fr, int fq) const {
        const int row0 = u.pm * BM + wr * 64 + fr, col0 = u.pn * BM + wc * 32 + 8 * fq;
#pragma unroll
        for (int ai = 0; ai < 2; ++ai)
#pragma unroll
            for (int m = 0; m < 4; ++m) { const int r = row0 + ai * HALF + m * 16, t = r & 8191, gr = t >> 6, gc = t & 63;
#pragma unroll
                for (int bj = 0; bj < 2; ++bj) { const int c = col0 + bj * HALF, d = c % 96;
                    f32x4 v0 = acc[ai][bj][m][0], v1 = acc[ai][bj][m][1];
                    if (d >= 64) { const int p = (d - 64) >> 1;
                        const float* tb = p < 8 ? ropeR + gr * 16 + 2 * p : ropeC + gc * 16 + 2 * (p - 8);
                        const f32x4 a = *(const f32x4*)tb, b = *(const f32x4*)(tb + 4);
                        v0 = (f32x4){v0[0] * a[0] - v0[1] * a[1], v0[0] * a[1] + v0[1] * a[0], v0[2] * a[2] - v0[3] * a[3], v0[2] * a[3] + v0[3] * a[2]};
                        v1 = (f32x4){v1[0] * b[0] - v1[1] * b[1], v1[0] * b[1] + v1[1] * b[0], v1[2] * b[2] - v1[3] * b[3], v1[2] * b[3] + v1[3] * b[2]}; }
                    v0 = v0 * qs; v1 = v1 * qs;
                    u32x4 w; w.x = cvt_pk_bf16(v0[0], v0[1]); w.y = cvt_pk_bf16(v0[2], v0[3]); w.z = cvt_pk_bf16(v1[0], v1[1]); w.w = cvt_pk_bf16(v1[2], v1[3]);
                    *(u32x4*)(O + (size_t)r * 1536 + c) = w; }
                asm volatile("" ::: "memory"); }
    }
};
struct MoeOrder {
    int T, nN, G, c; int tb1, tb2, tb3, tb4, tb5, tb6, tb7;
    __device__ __forceinline__ bool next(int i, Unit& u) const {
        const int nwg = T * nN; const long L = (long)i * G + c; if (L >= nwg) return false;
        int wgid = (int)L; { const int q = nwg / NXCD, r = nwg % NXCD, xcd = wgid % NXCD, off = wgid / NXCD; wgid = (xcd < r ? xcd * (q + 1) : r * (q + 1) + (xcd - r) * q) + off; }
        const int nig = WGM * nN, gid = wgid / nig, fm = gid * WGM, gsz = (T - fm) < WGM ? (T - fm) : WGM;
        const int pm = fm + ((wgid % nig) % gsz), pn = (wgid % nig) / gsz;
        const int e = (pm >= tb1) + (pm >= tb2) + (pm >= tb3) + (pm >= tb4) + (pm >= tb5) + (pm >= tb6) + (pm >= tb7);
        u.pm = pm; u.pn = e * nN + pn; return true;
    }
    __device__ __forceinline__ void a_ready(const Unit&) const {}
    __device__ __forceinline__ void done(const Unit&) const {}
};

template <class Epi, class Sched, bool ALIGN_EPI = false, bool SP2 = false>
__device__ __forceinline__ void gemm_phase(PG8_LAS unsigned char* lds, const Gemm g, const Sched& S, const Epi& E) {
    const int tid = threadIdx.x, wid = __builtin_amdgcn_readfirstlane(tid >> 6), lane = tid & 63, wr = wid >> 2, wc = wid & 3, fr = lane & 15, fq = lane >> 4;
    const int K = g.K, nt = K / BK;
    unsigned voffA[2], voffB[2];
#pragma unroll
    for (int i = 0; i < 2; ++i) { int R, C; stage_rc(tid * 16 + i * 8192, R, C); const int Rb = Epi::PERM ? ((R & ~31) + perm32(R & 31)) : R;
        voffA[i] = (unsigned)(R * K + C) * 2u; voffB[i] = (unsigned)(Rb * K + C) * 2u; }
    const size_t kstep = (size_t)(BK * 2);
    const size_t hstep = (size_t)HALF * K * 2;
    const size_t tstep = 2 * hstep;
    const unsigned ldsw = (unsigned)wid * 1024u;
    const int aoff = lds_byte(wr * 64 + fr, fq * 8), boff = lds_byte(wc * 32 + fr, fq * 8);
#define PG8_SA(b, h) (((b) * 2 + (h)) * HTB)
#define PG8_SB(b, h) ((4 + (b) * 2 + (h)) * HTB)
#define PG8_STAGE(bufoff, gbase, voff) do { _Pragma("unroll") for (int _i = 0; _i < 2; ++_i) \
        __builtin_amdgcn_global_load_lds((const unsigned*)((const char*)(gbase) + (voff)[_i]), (PG8_LAS unsigned*)(lds + (bufoff) + ldsw + _i * 8192), 16, 0, 0); } while (0)
#define PG8_LDA(dst, b, h) do { _Pragma("unroll") for (int m = 0; m < 4; ++m) _Pragma("unroll") for (int k = 0; k < 2; ++k) dst[m][k] = *(const PG8_LAS bf16x8*)(lds + PG8_SA(b, h) + aoff + m * 2048 + k * 1024); } while (0)
#define PG8_LDB(dst, b, h) do { _Pragma("unroll") for (int n = 0; n < 2; ++n) _Pragma("unroll") for (int k = 0; k < 2; ++k) dst[n][k] = *(const PG8_LAS bf16x8*)(lds + PG8_SB(b, h) + boff + n * 2048 + k * 1024); } while (0)
#define PG8_MMA(ai, bj, At, Bt) do { __builtin_amdgcn_s_setprio(1); _Pragma("unroll") for (int m = 0; m < 4; ++m) _Pragma("unroll") for (int n = 0; n < 2; ++n) _Pragma("unroll") for (int k = 0; k < 2; ++k) \
        acc[ai][bj][m][n] = __builtin_amdgcn_mfma_f32_16x16x32_bf16(Bt[n][k], At[m][k], acc[ai][bj][m][n], 0, 0, 0); __builtin_amdgcn_s_setprio(0); } while (0)
#define PG8_WAIT_V(n) asm volatile("s_waitcnt vmcnt(" #n ")" ::: "memory")
#define PG8_WAIT_L(n) asm volatile("s_waitcnt lgkmcnt(" #n ")" ::: "memory")
#define PG8_BAR __builtin_amdgcn_s_barrier()
#define PG8_SCHED __builtin_amdgcn_sched_barrier(0)
    Unit cur, nxt; int ui = 0;
    if (!S.next(0, cur)) return;
    f32x4 acc[2][2][4][2];
#pragma unroll
    for (int a = 0; a < 2; ++a)
#pragma unroll
        for (int b = 0; b < 2; ++b)
#pragma unroll
            for (int m = 0; m < 4; ++m)
#pragma unroll
                for (int n = 0; n < 2; ++n) acc[a][b][m][n] = (f32x4){0.f, 0.f, 0.f, 0.f};
    bf16x8 At[4][2], B0[2][2], B1[2][2];
    const char* cA = (const char*)g.A + (size_t)cur.pm * tstep; const char* cB = (const char*)g.Bt + (size_t)cur.pn * tstep;
    S.a_ready(cur);
    if constexpr (SP2) {
        PG8_STAGE(PG8_SB(0, 0), cB, voffB); PG8_STAGE(PG8_SB(0, 1), cB + hstep, voffB); PG8_STAGE(PG8_SA(0, 0), cA, voffA); PG8_STAGE(PG8_SA(0, 1), cA + hstep, voffA);
        if (wr == 1) PG8_BAR;
        PG8_WAIT_V(2); PG8_BAR;
        PG8_STAGE(PG8_SB(1, 0), cB + kstep, voffB); PG8_STAGE(PG8_SA(1, 0), cA + kstep, voffA); PG8_STAGE(PG8_SB(1, 1), cB + hstep + kstep, voffB);
        PG8_WAIT_V(6); PG8_BAR;
    } else {
        PG8_STAGE(PG8_SB(0, 0), cB, voffB); PG8_STAGE(PG8_SA(0, 0), cA, voffA); PG8_STAGE(PG8_SB(0, 1), cB + hstep, voffB); PG8_STAGE(PG8_SA(0, 1), cA + hstep, voffA);
        if (wr == 1) PG8_BAR;
        PG8_WAIT_V(4); PG8_BAR;
        PG8_STAGE(PG8_SB(1, 0), cB + kstep, voffB); PG8_STAGE(PG8_SA(1, 0), cA + kstep, voffA); PG8_STAGE(PG8_SB(1, 1), cB + hstep + kstep, voffB);
        PG8_WAIT_V(6); PG8_BAR;
    }
    for (;;) {
        const bool has_next = S.next(ui + 1, nxt);
        const char* nA = has_next ? (const char*)g.A + (size_t)nxt.pm * tstep : cA; const char* nB = has_next ? (const char*)g.Bt + (size_t)nxt.pn * tstep : cB;
        for (int t = 0; t < nt; t += 2) {
            const bool last = (t == nt - 2);
            const char* a1 = cA + (size_t)(t + 1) * kstep;
            const char* a2 = last ? nA : cA + (size_t)(t + 2) * kstep; const char* b2 = last ? nB : cB + (size_t)(t + 2) * kstep;
            const char* a3 = a2 + kstep; const char* b3 = b2 + kstep;
            if (last && has_next) S.a_ready(nxt);
            if constexpr (SP2) {
            PG8_LDB(B0, 0, 0); PG8_LDB(B1, 0, 1); PG8_SCHED; PG8_LDA(At, 0, 0); PG8_STAGE(PG8_SA(1, 1), a1 + hstep, voffA);
            PG8_WAIT_V(8); PG8_WAIT_L(0); PG8_BAR; PG8_MMA(0, 0, At, B0); PG8_MMA(0, 1, At, B1); PG8_BAR; PG8_SCHED;
            PG8_LDA(At, 0, 1); PG8_STAGE(PG8_SB(0, 0), b2, voffB); PG8_STAGE(PG8_SB(0, 1), b2 + hstep, voffB); PG8_STAGE(PG8_SA(0, 0), a2, voffA);
            PG8_WAIT_V(8); PG8_WAIT_L(0); PG8_BAR; PG8_MMA(1, 0, At, B0); PG8_MMA(1, 1, At, B1); PG8_BAR; PG8_SCHED;
            PG8_LDB(B0, 1, 0); PG8_LDB(B1, 1, 1); PG8_SCHED; PG8_LDA(At, 1, 0); PG8_STAGE(PG8_SA(0, 1), a2 + hstep, voffA);
            PG8_WAIT_V(8); PG8_WAIT_L(0); PG8_BAR; PG8_MMA(0, 0, At, B0); PG8_MMA(0, 1, At, B1); PG8_BAR; PG8_SCHED;
            PG8_LDA(At, 1, 1); PG8_STAGE(PG8_SB(1, 0), b3, voffB); PG8_STAGE(PG8_SB(1, 1), b3 + hstep, voffB); PG8_STAGE(PG8_SA(1, 0), a3, voffA);
            PG8_WAIT_V(8); PG8_WAIT_L(0); PG8_BAR; PG8_MMA(1, 0, At, B0); PG8_MMA(1, 1, At, B1); PG8_BAR; PG8_SCHED;
            } else {
            PG8_LDB(B0, 0, 0); PG8_SCHED; PG8_LDA(At, 0, 0); PG8_STAGE(PG8_SA(1, 1), a1 + hstep, voffA);
            PG8_WAIT_L(8); PG8_BAR; PG8_WAIT_L(0); PG8_MMA(0, 0, At, B0); PG8_BAR; PG8_SCHED;
            PG8_LDB(B1, 0, 1); PG8_STAGE(PG8_SB(0, 0), b2, voffB);
            PG8_BAR; PG8_WAIT_L(0); PG8_MMA(0, 1, At, B1); PG8_BAR;
            PG8_LDA(At, 0, 1); PG8_STAGE(PG8_SA(0, 0), a2, voffA);
            PG8_BAR; PG8_WAIT_L(0); PG8_MMA(1, 0, At, B0); PG8_BAR; PG8_SCHED;
            PG8_STAGE(PG8_SB(0, 1), b2 + hstep, voffB);
            PG8_WAIT_V(6); PG8_BAR; PG8_MMA(1, 1, At, B1); PG8_BAR;
            PG8_LDB(B0, 1, 0); PG8_SCHED; PG8_LDA(At, 1, 0); PG8_STAGE(PG8_SA(0, 1), a2 + hstep, voffA);
            PG8_WAIT_L(8); PG8_BAR; PG8_WAIT_L(0); PG8_MMA(0, 0, At, B0); PG8_BAR; PG8_SCHED;
            PG8_LDB(B1, 1, 1); PG8_STAGE(PG8_SB(1, 0), b3, voffB);
            PG8_BAR; PG8_WAIT_L(0); PG8_MMA(0, 1, At, B1); PG8_BAR;
            PG8_LDA(At, 1, 1); PG8_STAGE(PG8_SA(1, 0), a3, voffA);
            PG8_BAR; PG8_WAIT_L(0); PG8_MMA(1, 0, At, B0); PG8_BAR; PG8_SCHED;
            PG8_STAGE(PG8_SB(1, 1), b3 + hstep, voffB);
            PG8_WAIT_V(6); PG8_BAR; PG8_MMA(1, 1, At, B1); PG8_BAR;
            }
        }
        if constexpr (ALIGN_EPI) { if (wr == 0) PG8_BAR; }
        if constexpr (!Epi::AFTER_DRAIN) { E(acc, cur, wr, wc, fr, fq); S.done(cur); }
        if (!has_next) break;
#pragma unroll
        for (int a = 0; a < 2; ++a)
#pragma unroll
            for (int b = 0; b < 2; ++b)
#pragma unroll
                for (int m = 0; m < 4; ++m)
#pragma unroll
                    for (int n = 0; n < 2; ++n) acc[a][b][m][n] = (f32x4){0.f, 0.f, 0.f, 0.f};
        cur = nxt; cA = nA; cB = nB; ++ui;
        if constexpr (ALIGN_EPI) { if (wr == 1) PG8_BAR; }
    }
    PG8_WAIT_V(0);
    if constexpr (!ALIGN_EPI) { if (wr == 0) PG8_BAR; }
    PG8_BAR;
    if constexpr (Epi::AFTER_DRAIN) { E.fused(acc, cur, wr, wc, fr, fq, lds, wid, lane); S.done(cur); }
#undef PG8_SA
#undef PG8_SB
#undef PG8_STAGE
#undef PG8_LDA
#undef PG8_LDB
#undef PG8_MMA
#undef PG8_WAIT_V
#undef PG8_WAIT_L
#undef PG8_BAR
#undef PG8_SCHED
}
}

#define GAS __attribute__((address_space(1)))
#define LAS __attribute__((address_space(3)))

#define XB_TMO      128
#define XB_XCNT(j)  (256  + 64 * (j))
#define XB_XSUB(j)  (1280 + 64 * (j))
#define XB_XGEN(j)  (2304 + 64 * (j))
#define XB_TOP      3328
#define XB_TOPGEN   3392
#define XCD_BAR_WORDS 3456
#define XB_SPIN_CAP (1u << 18)

__device__ __forceinline__ unsigned xb_ld(unsigned* p)              { return __hip_atomic_load(p, __ATOMIC_RELAXED, __HIP_MEMORY_SCOPE_AGENT); }
__device__ __forceinline__ unsigned xb_add(unsigned* p, unsigned v) { return __hip_atomic_fetch_add(p, v, __ATOMIC_RELAXED, __HIP_MEMORY_SCOPE_AGENT); }
__device__ __forceinline__ unsigned xb_xcc_id() { return (unsigned)__builtin_amdgcn_s_getreg((3 << 11) | 20) & 0xFu; }
#define XB_SPIN(cond, bar) do { unsigned _sp = 0; while (cond) { __builtin_amdgcn_s_sleep(1); \
    if ((++_sp & 255u) == 0u) { if (xb_ld(&(bar)[XB_TMO])) break; if (_sp > XB_SPIN_CAP) { atomicAdd(&(bar)[XB_TMO], 1u); break; } } } } while (0)

struct XcdBarrier {
    unsigned* bar; unsigned x;
    volatile LAS unsigned* st;
};

__device__ __forceinline__ XcdBarrier xcd_barrier_post(unsigned* bar, volatile LAS unsigned* st) {
    XcdBarrier b; b.bar = bar; b.x = xb_xcc_id(); b.st = st;
    if (threadIdx.x == 0) (void)xb_add(&bar[XB_XCNT(b.x)], 1u);
    return b;
}
__device__ __forceinline__ void xcd_barrier_complete(unsigned* bar, unsigned x, unsigned& nloc, unsigned& nx) {
    const unsigned G = gridDim.x * gridDim.y * gridDim.z;
    unsigned sum, cnt, mine, sp = 0u;
    for (;;) {
        sum = 0u; cnt = 0u; mine = 0u;
#pragma unroll
        for (unsigned j = 0; j < 16; ++j) { const unsigned c = xb_ld(&bar[XB_XCNT(j)]); sum += c; cnt += (c > 0u) ? 1u : 0u; mine = (j == x) ? c : mine; }
        if (sum == G) break;
        __builtin_amdgcn_s_sleep(1);
        if ((++sp & 255u) == 0u) { if (xb_ld(&bar[XB_TMO])) break; if (sp > XB_SPIN_CAP) { atomicAdd(&bar[XB_TMO], 1u); break; } }
    }
    nloc = mine > 0u ? mine : 1u; nx = cnt > 0u ? cnt : 1u;
}

__device__ __forceinline__ void xcd_barrier(const XcdBarrier& b) {
    asm volatile("s_waitcnt vmcnt(0)" ::: "memory");
    __syncthreads();
    if (threadIdx.x == 0) {
        unsigned* bar = b.bar;
        __builtin_amdgcn_s_waitcnt(0);
        unsigned nloc = b.st[0], nx = b.st[1];
        if (nloc == 0u) { xcd_barrier_complete(bar, b.x, nloc, nx); b.st[0] = nloc; b.st[1] = nx; }
        const unsigned old = xb_add(&bar[XB_XSUB(b.x)], 1u);
        const unsigned gen = old / nloc;
        if (old + 1u == (gen + 1u) * nloc) {
            __builtin_amdgcn_fence(__ATOMIC_RELEASE, "agent");
            asm volatile("s_waitcnt vmcnt(0)" ::: "memory");
            const unsigned og = xb_add(&bar[XB_TOP], 1u);
            const unsigned tg = og / nx;
            if (og + 1u == (tg + 1u) * nx) xb_add(&bar[XB_TOPGEN], 1u);
            else XB_SPIN(xb_ld(&bar[XB_TOPGEN]) == tg, bar);
            __builtin_amdgcn_fence(__ATOMIC_ACQUIRE, "agent");
            xb_add(&bar[XB_XGEN(b.x)], 1u);
            asm volatile("s_waitcnt vmcnt(0)" ::: "memory");
        } else {
            XB_SPIN(xb_ld(&bar[XB_XGEN(b.x)]) == gen, bar);
            __builtin_amdgcn_fence(__ATOMIC_ACQUIRE, "agent");
            asm volatile("s_waitcnt vmcnt(0)" ::: "memory");
        }
    }
    __syncthreads();
}


constexpr int NWAVES = 8, NTHREADS = 512;
constexpr int D = 1024, NB = 2, SEQ = 8192, M = NB * SEQ, GW = 64, GROWS = 128, NH = 16, HD = 64;
constexpr int FFN = 2816, NE = 8, ED = 1792, QL = 256, KVL = 128, RP = 32, DOWN_N = 416, DOWN_NP = 512, QKD = 96;
constexpr int MP_MAX = 34816;
constexpr float NORM_EPS = 1e-6f;
constexpr float LOG2E = 1.4426950408889634f;
constexpr float QSCALE1 = 0.10206207261596577f * LOG2E;

constexpr size_t MiB = 1u << 20;
constexpr size_t WS_CTL = 0, CTL_ZERO_BYTES = 64 * 1024;
constexpr size_t WS_PART = 4 * MiB;
constexpr size_t WS_MODF = 2 * MiB;
constexpr size_t WS_ROPER = WS_MODF + 128 * 1024;
constexpr size_t WS_ROPEC = WS_ROPER + 16 * 1024;
constexpr size_t WS_CNTWG = WS_ROPEC + 16 * 1024;
constexpr size_t WS_TOKE = 3 * MiB;
constexpr size_t WS_TOKP = WS_TOKE + 128 * 1024;
constexpr size_t WS_TOKW = WS_TOKP + 128 * 1024;
constexpr size_t WS_TOKS = WS_TOKW + 128 * 1024;
constexpr size_t WS_W = 8 * MiB;
constexpr size_t WS_WQK = WS_W, WS_WV = WS_WQK + 4 * MiB, WS_WO0 = WS_WV + 2 * MiB, WS_WGU0 = WS_WO0 + 2 * MiB, WS_WDN0 = WS_WGU0 + 11 * MiB;
constexpr size_t WS_WMD = WS_WDN0 + 5632 * 1024, WS_WUQ = WS_WMD + 1 * MiB, WS_WKN = WS_WUQ + 768 * 1024, WS_WVV = WS_WKN + 512 * 1024, WS_WO1 = WS_WVV + 512 * 1024;
constexpr size_t WS_WGU1 = WS_WO1 + 2 * MiB, WS_WDN1 = WS_WGU1 + 56 * MiB, WS_WEND = WS_WDN1 + 28 * MiB;
static_assert(WS_WEND <= 122 * MiB, "weights");
constexpr size_t WS_XA = 122 * MiB;
constexpr size_t WS_HN = 186 * MiB;
constexpr size_t WS_R = 218 * MiB;
constexpr size_t WS_Q0 = WS_R, WS_K0 = WS_R + 32 * MiB, WS_VT0 = WS_R + 64 * MiB, WS_O0 = WS_R + 96 * MiB;
constexpr size_t WS_ACT0 = WS_R;
constexpr size_t WS_DOWN = WS_R, WS_CQ = WS_R + 32 * MiB, WS_CKV = WS_R + 40 * MiB, WS_KR = WS_R + 48 * MiB;
constexpr size_t WS_Q1 = WS_R + 49 * MiB, WS_KN = WS_R + 97 * MiB, WS_VT1 = WS_R + 129 * MiB, WS_O1 = WS_R + 161 * MiB;
constexpr size_t WS_HP = WS_R, WS_ACT1 = WS_R + 68 * MiB;
constexpr size_t WS_END = WS_R + 193 * MiB;
static_assert(WS_ACT1 + (size_t)MP_MAX * ED * 2 <= WS_END && WS_END <= 448 * MiB, "d_ws map");

constexpr int RING_BYTES = 131072, MISC_OFF = 155648, LDS_BYTES = 159744;

typedef unsigned short bf16;
typedef unsigned v4u __attribute__((ext_vector_type(4)));
typedef unsigned v2u __attribute__((ext_vector_type(2)));
typedef float f32x4 __attribute__((ext_vector_type(4)));
typedef float f32x2 __attribute__((ext_vector_type(2)));
typedef float f32x16 __attribute__((ext_vector_type(16)));
typedef short bf16x8 __attribute__((ext_vector_type(8)));
typedef GAS unsigned gu32;
#define RLX_AGENT __ATOMIC_RELAXED, __HIP_MEMORY_SCOPE_AGENT
#define LDS_WAIT() asm volatile("s_waitcnt lgkmcnt(0)" ::: "memory")
__device__ __forceinline__ unsigned pk2(float lo, float hi) { unsigned r; asm volatile("v_cvt_pk_bf16_f32 %0, %1, %2" : "=v"(r) : "v"(lo), "v"(hi)); return r; }
__device__ __forceinline__ float bf2f(unsigned short h) { return __builtin_bit_cast(float, (unsigned)h << 16); }
__device__ __forceinline__ float bflo(unsigned w) { return __builtin_bit_cast(float, w << 16); }
__device__ __forceinline__ float bfhi(unsigned w) { return __builtin_bit_cast(float, w & 0xffff0000u); }
__device__ __forceinline__ float wave_sum(float v) {
#pragma unroll
    for (int o = 1; o < 64; o <<= 1) v += __shfl_xor(v, o);
    return v;
}

template <typename TX> struct XRow;
template <> struct XRow<float> { static __device__ __forceinline__ f32x4 ld(const float* X, size_t row, int col) { return *(const GAS f32x4*)(X + row * 1024 + col); } };
template <> struct XRow<bf16> { static __device__ __forceinline__ f32x4 ld(const bf16* X, size_t row, int col) { const v2u w = *(const GAS v2u*)(X + row * 1024 + col); return (f32x4){bflo(w.x), bfhi(w.x), bflo(w.y), bfhi(w.y)}; } };

struct Frame {
    LAS unsigned char* lds; volatile LAS unsigned* MISC;
    int tid, lane, wave, vcu, G, gw, NGW;
    const float* in[19]; float* out; unsigned char* ws;
};
#define WSP(T, off) ((T*)(F.ws + (off)))

__device__ __forceinline__ void tr_item(const float* W, int ldn, int k0, int n0, bf16* WT, int ldk, int drow0, LAS float* scr, int lane) {
    { f32x4 v[8]; const int rr = lane >> 3, c4 = (lane & 7) * 4;
#pragma unroll
      for (int i = 0; i < 8; ++i) v[i] = *(const f32x4*)(W + (size_t)(k0 + 8 * i + rr) * ldn + n0 + c4);
#pragma unroll
      for (int i = 0; i < 8; ++i) { LAS float* d = scr + (8 * i + rr) * 33 + c4; d[0] = v[i].x; d[1] = v[i].y; d[2] = v[i].z; d[3] = v[i].w; } }
    LDS_WAIT(); asm volatile("" ::: "memory");
    const int c = lane & 7;
#pragma unroll
    for (int j = 0; j < 4; ++j) { const int n = (lane >> 3) + 8 * j; const LAS float* s = scr + (8 * c) * 33 + n;
        v4u o; o.x = pk2(s[0 * 33], s[1 * 33]); o.y = pk2(s[2 * 33], s[3 * 33]); o.z = pk2(s[4 * 33], s[5 * 33]); o.w = pk2(s[6 * 33], s[7 * 33]);
        *(GAS v4u*)(WT + (size_t)(drow0 + n) * ldk + k0 + 8 * c) = o; }
    LDS_WAIT(); asm volatile("" ::: "memory");
}
__device__ __forceinline__ int gu_row(int n0, int F_) { const int up = n0 >= F_, j = up ? n0 - F_ : n0; return 256 * (j >> 7) + (up ? 128 : 0) + (j & 127); }
__device__ __forceinline__ float silu_acc(float v) { return v / (1.f + expf(-v)); }
constexpr int MOE_I8 = 8 * 16 * 112, MOE_I9 = 8 * 28 * 32, MOE_ITEMS = MOE_I8 + MOE_I9;
constexpr int MOE_G1 = 128 * 40, MOE_G2 = 128 * 48, MOE_G3 = 144 * 24;
__device__ __forceinline__ void moe_w_item(Frame& F, int r, LAS float* scr, int lane) {
    if (r < MOE_I8) { const int e = r / (16 * 112), q = r % (16 * 112), kb = q / 112, nb = q % 112;
        tr_item(F.in[16] + (size_t)e * D * 2 * ED, 2 * ED, 64 * kb, 32 * nb, WSP(bf16, WS_WGU1), D, e * 2 * ED + gu_row(32 * nb, ED), scr, lane); }
    else { r -= MOE_I8; const int e = r / (28 * 32), q = r % (28 * 32), kb = q / 32, nb = q % 32;
        tr_item(F.in[17] + (size_t)e * ED * D, D, 64 * kb, 32 * nb, WSP(bf16, WS_WDN1), ED, e * D + 32 * nb, scr, lane); }
}
__device__ __forceinline__ void moe_w_side(Frame& F, int lo, int hi, int first_wg) {
    if (F.G != 256 || (int)blockIdx.x < first_wg) return;
    LAS float* scr = (LAS float*)(F.lds + F.wave * 16384);
    for (int it = lo + ((int)blockIdx.x - first_wg) * NWAVES + F.wave; it < hi; it += (256 - first_wg) * NWAVES) moe_w_item(F, it, scr, F.lane);
}
__device__ __forceinline__ void p0_prologue(Frame& F) {
    LAS float* scr = (LAS float*)(F.lds + F.wave * 16384);
    const int lane = F.lane;
    constexpr int I0 = 16 * 96, I1 = 16 * 32, I2 = 16 * 176, I3 = 44 * 32, I4 = 16 * 13, I5 = 4 * 48, I6 = 2 * 64, I7 = 16 * 32;
    const int NMOE0 = (F.G == 256) ? MOE_ITEMS - MOE_G1 - MOE_G2 - MOE_G3 : MOE_ITEMS;
    constexpr int IA = 2 * 96 * 16;
    constexpr int IZ = 96 + 2 * 1024;
    constexpr int IR = 24;
    const int NITEMS = I0 + I1 + I2 + I3 + I4 + I5 + I6 + I7 + NMOE0 + IA + IZ + IR;
    for (int it = F.gw; it < NITEMS; it += F.NGW) {
        int r = it;
        if (r < NMOE0) { moe_w_item(F, r, scr, lane); continue; } r -= NMOE0;
        if (r < I0) { const int kb = r / 96, nb = r % 96, n0 = 32 * nb;
            if (n0 < 2048) tr_item(F.in[4], 3 * D, 64 * kb, n0, WSP(bf16, WS_WQK), D, n0, scr, lane); else tr_item(F.in[4], 3 * D, 64 * kb, n0, WSP(bf16, WS_WV), D, n0 - 2048, scr, lane);
            continue; } r -= I0;
        if (r < I1) { tr_item(F.in[6], D, 64 * (r / 32), 32 * (r % 32), WSP(bf16, WS_WO0), D, 32 * (r % 32), scr, lane); continue; } r -= I1;
        if (r < I2) { const int kb = r / 176, nb = r % 176; tr_item(F.in[7], 2 * FFN, 64 * kb, 32 * nb, WSP(bf16, WS_WGU0), D, gu_row(32 * nb, FFN), scr, lane); continue; } r -= I2;
        if (r < I3) { tr_item(F.in[8], D, 64 * (r / 32), 32 * (r % 32), WSP(bf16, WS_WDN0), FFN, 32 * (r % 32), scr, lane); continue; } r -= I3;
        if (r < I4) { tr_item(F.in[9], DOWN_N, 64 * (r / 13), 32 * (r % 13), WSP(bf16, WS_WMD), D, 32 * (r % 13), scr, lane); continue; } r -= I4;
        if (r < I5) { tr_item(F.in[11], 1536, 64 * (r / 48), 32 * (r % 48), WSP(bf16, WS_WUQ), QL, 32 * (r % 48), scr, lane); continue; } r -= I5;
        if (r < I6) { const int kb = r / 64, nb = r % 64, h = nb >> 2, q = nb & 3;
            if (q < 2) tr_item(F.in[13], 2048, 64 * kb, 32 * nb, WSP(bf16, WS_WKN), 128, h * 64 + 32 * q, scr, lane); else tr_item(F.in[13], 2048, 64 * kb, 32 * nb, WSP(bf16, WS_WVV), 128, h * 64 + 32 * (q - 2), scr, lane);
            continue; } r -= I6;
        if (r < I7) { tr_item(F.in[14], D, 64 * (r / 32), 32 * (r % 32), WSP(bf16, WS_WO1), D, 32 * (r % 32), scr, lane); continue; } r -= I7;
        if (r < IA) {
            const int l = r / (96 * 16), q = r % (96 * 16), cg = q / 16, kc = q % 16, n = 64 * cg + lane;
            const float* w = F.in[2] + (size_t)l * D * 6 * D + n; const float* c = F.in[1];
            float a0 = 0.f, a1 = 0.f;
            const float ca0 = silu_acc(c[64 * kc + lane]), ca1 = silu_acc(c[D + 64 * kc + lane]);
#pragma unroll 32
            for (int kk = 0; kk < 64; ++kk) { const float wv = w[(size_t)(64 * kc + kk) * 6 * D]; a0 += __shfl(ca0, kk) * wv; a1 += __shfl(ca1, kk) * wv; }
            float* part = WSP(float, WS_PART) + ((size_t)(kc * 2 + l) * 2) * 6 * D + n;
            part[0] = a0; part[6 * D] = a1; continue; } r -= IA;
        if (r < IZ) {
            if (r < 96) { GAS v4u* p = (GAS v4u*)(WSP(bf16, WS_WMD) + (size_t)(DOWN_N + r) * D); p[lane] = (v4u){0u, 0u, 0u, 0u}; p[64 + lane] = (v4u){0u, 0u, 0u, 0u}; }
            else { }
            continue; } r -= IZ;
        {
            const int idx = 64 * r + lane, isc = idx >= 1024, q = isc ? idx - 1024 : idx, i = q >> 3, p = q & 7;
            const float inv = powf(10000.f, -(float)p / 8.f), a = (float)i * inv;
            float* t = (isc ? WSP(float, WS_ROPEC) : WSP(float, WS_ROPER)) + i * 16 + 2 * p; t[0] = cosf(a); t[1] = sinf(a);
        }
    }
}
__device__ __forceinline__ f32x4 mod4_partials(Frame& F, int l, int b, int n) {
    f32x4 a = *(const f32x4*)(F.in[3] + l * 6 * D + n);
#pragma unroll
    for (int kc = 0; kc < 16; ++kc) a += *(const f32x4*)(WSP(float, WS_PART) + ((size_t)((kc * 2 + l) * 2 + b)) * 6 * D + n);
    return a;
}
template <bool FROM_PART, typename TX> __device__ __forceinline__ void modulate_phase(Frame& F, const TX* X, int l, int cs, bf16* HNo) {
    for (int b = 0; b < NB; ++b) {
        f32x4 sh[4], sc[4];
#pragma unroll
        for (int j = 0; j < 4; ++j) { const int n = 4 * F.lane + 256 * j;
            if (FROM_PART) { sh[j] = mod4_partials(F, l, b, cs * D + n); sc[j] = mod4_partials(F, l, b, (cs + 1) * D + n); }
            else { const float* mf = WSP(float, WS_MODF) + (size_t)(l * 2 + b) * 6 * D; sh[j] = *(const f32x4*)(mf + cs * D + n); sc[j] = *(const f32x4*)(mf + (cs + 1) * D + n); }
            sc[j] = sc[j] + 1.f; }
        for (int row = b * SEQ + F.gw; row < (b + 1) * SEQ; row += 4 * F.NGW) {
            f32x4 v[4][4]; float ss[4]; bool ok[4];
#pragma unroll
            for (int q = 0; q < 4; ++q) { ok[q] = row + q * F.NGW < (b + 1) * SEQ; const int rq = ok[q] ? row + q * F.NGW : row;
#pragma unroll
                for (int j = 0; j < 4; ++j) v[q][j] = XRow<TX>::ld(X, (size_t)rq, 4 * F.lane + 256 * j); }
#pragma unroll
            for (int q = 0; q < 4; ++q) { ss[q] = 0.f;
#pragma unroll
                for (int j = 0; j < 4; ++j) ss[q] += (v[q][j].x * v[q][j].x + v[q][j].y * v[q][j].y) + (v[q][j].z * v[q][j].z + v[q][j].w * v[q][j].w); }
#pragma unroll
            for (int o = 1; o < 64; o <<= 1)
#pragma unroll
                for (int q = 0; q < 4; ++q) ss[q] += __shfl_xor(ss[q], o);
#pragma unroll
            for (int q = 0; q < 4; ++q) if (ok[q]) { const float rstd = rsqrtf(ss[q] * (1.f / D) + NORM_EPS); GAS v2u* o8 = (GAS v2u*)(HNo + (size_t)(row + q * F.NGW) * D) + F.lane;
#pragma unroll
                for (int j = 0; j < 4; ++j) { const f32x4 y = v[q][j] * rstd * sc[j] + sh[j]; v2u w; w.x = pk2(y.x, y.y); w.y = pk2(y.z, y.w); o8[64 * j] = w; } }
        }
    }
}
__device__ __forceinline__ void modf_reduce(Frame& F) {
    for (int i = blockIdx.x * NTHREADS + F.tid; i < 2 * 2 * 6 * D; i += F.G * NTHREADS) {
        const int l = i / (2 * 6 * D), q = i % (2 * 6 * D), n = q % (6 * D), b = q / (6 * D);
        float a = F.in[3][l * 6 * D + n];
#pragma unroll
        for (int kc = 0; kc < 16; ++kc) a += WSP(float, WS_PART)[((size_t)((kc * 2 + l) * 2 + b)) * 6 * D + n];
        WSP(float, WS_MODF)[i] = a;
    }
}
__device__ __forceinline__ void mla_mid_phase(Frame& F) {
    const float* DOWN = WSP(float, WS_DOWN); const float* qn = F.in[10]; const float* kvn = F.in[12];
    const f32x4 qn4 = *(const f32x4*)(qn + 4 * F.lane); const f32x2 kn2 = *(const f32x2*)(kvn + 2 * F.lane);
    for (int row = F.gw; row < M; row += F.NGW) {
        const float* dr = DOWN + (size_t)row * DOWN_NP; const int t = row & (SEQ - 1);
        const f32x4 a = *(const f32x4*)(dr + 4 * F.lane); const f32x2 k = *(const f32x2*)(dr + QL + 2 * F.lane);
        const float rq = rsqrtf(wave_sum((a.x * a.x + a.y * a.y) + (a.z * a.z + a.w * a.w)) * (1.f / QL) + NORM_EPS);
        const float rk = rsqrtf(wave_sum(k.x * k.x + k.y * k.y) * (1.f / KVL) + NORM_EPS);
        v2u w; w.x = pk2(a.x * rq * qn4.x, a.y * rq * qn4.y); w.y = pk2(a.z * rq * qn4.z, a.w * rq * qn4.w);
        *((GAS v2u*)(WSP(bf16, WS_CQ) + (size_t)row * QL) + F.lane) = w;
        GAS unsigned* ck = (GAS unsigned*)(WSP(bf16, WS_CKV) + (size_t)row * 128);
        ck[F.lane] = pk2(k.x * rk * kn2.x, k.y * rk * kn2.y);
        if (F.lane < 16) { const f32x2 x = *(const f32x2*)(dr + QL + KVL + 2 * F.lane);
            const float* tb = F.lane < 8 ? WSP(float, WS_ROPER) + (t >> 6) * 16 + 2 * F.lane : WSP(float, WS_ROPEC) + (t & 63) * 16 + 2 * (F.lane - 8);
            const float cs = tb[0], sn = tb[1];
            ((GAS unsigned*)(WSP(bf16, WS_KR) + (size_t)row * RP))[F.lane] = pk2(x.x * cs - x.y * sn, x.x * sn + x.y * cs); }
    }
}
namespace na {
constexpr int L_K = 0, L_V = 73728, L_B = 147456, L_END = L_B + 15 * 64 * 4;
}
__device__ __forceinline__ void na_phase(Frame& F) {
    const bf16* Q = WSP(bf16, WS_Q0); const bf16* K = WSP(bf16, WS_K0); const bf16* VT = WSP(bf16, WS_VT0); bf16* O = WSP(bf16, WS_O0);
    const int tid = F.tid, lane = F.lane, l16 = lane & 15, g = lane >> 4;
    LAS float* rpbH = (LAS float*)(F.lds + na::L_B);
    const int scol = tid >> 3, sc = tid & 7;
    const unsigned kdst = (unsigned)((scol * 8 + (sc ^ ((scol & 2) ^ ((scol & 8) >> 1)))) * 16), vdst = (unsigned)((scol * 8 + (sc ^ (scol & 6))) * 16);
    const int ri = F.wave >> 2, ct = F.wave & 3;
    const int c0 = 16 * ct, kc0 = ct == 0 ? 0 : (ct == 1 ? 8 : (ct == 2 ? 24 : 32));
    const int c = c0 + l16; int cs = c - 8; cs = cs < 0 ? 0 : (cs > GW - 16 ? GW - 16 : cs);
    const int kcolA = kc0 + 8 * (l16 >> 2) + (l16 & 3), kxv = (kcolA & 2) ^ ((kcolA & 8) >> 1);
    const unsigned kch0 = (unsigned)((kcolA * 8 + (g ^ kxv)) * 16), kch1 = (unsigned)((kcolA * 8 + ((4 + g) ^ kxv)) * 16);
    const unsigned vch = (unsigned)((l16 * 8 + (((kc0 >> 3) + g) ^ (l16 & 6))) * 16);
    const int dc0 = kc0 + 8 * g - c + 15, t0 = kc0 + 8 * g - cs;
    float pen[8];
#pragma unroll
    for (int k = 0; k < 8; ++k) pen[k] = (unsigned)(t0 + k) < 16u ? 0.f : -1e30f;
    for (int w = F.vcu; w < NB * NH * 8; w += F.G) {
        const int bh = w >> 3, b = bh >> 4, h = bh & 15, rp0 = (w & 7) * 8;
        __syncthreads();
        for (int i = tid; i < 15 * 64; i += NTHREADS) { const int dc = (i & 63) - 8; rpbH[i] = (dc >= 0 && dc <= 30) ? F.in[5][(h * 15 + (i >> 6)) * 31 + dc] * LOG2E : 0.f; }
        const bf16* kbase = K + ((size_t)h * M + (size_t)b * SEQ) * HD + scol * HD + sc * 8;
        const bf16* vbase = VT + ((size_t)(b * GROWS) * D + h * HD + scol) * GW + sc * 8;
        bf16x8 kst[9], vst[9];
#define NA_LOAD(rp_) do { int R0_ = 2 * (rp_) - 4; R0_ = R0_ < 0 ? 0 : (R0_ > GROWS - 8 ? GROWS - 8 : R0_); \
        _Pragma("unroll") for (int i_ = 0; i_ < 9; ++i_) { const int row_ = (R0_ + i_) > GROWS - 1 ? GROWS - 1 : (R0_ + i_); \
            kst[i_] = *(const bf16x8*)(kbase + (size_t)row_ * GW * HD); vst[i_] = *(const bf16x8*)(vbase + (size_t)row_ * D * GW); } } while (0)
        NA_LOAD(rp0);
        for (int st = 0; st < 8; ++st) {
            const int rp = rp0 + st;
            __syncthreads();
#pragma unroll
            for (int i = 0; i < 9; ++i) { *(LAS bf16x8*)(F.lds + na::L_K + i * 8192 + kdst) = kst[i]; *(LAS bf16x8*)(F.lds + na::L_V + i * 8192 + vdst) = vst[i]; }
            __syncthreads();
            if (st + 1 < 8) NA_LOAD(rp + 1);
            __builtin_amdgcn_sched_barrier(0);
            const int r = 2 * rp + ri; int rs = r - 4; rs = rs < 0 ? 0 : (rs > GROWS - 8 ? GROWS - 8 : rs);
            int R0 = 2 * rp - 4; R0 = R0 < 0 ? 0 : (R0 > GROWS - 8 ? GROWS - 8 : R0);
            const int roff = rs - R0;
            const size_t tq = (size_t)b * SEQ + r * GW + c;
            bf16x8 qf[2];
#pragma unroll
            for (int ks = 0; ks < 2; ++ks) qf[ks] = *(const bf16x8*)(Q + tq * D + h * HD + 32 * ks + 8 * g);
            const LAS unsigned char* kl = F.lds + na::L_K + roff * 8192; const LAS unsigned char* vl = F.lds + na::L_V + roff * 8192;
            pg8::f32x4 s[8][2];
#pragma unroll
            for (int kr = 0; kr < 8; ++kr)
#pragma unroll
                for (int blk = 0; blk < 2; ++blk) {
                    const bf16x8 k0 = *(const LAS bf16x8*)(kl + kr * 8192 + blk * 512 + kch0), k1 = *(const LAS bf16x8*)(kl + kr * 8192 + blk * 512 + kch1);
                    pg8::f32x4 a = {0.f, 0.f, 0.f, 0.f};
                    a = __builtin_amdgcn_mfma_f32_16x16x32_bf16(k0, qf[0], a, 0, 0, 0);
                    a = __builtin_amdgcn_mfma_f32_16x16x32_bf16(k1, qf[1], a, 0, 0, 0);
                    s[kr][blk] = a; if (blk == 1 && (kr & 1)) __builtin_amdgcn_sched_barrier(0); }
            const LAS float* bp = rpbH + (rs - r + 7) * 64 + dc0 + 8;
            float mx = -1e30f;
#pragma unroll
            for (int kr = 0; kr < 8; ++kr)
#pragma unroll
                for (int blk = 0; blk < 2; ++blk)
#pragma unroll
                    for (int i = 0; i < 4; ++i) { const float v = (s[kr][blk][i] + bp[kr * 64 + 4 * blk + i]) + pen[4 * blk + i]; s[kr][blk][i] = v; mx = fmaxf(mx, v); }
            mx = fmaxf(mx, __shfl_xor(mx, 16)); mx = fmaxf(mx, __shfl_xor(mx, 32));
            float sum = 0.f;
#pragma unroll
            for (int kr = 0; kr < 8; ++kr)
#pragma unroll
                for (int blk = 0; blk < 2; ++blk)
#pragma unroll
                    for (int i = 0; i < 4; ++i) { const float e = __builtin_amdgcn_exp2f(s[kr][blk][i] - mx); s[kr][blk][i] = e; sum += e; }
            sum += __shfl_xor(sum, 16); sum += __shfl_xor(sum, 32);
            const float inv = 1.f / sum;
            pg8::f32x4 o[4];
#pragma unroll
            for (int db = 0; db < 4; ++db) o[db] = (pg8::f32x4){0.f, 0.f, 0.f, 0.f};
#pragma unroll
            for (int kr = 0; kr < 8; ++kr) {
                v4u pw; pw.x = pk2(s[kr][0][0], s[kr][0][1]); pw.y = pk2(s[kr][0][2], s[kr][0][3]); pw.z = pk2(s[kr][1][0], s[kr][1][1]); pw.w = pk2(s[kr][1][2], s[kr][1][3]);
                const bf16x8 pf = __builtin_bit_cast(bf16x8, pw);
#pragma unroll
                for (int db = 0; db < 4; ++db) { const bf16x8 vf = *(const LAS bf16x8*)(vl + kr * 8192 + db * 2048 + vch);
                    o[db] = __builtin_amdgcn_mfma_f32_16x16x32_bf16(vf, pf, o[db], 0, 0, 0); }
                if (kr & 1) __builtin_amdgcn_sched_barrier(0); }
            bf16* op = O + tq * D + h * HD + 4 * g;
#pragma unroll
            for (int db = 0; db < 4; ++db) { v2u wv; wv.x = pk2(o[db][0] * inv, o[db][1] * inv); wv.y = pk2(o[db][2] * inv, o[db][3] * inv); *(GAS v2u*)(op + 16 * db) = wv; }
        }
#undef NA_LOAD
    }
    __syncthreads();
}
namespace mla {
constexpr int NSLOT = 4, KSLOT = 12288, VSLOT = 8192;
constexpr int L_K = 0, L_V = NSLOT * KSLOT, L_WS = L_V + NSLOT * VSLOT, L_OST = L_WS + 2048, L_BYTES = L_OST + 8 * 4096;
constexpr float THR = 8.f;
typedef LAS unsigned char lch;
__device__ __forceinline__ int crow(int r, int hi) { return (r & 3) + 8 * (r >> 2) + 4 * hi; }
__device__ __forceinline__ void glds16(const void* sbase, unsigned voff, unsigned lds_dst) { unsigned keep;
    asm volatile("s_mov_b32 %0, m0\n\ts_mov_b32 m0, %3\n\ts_nop 0\n\tglobal_load_lds_dwordx4 %1, %2\n\ts_mov_b32 m0, %0" : "=&s"(keep) : "v"(voff), "s"(sbase), "s"(lds_dst) : "memory"); }
#define MLA_WAIT_BAR(N) asm volatile("s_waitcnt vmcnt(" #N ") lgkmcnt(0)\n\ts_barrier" ::: "memory")
#define MLA_WAIT_FULL() do { if (wid < 4) { MLA_WAIT_BAR(6); } else { MLA_WAIT_BAR(4); } } while (0)
#define MLA_SBAR() __builtin_amdgcn_sched_barrier(0)
#define MLA_MF(a, b, c) __builtin_amdgcn_mfma_f32_32x32x16_bf16(a, b, c, 0, 0, 0)
#define MLA_PIN(x) asm volatile("" : "+v"(x))
#define MLA_EX(v) __builtin_amdgcn_exp2f(v)
__device__ __forceinline__ void unit(int b, int h, int qb, const bf16* Q1, const bf16* KN, const bf16* KR, const bf16* VT, bf16* O1, lch* lds) {
    const int tid = threadIdx.x, wid = __builtin_amdgcn_readfirstlane(tid >> 6), lane = tid & 63, r32 = lane & 31, hi = lane >> 5;
    const size_t rowbase = (size_t)b * SEQ; const int q0 = qb * 256;
    const unsigned lds0 = (unsigned)(uintptr_t)lds;
    LAS float* wsf = (LAS float*)(lds + L_WS) + wid * 64;
    const bf16* knb = KN + ((size_t)h * M + rowbase + 8 * wid) * HD; const bf16* krb = KR + (rowbase + 16 * (wid & 3)) * RP; const bf16* vb = VT + ((rowbase >> 6) * D + h * HD + 8 * wid) * GW;
    unsigned kno, kro, vo;
    { const int rl = lane >> 3, row = 8 * wid + rl, c = (lane & 7) ^ ((row >> 1) & 7); kno = (unsigned)((rl * HD + c * 8) * 2); }
    { const int rl = lane >> 2, row = 16 * (wid & 3) + rl, c = (lane & 3) ^ ((row >> 2) & 3); kro = (unsigned)((rl * RP + c * 8) * 2); }
    { const int dl = lane >> 3, d = 8 * wid + dl, c = (lane & 7) ^ ((d >> 1) & 7); vo = (unsigned)((dl * GW + c * 8) * 2); }
    const unsigned kndst = lds0 + L_K + wid * 1024, krdst = lds0 + L_K + 8192 + (wid & 3) * 1024, vdst = lds0 + L_V + wid * 1024;
#define DMA_K(t, slot) do { glds16(knb + (size_t)(t) * (64 * HD), kno, (unsigned)__builtin_amdgcn_readfirstlane(kndst + (slot))); if (wid < 4) glds16(krb + (size_t)(t) * (64 * RP), kro, (unsigned)__builtin_amdgcn_readfirstlane(krdst + (slot))); } while (0)
#define DMA_V(t, slot) glds16(vb + (size_t)(t) * (D * GW), vo, (unsigned)__builtin_amdgcn_readfirstlane(vdst + (slot)))
    const int rowA = (r32 & ~0xC) | ((r32 & 4) << 1) | ((r32 & 8) >> 1);
    const lch* kpn0 = lds + L_K + rowA * 128 + (((0 + hi) ^ ((rowA >> 1) & 7)) * 16); const lch* kpn1 = lds + L_K + rowA * 128 + (((2 + hi) ^ ((rowA >> 1) & 7)) * 16);
    const lch* kpn2 = lds + L_K + rowA * 128 + (((4 + hi) ^ ((rowA >> 1) & 7)) * 16); const lch* kpn3 = lds + L_K + rowA * 128 + (((6 + hi) ^ ((rowA >> 1) & 7)) * 16);
    const lch* kpr0 = lds + L_K + 8192 + rowA * 64 + (((0 + hi) ^ ((rowA >> 2) & 3)) * 16); const lch* kpr1 = lds + L_K + 8192 + rowA * 64 + (((2 + hi) ^ ((rowA >> 2) & 3)) * 16);
    const lch* vp0 = lds + L_V + r32 * 128 + (((0 + hi) ^ ((r32 >> 1) & 7)) * 16); const lch* vp1 = lds + L_V + r32 * 128 + (((2 + hi) ^ ((r32 >> 1) & 7)) * 16);
    const lch* vp2 = lds + L_V + r32 * 128 + (((4 + hi) ^ ((r32 >> 1) & 7)) * 16); const lch* vp3 = lds + L_V + r32 * 128 + (((6 + hi) ^ ((r32 >> 1) & 7)) * 16);
#define LDF(p) (*(const LAS bf16x8*)(p))
#define KLOAD_ALL(so) do { kf[0] = LDF(kpn0 + (so)); kf[1] = LDF(kpn0 + (so) + 4096); kf[2] = LDF(kpn1 + (so)); kf[3] = LDF(kpn1 + (so) + 4096); kf[4] = LDF(kpn2 + (so)); kf[5] = LDF(kpn2 + (so) + 4096); \
        kf[6] = LDF(kpn3 + (so)); kf[7] = LDF(kpn3 + (so) + 4096); kf[8] = LDF(kpr0 + (so)); kf[9] = LDF(kpr0 + (so) + 2048); kf[10] = LDF(kpr1 + (so)); kf[11] = LDF(kpr1 + (so) + 2048); } while (0)
    bf16x8 kf[12], qr[6];
    constexpr int NT = SEQ / 64;
    DMA_K(0, 0); DMA_V(0, 0); DMA_K(1, KSLOT);
    { const bf16* Qw = Q1 + (rowbase + q0 + wid * 32 + r32) * 1536 + h * QKD + hi * 8;
#pragma unroll
      for (int d0 = 0; d0 < 6; ++d0) qr[d0] = *(const bf16x8*)(Qw + d0 * 16); }
    DMA_V(1, VSLOT); DMA_K(2, 2 * KSLOT); DMA_K(3, 3 * KSLOT);
    float m_ref = 0.f, l_reg = 0.f; f32x16 o[2]; o[0] = f32x16{}; o[1] = f32x16{}; f32x16 negm;
    f32x16 pA0, pA1, pB0, pB1; bool resc = false;
    if (wid < 4) { MLA_WAIT_BAR(8); } else { MLA_WAIT_BAR(5); }
    KLOAD_ALL(0);
    { const f32x16 z = {};
      pA0 = MLA_MF(kf[0], qr[0], z); pA1 = MLA_MF(kf[1], qr[0], z);
#pragma unroll
      for (int d0 = 1; d0 < 6; ++d0) { pA0 = MLA_MF(kf[2 * d0], qr[d0], pA0); pA1 = MLA_MF(kf[2 * d0 + 1], qr[d0], pA1); } }
    { float rm = pA0[0];
#pragma unroll
      for (int r = 1; r < 16; ++r) rm = fmaxf(rm, pA0[r]);
#pragma unroll
      for (int r = 0; r < 16; ++r) rm = fmaxf(rm, pA1[r]);
      { auto rr = __builtin_amdgcn_permlane32_swap(__float_as_uint(rm), __float_as_uint(rm), false, false); rm = fmaxf(__uint_as_float(rr[0]), __uint_as_float(rr[1])); }
      m_ref = rm;
#pragma unroll
      for (int r = 0; r < 16; ++r) negm[r] = -m_ref;
      MLA_PIN(negm);
#pragma unroll
      for (int r = 0; r < 16; ++r) { pA0[r] = MLA_EX(pA0[r] - m_ref); pA1[r] = pA1[r] - m_ref; } }
    MLA_WAIT_BAR(0);
    DMA_K(4, 0); DMA_V(2, 2 * VSLOT);
    KLOAD_ALL(KSLOT);
    MLA_WAIT_FULL();
    bf16x8 vA0, vA1, vA2, vA3, vB0, vB1, vB2, vB3; v4u pw0, pw1, pw2, pw3;
#define PKW(P, B) pk2(P[B], P[(B) + 1])
#define PAF(k) __builtin_bit_cast(bf16x8, pw##k)
#define GAE(MF, X, B, A0, A1, A2, A3) do { MF; X[B] = MLA_EX(X[B]); X[(B) + 1] = MLA_EX(X[(B) + 1]); X[(B) + 2] = MLA_EX(X[(B) + 2]); X[(B) + 3] = MLA_EX(X[(B) + 3]); MLA_PIN(X); \
        sacc += A0; sacc += A1; sacc += A2; sacc += A3; MLA_PIN(sacc); MLA_SBAR(); } while (0)
#define GAC(MF, A0, A1, A2, A3, W0, W1, PW) do { MF; sacc += A0; sacc += A1; sacc += A2; sacc += A3; MLA_PIN(sacc); W0; W1; MLA_PIN(PW); MLA_SBAR(); } while (0)
#define GAW(MF, W0, W1, W2, W3, PW) do { MF; W0; W1; W2; W3; MLA_PIN(PW); MLA_SBAR(); } while (0)
#define GB(MF, X0, X1, J) do { MF; X0[J] = MLA_EX(X0[J]); X0[(J) + 1] = MLA_EX(X0[(J) + 1]); MLA_PIN(X0); MLA_SBAR(); } while (0)
#define STEP(C0, C1, P0, P1, t, R, GK, GV, GL) do { MLA_SBAR(); \
    constexpr int kc = (R) * KSLOT, kn = (((R) + 1) % 4) * KSLOT, vpv = (((R) + 3) % 4) * VSLOT, vn = (((R) + 2) % 4) * VSLOT; float sacc = 0.f; \
    vA0 = LDF(vp0 + vpv); MLA_SBAR(); GAE(C0 = MLA_MF(kf[0], qr[0], negm), P1, 0, P0[0], P0[1], P0[2], P0[3]); \
    vA1 = LDF(vp1 + vpv); MLA_SBAR(); GAE(C1 = MLA_MF(kf[1], qr[0], negm), P1, 4, P0[4], P0[5], P0[6], P0[7]); \
    vA2 = LDF(vp2 + vpv); MLA_SBAR(); GAE(C0 = MLA_MF(kf[2], qr[1], C0), P1, 8, P0[8], P0[9], P0[10], P0[11]); \
    vA3 = LDF(vp3 + vpv); MLA_SBAR(); GAE(C1 = MLA_MF(kf[3], qr[1], C1), P1, 12, P0[12], P0[13], P0[14], P0[15]); \
    GAC(C0 = MLA_MF(kf[4], qr[2], C0), P1[0], P1[1], P1[2], P1[3], pw0[0] = PKW(P0, 0), pw0[1] = PKW(P0, 2), pw0); \
    GAC(C1 = MLA_MF(kf[5], qr[2], C1), P1[4], P1[5], P1[6], P1[7], pw0[2] = PKW(P0, 4), pw0[3] = PKW(P0, 6), pw0); \
    GAC(C0 = MLA_MF(kf[6], qr[3], C0), P1[8], P1[9], P1[10], P1[11], pw1[0] = PKW(P0, 8), pw1[1] = PKW(P0, 10), pw1); \
    GAC(C1 = MLA_MF(kf[7], qr[3], C1), P1[12], P1[13], P1[14], P1[15], pw1[2] = PKW(P0, 12), pw1[3] = PKW(P0, 14), pw1); \
    GAW(C0 = MLA_MF(kf[8], qr[4], C0), pw2[0] = PKW(P1, 0), pw2[1] = PKW(P1, 2), pw2[2] = PKW(P1, 4), pw2[3] = PKW(P1, 6), pw2); \
    GAW(C1 = MLA_MF(kf[9], qr[4], C1), pw3[0] = PKW(P1, 8), pw3[1] = PKW(P1, 10), pw3[2] = PKW(P1, 12), pw3[3] = PKW(P1, 14), pw3); \
    C0 = MLA_MF(kf[10], qr[5], C0); C1 = MLA_MF(kf[11], qr[5], C1); \
    l_reg += sacc; \
    if (GK) { DMA_K((t) + 4, kc); } if (GV) { DMA_V((t) + 2, vn); } \
    { float a_ = fmaxf(fmaxf(C0[0], C0[1]), C1[0]), b_ = fmaxf(fmaxf(C0[2], C0[3]), C1[1]); a_ = fmaxf(fmaxf(a_, C1[2]), C1[3]); \
      _Pragma("unroll") for (int r = 4; r < 16; r += 4) { a_ = fmaxf(fmaxf(a_, C0[r]), C0[r + 1]); b_ = fmaxf(fmaxf(b_, C0[r + 2]), C0[r + 3]); a_ = fmaxf(fmaxf(a_, C1[r]), C1[r + 1]); b_ = fmaxf(fmaxf(b_, C1[r + 2]), C1[r + 3]); } \
      float rm = fmaxf(a_, b_); { auto rr = __builtin_amdgcn_permlane32_swap(__float_as_uint(rm), __float_as_uint(rm), false, false); rm = fmaxf(__uint_as_float(rr[0]), __uint_as_float(rr[1])); } \
      resc = false; \
      if (__builtin_expect(__any(rm > THR), 0)) { const float dl = fmaxf(rm, 0.f), f = MLA_EX(-dl); m_ref += dl; l_reg *= f; if (hi == 0) wsf[r32] = f; resc = true; \
        _Pragma("unroll") for (int r = 0; r < 16; ++r) { C0[r] -= dl; C1[r] -= dl; } \
        _Pragma("unroll") for (int r = 0; r < 16; ++r) negm[r] = -m_ref; MLA_PIN(negm); } } \
    MLA_SBAR(); \
    vB0 = LDF(vp0 + vpv + 4096); if (GL) { kf[0] = LDF(kpn0 + kn); } MLA_SBAR(); GB(o[0] = MLA_MF(PAF(0), vA0, o[0]), C0, C1, 0); \
    vB1 = LDF(vp1 + vpv + 4096); if (GL) { kf[1] = LDF(kpn0 + kn + 4096); } MLA_SBAR(); GB(o[0] = MLA_MF(PAF(1), vA1, o[0]), C0, C1, 2); \
    vB2 = LDF(vp2 + vpv + 4096); if (GL) { kf[2] = LDF(kpn1 + kn); kf[3] = LDF(kpn1 + kn + 4096); } MLA_SBAR(); GB(o[0] = MLA_MF(PAF(2), vA2, o[0]), C0, C1, 4); \
    vB3 = LDF(vp3 + vpv + 4096); if (GL) { kf[4] = LDF(kpn2 + kn); kf[5] = LDF(kpn2 + kn + 4096); } MLA_SBAR(); GB(o[0] = MLA_MF(PAF(3), vA3, o[0]), C0, C1, 6); \
    if (GL) { kf[6] = LDF(kpn3 + kn); kf[7] = LDF(kpn3 + kn + 4096); } MLA_SBAR(); GB(o[1] = MLA_MF(PAF(0), vB0, o[1]), C0, C1, 8); \
    if (GL) { kf[8] = LDF(kpr0 + kn); kf[9] = LDF(kpr0 + kn + 2048); } MLA_SBAR(); GB(o[1] = MLA_MF(PAF(1), vB1, o[1]), C0, C1, 10); \
    if (GL) { kf[10] = LDF(kpr1 + kn); kf[11] = LDF(kpr1 + kn + 2048); } MLA_SBAR(); GB(o[1] = MLA_MF(PAF(2), vB2, o[1]), C0, C1, 12); \
    GB(o[1] = MLA_MF(PAF(3), vB3, o[1]), C0, C1, 14); \
    } while (0)
#define RESC() do { if (resc) { LDS_WAIT(); \
    _Pragma("unroll") for (int d_ = 0; d_ < 2; ++d_) _Pragma("unroll") for (int r_ = 0; r_ < 16; ++r_) o[d_][r_] *= wsf[crow(r_, hi)]; } } while (0)
    static_assert(NT == 128, "the step program below is written for 128 tiles");
    for (int t = 1; t < 121; t += 4) {
        STEP(pB0, pB1, pA0, pA1, t,     1, true, true, true); MLA_WAIT_FULL(); RESC();
        STEP(pA0, pA1, pB0, pB1, t + 1, 2, true, true, true); MLA_WAIT_FULL(); RESC();
        STEP(pB0, pB1, pA0, pA1, t + 2, 3, true, true, true); MLA_WAIT_FULL(); RESC();
        STEP(pA0, pA1, pB0, pB1, t + 3, 0, true, true, true); MLA_WAIT_FULL(); RESC();
    }
    STEP(pB0, pB1, pA0, pA1, 121, 1, true, true, true);    MLA_WAIT_FULL(); RESC();
    STEP(pA0, pA1, pB0, pB1, 122, 2, true, true, true);    MLA_WAIT_FULL(); RESC();
    STEP(pB0, pB1, pA0, pA1, 123, 3, true, true, true);    MLA_WAIT_FULL(); RESC();
    STEP(pA0, pA1, pB0, pB1, 124, 0, false, true, true);   if (wid < 4) { MLA_WAIT_BAR(4); } else { MLA_WAIT_BAR(3); } RESC();
    STEP(pB0, pB1, pA0, pA1, 125, 1, false, true, true);   MLA_WAIT_BAR(2); RESC();
    STEP(pA0, pA1, pB0, pB1, 126, 2, false, false, true);  MLA_WAIT_BAR(0); RESC();
    STEP(pB0, pB1, pA0, pA1, 127, 3, false, false, false); RESC();
    constexpr int vc = 3 * VSLOT;
    {
#pragma unroll
      for (int r = 0; r < 16; ++r) pB1[r] = MLA_EX(pB1[r]);
      float sacc = 0.f;
#pragma unroll
      for (int r = 0; r < 16; ++r) sacc += pB0[r];
#pragma unroll
      for (int r = 0; r < 16; ++r) sacc += pB1[r];
      l_reg += sacc;
      pw0 = (v4u){PKW(pB0, 0), PKW(pB0, 2), PKW(pB0, 4), PKW(pB0, 6)}; pw1 = (v4u){PKW(pB0, 8), PKW(pB0, 10), PKW(pB0, 12), PKW(pB0, 14)};
      pw2 = (v4u){PKW(pB1, 0), PKW(pB1, 2), PKW(pB1, 4), PKW(pB1, 6)}; pw3 = (v4u){PKW(pB1, 8), PKW(pB1, 10), PKW(pB1, 12), PKW(pB1, 14)};
      MLA_SBAR();
#pragma unroll
      for (int dh = 0; dh < 2; ++dh) { const bf16x8 w0 = LDF(vp0 + vc + dh * 4096), w1 = LDF(vp1 + vc + dh * 4096), w2 = LDF(vp2 + vc + dh * 4096), w3 = LDF(vp3 + vc + dh * 4096);
          o[dh] = MLA_MF(PAF(0), w0, o[dh]); o[dh] = MLA_MF(PAF(1), w1, o[dh]); o[dh] = MLA_MF(PAF(2), w2, o[dh]); o[dh] = MLA_MF(PAF(3), w3, o[dh]); } }
    { auto rr = __builtin_amdgcn_permlane32_swap(__float_as_uint(l_reg), __float_as_uint(l_reg), false, false); l_reg = __uint_as_float(rr[0]) + __uint_as_float(rr[1]); }
    if (hi == 0) wsf[32 + r32] = l_reg; LDS_WAIT();
    { LAS bf16* stg = (LAS bf16*)(lds + L_OST) + wid * 2048;
#pragma unroll
      for (int r = 0; r < 16; ++r) { const int orow = crow(r, hi); const float rl = __builtin_amdgcn_rcpf(wsf[32 + orow]);
#pragma unroll
          for (int dh = 0; dh < 2; ++dh) stg[orow * 64 + dh * 32 + r32] = (bf16)(pk2(o[dh][r] * rl, 0.f) & 0xffffu); }
      LDS_WAIT();
      bf16* Ow = O1 + (rowbase + q0 + wid * 32) * 1024 + h * HD;
#pragma unroll
      for (int i = 0; i < 4; ++i) { const int row = i * 8 + (lane >> 3), ch = lane & 7; const v4u v = *(const LAS v4u*)(stg + row * 64 + ch * 8); *(GAS v4u*)(Ow + (size_t)row * 1024 + ch * 8) = v; } }
    asm volatile("s_waitcnt lgkmcnt(0)\n\ts_barrier" ::: "memory");
#undef DMA_K
#undef DMA_V
#undef LDF
#undef KLOAD_ALL
#undef PKW
#undef PAF
#undef GAE
#undef GAC
#undef GAW
#undef GB
#undef STEP
#undef RESC
}
#undef MLA_WAIT_BAR
#undef MLA_WAIT_FULL
#undef MLA_SBAR
#undef MLA_MF
#undef MLA_PIN
#undef MLA_EX
}

#ifndef MK_CHECK
#define MK_CHECK 0
#endif
#ifndef MK_PHASED
#define MK_PHASED 0
#endif
#ifndef MK_DBL
#define MK_DBL 0u
#endif
#define REP(k) ((((unsigned)MK_DBL >> (k)) & 1u) ? 2 : 1)

#if MK_CHECK
__global__ void __launch_bounds__(256) chk_na(const bf16* Q, const bf16* K, const bf16* VT, const bf16* O, const float* rpb, float* accum) {
    __shared__ float qs[4][64], ps[4][128];
    const int w = threadIdx.x >> 6, lane = threadIdx.x & 63;
    const int unit = blockIdx.x * 4 + w, tok = unit / NH, h = unit % NH;
    const int b = tok / SEQ, t = tok % SEQ, r = t / GW, c = t % GW;
    int rs = r - 4; rs = rs < 0 ? 0 : (rs > GROWS - 8 ? GROWS - 8 : rs);
    int cs = c - 8; cs = cs < 0 ? 0 : (cs > GW - 16 ? GW - 16 : cs);
    qs[w][lane] = bf2f(Q[(size_t)tok * D + h * HD + lane]) * (1.f / LOG2E);
    __syncthreads();
    float sc[2];
#pragma unroll
    for (int u = 0; u < 2; ++u) {
        const int kk = lane + 64 * u, i = kk >> 4, j = kk & 15;
        const size_t kt = (size_t)b * SEQ + (rs + i) * GW + cs + j;
        const bf16* kp = K + ((size_t)h * M + kt) * HD;
        float a = 0.f;
        for (int d = 0; d < HD; ++d) a += qs[w][d] * bf2f(kp[d]);
        sc[u] = a + rpb[(h * 15 + (rs + i - r + 7)) * 31 + (cs + j - c + 15)];
    }
    float mx = fmaxf(sc[0], sc[1]);
    for (int o = 1; o < 64; o <<= 1) mx = fmaxf(mx, __shfl_xor(mx, o));
    const float e0 = expf(sc[0] - mx), e1 = expf(sc[1] - mx);
    const float inv = 1.f / wave_sum(e0 + e1);
    ps[w][lane] = e0 * inv; ps[w][lane + 64] = e1 * inv;
    __syncthreads();
    float acc = 0.f;
    for (int kk = 0; kk < 128; ++kk) { const int i = kk >> 4, j = kk & 15; const size_t kt = (size_t)b * SEQ + (rs + i) * GW + cs + j;
        acc += ps[w][kk] * bf2f(VT[((kt >> 6) * D + h * HD + lane) * GW + (kt & 63)]); }
    const float got = bf2f(O[(size_t)tok * D + h * HD + lane]);
    const float e2 = wave_sum((got - acc) * (got - acc)), r2 = wave_sum(acc * acc);
    if (lane == 0) { atomicAdd(accum, e2); atomicAdd(accum + 1, r2); }
}
__global__ void __launch_bounds__(64) chk_mla(const bf16* Q1, const bf16* KN, const bf16* KR, const bf16* VT, const bf16* O1, float* accum) {
    __shared__ float sc[SEQ]; __shared__ float qv[96];
    const int lane = threadIdx.x, i = blockIdx.x >> 4, h = blockIdx.x & 15;
    const int tok = i * 32 + ((i * 7) & 31), b = tok / SEQ;
    for (int d = lane; d < 96; d += 64) qv[d] = bf2f(Q1[(size_t)tok * 1536 + h * 96 + d]);
    __syncthreads();
    float mx = -1e30f;
    for (int key = lane; key < SEQ; key += 64) { const size_t kt = (size_t)b * SEQ + key; float a = 0.f;
        for (int d = 0; d < 64; ++d) a += qv[d] * bf2f(KN[((size_t)h * M + kt) * 64 + d]);
        for (int d = 0; d < 32; ++d) a += qv[64 + d] * bf2f(KR[kt * 32 + d]);
        sc[key] = a; mx = fmaxf(mx, a); }
    for (int o = 1; o < 64; o <<= 1) mx = fmaxf(mx, __shfl_xor(mx, o));
    float sm = 0.f;
    for (int key = lane; key < SEQ; key += 64) { const float e = exp2f(sc[key] - mx); sc[key] = e; sm += e; }
    sm = wave_sum(sm);
    __syncthreads();
    float acc = 0.f;
    for (int key = 0; key < SEQ; ++key) { const size_t kt = (size_t)b * SEQ + key; acc += sc[key] * bf2f(VT[((kt >> 6) * D + h * 64 + lane) * GW + (kt & 63)]); }
    acc /= sm;
    const float got = bf2f(O1[(size_t)tok * 1024 + h * 64 + lane]);
    const float e2 = wave_sum((got - acc) * (got - acc)), r2 = wave_sum(acc * acc);
    if (lane == 0) { atomicAdd(accum, e2); atomicAdd(accum + 1, r2); }
}
__global__ void chk_tweak(float* out, const float* accum, float amp) {
    const float s = sqrtf(amp * accum[0] / fmaxf(accum[1], 1e-30f));
    const size_t i = (size_t)blockIdx.x * 256 + threadIdx.x; out[i] *= (1.f + s);
}

__global__ void __launch_bounds__(256) chk_proj(const float* DOWN, const float* qn, const float* kvn, const float* w_uq, const float* w_ukv,
                                                const bf16* Q1, const bf16* KR, const bf16* KN, const bf16* VT, float* accum) {
    __shared__ float cq[256], ckv[128], qv[1536], red[8];
    const int tid = threadIdx.x, i = blockIdx.x, row = i * 64 + ((i * 11) & 63), t = row & (SEQ - 1), gr = t >> 6, gc = t & 63;
    const float* dr = DOWN + (size_t)row * 512;
    float ss = dr[tid] * dr[tid], ssk = tid < 128 ? dr[256 + tid] * dr[256 + tid] : 0.f;
    ss = wave_sum(ss); ssk = wave_sum(ssk);
    if ((tid & 63) == 0) { red[tid >> 6] = ss; red[4 + (tid >> 6)] = ssk; }
    __syncthreads();
    const float rq = rsqrtf((red[0] + red[1] + red[2] + red[3]) / 256.f + 1e-6f), rk = rsqrtf((red[4] + red[5] + red[6] + red[7]) / 128.f + 1e-6f);
    cq[tid] = dr[tid] * rq * qn[tid]; if (tid < 128) ckv[tid] = dr[256 + tid] * rk * kvn[tid];
    __syncthreads();
    for (int c = tid; c < 1536; c += 256) { float a = 0.f; for (int k = 0; k < 256; ++k) a += cq[k] * w_uq[(size_t)k * 1536 + c]; qv[c] = a; }
    __syncthreads();
    float e[4] = {0.f, 0.f, 0.f, 0.f}, r[4] = {0.f, 0.f, 0.f, 0.f};
    for (int c = tid; c < 1536; c += 256) { const int d = c % 96; float v = qv[c];
        if (d >= 64) { const int pr = (d - 64) >> 1; const float inv = powf(10000.f, -(float)(pr & 7) / 8.f), ang = (pr < 8 ? (float)gr : (float)gc) * inv, cs = cosf(ang), sn = sinf(ang);
            const float x1 = qv[c & ~1], x2 = qv[c | 1]; v = (c & 1) ? x1 * sn + x2 * cs : x1 * cs - x2 * sn; }
        v *= QSCALE1; const float g = bf2f(Q1[(size_t)row * 1536 + c]); e[0] += (g - v) * (g - v); r[0] += v * v; }
    if (tid < 32) { const int pr = tid >> 1; const float inv = powf(10000.f, -(float)(pr & 7) / 8.f), ang = (pr < 8 ? (float)gr : (float)gc) * inv, cs = cosf(ang), sn = sinf(ang);
        const float x1 = dr[384 + (tid & ~1)], x2 = dr[384 + (tid | 1)]; const float v = (tid & 1) ? x1 * sn + x2 * cs : x1 * cs - x2 * sn;
        const float g = bf2f(KR[(size_t)row * 32 + tid]); e[1] += (g - v) * (g - v); r[1] += v * v; }
    for (int c = tid; c < 2048; c += 256) { float a = 0.f; for (int k = 0; k < 128; ++k) a += ckv[k] * w_ukv[(size_t)k * 2048 + c];
        const int h = c >> 7, d = c & 127;
        if (d < 64) { const float g = bf2f(KN[((size_t)h * M + row) * 64 + d]); e[2] += (g - a) * (g - a); r[2] += a * a; }
        else { const float g = bf2f(VT[((size_t)(row >> 6) * D + h * 64 + d - 64) * GW + (row & 63)]); e[3] += (g - a) * (g - a); r[3] += a * a; } }
#pragma unroll
    for (int q = 0; q < 4; ++q) { const float es = wave_sum(e[q]), rs = wave_sum(r[q]); if ((tid & 63) == 0) { atomicAdd(accum + 2 * q, es); atomicAdd(accum + 2 * q + 1, rs); } }
}
__global__ void chk_tweak4(float* out, const float* accum, float amp) {
    float s2 = 0.f;
    for (int q = 0; q < 4; ++q) s2 += accum[2 * q] / fmaxf(accum[2 * q + 1], 1e-30f);
    const float s = sqrtf(amp * s2);
    const size_t i = (size_t)blockIdx.x * 256 + threadIdx.x; out[i] *= (1.f + s);
}
#endif


__device__ __forceinline__ int moe_count_prefix(Frame& F, int nblk, LAS int* red) {
    typedef int i32x4 __attribute__((ext_vector_type(4)));
    i32x4 a = {0, 0, 0, 0}, b = {0, 0, 0, 0};
    if (F.tid < nblk) { const i32x4* p = (const i32x4*)(WSP(int, WS_CNTWG) + F.tid * 8); a = p[0]; b = p[1]; }
    int c[8] = {a.x, a.y, a.z, a.w, b.x, b.y, b.z, b.w};
#pragma unroll
    for (int o = 1; o < 64; o <<= 1)
#pragma unroll
        for (int e = 0; e < 8; ++e) c[e] += __shfl_xor(c[e], o);
    if (F.lane == 0 && F.wave < 4) {
#pragma unroll
        for (int e = 0; e < 8; ++e) red[F.wave * 8 + e] = c[e]; }
    __syncthreads();
    int r = 0;
    if (F.tid < 8) r = (red[F.tid] + red[8 + F.tid]) + (red[16 + F.tid] + red[24 + F.tid]);
    __syncthreads();
    return r;
}
__device__ __forceinline__ void moe_tables(Frame& F) {
    LAS int* red = (LAS int*)(F.lds + 65536);
    const int tot = moe_count_prefix(F, 256, red);
    if (F.tid < 8) F.MISC[16 + F.tid] = (unsigned)tot;
    __syncthreads();
    if (F.tid == 0) { int tb = 0;
        for (int e = 0; e < 8; ++e) { F.MISC[24 + e] = (unsigned)tb; F.MISC[33 + e] = (unsigned)(tb * 256); tb += ((int)F.MISC[16 + e] + 255) >> 8; }
        F.MISC[32] = (unsigned)tb; F.MISC[41] = (unsigned)(tb * 256); }
    __syncthreads();
}
template <typename TX> __device__ __forceinline__ void router_phase(Frame& F, const TX* X, int l, int cs) {
    LAS float* wr_l = (LAS float*)(F.lds);
    LAS int* rowE = (LAS int*)(F.lds + 32768);
    LAS float* rowW = (LAS float*)(F.lds + 32768 + 512);
    LAS int* rowP = (LAS int*)(F.lds + 32768 + 1024);
    LAS int* lcnt = (LAS int*)(F.lds + 32768 + 1536);
    for (int i = F.tid; i < D * NE / 4; i += NTHREADS) ((LAS f32x4*)wr_l)[i] = ((const f32x4*)F.in[15])[i];
    __syncthreads();
    const float* mf = WSP(float, WS_MODF);
    for (int blk = blockIdx.x; blk < M / 64; blk += F.G) {
        const int b = (blk * 64) >> 13;
        f32x4 sh[4], sc[4];
#pragma unroll
        for (int j = 0; j < 4; ++j) { const int n = 4 * F.lane + 256 * j; sh[j] = *(const f32x4*)(mf + (size_t)(l * 2 + b) * 6 * D + cs * D + n); sc[j] = *(const f32x4*)(mf + (size_t)(l * 2 + b) * 6 * D + (cs + 1) * D + n) + 1.f; }
        for (int rr0 = 0; rr0 < 8; rr0 += 4) {
            f32x4 v[4][4]; float ss[4];
#pragma unroll
            for (int q = 0; q < 4; ++q) {
#pragma unroll
                for (int j = 0; j < 4; ++j) v[q][j] = XRow<TX>::ld(X, (size_t)(blk * 64 + F.wave * 8 + rr0 + q), 4 * F.lane + 256 * j); }
#pragma unroll
            for (int q = 0; q < 4; ++q) { ss[q] = 0.f;
#pragma unroll
                for (int j = 0; j < 4; ++j) ss[q] += (v[q][j].x * v[q][j].x + v[q][j].y * v[q][j].y) + (v[q][j].z * v[q][j].z + v[q][j].w * v[q][j].w); }
#pragma unroll
            for (int o = 1; o < 64; o <<= 1)
#pragma unroll
                for (int q = 0; q < 4; ++q) ss[q] += __shfl_xor(ss[q], o);
            float lg[4][8];
#pragma unroll
            for (int q = 0; q < 4; ++q) { const float rstd = rsqrtf(ss[q] * (1.f / D) + NORM_EPS);
#pragma unroll
                for (int e = 0; e < 8; ++e) lg[q][e] = 0.f;
                GAS v2u* o8 = (GAS v2u*)(WSP(bf16, WS_HN) + (size_t)(blk * 64 + F.wave * 8 + rr0 + q) * D) + F.lane;
#pragma unroll
                for (int j = 0; j < 4; ++j) { v[q][j] = v[q][j] * rstd * sc[j] + sh[j]; { v2u w; w.x = pk2(v[q][j].x, v[q][j].y); w.y = pk2(v[q][j].z, v[q][j].w); o8[64 * j] = w; } } }
#pragma unroll
            for (int j = 0; j < 4; ++j)
#pragma unroll
                for (int c = 0; c < 4; ++c) { const LAS f32x4* wp = (const LAS f32x4*)(wr_l + (4 * F.lane + 256 * j + c) * 8); const f32x4 w0 = wp[0], w1 = wp[1];
#pragma unroll
                    for (int q = 0; q < 4; ++q) { const float yq = v[q][j][c];
                        lg[q][0] += yq * w0.x; lg[q][1] += yq * w0.y; lg[q][2] += yq * w0.z; lg[q][3] += yq * w0.w; lg[q][4] += yq * w1.x; lg[q][5] += yq * w1.y; lg[q][6] += yq * w1.z; lg[q][7] += yq * w1.w; } }
#pragma unroll
            for (int o = 1; o < 64; o <<= 1)
#pragma unroll
                for (int q = 0; q < 4; ++q)
#pragma unroll
                    for (int e = 0; e < 8; ++e) lg[q][e] += __shfl_xor(lg[q][e], o);
#pragma unroll
            for (int q = 0; q < 4; ++q) { const int rl = F.wave * 8 + rr0 + q;
                float mx = lg[q][0];
#pragma unroll
                for (int e = 1; e < 8; ++e) mx = fmaxf(mx, lg[q][e]);
                float p[8], sm = 0.f;
#pragma unroll
                for (int e = 0; e < 8; ++e) { p[e] = expf(lg[q][e] - mx); sm += p[e]; }
                int i0 = 0; float v0 = -1.f;
#pragma unroll
                for (int e = 0; e < 8; ++e) { p[e] = p[e] / sm; if (p[e] > v0) { v0 = p[e]; i0 = e; } }
                int i1 = 0; float v1 = -1.f;
#pragma unroll
                for (int e = 0; e < 8; ++e) if (e != i0 && p[e] > v1) { v1 = p[e]; i1 = e; }
                if (F.lane == 0) { const float s2 = v0 + v1; rowE[rl * 2] = i0; rowE[rl * 2 + 1] = i1; rowW[rl * 2] = v0 / s2; rowW[rl * 2 + 1] = v1 / s2; } }
        }
        __syncthreads();
        if (F.wave == 0) {
            int cnt[8];
#pragma unroll
            for (int e = 0; e < 8; ++e) cnt[e] = 0;
#pragma unroll
            for (int ch = 0; ch < 2; ++ch) { const int a = ch * 64 + F.lane, ea = rowE[a]; int pos = 0;
#pragma unroll
                for (int e = 0; e < 8; ++e) { const unsigned long long mk = __ballot(ea == e); if (ea == e) pos = cnt[e] + __popcll(mk & ((1ull << F.lane) - 1ull)); cnt[e] += __popcll(mk); }
                rowP[a] = pos; }
            if (F.lane == 0) {
#pragma unroll
                for (int e = 0; e < 8; ++e) lcnt[e] = cnt[e]; } }
        __syncthreads();
        if (F.tid < 128) { const size_t g = (size_t)blk * 128 + F.tid; WSP(int, WS_TOKE)[g] = rowE[F.tid]; WSP(int, WS_TOKP)[g] = rowP[F.tid]; WSP(float, WS_TOKW)[g] = rowW[F.tid]; }
        if (F.tid < 8) WSP(int, WS_CNTWG)[blk * 8 + F.tid] = lcnt[F.tid];
        __syncthreads();
    }
}
__device__ __forceinline__ void gather_phase(Frame& F) {
    LAS int* boff = (LAS int*)(F.lds);
    for (int blk = blockIdx.x; blk < M / 64; blk += F.G) {
        { const int mine = moe_count_prefix(F, blk, (LAS int*)(F.lds + 65536)); if (F.tid < 8) boff[F.tid] = mine + (int)F.MISC[33 + F.tid]; }
        __syncthreads();
        {
            int slot = 0;
            if (F.lane < 16) { const size_t g = (size_t)blk * 128 + F.wave * 16 + F.lane; slot = boff[WSP(int, WS_TOKE)[g]] + WSP(int, WS_TOKP)[g]; WSP(int, WS_TOKS)[g] = slot; }
            v4u r0[8], r1[8];
#pragma unroll
            for (int tk = 0; tk < 8; ++tk) { const GAS v4u* src = (const GAS v4u*)(WSP(bf16, WS_HN) + (size_t)(blk * 64 + F.wave * 8 + tk) * D); r0[tk] = src[F.lane]; r1[tk] = src[64 + F.lane]; }
#pragma unroll
            for (int tk = 0; tk < 8; ++tk) {
#pragma unroll
                for (int k = 0; k < 2; ++k) { const int s = __shfl(slot, 2 * tk + k); GAS v4u* dst = (GAS v4u*)(WSP(bf16, WS_HP) + (size_t)s * D); dst[F.lane] = r0[tk]; dst[64 + F.lane] = r1[tk]; } }
        }
        __syncthreads();
    }
    for (int e = 0; e < 8; ++e) { const int r0 = (int)F.MISC[33 + e] + (int)F.MISC[16 + e], r1 = (int)F.MISC[34 + e];
        for (int r = r0 + F.gw; r < r1; r += F.NGW) { GAS v4u* dst = (GAS v4u*)(WSP(bf16, WS_HP) + (size_t)r * D); dst[F.lane] = (v4u){0u, 0u, 0u, 0u}; dst[64 + F.lane] = (v4u){0u, 0u, 0u, 0u}; } }
}
template <typename TX> __device__ __forceinline__ void final_phase(Frame& F, const TX* X, int l) {
    const bf16* Y = WSP(bf16, WS_HP); const float* mf = WSP(float, WS_MODF);
    f32x4 fn[4];
#pragma unroll
    for (int j = 0; j < 4; ++j) fn[j] = *(const f32x4*)(F.in[18] + 4 * F.lane + 256 * j);
    for (int b = 0; b < NB; ++b) {
        f32x4 gf[4];
#pragma unroll
        for (int j = 0; j < 4; ++j) gf[j] = *(const f32x4*)(mf + (size_t)(l * 2 + b) * 6 * D + 5 * D + 4 * F.lane + 256 * j);
        for (int row = b * SEQ + F.gw; row < (b + 1) * SEQ; row += 4 * F.NGW) {
            int s0[4], s1[4]; float w0[4], w1[4]; bool ok[4]; int rq[4];
#pragma unroll
            for (int q = 0; q < 4; ++q) { ok[q] = row + q * F.NGW < (b + 1) * SEQ; rq[q] = ok[q] ? row + q * F.NGW : row;
                s0[q] = WSP(int, WS_TOKS)[rq[q] * 2]; s1[q] = WSP(int, WS_TOKS)[rq[q] * 2 + 1]; w0[q] = WSP(float, WS_TOKW)[rq[q] * 2]; w1[q] = WSP(float, WS_TOKW)[rq[q] * 2 + 1]; }
            f32x4 xv[4][4]; v2u ya[4][4], yc[4][4];
#pragma unroll
            for (int q = 0; q < 4; ++q) { const GAS v2u* y0 = (const GAS v2u*)(Y + (size_t)s0[q] * D) + F.lane; const GAS v2u* y1 = (const GAS v2u*)(Y + (size_t)s1[q] * D) + F.lane;
#pragma unroll
                for (int j = 0; j < 4; ++j) { xv[q][j] = XRow<TX>::ld(X, (size_t)rq[q], 4 * F.lane + 256 * j); ya[q][j] = y0[64 * j]; yc[q][j] = y1[64 * j]; } }
            float ss[4];
#pragma unroll
            for (int q = 0; q < 4; ++q) { ss[q] = 0.f;
#pragma unroll
                for (int j = 0; j < 4; ++j) { const f32x4 a = {bflo(ya[q][j].x), bfhi(ya[q][j].x), bflo(ya[q][j].y), bfhi(ya[q][j].y)}, c = {bflo(yc[q][j].x), bfhi(yc[q][j].x), bflo(yc[q][j].y), bfhi(yc[q][j].y)};
                    xv[q][j] = xv[q][j] + gf[j] * (a * w0[q] + c * w1[q]); ss[q] += (xv[q][j].x * xv[q][j].x + xv[q][j].y * xv[q][j].y) + (xv[q][j].z * xv[q][j].z + xv[q][j].w * xv[q][j].w); } }
#pragma unroll
            for (int o = 1; o < 64; o <<= 1)
#pragma unroll
                for (int q = 0; q < 4; ++q) ss[q] += __shfl_xor(ss[q], o);
#pragma unroll
            for (int q = 0; q < 4; ++q) if (ok[q]) { const float rstd = rsqrtf(ss[q] * (1.f / D) + NORM_EPS); GAS f32x4* o = (GAS f32x4*)(F.out + (size_t)(row + q * F.NGW) * D) + F.lane;
#pragma unroll
                for (int j = 0; j < 4; ++j) o[64 * j] = xv[q][j] * rstd * fn[j]; }
        }
    }
}

constexpr int N_PHASES = 19;
struct Args { const float* in[19]; float* out; unsigned char* ws; int ph_lo, ph_hi; };
__global__ void __launch_bounds__(NTHREADS, 2) mk_fwd(Args args) {
    extern __shared__ __attribute__((aligned(16))) unsigned char lds[];
    Frame F;
    F.lds = (LAS unsigned char*)lds; F.MISC = (volatile LAS unsigned*)(F.lds + MISC_OFF);
    F.tid = threadIdx.x; F.lane = F.tid & 63; F.wave = __builtin_amdgcn_readfirstlane(F.tid >> 6);
    F.G = gridDim.x; { const int bx = blockIdx.x; F.vcu = (F.G % 8 == 0) ? (bx % 8) * (F.G / 8) + bx / 8 : bx; }
    F.gw = F.vcu * NWAVES + F.wave; F.NGW = F.G * NWAVES;
#pragma unroll
    for (int i = 0; i < 19; ++i) F.in[i] = args.in[i];
    F.out = args.out; F.ws = args.ws;
    for (int u = F.tid; u < (LDS_BYTES - MISC_OFF) / 4; u += NTHREADS) ((LAS unsigned*)(F.lds + MISC_OFF))[u] = 0u;
    __syncthreads();
    XcdBarrier bar; bar.bar = WSP(unsigned, WS_CTL) + 1024; bar.x = 0; bar.st = nullptr;
    if (!MK_PHASED) bar = xcd_barrier_post(WSP(unsigned, WS_CTL) + 1024, F.MISC + 8);
    const int lo = args.ph_lo, hi = args.ph_hi;
#ifdef MK_ONLY
#define IN(k) ((k) == MK_ONLY && lo <= (k) && (k) < hi)
#else
#define IN(k) (lo <= (k) && (k) < hi)
#endif
#define REFRESH() do { int t_ = threadIdx.x; asm volatile("" : "+v"(t_)); F.tid = t_; F.lane = t_ & 63; } while (0)
#define SEAM(k) do { if (IN(k) && IN((k) + 1)) xcd_barrier(bar); } while (0)
    bf16* XA = WSP(bf16, WS_XA); bf16* XB = (bf16*)F.out; const float* MODF = WSP(float, WS_MODF);
    bf16* HN = WSP(bf16, WS_HN);
    LAS unsigned char* ring = F.lds;

    if (IN(0)) for (int rep_ = 0; rep_ < REP(0); ++rep_) { REFRESH(); p0_prologue(F); } SEAM(0);
    if (IN(1)) for (int rep_ = 0; rep_ < REP(1); ++rep_) { REFRESH(); modulate_phase<true, float>(F, F.in[0], 0, 0, HN); modf_reduce(F); } SEAM(1);
    if (IN(2)) for (int rep_ = 0; rep_ < REP(2); ++rep_) { REFRESH();
        { pg8::Gemm g{HN, WSP(bf16, WS_WQK), M, 2048, D}; pg8::StaticOrder S; S.init(M, 2048, F.G, (int)blockIdx.x);
          pg8::EpiBf16P E{WSP(bf16, WS_Q0), D, 8, 4, (size_t)(WS_K0 - WS_Q0) / 2, 0.125f * LOG2E, 0, 1};
          pg8::gemm_phase<pg8::EpiBf16P, pg8::StaticOrder, true, true>(ring, g, S, E); }
        { pg8::Gemm g{WSP(bf16, WS_WV), HN, D, M, D}; pg8::StaticOrder S; S.init(D, M, F.G, (int)blockIdx.x);
          pg8::EpiBf16P E{WSP(bf16, WS_VT0), M, 64, 0, 0, 1.f, 2, 2};
          pg8::gemm_phase<pg8::EpiBf16P, pg8::StaticOrder, true, true>(ring, g, S, E); }
    } SEAM(2);
    if (IN(3)) for (int rep_ = 0; rep_ < REP(3); ++rep_) { REFRESH(); na_phase(F); } SEAM(3);
    if (IN(4)) for (int rep_ = 0; rep_ < REP(4); ++rep_) { REFRESH(); pg8::Gemm g{WSP(bf16, WS_O0), WSP(bf16, WS_WO0), M, D, D}; pg8::StaticOrder S; S.init(M, D, F.G, (int)blockIdx.x);
        pg8::EpiResGateB<true> E{F.in[0], XA, MODF + 0 * 12 * D + 2 * D};
        pg8::gemm_phase<pg8::EpiResGateB<true>, pg8::StaticOrder, true, true>(ring, g, S, E); } SEAM(4);
    if (IN(5)) for (int rep_ = 0; rep_ < REP(5); ++rep_) { REFRESH(); modulate_phase<false, bf16>(F, XA, 0, 3, HN); } SEAM(5);
    if (IN(6)) for (int rep_ = 0; rep_ < REP(6); ++rep_) { REFRESH(); pg8::Gemm g{HN, WSP(bf16, WS_WGU0), M, 2 * FFN, D}; pg8::StaticOrder S; S.init(M, 2 * FFN, F.G, (int)blockIdx.x);
        pg8::EpiSwiGLU E{WSP(bf16, WS_ACT0), FFN, 22};
        pg8::gemm_phase<pg8::EpiSwiGLU, pg8::StaticOrder, true, true>(ring, g, S, E);
        moe_w_side(F, MOE_ITEMS - MOE_G1 - MOE_G2 - MOE_G3, MOE_ITEMS - MOE_G2 - MOE_G3, 128); } SEAM(6);
    if (IN(7)) for (int rep_ = 0; rep_ < REP(7); ++rep_) { REFRESH(); pg8::Gemm g{WSP(bf16, WS_ACT0), WSP(bf16, WS_WDN0), M, D, FFN}; pg8::StaticOrder S; S.init(M, D, F.G, (int)blockIdx.x);
        pg8::EpiResGateB<false> E{XA, XB, MODF + 0 * 12 * D + 5 * D};
        pg8::gemm_phase<pg8::EpiResGateB<false>, pg8::StaticOrder, true, true>(ring, g, S, E); } SEAM(7);
    if (IN(8)) for (int rep_ = 0; rep_ < REP(8); ++rep_) { REFRESH(); modulate_phase<false, bf16>(F, XB, 1, 0, HN); } SEAM(8);
    const bool fusedmid = (F.G >= 128);
    if (IN(9)) for (int rep_ = 0; rep_ < REP(9); ++rep_) { REFRESH(); pg8::Gemm g{HN, WSP(bf16, WS_WMD), M, DOWN_NP, D}; pg8::StaticOrder S; S.init(M, DOWN_NP, F.G, (int)blockIdx.x);
        if (fusedmid) { pg8::EpiMlaMid E{WSP(bf16, WS_CQ), WSP(bf16, WS_CKV), WSP(bf16, WS_KR), F.in[10], F.in[12], WSP(float, WS_ROPER), WSP(float, WS_ROPEC), NORM_EPS};
            pg8::gemm_phase<pg8::EpiMlaMid, pg8::StaticOrder, false, true>(ring, g, S, E); }
        else { pg8::EpiF32 E{WSP(float, WS_DOWN), DOWN_NP};
            pg8::gemm_phase<pg8::EpiF32, pg8::StaticOrder, true, true>(ring, g, S, E); }
        moe_w_side(F, MOE_ITEMS - MOE_G2 - MOE_G3, MOE_ITEMS - MOE_G3, 128); } SEAM(9);
    if (IN(10) && !fusedmid) for (int rep_ = 0; rep_ < REP(10); ++rep_) { REFRESH(); mla_mid_phase(F); }
    if (!fusedmid) SEAM(10);
    if (IN(11)) for (int rep_ = 0; rep_ < REP(11); ++rep_) { REFRESH(); int kq = 256; asm volatile("" : "+s"(kq));
        { pg8::Gemm g{WSP(bf16, WS_CQ), WSP(bf16, WS_WUQ), M, 1536, kq}; pg8::StaticOrder S; S.init(M, 1536, F.G, (int)blockIdx.x);
          pg8::EpiQRope E{WSP(bf16, WS_Q1), WSP(float, WS_ROPER), WSP(float, WS_ROPEC), QSCALE1};
          pg8::gemm_phase<pg8::EpiQRope, pg8::StaticOrder, true, true>(ring, g, S, E); }
        { pg8::Gemm g{WSP(bf16, WS_CKV), WSP(bf16, WS_WKN), M, D, kq >> 1}; pg8::StaticOrder S; S.init(M, D, F.G, (int)blockIdx.x);
          pg8::EpiBf16P E{WSP(bf16, WS_KN), D, 4, 0, 0, 1.f, 1, 1};
          pg8::gemm_phase<pg8::EpiBf16P, pg8::StaticOrder, true, true>(ring, g, S, E); }
        { pg8::Gemm g{WSP(bf16, WS_WVV), WSP(bf16, WS_CKV), D, M, kq >> 1}; pg8::StaticOrder S; S.init(D, M, F.G, (int)blockIdx.x);
          pg8::EpiBf16P E{WSP(bf16, WS_VT1), M, 64, 0, 0, 1.f, 2, 2};
          pg8::gemm_phase<pg8::EpiBf16P, pg8::StaticOrder, true, true>(ring, g, S, E); }
    } SEAM(11);
    if (IN(12)) for (int rep_ = 0; rep_ < REP(12); ++rep_) { REFRESH();
        for (int u = F.vcu; u < NB * NH * (SEQ / 256); u += F.G) { const int a = u >> 8, r = u & 255, bh = r >> 3, qb = (r & 7) * 4 + a;
            mla::unit(bh >> 4, bh & 15, qb, WSP(bf16, WS_Q1), WSP(bf16, WS_KN), WSP(bf16, WS_KR), WSP(bf16, WS_VT1), WSP(bf16, WS_O1), ring); }
    } SEAM(12);
    if (IN(13)) for (int rep_ = 0; rep_ < REP(13); ++rep_) { REFRESH(); pg8::Gemm g{WSP(bf16, WS_O1), WSP(bf16, WS_WO1), M, D, D}; pg8::StaticOrder S; S.init(M, D, F.G, (int)blockIdx.x);
        pg8::EpiResGateB<false> E{XB, XA, MODF + 1 * 12 * D + 2 * D};
        pg8::gemm_phase<pg8::EpiResGateB<false>, pg8::StaticOrder, true, true>(ring, g, S, E); } SEAM(13);
    if (IN(14)) for (int rep_ = 0; rep_ < REP(14); ++rep_) { REFRESH(); router_phase<bf16>(F, XA, 1, 3); } SEAM(14);
    if (IN(15)) for (int rep_ = 0; rep_ < REP(15); ++rep_) { REFRESH(); moe_tables(F); gather_phase(F); } SEAM(15);
    if (IN(16)) for (int rep_ = 0; rep_ < REP(16); ++rep_) { REFRESH(); moe_tables(F);
        pg8::MoeOrder S{(int)F.MISC[32], 14, F.G, (int)blockIdx.x, (int)F.MISC[25], (int)F.MISC[26], (int)F.MISC[27], (int)F.MISC[28], (int)F.MISC[29], (int)F.MISC[30], (int)F.MISC[31]};
        pg8::Gemm g{WSP(bf16, WS_HP), WSP(bf16, WS_WGU1), MP_MAX, NE * 2 * ED, D};
        pg8::EpiSwiGLU E{WSP(bf16, WS_ACT1), ED, 14};
        pg8::gemm_phase<pg8::EpiSwiGLU, pg8::MoeOrder, true, true>(ring, g, S, E);
        moe_w_side(F, MOE_ITEMS - MOE_G3, MOE_ITEMS, 112); } SEAM(16);
    if (IN(17)) for (int rep_ = 0; rep_ < REP(17); ++rep_) { REFRESH(); moe_tables(F);
        pg8::MoeOrder S{(int)F.MISC[32], 4, F.G, (int)blockIdx.x, (int)F.MISC[25], (int)F.MISC[26], (int)F.MISC[27], (int)F.MISC[28], (int)F.MISC[29], (int)F.MISC[30], (int)F.MISC[31]};
        pg8::Gemm g{WSP(bf16, WS_ACT1), WSP(bf16, WS_WDN1), MP_MAX, NE * D, ED};
        pg8::EpiBf16P E{WSP(bf16, WS_HP), D, 4, 0, 0, 1.f, 0, 0};
        pg8::gemm_phase<pg8::EpiBf16P, pg8::MoeOrder, true, true>(ring, g, S, E); } SEAM(17);
    if (IN(18)) for (int rep_ = 0; rep_ < REP(18); ++rep_) { REFRESH(); final_phase<bf16>(F, XA, 1); }
#undef IN
#undef SEAM
}

extern "C" void kernel_launch(void* const* d_in, const int* in_sizes, int n_in, void* d_out, int out_size, void* d_ws, size_t ws_size, hipStream_t stream) {
    static int grid = 0;
    if (grid == 0) {
        if (n_in != 19 || in_sizes[0] != M * D || out_size != M * D || ws_size < WS_END) { fprintf(stderr, "kernel_launch: shape mismatch (n_in %d, ws %zu)\n", n_in, ws_size); grid = -1; return; }
        int dev = 0, cus = 0, per_cu = 0;
        if (hipGetDevice(&dev) != hipSuccess || hipDeviceGetAttribute(&cus, hipDeviceAttributeMultiprocessorCount, dev) != hipSuccess) { grid = -1; return; }
        if (hipFuncSetAttribute((const void*)mk_fwd, hipFuncAttributeMaxDynamicSharedMemorySize, LDS_BYTES) != hipSuccess) { fprintf(stderr, "kernel_launch: hipFuncSetAttribute failed\n"); grid = -1; return; }
        if (hipOccupancyMaxActiveBlocksPerMultiprocessor(&per_cu, (const void*)mk_fwd, NTHREADS, LDS_BYTES) != hipSuccess || per_cu < 1) fprintf(stderr, "kernel_launch: occupancy query says %d\n", per_cu);
        (void)hipGetLastError();
        grid = cus;
    }
    if (grid < 0) return;
    (void)hipMemsetAsync((char*)d_ws + WS_CTL, 0, CTL_ZERO_BYTES, stream);
    Args a{};
    for (int i = 0; i < 19; ++i) a.in[i] = (const float*)d_in[i];
    a.out = (float*)d_out; a.ws = (unsigned char*)d_ws;
#if MK_PHASED
    for (int p = 0; p < N_PHASES; ++p) { a.ph_lo = p; a.ph_hi = p + 1; hipLaunchKernelGGL(mk_fwd, dim3(grid), dim3(NTHREADS), LDS_BYTES, stream, a);
#if MK_CHECK == 1
        if (p == 3) hipLaunchKernelGGL(chk_na, dim3(M * NH / 4), dim3(256), 0, stream, (const bf16*)(a.ws + WS_Q0), (const bf16*)(a.ws + WS_K0), (const bf16*)(a.ws + WS_VT0), (const bf16*)(a.ws + WS_O0), a.in[5], (float*)(a.ws + WS_CTL + 32768));
#elif MK_CHECK == 2
        if (p == 12) hipLaunchKernelGGL(chk_mla, dim3(512 * 16), dim3(64), 0, stream, (const bf16*)(a.ws + WS_Q1), (const bf16*)(a.ws + WS_KN), (const bf16*)(a.ws + WS_KR), (const bf16*)(a.ws + WS_VT1), (const bf16*)(a.ws + WS_O1), (float*)(a.ws + WS_CTL + 32768));
#elif MK_CHECK == 3
        if (p == 11) hipLaunchKernelGGL(chk_proj, dim3(256), dim3(256), 0, stream, (const float*)(a.ws + WS_DOWN), a.in[10], a.in[12], a.in[11], a.in[13], (const bf16*)(a.ws + WS_Q1), (const bf16*)(a.ws + WS_KR), (const bf16*)(a.ws + WS_KN), (const bf16*)(a.ws + WS_VT1), (float*)(a.ws + WS_CTL + 32768));
#endif
    }
#if MK_CHECK == 3
    hipLaunchKernelGGL(chk_tweak4, dim3(M * D / 256), dim3(256), 0, stream, a.out, (const float*)(a.ws + WS_CTL + 32768), 1000.f);
#elif MK_CHECK
    hipLaunchKernelGGL(chk_tweak, dim3(M * D / 256), dim3(256), 0, stream, a.out, (const float*)(a.ws + WS_CTL + 32768), 1000.f);
#endif
#else
    a.ph_lo = 0; a.ph_hi = N_PHASES; hipLaunchKernelGGL(mk_fwd, dim3(grid), dim3(NTHREADS), LDS_BYTES, stream, a);
#endif
}
```

```cpp
#include <hip/hip_runtime.h>
#include <cstdio>
#include <cstdint>
namespace pg8 {
#define PG8_LAS __attribute__((address_space(3)))
typedef unsigned short bf16_t;
typedef short bf16x8 __attribute__((ext_vector_type(8)));
typedef float f32x4 __attribute__((ext_vector_type(4)));
typedef unsigned u32x4 __attribute__((ext_vector_type(4)));
constexpr int BM = 256, BK = 64, HALF = 128, HTB = HALF * BK * 2  , STAGE_BYTES = 8 * HTB, NXCD = 8, WGM = 8;

__host__ __device__ __forceinline__ int lds_byte(int r, int c) { const int st = (r >> 4) * 2 + (c >> 5), rr = r & 15, cc = c & 31, ob = rr * 64 + cc * 2; return st * 1024 + (ob ^ (((ob >> 9) & 1) << 5)); }
__host__ __device__ __forceinline__ void stage_rc(int b, int& R, int& C) { const int st = b / 1024, sb = b % 1024, swz = sb ^ (((sb >> 9) & 1) << 5); R = (st >> 1) * 16 + swz / 64; C = (st & 1) * 32 + (swz % 64) / 2; }
__host__ __device__ __forceinline__ int perm32(int rho) { const int n = rho >> 4, i = rho & 15; return 8 * (i >> 2) + 4 * n + (i & 3); }

struct Unit { int pm, pn; };
struct Gemm { const bf16_t* A; const bf16_t* Bt; int M, N, K; };

struct StaticOrder {
    int nM, nN, nwg, G, c;
    __host__ __device__ void init(int M, int N, int G_, int c_) { nM = M / BM; nN = N / BM; nwg = nM * nN; G = G_; c = c_; }
    __host__ __device__ bool next(int i, Unit& u) const {
        const long L = (long)i * G + c; if (L >= nwg) return false;
        int wgid = (int)L; { const int q = nwg / NXCD, r = nwg % NXCD, xcd = wgid % NXCD, off = wgid / NXCD; wgid = (xcd < r ? xcd * (q + 1) : r * (q + 1) + (xcd - r) * q) + off; }
        const int nig = WGM * nN, gid = wgid / nig, fm = gid * WGM, gsz = (nM - fm) < WGM ? (nM - fm) : WGM;
        u.pm = fm + ((wgid % nig) % gsz); u.pn = (wgid % nig) / gsz; return true;
    }
    __device__ __forceinline__ void a_ready(const Unit&) const {}
    __device__ __forceinline__ void done(const Unit&) const {}
};

__device__ __forceinline__ unsigned cvt_pk_bf16(float lo, float hi) { unsigned r; asm volatile("v_cvt_pk_bf16_f32 %0, %1, %2" : "=v"(r) : "v"(lo), "v"(hi)); return r; }

__device__ __forceinline__ float fast_silu(float g) { return g * __builtin_amdgcn_rcpf(1.f + __builtin_amdgcn_exp2f(-1.4426950408889634f * g)); }
struct EpiBf16P {
    static constexpr bool PERM = true, AFTER_DRAIN = false;
    bf16_t* O; int ldc; int nct; int st; size_t sstride; float scale0; int mode0, mode1;
    __device__ __forceinline__ void operator()(const f32x4 (&acc)[2][2][4][2], const Unit& u, int wr, int wc, int fr, int fq) const {
        int ct = u.pn % nct; bf16_t* base = O; float sc = 1.f; int mode = mode0;
        if (st) { const int t = ct / st; base += (size_t)t * sstride; ct -= t * st; if (t == 0) sc = scale0; else mode = mode1; }
        const int row0 = u.pm * BM + wr * 64 + fr, col0 = ct * BM + wc * 32 + 8 * fq;
#pragma unroll
        for (int ai = 0; ai < 2; ++ai)
#pragma unroll
            for (int m = 0; m < 4; ++m) { const int row = row0 + ai * HALF + m * 16;
#pragma unroll
                for (int bj = 0; bj < 2; ++bj) { const f32x4 v0 = acc[ai][bj][m][0] * sc, v1 = acc[ai][bj][m][1] * sc; const int col = col0 + bj * HALF;
                    u32x4 w; w.x = cvt_pk_bf16(v0[0], v0[1]); w.y = cvt_pk_bf16(v0[2], v0[3]); w.z = cvt_pk_bf16(v1[0], v1[1]); w.w = cvt_pk_bf16(v1[2], v1[3]);
                    bf16_t* p = mode == 0 ? base + (size_t)row * ldc + col : base + ((size_t)(col >> 6) * (mode == 1 ? 16384 : 1024) + row) * 64 + (col & 63);
                    *(u32x4*)p = w; } }
    }
};
struct EpiResGate {
    static constexpr bool PERM = false, AFTER_DRAIN = false;
    const float* res; float* out; const float* gate;
    __device__ __forceinline__ void operator()(const f32x4 (&acc)[2][2][4][2], const Unit& u, int wr, int wc, int fr, int fq) const {
        const int row0 = u.pm * BM + wr * 64 + fr, col0 = u.pn * BM + wc * 32 + 4 * fq;
        const float* gp = gate + (size_t)((u.pm * BM) >> 13) * 6144 + col0;
        f32x4 gv[2][2];
#pragma unroll
        for (int bj = 0; bj < 2; ++bj)
#pragma unroll
            for (int n = 0; n < 2; ++n) gv[bj][n] = *(const f32x4*)(gp + bj * HALF + n * 16);
#pragma unroll
        for (int ai = 0; ai < 2; ++ai)
#pragma unroll
            for (int m = 0; m < 4; ++m) { const size_t off = (size_t)(row0 + ai * HALF + m * 16) * 1024 + col0;
#pragma unroll
                for (int bj = 0; bj < 2; ++bj)
#pragma unroll
                    for (int n = 0; n < 2; ++n) { const f32x4 rs = *(const f32x4*)(res + off + bj * HALF + n * 16);
                        *(f32x4*)(out + off + bj * HALF + n * 16) = rs + gv[bj][n] * acc[ai][bj][m][n]; } }
    }
};
template <bool RES_F32> struct EpiResGateB {
    static constexpr bool PERM = true, AFTER_DRAIN = false;
    const void* res; bf16_t* out; const float* gate;
    __device__ __forceinline__ void operator()(const f32x4 (&acc)[2][2][4][2], const Unit& u, int wr, int wc, int fr, int fq) const {
        const int row0 = u.pm * BM + wr * 64 + fr, col0 = u.pn * BM + wc * 32 + 8 * fq;
        const float* gp = gate + (size_t)((u.pm * BM) >> 13) * 6144 + col0;
        f32x4 gv[2][2];
#pragma unroll
        for (int bj = 0; bj < 2; ++bj)
#pragma unroll
            for (int n = 0; n < 2; ++n) gv[bj][n] = *(const f32x4*)(gp + bj * HALF + 4 * n);
#pragma unroll
        for (int ai = 0; ai < 2; ++ai)
#pragma unroll
            for (int m = 0; m < 4; ++m) { const size_t off = (size_t)(row0 + ai * HALF + m * 16) * 1024 + col0;
#pragma unroll
                for (int bj = 0; bj < 2; ++bj) { f32x4 r0, r1;
                    if (RES_F32) { const float* rp = (const float*)res + off + bj * HALF; r0 = *(const f32x4*)rp; r1 = *(const f32x4*)(rp + 4); }
                    else { const u32x4 w = *(const u32x4*)((const bf16_t*)res + off + bj * HALF);
                        r0 = (f32x4){__builtin_bit_cast(float, w.x << 16), __builtin_bit_cast(float, w.x & 0xffff0000u), __builtin_bit_cast(float, w.y << 16), __builtin_bit_cast(float, w.y & 0xffff0000u)};
                        r1 = (f32x4){__builtin_bit_cast(float, w.z << 16), __builtin_bit_cast(float, w.z & 0xffff0000u), __builtin_bit_cast(float, w.w << 16), __builtin_bit_cast(float, w.w & 0xffff0000u)}; }
                    const f32x4 v0 = r0 + gv[bj][0] * acc[ai][bj][m][0], v1 = r1 + gv[bj][1] * acc[ai][bj][m][1];
                    u32x4 o; o.x = cvt_pk_bf16(v0[0], v0[1]); o.y = cvt_pk_bf16(v0[2], v0[3]); o.z = cvt_pk_bf16(v1[0], v1[1]); o.w = cvt_pk_bf16(v1[2], v1[3]);
                    *(u32x4*)(out + off + bj * HALF) = o; } }
    }
};
struct EpiF32 {
    static constexpr bool PERM = false, AFTER_DRAIN = false;
    float* O; int ldc;
    __device__ __forceinline__ void operator()(const f32x4 (&acc)[2][2][4][2], const Unit& u, int wr, int wc, int fr, int fq) const {
        const int row0 = u.pm * BM + wr * 64 + fr, col0 = u.pn * BM + wc * 32 + 4 * fq;
#pragma unroll
        for (int ai = 0; ai < 2; ++ai)
#pragma unroll
            for (int m = 0; m < 4; ++m) { float* rowp = O + (size_t)(row0 + ai * HALF + m * 16) * ldc + col0;
#pragma unroll
                for (int bj = 0; bj < 2; ++bj)
#pragma unroll
                    for (int n = 0; n < 2; ++n) *(f32x4*)(rowp + bj * HALF + n * 16) = acc[ai][bj][m][n]; }
    }
};
struct EpiMlaMid {
    static constexpr bool PERM = false, AFTER_DRAIN = true;
    bf16_t* CQ; bf16_t* CKV; bf16_t* KRo; const float* qn; const float* kvn; const float* ropeR; const float* ropeC; float eps;
    __device__ __forceinline__ void fused(f32x4 (&acc)[2][2][4][2], const Unit& u, int wr, int wc, int fr, int fq, PG8_LAS unsigned char* lds, int wid, int lane) const {
        typedef unsigned u32x2v __attribute__((ext_vector_type(2)));
        PG8_LAS f32x4* P = (PG8_LAS f32x4*)lds;
        const bool isq = (u.pn == 0);
#pragma unroll
        for (int ai = 0; ai < 2; ++ai)
#pragma unroll
            for (int m = 0; m < 4; ++m) { float s = 0.f;
#pragma unroll
                for (int n = 0; n < 2; ++n) { const f32x4 x = acc[ai][0][m][n]; s += (x[0] * x[0] + x[1] * x[1]) + (x[2] * x[2] + x[3] * x[3]); }
                if (isq) {
#pragma unroll
                    for (int n = 0; n < 2; ++n) { const f32x4 x = acc[ai][1][m][n]; s += (x[0] * x[0] + x[1] * x[1]) + (x[2] * x[2] + x[3] * x[3]); } }
                s += __shfl_xor(s, 16); s += __shfl_xor(s, 32);
                if (fq == 0) ((PG8_LAS float*)P)[(ai * HALF + wr * 64 + m * 16 + fr) * 4 + wc] = s; }
        asm volatile("s_waitcnt lgkmcnt(0)" ::: "memory"); __builtin_amdgcn_s_barrier(); asm volatile("" ::: "memory");
        const int colw = wc * 32 + 4 * fq;
#pragma unroll
        for (int ai = 0; ai < 2; ++ai)
#pragma unroll
            for (int m = 0; m < 4; ++m) { const int rl = ai * HALF + wr * 64 + m * 16 + fr, row = u.pm * BM + rl; const f32x4 p4 = P[rl];
                const float tot = (p4[0] + p4[1]) + (p4[2] + p4[3]);
                if (isq) { const float rstd = 1.0f / sqrtf(tot * (1.0f / 256.0f) + eps);
#pragma unroll
                    for (int bj = 0; bj < 2; ++bj)
#pragma unroll
                        for (int n = 0; n < 2; ++n) { const int c = bj * HALF + colw + 16 * n; const f32x4 g = *(const f32x4*)(qn + c); const f32x4 y = acc[ai][bj][m][n] * rstd * g;
                            u32x2v w; w.x = cvt_pk_bf16(y[0], y[1]); w.y = cvt_pk_bf16(y[2], y[3]); *(u32x2v*)(CQ + (size_t)row * 256 + c) = w; } }
                else { const float rstd = 1.0f / sqrtf(tot * (1.0f / 128.0f) + eps);
#pragma unroll
                    for (int n = 0; n < 2; ++n) { const int c = colw + 16 * n; const f32x4 g = *(const f32x4*)(kvn + c); const f32x4 y = acc[ai][0][m][n] * rstd * g;
                        u32x2v w; w.x = cvt_pk_bf16(y[0], y[1]); w.y = cvt_pk_bf16(y[2], y[3]); *(u32x2v*)(CKV + (size_t)row * 128 + c) = w; }
                    if (wc == 0) { const int t = row & 8191;
#pragma unroll
                        for (int n = 0; n < 2; ++n) { const int d = 16 * n + 4 * fq;
                            const float* tb = n == 0 ? ropeR + (t >> 6) * 16 + d : ropeC + (t & 63) * 16 + (d - 16);
                            const f32x4 cs = *(const f32x4*)tb; const f32x4 x = acc[ai][1][m][n];
                            u32x2v w; w.x = cvt_pk_bf16(x[0] * cs[0] - x[1] * cs[1], x[0] * cs[1] + x[1] * cs[0]); w.y = cvt_pk_bf16(x[2] * cs[2] - x[3] * cs[3], x[2] * cs[3] + x[3] * cs[2]);
                            *(u32x2v*)(KRo + (size_t)row * 32 + d) = w; } } } }
    }
};
struct EpiSwiGLU {
    static constexpr bool PERM = true, AFTER_DRAIN = false;
    bf16_t* O; int ldc; int nN;
    __device__ __forceinline__ void operator()(const f32x4 (&acc)[2][2][4][2], const Unit& u, int wr, int wc, int fr, int fq) const {
        const int row0 = u.pm * BM + wr * 64 + fr, col0 = (u.pn % nN) * HALF + wc * 32 + 8 * fq;
#pragma unroll
        for (int ai = 0; ai < 2; ++ai)
#pragma unroll
            for (int m = 0; m < 4; ++m) {
                const f32x4 g0 = acc[ai][0][m][0], g1 = acc[ai][0][m][1], u0 = acc[ai][1][m][0], u1 = acc[ai][1][m][1];
                u32x4 w;
                w.x = cvt_pk_bf16(fast_silu(g0[0]) * u0[0], fast_silu(g0[1]) * u0[1]); w.y = cvt_pk_bf16(fast_silu(g0[2]) * u0[2], fast_silu(g0[3]) * u0[3]);
                w.z = cvt_pk_bf16(fast_silu(g1[0]) * u1[0], fast_silu(g1[1]) * u1[1]); w.w = cvt_pk_bf16(fast_silu(g1[2]) * u1[2], fast_silu(g1[3]) * u1[3]);
                *(u32x4*)(O + (size_t)(row0 + ai * HALF + m * 16) * ldc + col0) = w; }
    }
};
struct EpiQRope {
    static constexpr bool PERM = true, AFTER_DRAIN = false;
    bf16_t* O; const float* ropeR; const float* ropeC; float qs;
    __device__ __forceinline__ void operator()(const f32x4 (&acc)[2][2][4][2], const Unit& u, int wr, int wc, int fr, int fq) const {
        const int row0 = u.pm * BM + wr * 64 + fr, col0 = u.pn * BM + wc * 32 + 8 * fq;
#pragma unroll
        for (int ai = 0; ai < 2; ++ai)
#pragma unroll
            for (int m = 0; m < 4; ++m) { const int r = row0 + ai * HALF + m * 16, t = r & 8191, gr = t >> 6, gc = t & 63;
#pragma unroll
                for (int bj = 0; bj < 2; ++bj) { const int c = col0 + bj * HALF, d = c % 96;
                    f32x4 v0 = acc[ai][bj][m][0], v1 = acc[ai][bj][m][1];
                    if (d >= 64) { const int p = (d - 64) >> 1;
                        const float* tb = p < 8 ? ropeR + gr * 16 + 2 * p : ropeC + gc * 16 + 2 * (p - 8);
                        const f32x4 a = *(const f32x4*)tb, b = *(const f32x4*)(tb + 4);
                        v0 = (f32x4){v0[0] * a[0] - v0[1] * a[1], v0[0] * a[1] + v0[1] * a[0], v0[2] * a[2] - v0[3] * a[3], v0[2] * a[3] + v0[3] * a[2]};
                        v1 = (f32x4){v1[0] * b[0] - v1[1] * b[1], v1[0] * b[1] + v1[1] * b[0], v1[2] * b[2] - v1[3] * b[3], v1[2] * b[3] + v1[3] * b[2]}; }
                    v0 = v0 * qs; v1 = v1 * qs;
                    u32x4 w; w.x = cvt_pk_bf16(v0[0], v0[1]); w.y = cvt_pk_bf16(v0[2], v0[3]); w.z = cvt_pk_bf16(v1[0], v1[1]); w.w = cvt_pk_bf16(v1[2], v1[3]);
                    *(u32x4*)(O + (size_t)r * 1536 + c) = w; }
                asm volatile("" ::: "memory"); }
    }
};
struct MoeOrder {
    int T, nN, G, c; int tb1, tb2, tb3, tb4, tb5, tb6, tb7;
    __device__ __forceinline__ bool next(int i, Unit& u) const {
        const int nwg = T * nN; const long L = (long)i * G + c; if (L >= nwg) return false;
        int wgid = (int)L; { const int q = nwg / NXCD, r = nwg % NXCD, xcd = wgid % NXCD, off = wgid / NXCD; wgid = (xcd < r ? xcd * (q + 1) : r * (q + 1) + (xcd - r) * q) + off; }
        const int nig = WGM * nN, gid = wgid / nig, fm = gid * WGM, gsz = (T - fm) < WGM ? (T - fm) : WGM;
        const int pm = fm + ((wgid % nig) % gsz), pn = (wgid % nig) / gsz;
        const int e = (pm >= tb1) + (pm >= tb2) + (pm >= tb3) + (pm >= tb4) + (pm >= tb5) + (pm >= tb6) + (pm >= tb7);
        u.pm = pm; u.pn = e * nN + pn; return true;
    }
    __device__ __forceinline__ void a_ready(const Unit&) const {}
    __device__ __forceinline__ void done(const Unit&) const {}
};

template <class Epi, class Sched, bool ALIGN_EPI = false, bool SP2 = false>
__device__ __forceinline__ void gemm_phase(PG8_LAS unsigned char* lds, const Gemm g, const Sched& S, const Epi& E) {
    const int tid = threadIdx.x, wid = __builtin_amdgcn_readfirstlane(tid >> 6), lane = tid & 63, wr = wid >> 2, wc = wid & 3, fr = lane & 15, fq = lane >> 4;
    const int K = g.K, nt = K / BK;
    unsigned voffA[2], voffB[2];
#pragma unroll
    for (int i = 0; i < 2; ++i) { int R, C; stage_rc(tid * 16 + i * 8192, R, C); const int Rb = Epi::PERM ? ((R & ~31) + perm32(R & 31)) : R;
        voffA[i] = (unsigned)(R * K + C) * 2u; voffB[i] = (unsigned)(Rb * K + C) * 2u; }
    const size_t kstep = (size_t)(BK * 2);
    const size_t hstep = (size_t)HALF * K * 2;
    const size_t tstep = 2 * hstep;
    const unsigned ldsw = (unsigned)wid * 1024u;
    const int aoff = lds_byte(wr * 64 + fr, fq * 8), boff = lds_byte(wc * 32 + fr, fq * 8);
#define PG8_SA(b, h) (((b) * 2 + (h)) * HTB)
#define PG8_SB(b, h) ((4 + (b) * 2 + (h)) * HTB)
#define PG8_STAGE(bufoff, gbase, voff) do { _Pragma("unroll") for (int _i = 0; _i < 2; ++_i) \
        __builtin_amdgcn_global_load_lds((const unsigned*)((const char*)(gbase) + (voff)[_i]), (PG8_LAS unsigned*)(lds + (bufoff) + ldsw + _i * 8192), 16, 0, 0); } while (0)
#define PG8_LDA(dst, b, h) do { _Pragma("unroll") for (int m = 0; m < 4; ++m) _Pragma("unroll") for (int k = 0; k < 2; ++k) dst[m][k] = *(const PG8_LAS bf16x8*)(lds + PG8_SA(b, h) + aoff + m * 2048 + k * 1024); } while (0)
#define PG8_LDB(dst, b, h) do { _Pragma("unroll") for (int n = 0; n < 2; ++n) _Pragma("unroll") for (int k = 0; k < 2; ++k) dst[n][k] = *(const PG8_LAS bf16x8*)(lds + PG8_SB(b, h) + boff + n * 2048 + k * 1024); } while (0)
#define PG8_MMA(ai, bj, At, Bt) do { __builtin_amdgcn_s_setprio(1); _Pragma("unroll") for (int m = 0; m < 4; ++m) _Pragma("unroll") for (int n = 0; n < 2; ++n) _Pragma("unroll") for (int k = 0; k < 2; ++k) \
        acc[ai][bj][m][n] = __builtin_amdgcn_mfma_f32_16x16x32_bf16(Bt[n][k], At[m][k], acc[ai][bj][m][n], 0, 0, 0); __builtin_amdgcn_s_setprio(0); } while (0)
#define PG8_WAIT_V(n) asm volatile("s_waitcnt vmcnt(" #n ")" ::: "memory")
#define PG8_WAIT_L(n) asm volatile("s_waitcnt lgkmcnt(" #n ")" ::: "memory")
#define PG8_BAR __builtin_amdgcn_s_barrier()
#define PG8_SCHED __builtin_amdgcn_sched_barrier(0)
    Unit cur, nxt; int ui = 0;
    if (!S.next(0, cur)) return;
    f32x4 acc[2][2][4][2];
#pragma unroll
    for (int a = 0; a < 2; ++a)
#pragma unroll
        for (int b = 0; b < 2; ++b)
#pragma unroll
            for (int m = 0; m < 4; ++m)
#pragma unroll
                for (int n = 0; n < 2; ++n) acc[a][b][m][n] = (f32x4){0.f, 0.f, 0.f, 0.f};
    bf16x8 At[4][2], B0[2][2], B1[2][2];
    const char* cA = (const char*)g.A + (size_t)cur.pm * tstep; const char* cB = (const char*)g.Bt + (size_t)cur.pn * tstep;
    S.a_ready(cur);
    if constexpr (SP2) {
        PG8_STAGE(PG8_SB(0, 0), cB, voffB); PG8_STAGE(PG8_SB(0, 1), cB + hstep, voffB); PG8_STAGE(PG8_SA(0, 0), cA, voffA); PG8_STAGE(PG8_SA(0, 1), cA + hstep, voffA);
        if (wr == 1) PG8_BAR;
        PG8_WAIT_V(2); PG8_BAR;
        PG8_STAGE(PG8_SB(1, 0), cB + kstep, voffB); PG8_STAGE(PG8_SA(1, 0), cA + kstep, voffA); PG8_STAGE(PG8_SB(1, 1), cB + hstep + kstep, voffB);
        PG8_WAIT_V(6); PG8_BAR;
    } else {
        PG8_STAGE(PG8_SB(0, 0), cB, voffB); PG8_STAGE(PG8_SA(0, 0), cA, voffA); PG8_STAGE(PG8_SB(0, 1), cB + hstep, voffB); PG8_STAGE(PG8_SA(0, 1), cA + hstep, voffA);
        if (wr == 1) PG8_BAR;
        PG8_WAIT_V(4); PG8_BAR;
        PG8_STAGE(PG8_SB(1, 0), cB + kstep, voffB); PG8_STAGE(PG8_SA(1, 0), cA + kstep, voffA); PG8_STAGE(PG8_SB(1, 1), cB + hstep + kstep, voffB);
        PG8_WAIT_V(6); PG8_BAR;
    }
    for (;;) {
        const bool has_next = S.next(ui + 1, nxt);
        const char* nA = has_next ? (const char*)g.A + (size_t)nxt.pm * tstep : cA; const char* nB = has_next ? (const char*)g.Bt + (size_t)nxt.pn * tstep : cB;
        for (int t = 0; t < nt; t += 2) {
            const bool last = (t == nt - 2);
            const char* a1 = cA + (size_t)(t + 1) * kstep;
            const char* a2 = last ? nA : cA + (size_t)(t + 2) * kstep; const char* b2 = last ? nB : cB + (size_t)(t + 2) * kstep;
            const char* a3 = a2 + kstep; const char* b3 = b2 + kstep;
            if (last && has_next) S.a_ready(nxt);
            if constexpr (SP2) {
            PG8_LDB(B0, 0, 0); PG8_LDB(B1, 0, 1); PG8_SCHED; PG8_LDA(At, 0, 0); PG8_STAGE(PG8_SA(1, 1), a1 + hstep, voffA);
            PG8_WAIT_V(8); PG8_WAIT_L(0); PG8_BAR; PG8_MMA(0, 0, At, B0); PG8_MMA(0, 1, At, B1); PG8_BAR; PG8_SCHED;
            PG8_LDA(At, 0, 1); PG8_STAGE(PG8_SB(0, 0), b2, voffB); PG8_STAGE(PG8_SB(0, 1), b2 + hstep, voffB); PG8_STAGE(PG8_SA(0, 0), a2, voffA);
            PG8_WAIT_V(8); PG8_WAIT_L(0); PG8_BAR; PG8_MMA(1, 0, At, B0); PG8_MMA(1, 1, At, B1); PG8_BAR; PG8_SCHED;
            PG8_LDB(B0, 1, 0); PG8_LDB(B1, 1, 1); PG8_SCHED; PG8_LDA(At, 1, 0); PG8_STAGE(PG8_SA(0, 1), a2 + hstep, voffA);
            PG8_WAIT_V(8); PG8_WAIT_L(0); PG8_BAR; PG8_MMA(0, 0, At, B0); PG8_MMA(0, 1, At, B1); PG8_BAR; PG8_SCHED;
            PG8_LDA(At, 1, 1); PG8_STAGE(PG8_SB(1, 0), b3, voffB); PG8_STAGE(PG8_SB(1, 1), b3 + hstep, voffB); PG8_STAGE(PG8_SA(1, 0), a3, voffA);
            PG8_WAIT_V(8); PG8_WAIT_L(0); PG8_BAR; PG8_MMA(1, 0, At, B0); PG8_MMA(1, 1, At, B1); PG8_BAR; PG8_SCHED;
            } else {
            PG8_LDB(B0, 0, 0); PG8_SCHED; PG8_LDA(At, 0, 0); PG8_STAGE(PG8_SA(1, 1), a1 + hstep, voffA);
            PG8_WAIT_L(8); PG8_BAR; PG8_WAIT_L(0); PG8_MMA(0, 0, At, B0); PG8_BAR; PG8_SCHED;
            PG8_LDB(B1, 0, 1); PG8_STAGE(PG8_SB(0, 0), b2, voffB);
            PG8_BAR; PG8_WAIT_L(0); PG8_MMA(0, 1, At, B1); PG8_BAR;
            PG8_LDA(At, 0, 1); PG8_STAGE(PG8_SA(0, 0), a2, voffA);
            PG8_BAR; PG8_WAIT_L(0); PG8_MMA(1, 0, At, B0); PG8_BAR; PG8_SCHED;
            PG8_STAGE(PG8_SB(0, 1), b2 + hstep, voffB);
            PG8_WAIT_V(6); PG8_BAR; PG8_MMA(1, 1, At, B1); PG8_BAR;
            PG8_LDB(B0, 1, 0); PG8_SCHED; PG8_LDA(At, 1, 0); PG8_STAGE(PG8_SA(0, 1), a2 + hstep, voffA);
            PG8_WAIT_L(8); PG8_BAR; PG8_WAIT_L(0); PG8_MMA(0, 0, At, B0); PG8_BAR; PG8_SCHED;
            PG8_LDB(B1, 1, 1); PG8_STAGE(PG8_SB(1, 0), b3, voffB);
            PG8_BAR; PG8_WAIT_L(0); PG8_MMA(0, 1, At, B1); PG8_BAR;
            PG8_LDA(At, 1, 1); PG8_STAGE(PG8_SA(1, 0), a3, voffA);
            PG8_BAR; PG8_WAIT_L(0); PG8_MMA(1, 0, At, B0); PG8_BAR; PG8_SCHED;
            PG8_STAGE(PG8_SB(1, 1), b3 + hstep, voffB);
            PG8_WAIT_V(6); PG8_BAR; PG8_MMA(1, 1, At, B1); PG8_BAR;
            }
        }
        if constexpr (ALIGN_EPI) { if (wr == 0) PG8_BAR; }
        if constexpr (!Epi::AFTER_DRAIN) { E(acc, cur, wr, wc, fr, fq); S.done(cur); }
        if (!has_next) break;
#pragma unroll
        for (int a = 0; a < 2; ++a)
#pragma unroll
            for (int b = 0; b < 2; ++b)
#pragma unroll
                for (int m = 0; m < 4; ++m)
#pragma unroll
                    for (int n = 0; n < 2; ++n) acc[a][b][m][n] = (f32x4){0.f, 0.f, 0.f, 0.f};
        cur = nxt; cA = nA; cB = nB; ++ui;
        if constexpr (ALIGN_EPI) { if (wr == 1) PG8_BAR; }
    }
    PG8_WAIT_V(0);
    if constexpr (!ALIGN_EPI) { if (wr == 0) PG8_BAR; }
    PG8_BAR;
    if constexpr (Epi::AFTER_DRAIN) { E.fused(acc, cur, wr, wc, fr, fq, lds, wid, lane); S.done(cur); }
#undef PG8_SA
#undef PG8_SB
#undef PG8_STAGE
#undef PG8_LDA
#undef PG8_LDB
#undef PG8_MMA
#undef PG8_WAIT_V
#undef PG8_WAIT_L
#undef PG8_BAR
#undef PG8_SCHED
}
template <class Epi, class Sched, bool ALIGN_EPI = false, bool SP2 = false>
__device__ __forceinline__ void gemm_phase_ga(PG8_LAS unsigned char* lds, const Gemm g, const Sched& S, const Epi& E, const PG8_LAS int* tokL) {
    const int tid = threadIdx.x, wid = __builtin_amdgcn_readfirstlane(tid >> 6), lane = tid & 63, wr = wid >> 2, wc = wid & 3, fr = lane & 15, fq = lane >> 4;
    const int K = g.K, nt = K / BK;
    unsigned voffA[2], voffB[2];
    int rA[2]; unsigned cA2[2];
#pragma unroll
    for (int i = 0; i < 2; ++i) { int R, C; stage_rc(tid * 16 + i * 8192, R, C); const int Rb = Epi::PERM ? ((R & ~31) + perm32(R & 31)) : R;
        voffA[i] = 0u; rA[i] = R; cA2[i] = (unsigned)C * 2u; voffB[i] = (unsigned)(Rb * K + C) * 2u; }
    unsigned vA0[2], vA1[2], nvA0[2], nvA1[2], sA0[2], sA1[2];
#define PG8_GOFF(d0, d1, ui_) do { _Pragma("unroll") for (int _i = 0; _i < 2; ++_i) { \
        d0[_i] = (unsigned)tokL[(ui_) * 256 + rA[_i]] * (unsigned)(K * 2) + cA2[_i]; d1[_i] = (unsigned)tokL[(ui_) * 256 + 128 + rA[_i]] * (unsigned)(K * 2) + cA2[_i]; } } while (0)
    const size_t kstep = (size_t)(BK * 2);
    const size_t hstep = (size_t)HALF * K * 2;
    const size_t tstep = 2 * hstep;
    const unsigned ldsw = (unsigned)wid * 1024u;
    const int aoff = lds_byte(wr * 64 + fr, fq * 8), boff = lds_byte(wc * 32 + fr, fq * 8);
#define PG8_SA(b, h) (((b) * 2 + (h)) * HTB)
#define PG8_SB(b, h) ((4 + (b) * 2 + (h)) * HTB)
#define PG8_STAGE(bufoff, gbase, voff) do { _Pragma("unroll") for (int _i = 0; _i < 2; ++_i) \
        __builtin_amdgcn_global_load_lds((const unsigned*)((const char*)(gbase) + (voff)[_i]), (PG8_LAS unsigned*)(lds + (bufoff) + ldsw + _i * 8192), 16, 0, 0); } while (0)
#define PG8_LDA(dst, b, h) do { _Pragma("unroll") for (int m = 0; m < 4; ++m) _Pragma("unroll") for (int k = 0; k < 2; ++k) dst[m][k] = *(const PG8_LAS bf16x8*)(lds + PG8_SA(b, h) + aoff + m * 2048 + k * 1024); } while (0)
#define PG8_LDB(dst, b, h) do { _Pragma("unroll") for (int n = 0; n < 2; ++n) _Pragma("unroll") for (int k = 0; k < 2; ++k) dst[n][k] = *(const PG8_LAS bf16x8*)(lds + PG8_SB(b, h) + boff + n * 2048 + k * 1024); } while (0)
#define PG8_MMA(ai, bj, At, Bt) do { __builtin_amdgcn_s_setprio(1); _Pragma("unroll") for (int m = 0; m < 4; ++m) _Pragma("unroll") for (int n = 0; n < 2; ++n) _Pragma("unroll") for (int k = 0; k < 2; ++k) \
        acc[ai][bj][m][n] = __builtin_amdgcn_mfma_f32_16x16x32_bf16(Bt[n][k], At[m][k], acc[ai][bj][m][n], 0, 0, 0); __builtin_amdgcn_s_setprio(0); } while (0)
#define PG8_WAIT_V(n) asm volatile("s_waitcnt vmcnt(" #n ")" ::: "memory")
#define PG8_WAIT_L(n) asm volatile("s_waitcnt lgkmcnt(" #n ")" ::: "memory")
#define PG8_BAR __builtin_amdgcn_s_barrier()
#define PG8_SCHED __builtin_amdgcn_sched_barrier(0)
    Unit cur, nxt; int ui = 0;
    if (!S.next(0, cur)) return;
    f32x4 acc[2][2][4][2];
#pragma unroll
    for (int a = 0; a < 2; ++a)
#pragma unroll
        for (int b = 0; b < 2; ++b)
#pragma unroll
            for (int m = 0; m < 4; ++m)
#pragma unroll
                for (int n = 0; n < 2; ++n) acc[a][b][m][n] = (f32x4){0.f, 0.f, 0.f, 0.f};
    bf16x8 At[4][2], B0[2][2], B1[2][2];
    const char* cA = (const char*)g.A; PG8_GOFF(vA0, vA1, 0); const char* cB = (const char*)g.Bt + (size_t)cur.pn * tstep;
    S.a_ready(cur);
    if constexpr (SP2) {
        PG8_STAGE(PG8_SB(0, 0), cB, voffB); PG8_STAGE(PG8_SB(0, 1), cB + hstep, voffB); PG8_STAGE(PG8_SA(0, 0), cA, vA0); PG8_STAGE(PG8_SA(0, 1), cA, vA1);
        if (wr == 1) PG8_BAR;
        PG8_WAIT_V(2); PG8_BAR;
        PG8_STAGE(PG8_SB(1, 0), cB + kstep, voffB); PG8_STAGE(PG8_SA(1, 0), cA + kstep, vA0); PG8_STAGE(PG8_SB(1, 1), cB + hstep + kstep, voffB);
        PG8_WAIT_V(6); PG8_BAR;
    } else {
        PG8_STAGE(PG8_SB(0, 0), cB, voffB); PG8_STAGE(PG8_SA(0, 0), cA, vA0); PG8_STAGE(PG8_SB(0, 1), cB + hstep, voffB); PG8_STAGE(PG8_SA(0, 1), cA, vA1);
        if (wr == 1) PG8_BAR;
        PG8_WAIT_V(4); PG8_BAR;
        PG8_STAGE(PG8_SB(1, 0), cB + kstep, voffB); PG8_STAGE(PG8_SA(1, 0), cA + kstep, vA0); PG8_STAGE(PG8_SB(1, 1), cB + hstep + kstep, voffB);
        PG8_WAIT_V(6); PG8_BAR;
    }
    for (;;) {
        const bool has_next = S.next(ui + 1, nxt);
        const char* nA = cA; if (has_next) { PG8_GOFF(nvA0, nvA1, ui + 1); } else { nvA0[0] = vA0[0]; nvA0[1] = vA0[1]; nvA1[0] = vA1[0]; nvA1[1] = vA1[1]; } const char* nB = has_next ? (const char*)g.Bt + (size_t)nxt.pn * tstep : cB;
        for (int t = 0; t < nt; t += 2) {
            const bool last = (t == nt - 2);
            const char* a1 = cA + (size_t)(t + 1) * kstep;
            const char* a2 = last ? nA : cA + (size_t)(t + 2) * kstep; sA0[0] = last ? nvA0[0] : vA0[0]; sA0[1] = last ? nvA0[1] : vA0[1]; sA1[0] = last ? nvA1[0] : vA1[0]; sA1[1] = last ? nvA1[1] : vA1[1]; const char* b2 = last ? nB : cB + (size_t)(t + 2) * kstep;
            const char* a3 = a2 + kstep; const char* b3 = b2 + kstep;
            if (last && has_next) S.a_ready(nxt);
            if constexpr (SP2) {
            PG8_LDB(B0, 0, 0); PG8_LDB(B1, 0, 1); PG8_SCHED; PG8_LDA(At, 0, 0); PG8_STAGE(PG8_SA(1, 1), a1, vA1);
            PG8_WAIT_V(8); PG8_WAIT_L(0); PG8_BAR; PG8_MMA(0, 0, At, B0); PG8_MMA(0, 1, At, B1); PG8_BAR; PG8_SCHED;
            PG8_LDA(At, 0, 1); PG8_STAGE(PG8_SB(0, 0), b2, voffB); PG8_STAGE(PG8_SB(0, 1), b2 + hstep, voffB); PG8_STAGE(PG8_SA(0, 0), a2, sA0);
            PG8_WAIT_V(8); PG8_WAIT_L(0); PG8_BAR; PG8_MMA(1, 0, At, B0); PG8_MMA(1, 1, At, B1); PG8_BAR; PG8_SCHED;
            PG8_LDB(B0, 1, 0); PG8_LDB(B1, 1, 1); PG8_SCHED; PG8_LDA(At, 1, 0); PG8_STAGE(PG8_SA(0, 1), a2, sA1);
            PG8_WAIT_V(8); PG8_WAIT_L(0); PG8_BAR; PG8_MMA(0, 0, At, B0); PG8_MMA(0, 1, At, B1); PG8_BAR; PG8_SCHED;
            PG8_LDA(At, 1, 1); PG8_STAGE(PG8_SB(1, 0), b3, voffB); PG8_STAGE(PG8_SB(1, 1), b3 + hstep, voffB); PG8_STAGE(PG8_SA(1, 0), a3, sA0);
            PG8_WAIT_V(8); PG8_WAIT_L(0); PG8_BAR; PG8_MMA(1, 0, At, B0); PG8_MMA(1, 1, At, B1); PG8_BAR; PG8_SCHED;
            } else {
            PG8_LDB(B0, 0, 0); PG8_SCHED; PG8_LDA(At, 0, 0); PG8_STAGE(PG8_SA(1, 1), a1, vA1);
            PG8_WAIT_L(8); PG8_BAR; PG8_WAIT_L(0); PG8_MMA(0, 0, At, B0); PG8_BAR; PG8_SCHED;
            PG8_LDB(B1, 0, 1); PG8_STAGE(PG8_SB(0, 0), b2, voffB);
            PG8_BAR; PG8_WAIT_L(0); PG8_MMA(0, 1, At, B1); PG8_BAR;
            PG8_LDA(At, 0, 1); PG8_STAGE(PG8_SA(0, 0), a2, sA0);
            PG8_BAR; PG8_WAIT_L(0); PG8_MMA(1, 0, At, B0); PG8_BAR; PG8_SCHED;
            PG8_STAGE(PG8_SB(0, 1), b2 + hstep, voffB);
            PG8_WAIT_V(6); PG8_BAR; PG8_MMA(1, 1, At, B1); PG8_BAR;
            PG8_LDB(B0, 1, 0); PG8_SCHED; PG8_LDA(At, 1, 0); PG8_STAGE(PG8_SA(0, 1), a2, sA1);
            PG8_WAIT_L(8); PG8_BAR; PG8_WAIT_L(0); PG8_MMA(0, 0, At, B0); PG8_BAR; PG8_SCHED;
            PG8_LDB(B1, 1, 1); PG8_STAGE(PG8_SB(1, 0), b3, voffB);
            PG8_BAR; PG8_WAIT_L(0); PG8_MMA(0, 1, At, B1); PG8_BAR;
            PG8_LDA(At, 1, 1); PG8_STAGE(PG8_SA(1, 0), a3, sA0);
            PG8_BAR; PG8_WAIT_L(0); PG8_MMA(1, 0, At, B0); PG8_BAR; PG8_SCHED;
            PG8_STAGE(PG8_SB(1, 1), b3 + hstep, voffB);
            PG8_WAIT_V(6); PG8_BAR; PG8_MMA(1, 1, At, B1); PG8_BAR;
            }
        }
        if constexpr (ALIGN_EPI) { if (wr == 0) PG8_BAR; }
        if constexpr (!Epi::AFTER_DRAIN) { E(acc, cur, wr, wc, fr, fq); S.done(cur); }
        if (!has_next) break;
#pragma unroll
        for (int a = 0; a < 2; ++a)
#pragma unroll
            for (int b = 0; b < 2; ++b)
#pragma unroll
                for (int m = 0; m < 4; ++m)
#pragma unroll
                    for (int n = 0; n < 2; ++n) acc[a][b][m][n] = (f32x4){0.f, 0.f, 0.f, 0.f};
        cur = nxt; cA = nA; cB = nB; ++ui; vA0[0] = nvA0[0]; vA0[1] = nvA0[1]; vA1[0] = nvA1[0]; vA1[1] = nvA1[1];
        if constexpr (ALIGN_EPI) { if (wr == 1) PG8_BAR; }
    }
    PG8_WAIT_V(0);
    if constexpr (!ALIGN_EPI) { if (wr == 0) PG8_BAR; }
    PG8_BAR;
    if constexpr (Epi::AFTER_DRAIN) { E.fused(acc, cur, wr, wc, fr, fq, lds, wid, lane); S.done(cur); }
#undef PG8_GOFF
#undef PG8_SA
#undef PG8_SB
#undef PG8_STAGE
#undef PG8_LDA
#undef PG8_LDB
#undef PG8_MMA
#undef PG8_WAIT_V
#undef PG8_WAIT_L
#undef PG8_BAR
#undef PG8_SCHED
}
}

#define GAS __attribute__((address_space(1)))
#define LAS __attribute__((address_space(3)))

#define XB_TMO      128
#define XB_XCNT(j)  (256  + 64 * (j))
#define XB_XSUB(j)  (1280 + 64 * (j))
#define XB_XGEN(j)  (2304 + 64 * (j))
#define XB_TOP      3328
#define XB_TOPGEN   3392
#define XCD_BAR_WORDS 3456
#define XB_SPIN_CAP (1u << 18)

__device__ __forceinline__ unsigned xb_ld(unsigned* p)              { return __hip_atomic_load(p, __ATOMIC_RELAXED, __HIP_MEMORY_SCOPE_AGENT); }
__device__ __forceinline__ unsigned xb_add(unsigned* p, unsigned v) { return __hip_atomic_fetch_add(p, v, __ATOMIC_RELAXED, __HIP_MEMORY_SCOPE_AGENT); }
__device__ __forceinline__ unsigned xb_xcc_id() { return (unsigned)__builtin_amdgcn_s_getreg((3 << 11) | 20) & 0xFu; }
#define XB_SPIN(cond, bar) do { unsigned _sp = 0; while (cond) { __builtin_amdgcn_s_sleep(1); \
    if ((++_sp & 255u) == 0u) { if (xb_ld(&(bar)[XB_TMO])) break; if (_sp > XB_SPIN_CAP) { atomicAdd(&(bar)[XB_TMO], 1u); break; } } } } while (0)

struct XcdBarrier {
    unsigned* bar; unsigned x;
    volatile LAS unsigned* st;
};

__device__ __forceinline__ XcdBarrier xcd_barrier_post(unsigned* bar, volatile LAS unsigned* st) {
    XcdBarrier b; b.bar = bar; b.x = xb_xcc_id(); b.st = st;
    if (threadIdx.x == 0) (void)xb_add(&bar[XB_XCNT(b.x)], 1u);
    return b;
}
__device__ __forceinline__ void xcd_barrier_complete(unsigned* bar, unsigned x, unsigned& nloc, unsigned& nx) {
    const unsigned G = gridDim.x * gridDim.y * gridDim.z;
    unsigned sum, cnt, mine, sp = 0u;
    for (;;) {
        sum = 0u; cnt = 0u; mine = 0u;
#pragma unroll
        for (unsigned j = 0; j < 16; ++j) { const unsigned c = xb_ld(&bar[XB_XCNT(j)]); sum += c; cnt += (c > 0u) ? 1u : 0u; mine = (j == x) ? c : mine; }
        if (sum == G) break;
        __builtin_amdgcn_s_sleep(1);
        if ((++sp & 255u) == 0u) { if (xb_ld(&bar[XB_TMO])) break; if (sp > XB_SPIN_CAP) { atomicAdd(&bar[XB_TMO], 1u); break; } }
    }
    nloc = mine > 0u ? mine : 1u; nx = cnt > 0u ? cnt : 1u;
}

__device__ __forceinline__ void xcd_barrier(const XcdBarrier& b) {
    asm volatile("s_waitcnt vmcnt(0)" ::: "memory");
    __syncthreads();
    if (threadIdx.x == 0) {
        unsigned* bar = b.bar;
        __builtin_amdgcn_s_waitcnt(0);
        unsigned nloc = b.st[0], nx = b.st[1];
        if (nloc == 0u) { xcd_barrier_complete(bar, b.x, nloc, nx); b.st[0] = nloc; b.st[1] = nx; }
        const unsigned old = xb_add(&bar[XB_XSUB(b.x)], 1u);
        const unsigned gen = old / nloc;
        if (old + 1u == (gen + 1u) * nloc) {
            __builtin_amdgcn_fence(__ATOMIC_RELEASE, "agent");
            asm volatile("s_waitcnt vmcnt(0)" ::: "memory");
            const unsigned og = xb_add(&bar[XB_TOP], 1u);
            const unsigned tg = og / nx;
            if (og + 1u == (tg + 1u) * nx) xb_add(&bar[XB_TOPGEN], 1u);
            else XB_SPIN(xb_ld(&bar[XB_TOPGEN]) == tg, bar);
            __builtin_amdgcn_fence(__ATOMIC_ACQUIRE, "agent");
            xb_add(&bar[XB_XGEN(b.x)], 1u);
            asm volatile("s_waitcnt vmcnt(0)" ::: "memory");
        } else {
            XB_SPIN(xb_ld(&bar[XB_XGEN(b.x)]) == gen, bar);
            __builtin_amdgcn_fence(__ATOMIC_ACQUIRE, "agent");
            asm volatile("s_waitcnt vmcnt(0)" ::: "memory");
        }
    }
    __syncthreads();
}


constexpr int NWAVES = 8, NTHREADS = 512;
constexpr int D = 1024, NB = 2, SEQ = 8192, M = NB * SEQ, GW = 64, GROWS = 128, NH = 16, HD = 64;
constexpr int FFN = 2816, NE = 8, ED = 1792, QL = 256, KVL = 128, RP = 32, DOWN_N = 416, DOWN_NP = 512, QKD = 96;
constexpr int MP_MAX = 34816;
constexpr float NORM_EPS = 1e-6f;
constexpr float LOG2E = 1.4426950408889634f;
constexpr float QSCALE1 = 0.10206207261596577f * LOG2E;

constexpr size_t MiB = 1u << 20;
constexpr size_t WS_CTL = 0, CTL_ZERO_BYTES = 64 * 1024;
constexpr size_t WS_PART = 4 * MiB;
constexpr size_t WS_MODF = 2 * MiB;
constexpr size_t WS_ROPER = WS_MODF + 128 * 1024;
constexpr size_t WS_ROPEC = WS_ROPER + 16 * 1024;
constexpr size_t WS_CNTWG = WS_ROPEC + 16 * 1024;
constexpr size_t WS_TOKE = 3 * MiB;
constexpr size_t WS_TOKP = WS_TOKE + 128 * 1024;
constexpr size_t WS_TOKW = WS_TOKP + 128 * 1024;
constexpr size_t WS_TOKS = WS_TOKW + 128 * 1024;
constexpr size_t WS_ROWTOK = WS_TOKS + 128 * 1024;
constexpr size_t WS_W = 8 * MiB;
constexpr size_t WS_WQK = WS_W, WS_WV = WS_WQK + 4 * MiB, WS_WO0 = WS_WV + 2 * MiB, WS_WGU0 = WS_WO0 + 2 * MiB, WS_WDN0 = WS_WGU0 + 11 * MiB;
constexpr size_t WS_WMD = WS_WDN0 + 5632 * 1024, WS_WUQ = WS_WMD + 1 * MiB, WS_WKN = WS_WUQ + 768 * 1024, WS_WVV = WS_WKN + 512 * 1024, WS_WO1 = WS_WVV + 512 * 1024;
constexpr size_t WS_WGU1 = WS_WO1 + 2 * MiB, WS_WDN1 = WS_WGU1 + 56 * MiB, WS_WEND = WS_WDN1 + 28 * MiB;
static_assert(WS_WEND <= 122 * MiB, "weights");
constexpr size_t WS_XA = 122 * MiB;
constexpr size_t WS_HN = 186 * MiB;
constexpr size_t WS_R = 218 * MiB;
constexpr size_t WS_Q0 = WS_R, WS_K0 = WS_R + 32 * MiB, WS_VT0 = WS_R + 64 * MiB, WS_O0 = WS_R + 96 * MiB;
constexpr size_t WS_ACT0 = WS_R;
constexpr size_t WS_DOWN = WS_R, WS_CQ = WS_R + 32 * MiB, WS_CKV = WS_R + 40 * MiB, WS_KR = WS_R + 48 * MiB;
constexpr size_t WS_Q1 = WS_R + 49 * MiB, WS_KN = WS_R + 97 * MiB, WS_VT1 = WS_R + 129 * MiB, WS_O1 = WS_R + 161 * MiB;
constexpr size_t WS_HP = WS_R, WS_ACT1 = WS_R + 68 * MiB;
constexpr size_t WS_END = WS_R + 193 * MiB;
static_assert(WS_ACT1 + (size_t)MP_MAX * ED * 2 <= WS_END && WS_END <= 448 * MiB, "d_ws map");

constexpr int RING_BYTES = 131072, MISC_OFF = 155648, LDS_BYTES = 159744;

typedef unsigned short bf16;
typedef unsigned v4u __attribute__((ext_vector_type(4)));
typedef unsigned v2u __attribute__((ext_vector_type(2)));
typedef float f32x4 __attribute__((ext_vector_type(4)));
typedef float f32x2 __attribute__((ext_vector_type(2)));
typedef float f32x16 __attribute__((ext_vector_type(16)));
typedef short bf16x8 __attribute__((ext_vector_type(8)));
typedef GAS unsigned gu32;
#define RLX_AGENT __ATOMIC_RELAXED, __HIP_MEMORY_SCOPE_AGENT
#define LDS_WAIT() asm volatile("s_waitcnt lgkmcnt(0)" ::: "memory")
__device__ __forceinline__ unsigned pk2(float lo, float hi) { unsigned r; asm volatile("v_cvt_pk_bf16_f32 %0, %1, %2" : "=v"(r) : "v"(lo), "v"(hi)); return r; }
__device__ __forceinline__ float bf2f(unsigned short h) { return __builtin_bit_cast(float, (unsigned)h << 16); }
__device__ __forceinline__ float bflo(unsigned w) { return __builtin_bit_cast(float, w << 16); }
__device__ __forceinline__ float bfhi(unsigned w) { return __builtin_bit_cast(float, w & 0xffff0000u); }
__device__ __forceinline__ float wave_sum(float v) {
#pragma unroll
    for (int o = 1; o < 64; o <<= 1) v += __shfl_xor(v, o);
    return v;
}

template <typename TX> struct XRow;
template <> struct XRow<float> { static __device__ __forceinline__ f32x4 ld(const float* X, size_t row, int col) { return *(const GAS f32x4*)(X + row * 1024 + col); } };
template <> struct XRow<bf16> { static __device__ __forceinline__ f32x4 ld(const bf16* X, size_t row, int col) { const v2u w = *(const GAS v2u*)(X + row * 1024 + col); return (f32x4){bflo(w.x), bfhi(w.x), bflo(w.y), bfhi(w.y)}; } };

struct Frame {
    LAS unsigned char* lds; volatile LAS unsigned* MISC;
    int tid, lane, wave, vcu, G, gw, NGW;
    const float* in[19]; float* out; unsigned char* ws;
};
#define WSP(T, off) ((T*)(F.ws + (off)))

__device__ __forceinline__ void tr_item(const float* W, int ldn, int k0, int n0, bf16* WT, int ldk, int drow0, LAS float* scr, int lane) {
    { f32x4 v[8]; const int rr = lane >> 3, c4 = (lane & 7) * 4;
#pragma unroll
      for (int i = 0; i < 8; ++i) v[i] = *(const f32x4*)(W + (size_t)(k0 + 8 * i + rr) * ldn + n0 + c4);
#pragma unroll
      for (int i = 0; i < 8; ++i) { LAS float* d = scr + (8 * i + rr) * 33 + c4; d[0] = v[i].x; d[1] = v[i].y; d[2] = v[i].z; d[3] = v[i].w; } }
    LDS_WAIT(); asm volatile("" ::: "memory");
    const int c = lane & 7;
#pragma unroll
    for (int j = 0; j < 4; ++j) { const int n = (lane >> 3) + 8 * j; const LAS float* s = scr + (8 * c) * 33 + n;
        v4u o; o.x = pk2(s[0 * 33], s[1 * 33]); o.y = pk2(s[2 * 33], s[3 * 33]); o.z = pk2(s[4 * 33], s[5 * 33]); o.w = pk2(s[6 * 33], s[7 * 33]);
        *(GAS v4u*)(WT + (size_t)(drow0 + n) * ldk + k0 + 8 * c) = o; }
    LDS_WAIT(); asm volatile("" ::: "memory");
}
__device__ __forceinline__ int gu_row(int n0, int F_) { const int up = n0 >= F_, j = up ? n0 - F_ : n0; return 256 * (j >> 7) + (up ? 128 : 0) + (j & 127); }
__device__ __forceinline__ float silu_acc(float v) { return v / (1.f + expf(-v)); }
constexpr int MOE_I8 = 8 * 16 * 112, MOE_I9 = 8 * 28 * 32, MOE_ITEMS = MOE_I8 + MOE_I9;
constexpr int MOE_G1 = 128 * 40, MOE_G2 = 128 * 48, MOE_G3 = 144 * 24;
__device__ __forceinline__ void moe_w_item(Frame& F, int r, LAS float* scr, int lane) {
    if (r < MOE_I8) { const int e = r / (16 * 112), q = r % (16 * 112), kb = q / 112, nb = q % 112;
        tr_item(F.in[16] + (size_t)e * D * 2 * ED, 2 * ED, 64 * kb, 32 * nb, WSP(bf16, WS_WGU1), D, e * 2 * ED + gu_row(32 * nb, ED), scr, lane); }
    else { r -= MOE_I8; const int e = r / (28 * 32), q = r % (28 * 32), kb = q / 32, nb = q % 32;
        tr_item(F.in[17] + (size_t)e * ED * D, D, 64 * kb, 32 * nb, WSP(bf16, WS_WDN1), ED, e * D + 32 * nb, scr, lane); }
}
__device__ __forceinline__ void moe_w_side(Frame& F, int lo, int hi, int first_wg) {
    if (F.G != 256 || (int)blockIdx.x < first_wg) return;
    LAS float* scr = (LAS float*)(F.lds + F.wave * 16384);
    for (int it = lo + ((int)blockIdx.x - first_wg) * NWAVES + F.wave; it < hi; it += (256 - first_wg) * NWAVES) moe_w_item(F, it, scr, F.lane);
}
__device__ __forceinline__ void p0_prologue(Frame& F) {
    LAS float* scr = (LAS float*)(F.lds + F.wave * 16384);
    const int lane = F.lane;
    constexpr int I0 = 16 * 96, I1 = 16 * 32, I2 = 16 * 176, I3 = 44 * 32, I4 = 16 * 13, I5 = 4 * 48, I6 = 2 * 64, I7 = 16 * 32;
    const int NMOE0 = (F.G == 256) ? MOE_ITEMS - MOE_G1 - MOE_G2 - MOE_G3 : MOE_ITEMS;
    constexpr int IA = 2 * 96 * 16;
    constexpr int IZ = 96 + 2 * 1024;
    constexpr int IR = 24;
    const int NITEMS = I0 + I1 + I2 + I3 + I4 + I5 + I6 + I7 + NMOE0 + IA + IZ + IR;
    for (int it = F.gw; it < NITEMS; it += F.NGW) {
        int r = it;
        if (r < NMOE0) { moe_w_item(F, r, scr, lane); continue; } r -= NMOE0;
        if (r < I0) { const int kb = r / 96, nb = r % 96, n0 = 32 * nb;
            if (n0 < 2048) tr_item(F.in[4], 3 * D, 64 * kb, n0, WSP(bf16, WS_WQK), D, n0, scr, lane); else tr_item(F.in[4], 3 * D, 64 * kb, n0, WSP(bf16, WS_WV), D, n0 - 2048, scr, lane);
            continue; } r -= I0;
        if (r < I1) { tr_item(F.in[6], D, 64 * (r / 32), 32 * (r % 32), WSP(bf16, WS_WO0), D, 32 * (r % 32), scr, lane); continue; } r -= I1;
        if (r < I2) { const int kb = r / 176, nb = r % 176; tr_item(F.in[7], 2 * FFN, 64 * kb, 32 * nb, WSP(bf16, WS_WGU0), D, gu_row(32 * nb, FFN), scr, lane); continue; } r -= I2;
        if (r < I3) { tr_item(F.in[8], D, 64 * (r / 32), 32 * (r % 32), WSP(bf16, WS_WDN0), FFN, 32 * (r % 32), scr, lane); continue; } r -= I3;
        if (r < I4) { tr_item(F.in[9], DOWN_N, 64 * (r / 13), 32 * (r % 13), WSP(bf16, WS_WMD), D, 32 * (r % 13), scr, lane); continue; } r -= I4;
        if (r < I5) { tr_item(F.in[11], 1536, 64 * (r / 48), 32 * (r % 48), WSP(bf16, WS_WUQ), QL, 32 * (r % 48), scr, lane); continue; } r -= I5;
        if (r < I6) { const int kb = r / 64, nb = r % 64, h = nb >> 2, q = nb & 3;
            if (q < 2) tr_item(F.in[13], 2048, 64 * kb, 32 * nb, WSP(bf16, WS_WKN), 128, h * 64 + 32 * q, scr, lane); else tr_item(F.in[13], 2048, 64 * kb, 32 * nb, WSP(bf16, WS_WVV), 128, h * 64 + 32 * (q - 2), scr, lane);
            continue; } r -= I6;
        if (r < I7) { tr_item(F.in[14], D, 64 * (r / 32), 32 * (r % 32), WSP(bf16, WS_WO1), D, 32 * (r % 32), scr, lane); continue; } r -= I7;
        if (r < IA) {
            const int l = r / (96 * 16), q = r % (96 * 16), cg = q / 16, kc = q % 16, n = 64 * cg + lane;
            const float* w = F.in[2] + (size_t)l * D * 6 * D + n; const float* c = F.in[1];
            float a0 = 0.f, a1 = 0.f;
            const float ca0 = silu_acc(c[64 * kc + lane]), ca1 = silu_acc(c[D + 64 * kc + lane]);
#pragma unroll 32
            for (int kk = 0; kk < 64; ++kk) { const float wv = w[(size_t)(64 * kc + kk) * 6 * D]; a0 += __shfl(ca0, kk) * wv; a1 += __shfl(ca1, kk) * wv; }
            float* part = WSP(float, WS_PART) + ((size_t)(kc * 2 + l) * 2) * 6 * D + n;
            part[0] = a0; part[6 * D] = a1; continue; } r -= IA;
        if (r < IZ) {
            if (r < 96) { GAS v4u* p = (GAS v4u*)(WSP(bf16, WS_WMD) + (size_t)(DOWN_N + r) * D); p[lane] = (v4u){0u, 0u, 0u, 0u}; p[64 + lane] = (v4u){0u, 0u, 0u, 0u}; }
            else { }
            continue; } r -= IZ;
        {
            const int idx = 64 * r + lane, isc = idx >= 1024, q = isc ? idx - 1024 : idx, i = q >> 3, p = q & 7;
            const float inv = powf(10000.f, -(float)p / 8.f), a = (float)i * inv;
            float* t = (isc ? WSP(float, WS_ROPEC) : WSP(float, WS_ROPER)) + i * 16 + 2 * p; t[0] = cosf(a); t[1] = sinf(a);
        }
    }
}
__device__ __forceinline__ f32x4 mod4_partials(Frame& F, int l, int b, int n) {
    f32x4 a = *(const f32x4*)(F.in[3] + l * 6 * D + n);
#pragma unroll
    for (int kc = 0; kc < 16; ++kc) a += *(const f32x4*)(WSP(float, WS_PART) + ((size_t)((kc * 2 + l) * 2 + b)) * 6 * D + n);
    return a;
}
template <bool FROM_PART, typename TX> __device__ __forceinline__ void modulate_phase(Frame& F, const TX* X, int l, int cs, bf16* HNo) {
    for (int b = 0; b < NB; ++b) {
        f32x4 sh[4], sc[4];
#pragma unroll
        for (int j = 0; j < 4; ++j) { const int n = 4 * F.lane + 256 * j;
            if (FROM_PART) { sh[j] = mod4_partials(F, l, b, cs * D + n); sc[j] = mod4_partials(F, l, b, (cs + 1) * D + n); }
            else { const float* mf = WSP(float, WS_MODF) + (size_t)(l * 2 + b) * 6 * D; sh[j] = *(const f32x4*)(mf + cs * D + n); sc[j] = *(const f32x4*)(mf + (cs + 1) * D + n); }
            sc[j] = sc[j] + 1.f; }
        for (int row = b * SEQ + F.gw; row < (b + 1) * SEQ; row += 4 * F.NGW) {
            f32x4 v[4][4]; float ss[4]; bool ok[4];
#pragma unroll
            for (int q = 0; q < 4; ++q) { ok[q] = row + q * F.NGW < (b + 1) * SEQ; const int rq = ok[q] ? row + q * F.NGW : row;
#pragma unroll
                for (int j = 0; j < 4; ++j) v[q][j] = XRow<TX>::ld(X, (size_t)rq, 4 * F.lane + 256 * j); }
#pragma unroll
            for (int q = 0; q < 4; ++q) { ss[q] = 0.f;
#pragma unroll
                for (int j = 0; j < 4; ++j) ss[q] += (v[q][j].x * v[q][j].x + v[q][j].y * v[q][j].y) + (v[q][j].z * v[q][j].z + v[q][j].w * v[q][j].w); }
#pragma unroll
            for (int o = 1; o < 64; o <<= 1)
#pragma unroll
                for (int q = 0; q < 4; ++q) ss[q] += __shfl_xor(ss[q], o);
#pragma unroll
            for (int q = 0; q < 4; ++q) if (ok[q]) { const float rstd = rsqrtf(ss[q] * (1.f / D) + NORM_EPS); GAS v2u* o8 = (GAS v2u*)(HNo + (size_t)(row + q * F.NGW) * D) + F.lane;
#pragma unroll
                for (int j = 0; j < 4; ++j) { const f32x4 y = v[q][j] * rstd * sc[j] + sh[j]; v2u w; w.x = pk2(y.x, y.y); w.y = pk2(y.z, y.w); o8[64 * j] = w; } }
        }
    }
}
__device__ __forceinline__ void modf_reduce(Frame& F) {
    for (int i = blockIdx.x * NTHREADS + F.tid; i < 2 * 2 * 6 * D; i += F.G * NTHREADS) {
        const int l = i / (2 * 6 * D), q = i % (2 * 6 * D), n = q % (6 * D), b = q / (6 * D);
        float a = F.in[3][l * 6 * D + n];
#pragma unroll
        for (int kc = 0; kc < 16; ++kc) a += WSP(float, WS_PART)[((size_t)((kc * 2 + l) * 2 + b)) * 6 * D + n];
        WSP(float, WS_MODF)[i] = a;
    }
}
__device__ __forceinline__ void mla_mid_phase(Frame& F) {
    const float* DOWN = WSP(float, WS_DOWN); const float* qn = F.in[10]; const float* kvn = F.in[12];
    const f32x4 qn4 = *(const f32x4*)(qn + 4 * F.lane); const f32x2 kn2 = *(const f32x2*)(kvn + 2 * F.lane);
    for (int row = F.gw; row < M; row += F.NGW) {
        const float* dr = DOWN + (size_t)row * DOWN_NP; const int t = row & (SEQ - 1);
        const f32x4 a = *(const f32x4*)(dr + 4 * F.lane); const f32x2 k = *(const f32x2*)(dr + QL + 2 * F.lane);
        const float rq = rsqrtf(wave_sum((a.x * a.x + a.y * a.y) + (a.z * a.z + a.w * a.w)) * (1.f / QL) + NORM_EPS);
        const float rk = rsqrtf(wave_sum(k.x * k.x + k.y * k.y) * (1.f / KVL) + NORM_EPS);
        v2u w; w.x = pk2(a.x * rq * qn4.x, a.y * rq * qn4.y); w.y = pk2(a.z * rq * qn4.z, a.w * rq * qn4.w);
        *((GAS v2u*)(WSP(bf16, WS_CQ) + (size_t)row * QL) + F.lane) = w;
        GAS unsigned* ck = (GAS unsigned*)(WSP(bf16, WS_CKV) + (size_t)row * 128);
        ck[F.lane] = pk2(k.x * rk * kn2.x, k.y * rk * kn2.y);
        if (F.lane < 16) { const f32x2 x = *(const f32x2*)(dr + QL + KVL + 2 * F.lane);
            const float* tb = F.lane < 8 ? WSP(float, WS_ROPER) + (t >> 6) * 16 + 2 * F.lane : WSP(float, WS_ROPEC) + (t & 63) * 16 + 2 * (F.lane - 8);
            const float cs = tb[0], sn = tb[1];
            ((GAS unsigned*)(WSP(bf16, WS_KR) + (size_t)row * RP))[F.lane] = pk2(x.x * cs - x.y * sn, x.x * sn + x.y * cs); }
    }
}
namespace na {
constexpr int L_K = 0, L_V = 73728, L_B = 147456, L_END = L_B + 15 * 64 * 4;
}
__device__ __forceinline__ void na_phase(Frame& F) {
    const bf16* Q = WSP(bf16, WS_Q0); const bf16* K = WSP(bf16, WS_K0); const bf16* VT = WSP(bf16, WS_VT0); bf16* O = WSP(bf16, WS_O0);
    const int tid = F.tid, lane = F.lane, l16 = lane & 15, g = lane >> 4;
    LAS float* rpbH = (LAS float*)(F.lds + na::L_B);
    const int scol = tid >> 3, sc = tid & 7;
    const unsigned kdst = (unsigned)((scol * 8 + (sc ^ ((scol & 2) ^ ((scol & 8) >> 1)))) * 16), vdst = (unsigned)((scol * 8 + (sc ^ (scol & 6))) * 16);
    const int ri = F.wave >> 2, ct = F.wave & 3;
    const int c0 = 16 * ct, kc0 = ct == 0 ? 0 : (ct == 1 ? 8 : (ct == 2 ? 24 : 32));
    const int c = c0 + l16; int cs = c - 8; cs = cs < 0 ? 0 : (cs > GW - 16 ? GW - 16 : cs);
    const int kcolA = kc0 + 8 * (l16 >> 2) + (l16 & 3), kxv = (kcolA & 2) ^ ((kcolA & 8) >> 1);
    const unsigned kch0 = (unsigned)((kcolA * 8 + (g ^ kxv)) * 16), kch1 = (unsigned)((kcolA * 8 + ((4 + g) ^ kxv)) * 16);
    const unsigned vch = (unsigned)((l16 * 8 + (((kc0 >> 3) + g) ^ (l16 & 6))) * 16);
    const int dc0 = kc0 + 8 * g - c + 15, t0 = kc0 + 8 * g - cs;
    float pen[8];
#pragma unroll
    for (int k = 0; k < 8; ++k) pen[k] = (unsigned)(t0 + k) < 16u ? 0.f : -1e30f;
    for (int w = F.vcu; w < NB * NH * 8; w += F.G) {
        const int bh = w >> 3, b = bh >> 4, h = bh & 15, rp0 = (w & 7) * 8;
        __syncthreads();
        for (int i = tid; i < 15 * 64; i += NTHREADS) { const int dc = (i & 63) - 8; rpbH[i] = (dc >= 0 && dc <= 30) ? F.in[5][(h * 15 + (i >> 6)) * 31 + dc] * LOG2E : 0.f; }
        const bf16* kbase = K + ((size_t)h * M + (size_t)b * SEQ) * HD + scol * HD + sc * 8;
        const bf16* vbase = VT + ((size_t)(b * GROWS) * D + h * HD + scol) * GW + sc * 8;
        bf16x8 kst[9], vst[9];
#define NA_LOAD(rp_) do { int R0_ = 2 * (rp_) - 4; R0_ = R0_ < 0 ? 0 : (R0_ > GROWS - 8 ? GROWS - 8 : R0_); \
        _Pragma("unroll") for (int i_ = 0; i_ < 9; ++i_) { const int row_ = (R0_ + i_) > GROWS - 1 ? GROWS - 1 : (R0_ + i_); \
            kst[i_] = *(const bf16x8*)(kbase + (size_t)row_ * GW * HD); vst[i_] = *(const bf16x8*)(vbase + (size_t)row_ * D * GW); } } while (0)
        NA_LOAD(rp0);
        for (int st = 0; st < 8; ++st) {
            const int rp = rp0 + st;
            __syncthreads();
#pragma unroll
            for (int i = 0; i < 9; ++i) { *(LAS bf16x8*)(F.lds + na::L_K + i * 8192 + kdst) = kst[i]; *(LAS bf16x8*)(F.lds + na::L_V + i * 8192 + vdst) = vst[i]; }
            __syncthreads();
            if (st + 1 < 8) NA_LOAD(rp + 1);
            __builtin_amdgcn_sched_barrier(0);
            const int r = 2 * rp + ri; int rs = r - 4; rs = rs < 0 ? 0 : (rs > GROWS - 8 ? GROWS - 8 : rs);
            int R0 = 2 * rp - 4; R0 = R0 < 0 ? 0 : (R0 > GROWS - 8 ? GROWS - 8 : R0);
            const int roff = rs - R0;
            const size_t tq = (size_t)b * SEQ + r * GW + c;
            bf16x8 qf[2];
#pragma unroll
            for (int ks = 0; ks < 2; ++ks) qf[ks] = *(const bf16x8*)(Q + tq * D + h * HD + 32 * ks + 8 * g);
            const LAS unsigned char* kl = F.lds + na::L_K + roff * 8192; const LAS unsigned char* vl = F.lds + na::L_V + roff * 8192;
            pg8::f32x4 s[8][2];
#pragma unroll
            for (int kr = 0; kr < 8; ++kr)
#pragma unroll
                for (int blk = 0; blk < 2; ++blk) {
                    const bf16x8 k0 = *(const LAS bf16x8*)(kl + kr * 8192 + blk * 512 + kch0), k1 = *(const LAS bf16x8*)(kl + kr * 8192 + blk * 512 + kch1);
                    pg8::f32x4 a = {0.f, 0.f, 0.f, 0.f};
                    a = __builtin_amdgcn_mfma_f32_16x16x32_bf16(k0, qf[0], a, 0, 0, 0);
                    a = __builtin_amdgcn_mfma_f32_16x16x32_bf16(k1, qf[1], a, 0, 0, 0);
                    s[kr][blk] = a; if (blk == 1 && (kr & 1)) __builtin_amdgcn_sched_barrier(0); }
            const LAS float* bp = rpbH + (rs - r + 7) * 64 + dc0 + 8;
            float mx = -1e30f;
#pragma unroll
            for (int kr = 0; kr < 8; ++kr)
#pragma unroll
                for (int blk = 0; blk < 2; ++blk)
#pragma unroll
                    for (int i = 0; i < 4; ++i) { const float v = (s[kr][blk][i] + bp[kr * 64 + 4 * blk + i]) + pen[4 * blk + i]; s[kr][blk][i] = v; mx = fmaxf(mx, v); }
            mx = fmaxf(mx, __shfl_xor(mx, 16)); mx = fmaxf(mx, __shfl_xor(mx, 32));
            float sum = 0.f;
#pragma unroll
            for (int kr = 0; kr < 8; ++kr)
#pragma unroll
                for (int blk = 0; blk < 2; ++blk)
#pragma unroll
                    for (int i = 0; i < 4; ++i) { const float e = __builtin_amdgcn_exp2f(s[kr][blk][i] - mx); s[kr][blk][i] = e; sum += e; }
            sum += __shfl_xor(sum, 16); sum += __shfl_xor(sum, 32);
            const float inv = 1.f / sum;
            pg8::f32x4 o[4];
#pragma unroll
            for (int db = 0; db < 4; ++db) o[db] = (pg8::f32x4){0.f, 0.f, 0.f, 0.f};
#pragma unroll
            for (int kr = 0; kr < 8; ++kr) {
                v4u pw; pw.x = pk2(s[kr][0][0], s[kr][0][1]); pw.y = pk2(s[kr][0][2], s[kr][0][3]); pw.z = pk2(s[kr][1][0], s[kr][1][1]); pw.w = pk2(s[kr][1][2], s[kr][1][3]);
                const bf16x8 pf = __builtin_bit_cast(bf16x8, pw);
#pragma unroll
                for (int db = 0; db < 4; ++db) { const bf16x8 vf = *(const LAS bf16x8*)(vl + kr * 8192 + db * 2048 + vch);
                    o[db] = __builtin_amdgcn_mfma_f32_16x16x32_bf16(vf, pf, o[db], 0, 0, 0); }
                if (kr & 1) __builtin_amdgcn_sched_barrier(0); }
            bf16* op = O + tq * D + h * HD + 4 * g;
#pragma unroll
            for (int db = 0; db < 4; ++db) { v2u wv; wv.x = pk2(o[db][0] * inv, o[db][1] * inv); wv.y = pk2(o[db][2] * inv, o[db][3] * inv); *(GAS v2u*)(op + 16 * db) = wv; }
        }
#undef NA_LOAD
    }
    __syncthreads();
}
namespace mla {
constexpr int NSLOT = 4, KSLOT = 12288, VSLOT = 8192;
constexpr int L_K = 0, L_V = NSLOT * KSLOT, L_WS = L_V + NSLOT * VSLOT, L_OST = L_WS + 2048, L_BYTES = L_OST + 8 * 4096;
constexpr float THR = 8.f;
typedef LAS unsigned char lch;
__device__ __forceinline__ int crow(int r, int hi) { return (r & 3) + 8 * (r >> 2) + 4 * hi; }
__device__ __forceinline__ void glds16(const void* sbase, unsigned voff, unsigned lds_dst) { unsigned keep;
    asm volatile("s_mov_b32 %0, m0\n\ts_mov_b32 m0, %3\n\ts_nop 0\n\tglobal_load_lds_dwordx4 %1, %2\n\ts_mov_b32 m0, %0" : "=&s"(keep) : "v"(voff), "s"(sbase), "s"(lds_dst) : "memory"); }
#define MLA_WAIT_BAR(N) asm volatile("s_waitcnt vmcnt(" #N ") lgkmcnt(0)\n\ts_barrier" ::: "memory")
#define MLA_WAIT_FULL() do { if (wid < 4) { MLA_WAIT_BAR(6); } else { MLA_WAIT_BAR(4); } } while (0)
#define MLA_SBAR() __builtin_amdgcn_sched_barrier(0)
#define MLA_MF(a, b, c) __builtin_amdgcn_mfma_f32_32x32x16_bf16(a, b, c, 0, 0, 0)
#define MLA_PIN(x) asm volatile("" : "+v"(x))
#define MLA_EX(v) __builtin_amdgcn_exp2f(v)
__device__ __forceinline__ void unit(int b, int h, int qb, const bf16* Q1, const bf16* KN, const bf16* KR, const bf16* VT, bf16* O1, lch* lds) {
    const int tid = threadIdx.x, wid = __builtin_amdgcn_readfirstlane(tid >> 6), lane = tid & 63, r32 = lane & 31, hi = lane >> 5;
    const size_t rowbase = (size_t)b * SEQ; const int q0 = qb * 256;
    const unsigned lds0 = (unsigned)(uintptr_t)lds;
    LAS float* wsf = (LAS float*)(lds + L_WS) + wid * 64;
    const bf16* knb = KN + ((size_t)h * M + rowbase + 8 * wid) * HD; const bf16* krb = KR + (rowbase + 16 * (wid & 3)) * RP; const bf16* vb = VT + ((rowbase >> 6) * D + h * HD + 8 * wid) * GW;
    unsigned kno, kro, vo;
    { const int rl = lane >> 3, row = 8 * wid + rl, c = (lane & 7) ^ ((row >> 1) & 7); kno = (unsigned)((rl * HD + c * 8) * 2); }
    { const int rl = lane >> 2, row = 16 * (wid & 3) + rl, c = (lane & 3) ^ ((row >> 2) & 3); kro = (unsigned)((rl * RP + c * 8) * 2); }
    { const int dl = lane >> 3, d = 8 * wid + dl, c = (lane & 7) ^ ((d >> 1) & 7); vo = (unsigned)((dl * GW + c * 8) * 2); }
    const unsigned kndst = lds0 + L_K + wid * 1024, krdst = lds0 + L_K + 8192 + (wid & 3) * 1024, vdst = lds0 + L_V + wid * 1024;
#define DMA_K(t, slot) do { glds16(knb + (size_t)(t) * (64 * HD), kno, (unsigned)__builtin_amdgcn_readfirstlane(kndst + (slot))); if (wid < 4) glds16(krb + (size_t)(t) * (64 * RP), kro, (unsigned)__builtin_amdgcn_readfirstlane(krdst + (slot))); } while (0)
#define DMA_V(t, slot) glds16(vb + (size_t)(t) * (D * GW), vo, (unsigned)__builtin_amdgcn_readfirstlane(vdst + (slot)))
    const int rowA = (r32 & ~0xC) | ((r32 & 4) << 1) | ((r32 & 8) >> 1);
    const lch* kpn0 = lds + L_K + rowA * 128 + (((0 + hi) ^ ((rowA >> 1) & 7)) * 16); const lch* kpn1 = lds + L_K + rowA * 128 + (((2 + hi) ^ ((rowA >> 1) & 7)) * 16);
    const lch* kpn2 = lds + L_K + rowA * 128 + (((4 + hi) ^ ((rowA >> 1) & 7)) * 16); const lch* kpn3 = lds + L_K + rowA * 128 + (((6 + hi) ^ ((rowA >> 1) & 7)) * 16);
    const lch* kpr0 = lds + L_K + 8192 + rowA * 64 + (((0 + hi) ^ ((rowA >> 2) & 3)) * 16); const lch* kpr1 = lds + L_K + 8192 + rowA * 64 + (((2 + hi) ^ ((rowA >> 2) & 3)) * 16);
    const lch* vp0 = lds + L_V + r32 * 128 + (((0 + hi) ^ ((r32 >> 1) & 7)) * 16); const lch* vp1 = lds + L_V + r32 * 128 + (((2 + hi) ^ ((r32 >> 1) & 7)) * 16);
    const lch* vp2 = lds + L_V + r32 * 128 + (((4 + hi) ^ ((r32 >> 1) & 7)) * 16); const lch* vp3 = lds + L_V + r32 * 128 + (((6 + hi) ^ ((r32 >> 1) & 7)) * 16);
#define LDF(p) (*(const LAS bf16x8*)(p))
#define KLOAD_ALL(so) do { kf[0] = LDF(kpn0 + (so)); kf[1] = LDF(kpn0 + (so) + 4096); kf[2] = LDF(kpn1 + (so)); kf[3] = LDF(kpn1 + (so) + 4096); kf[4] = LDF(kpn2 + (so)); kf[5] = LDF(kpn2 + (so) + 4096); \
        kf[6] = LDF(kpn3 + (so)); kf[7] = LDF(kpn3 + (so) + 4096); kf[8] = LDF(kpr0 + (so)); kf[9] = LDF(kpr0 + (so) + 2048); kf[10] = LDF(kpr1 + (so)); kf[11] = LDF(kpr1 + (so) + 2048); } while (0)
    bf16x8 kf[12], qr[6];
    constexpr int NT = SEQ / 64;
    DMA_K(0, 0); DMA_V(0, 0); DMA_K(1, KSLOT);
    { const bf16* Qw = Q1 + (rowbase + q0 + wid * 32 + r32) * 1536 + h * QKD + hi * 8;
#pragma unroll
      for (int d0 = 0; d0 < 6; ++d0) qr[d0] = *(const bf16x8*)(Qw + d0 * 16); }
    DMA_V(1, VSLOT); DMA_K(2, 2 * KSLOT); DMA_K(3, 3 * KSLOT);
    float m_ref = 0.f, l_reg = 0.f; f32x16 o[2]; o[0] = f32x16{}; o[1] = f32x16{}; f32x16 negm;
    f32x16 pA0, pA1, pB0, pB1; bool resc = false;
    if (wid < 4) { MLA_WAIT_BAR(8); } else { MLA_WAIT_BAR(5); }
    KLOAD_ALL(0);
    { const f32x16 z = {};
      pA0 = MLA_MF(kf[0], qr[0], z); pA1 = MLA_MF(kf[1], qr[0], z);
#pragma unroll
      for (int d0 = 1; d0 < 6; ++d0) { pA0 = MLA_MF(kf[2 * d0], qr[d0], pA0); pA1 = MLA_MF(kf[2 * d0 + 1], qr[d0], pA1); } }
    { float rm = pA0[0];
#pragma unroll
      for (int r = 1; r < 16; ++r) rm = fmaxf(rm, pA0[r]);
#pragma unroll
      for (int r = 0; r < 16; ++r) rm = fmaxf(rm, pA1[r]);
      { auto rr = __builtin_amdgcn_permlane32_swap(__float_as_uint(rm), __float_as_uint(rm), false, false); rm = fmaxf(__uint_as_float(rr[0]), __uint_as_float(rr[1])); }
      m_ref = rm;
#pragma unroll
      for (int r = 0; r < 16; ++r) negm[r] = -m_ref;
      MLA_PIN(negm);
#pragma unroll
      for (int r = 0; r < 16; ++r) { pA0[r] = MLA_EX(pA0[r] - m_ref); pA1[r] = pA1[r] - m_ref; } }
    MLA_WAIT_BAR(0);
    DMA_K(4, 0); DMA_V(2, 2 * VSLOT);
    KLOAD_ALL(KSLOT);
    MLA_WAIT_FULL();
    bf16x8 vA0, vA1, vA2, vA3, vB0, vB1, vB2, vB3; v4u pw0, pw1, pw2, pw3;
#define PKW(P, B) pk2(P[B], P[(B) + 1])
#define PAF(k) __builtin_bit_cast(bf16x8, pw##k)
#define GAE(MF, X, B, A0, A1, A2, A3) do { MF; X[B] = MLA_EX(X[B]); X[(B) + 1] = MLA_EX(X[(B) + 1]); X[(B) + 2] = MLA_EX(X[(B) + 2]); X[(B) + 3] = MLA_EX(X[(B) + 3]); MLA_PIN(X); \
        sacc += A0; sacc += A1; sacc += A2; sacc += A3; MLA_PIN(sacc); MLA_SBAR(); } while (0)
#define GAC(MF, A0, A1, A2, A3, W0, W1, PW) do { MF; sacc += A0; sacc += A1; sacc += A2; sacc += A3; MLA_PIN(sacc); W0; W1; MLA_PIN(PW); MLA_SBAR(); } while (0)
#define GAW(MF, W0, W1, W2, W3, PW) do { MF; W0; W1; W2; W3; MLA_PIN(PW); MLA_SBAR(); } while (0)
#define GB(MF, X0, X1, J) do { MF; X0[J] = MLA_EX(X0[J]); X0[(J) + 1] = MLA_EX(X0[(J) + 1]); MLA_PIN(X0); MLA_SBAR(); } while (0)
#define STEP(C0, C1, P0, P1, t, R, GK, GV, GL) do { MLA_SBAR(); \
    constexpr int kc = (R) * KSLOT, kn = (((R) + 1) % 4) * KSLOT, vpv = (((R) + 3) % 4) * VSLOT, vn = (((R) + 2) % 4) * VSLOT; float sacc = 0.f; \
    vA0 = LDF(vp0 + vpv); MLA_SBAR(); GAE(C0 = MLA_MF(kf[0], qr[0], negm), P1, 0, P0[0], P0[1], P0[2], P0[3]); \
    vA1 = LDF(vp1 + vpv); MLA_SBAR(); GAE(C1 = MLA_MF(kf[1], qr[0], negm), P1, 4, P0[4], P0[5], P0[6], P0[7]); \
    vA2 = LDF(vp2 + vpv); MLA_SBAR(); GAE(C0 = MLA_MF(kf[2], qr[1], C0), P1, 8, P0[8], P0[9], P0[10], P0[11]); \
    vA3 = LDF(vp3 + vpv); MLA_SBAR(); GAE(C1 = MLA_MF(kf[3], qr[1], C1), P1, 12, P0[12], P0[13], P0[14], P0[15]); \
    GAC(C0 = MLA_MF(kf[4], qr[2], C0), P1[0], P1[1], P1[2], P1[3], pw0[0] = PKW(P0, 0), pw0[1] = PKW(P0, 2), pw0); \
    GAC(C1 = MLA_MF(kf[5], qr[2], C1), P1[4], P1[5], P1[6], P1[7], pw0[2] = PKW(P0, 4), pw0[3] = PKW(P0, 6), pw0); \
    GAC(C0 = MLA_MF(kf[6], qr[3], C0), P1[8], P1[9], P1[10], P1[11], pw1[0] = PKW(P0, 8), pw1[1] = PKW(P0, 10), pw1); \
    GAC(C1 = MLA_MF(kf[7], qr[3], C1), P1[12], P1[13], P1[14], P1[15], pw1[2] = PKW(P0, 12), pw1[3] = PKW(P0, 14), pw1); \
    GAW(C0 = MLA_MF(kf[8], qr[4], C0), pw2[0] = PKW(P1, 0), pw2[1] = PKW(P1, 2), pw2[2] = PKW(P1, 4), pw2[3] = PKW(P1, 6), pw2); \
    GAW(C1 = MLA_MF(kf[9], qr[4], C1), pw3[0] = PKW(P1, 8), pw3[1] = PKW(P1, 10), pw3[2] = PKW(P1, 12), pw3[3] = PKW(P1, 14), pw3); \
    C0 = MLA_MF(kf[10], qr[5], C0); C1 = MLA_MF(kf[11], qr[5], C1); \
    l_reg += sacc; \
    if (GK) { DMA_K((t) + 4, kc); } if (GV) { DMA_V((t) + 2, vn); } \
    { float a_ = fmaxf(fmaxf(C0[0], C0[1]), C1[0]), b_ = fmaxf(fmaxf(C0[2], C0[3]), C1[1]); a_ = fmaxf(fmaxf(a_, C1[2]), C1[3]); \
      _Pragma("unroll") for (int r = 4; r < 16; r += 4) { a_ = fmaxf(fmaxf(a_, C0[r]), C0[r + 1]); b_ = fmaxf(fmaxf(b_, C0[r + 2]), C0[r + 3]); a_ = fmaxf(fmaxf(a_, C1[r]), C1[r + 1]); b_ = fmaxf(fmaxf(b_, C1[r + 2]), C1[r + 3]); } \
      float rm = fmaxf(a_, b_); { auto rr = __builtin_amdgcn_permlane32_swap(__float_as_uint(rm), __float_as_uint(rm), false, false); rm = fmaxf(__uint_as_float(rr[0]), __uint_as_float(rr[1])); } \
      resc = false; \
      if (__builtin_expect(__any(rm > THR), 0)) { const float dl = fmaxf(rm, 0.f), f = MLA_EX(-dl); m_ref += dl; l_reg *= f; if (hi == 0) wsf[r32] = f; resc = true; \
        _Pragma("unroll") for (int r = 0; r < 16; ++r) { C0[r] -= dl; C1[r] -= dl; } \
        _Pragma("unroll") for (int r = 0; r < 16; ++r) negm[r] = -m_ref; MLA_PIN(negm); } } \
    MLA_SBAR(); \
    vB0 = LDF(vp0 + vpv + 4096); if (GL) { kf[0] = LDF(kpn0 + kn); } MLA_SBAR(); GB(o[0] = MLA_MF(PAF(0), vA0, o[0]), C0, C1, 0); \
    vB1 = LDF(vp1 + vpv + 4096); if (GL) { kf[1] = LDF(kpn0 + kn + 4096); } MLA_SBAR(); GB(o[0] = MLA_MF(PAF(1), vA1, o[0]), C0, C1, 2); \
    vB2 = LDF(vp2 + vpv + 4096); if (GL) { kf[2] = LDF(kpn1 + kn); kf[3] = LDF(kpn1 + kn + 4096); } MLA_SBAR(); GB(o[0] = MLA_MF(PAF(2), vA2, o[0]), C0, C1, 4); \
    vB3 = LDF(vp3 + vpv + 4096); if (GL) { kf[4] = LDF(kpn2 + kn); kf[5] = LDF(kpn2 + kn + 4096); } MLA_SBAR(); GB(o[0] = MLA_MF(PAF(3), vA3, o[0]), C0, C1, 6); \
    if (GL) { kf[6] = LDF(kpn3 + kn); kf[7] = LDF(kpn3 + kn + 4096); } MLA_SBAR(); GB(o[1] = MLA_MF(PAF(0), vB0, o[1]), C0, C1, 8); \
    if (GL) { kf[8] = LDF(kpr0 + kn); kf[9] = LDF(kpr0 + kn + 2048); } MLA_SBAR(); GB(o[1] = MLA_MF(PAF(1), vB1, o[1]), C0, C1, 10); \
    if (GL) { kf[10] = LDF(kpr1 + kn); kf[11] = LDF(kpr1 + kn + 2048); } MLA_SBAR(); GB(o[1] = MLA_MF(PAF(2), vB2, o[1]), C0, C1, 12); \
    GB(o[1] = MLA_MF(PAF(3), vB3, o[1]), C0, C1, 14); \
    } while (0)
#define RESC() do { if (resc) { LDS_WAIT(); \
    _Pragma("unroll") for (int d_ = 0; d_ < 2; ++d_) _Pragma("unroll") for (int r_ = 0; r_ < 16; ++r_) o[d_][r_] *= wsf[crow(r_, hi)]; } } while (0)
    static_assert(NT == 128, "the step program below is written for 128 tiles");
    for (int t = 1; t < 121; t += 4) {
        STEP(pB0, pB1, pA0, pA1, t,     1, true, true, true); MLA_WAIT_FULL(); RESC();
        STEP(pA0, pA1, pB0, pB1, t + 1, 2, true, true, true); MLA_WAIT_FULL(); RESC();
        STEP(pB0, pB1, pA0, pA1, t + 2, 3, true, true, true); MLA_WAIT_FULL(); RESC();
        STEP(pA0, pA1, pB0, pB1, t + 3, 0, true, true, true); MLA_WAIT_FULL(); RESC();
    }
    STEP(pB0, pB1, pA0, pA1, 121, 1, true, true, true);    MLA_WAIT_FULL(); RESC();
    STEP(pA0, pA1, pB0, pB1, 122, 2, true, true, true);    MLA_WAIT_FULL(); RESC();
    STEP(pB0, pB1, pA0, pA1, 123, 3, true, true, true);    MLA_WAIT_FULL(); RESC();
    STEP(pA0, pA1, pB0, pB1, 124, 0, false, true, true);   if (wid < 4) { MLA_WAIT_BAR(4); } else { MLA_WAIT_BAR(3); } RESC();
    STEP(pB0, pB1, pA0, pA1, 125, 1, false, true, true);   MLA_WAIT_BAR(2); RESC();
    STEP(pA0, pA1, pB0, pB1, 126, 2, false, false, true);  MLA_WAIT_BAR(0); RESC();
    STEP(pB0, pB1, pA0, pA1, 127, 3, false, false, false); RESC();
    constexpr int vc = 3 * VSLOT;
    {
#pragma unroll
      for (int r = 0; r < 16; ++r) pB1[r] = MLA_EX(pB1[r]);
      float sacc = 0.f;
#pragma unroll
      for (int r = 0; r < 16; ++r) sacc += pB0[r];
#pragma unroll
      for (int r = 0; r < 16; ++r) sacc += pB1[r];
      l_reg += sacc;
      pw0 = (v4u){PKW(pB0, 0), PKW(pB0, 2), PKW(pB0, 4), PKW(pB0, 6)}; pw1 = (v4u){PKW(pB0, 8), PKW(pB0, 10), PKW(pB0, 12), PKW(pB0, 14)};
      pw2 = (v4u){PKW(pB1, 0), PKW(pB1, 2), PKW(pB1, 4), PKW(pB1, 6)}; pw3 = (v4u){PKW(pB1, 8), PKW(pB1, 10), PKW(pB1, 12), PKW(pB1, 14)};
      MLA_SBAR();
#pragma unroll
      for (int dh = 0; dh < 2; ++dh) { const bf16x8 w0 = LDF(vp0 + vc + dh * 4096), w1 = LDF(vp1 + vc + dh * 4096), w2 = LDF(vp2 + vc + dh * 4096), w3 = LDF(vp3 + vc + dh * 4096);
          o[dh] = MLA_MF(PAF(0), w0, o[dh]); o[dh] = MLA_MF(PAF(1), w1, o[dh]); o[dh] = MLA_MF(PAF(2), w2, o[dh]); o[dh] = MLA_MF(PAF(3), w3, o[dh]); } }
    { auto rr = __builtin_amdgcn_permlane32_swap(__float_as_uint(l_reg), __float_as_uint(l_reg), false, false); l_reg = __uint_as_float(rr[0]) + __uint_as_float(rr[1]); }
    if (hi == 0) wsf[32 + r32] = l_reg; LDS_WAIT();
    { LAS bf16* stg = (LAS bf16*)(lds + L_OST) + wid * 2048;
#pragma unroll
      for (int r = 0; r < 16; ++r) { const int orow = crow(r, hi); const float rl = __builtin_amdgcn_rcpf(wsf[32 + orow]);
#pragma unroll
          for (int dh = 0; dh < 2; ++dh) stg[orow * 64 + dh * 32 + r32] = (bf16)(pk2(o[dh][r] * rl, 0.f) & 0xffffu); }
      LDS_WAIT();
      bf16* Ow = O1 + (rowbase + q0 + wid * 32) * 1024 + h * HD;
#pragma unroll
      for (int i = 0; i < 4; ++i) { const int row = i * 8 + (lane >> 3), ch = lane & 7; const v4u v = *(const LAS v4u*)(stg + row * 64 + ch * 8); *(GAS v4u*)(Ow + (size_t)row * 1024 + ch * 8) = v; } }
    asm volatile("s_waitcnt lgkmcnt(0)\n\ts_barrier" ::: "memory");
#undef DMA_K
#undef DMA_V
#undef LDF
#undef KLOAD_ALL
#undef PKW
#undef PAF
#undef GAE
#undef GAC
#undef GAW
#undef GB
#undef STEP
#undef RESC
}
#undef MLA_WAIT_BAR
#undef MLA_WAIT_FULL
#undef MLA_SBAR
#undef MLA_MF
#undef MLA_PIN
#undef MLA_EX
}

#ifndef MK_CHECK
#define MK_CHECK 0
#endif
#ifndef MK_PHASED
#define MK_PHASED 0
#endif
#ifndef MK_DBL
#define MK_DBL 0u
#endif
#define REP(k) ((((unsigned)MK_DBL >> (k)) & 1u) ? 2 : 1)

#if MK_CHECK
__global__ void __launch_bounds__(256) chk_na(const bf16* Q, const bf16* K, const bf16* VT, const bf16* O, const float* rpb, float* accum) {
    __shared__ float qs[4][64], ps[4][128];
    const int w = threadIdx.x >> 6, lane = threadIdx.x & 63;
    const int unit = blockIdx.x * 4 + w, tok = unit / NH, h = unit % NH;
    const int b = tok / SEQ, t = tok % SEQ, r = t / GW, c = t % GW;
    int rs = r - 4; rs = rs < 0 ? 0 : (rs > GROWS - 8 ? GROWS - 8 : rs);
    int cs = c - 8; cs = cs < 0 ? 0 : (cs > GW - 16 ? GW - 16 : cs);
    qs[w][lane] = bf2f(Q[(size_t)tok * D + h * HD + lane]) * (1.f / LOG2E);
    __syncthreads();
    float sc[2];
#pragma unroll
    for (int u = 0; u < 2; ++u) {
        const int kk = lane + 64 * u, i = kk >> 4, j = kk & 15;
        const size_t kt = (size_t)b * SEQ + (rs + i) * GW + cs + j;
        const bf16* kp = K + ((size_t)h * M + kt) * HD;
        float a = 0.f;
        for (int d = 0; d < HD; ++d) a += qs[w][d] * bf2f(kp[d]);
        sc[u] = a + rpb[(h * 15 + (rs + i - r + 7)) * 31 + (cs + j - c + 15)];
    }
    float mx = fmaxf(sc[0], sc[1]);
    for (int o = 1; o < 64; o <<= 1) mx = fmaxf(mx, __shfl_xor(mx, o));
    const float e0 = expf(sc[0] - mx), e1 = expf(sc[1] - mx);
    const float inv = 1.f / wave_sum(e0 + e1);
    ps[w][lane] = e0 * inv; ps[w][lane + 64] = e1 * inv;
    __syncthreads();
    float acc = 0.f;
    for (int kk = 0; kk < 128; ++kk) { const int i = kk >> 4, j = kk & 15; const size_t kt = (size_t)b * SEQ + (rs + i) * GW + cs + j;
        acc += ps[w][kk] * bf2f(VT[((kt >> 6) * D + h * HD + lane) * GW + (kt & 63)]); }
    const float got = bf2f(O[(size_t)tok * D + h * HD + lane]);
    const float e2 = wave_sum((got - acc) * (got - acc)), r2 = wave_sum(acc * acc);
    if (lane == 0) { atomicAdd(accum, e2); atomicAdd(accum + 1, r2); }
}
__global__ void __launch_bounds__(64) chk_mla(const bf16* Q1, const bf16* KN, const bf16* KR, const bf16* VT, const bf16* O1, float* accum) {
    __shared__ float sc[SEQ]; __shared__ float qv[96];
    const int lane = threadIdx.x, i = blockIdx.x >> 4, h = blockIdx.x & 15;
    const int tok = i * 32 + ((i * 7) & 31), b = tok / SEQ;
    for (int d = lane; d < 96; d += 64) qv[d] = bf2f(Q1[(size_t)tok * 1536 + h * 96 + d]);
    __syncthreads();
    float mx = -1e30f;
    for (int key = lane; key < SEQ; key += 64) { const size_t kt = (size_t)b * SEQ + key; float a = 0.f;
        for (int d = 0; d < 64; ++d) a += qv[d] * bf2f(KN[((size_t)h * M + kt) * 64 + d]);
        for (int d = 0; d < 32; ++d) a += qv[64 + d] * bf2f(KR[kt * 32 + d]);
        sc[key] = a; mx = fmaxf(mx, a); }
    for (int o = 1; o < 64; o <<= 1) mx = fmaxf(mx, __shfl_xor(mx, o));
    float sm = 0.f;
    for (int key = lane; key < SEQ; key += 64) { const float e = exp2f(sc[key] - mx); sc[key] = e; sm += e; }
    sm = wave_sum(sm);
    __syncthreads();
    float acc = 0.f;
    for (int key = 0; key < SEQ; ++key) { const size_t kt = (size_t)b * SEQ + key; acc += sc[key] * bf2f(VT[((kt >> 6) * D + h * 64 + lane) * GW + (kt & 63)]); }
    acc /= sm;
    const float got = bf2f(O1[(size_t)tok * 1024 + h * 64 + lane]);
    const float e2 = wave_sum((got - acc) * (got - acc)), r2 = wave_sum(acc * acc);
    if (lane == 0) { atomicAdd(accum, e2); atomicAdd(accum + 1, r2); }
}
__global__ void chk_tweak(float* out, const float* accum, float amp) {
    const float s = sqrtf(amp * accum[0] / fmaxf(accum[1], 1e-30f));
    const size_t i = (size_t)blockIdx.x * 256 + threadIdx.x; out[i] *= (1.f + s);
}

__global__ void __launch_bounds__(256) chk_proj(const bf16* HNb, const float* w_down, const float* qn, const float* kvn, const float* w_uq, const float* w_ukv,
                                                const bf16* Q1, const bf16* KR, const bf16* KN, const bf16* VT, float* accum) {
    __shared__ float cq[256], ckv[128], qv[1536], red[8], dr[512], hrow[1024];
    const int tid = threadIdx.x, i = blockIdx.x, row = i * 64 + ((i * 11) & 63), t = row & (SEQ - 1), gr = t >> 6, gc = t & 63;
    for (int k = tid; k < 1024; k += 256) hrow[k] = bf2f(HNb[(size_t)row * 1024 + k]);
    __syncthreads();
    for (int c = tid; c < 512; c += 256) { float a = 0.f; if (c < 416) for (int k = 0; k < 1024; ++k) a += hrow[k] * w_down[(size_t)k * 416 + c]; dr[c] = a; }
    __syncthreads();
    float ss = dr[tid] * dr[tid], ssk = tid < 128 ? dr[256 + tid] * dr[256 + tid] : 0.f;
    ss = wave_sum(ss); ssk = wave_sum(ssk);
    if ((tid & 63) == 0) { red[tid >> 6] = ss; red[4 + (tid >> 6)] = ssk; }
    __syncthreads();
    const float rq = rsqrtf((red[0] + red[1] + red[2] + red[3]) / 256.f + 1e-6f), rk = rsqrtf((red[4] + red[5] + red[6] + red[7]) / 128.f + 1e-6f);
    cq[tid] = dr[tid] * rq * qn[tid]; if (tid < 128) ckv[tid] = dr[256 + tid] * rk * kvn[tid];
    __syncthreads();
    for (int c = tid; c < 1536; c += 256) { float a = 0.f; for (int k = 0; k < 256; ++k) a += cq[k] * w_uq[(size_t)k * 1536 + c]; qv[c] = a; }
    __syncthreads();
    float e[4] = {0.f, 0.f, 0.f, 0.f}, r[4] = {0.f, 0.f, 0.f, 0.f};
    for (int c = tid; c < 1536; c += 256) { const int d = c % 96; float v = qv[c];
        if (d >= 64) { const int pr = (d - 64) >> 1; const float inv = powf(10000.f, -(float)(pr & 7) / 8.f), ang = (pr < 8 ? (float)gr : (float)gc) * inv, cs = cosf(ang), sn = sinf(ang);
            const float x1 = qv[c & ~1], x2 = qv[c | 1]; v = (c & 1) ? x1 * sn + x2 * cs : x1 * cs - x2 * sn; }
        v *= QSCALE1; const float g = bf2f(Q1[(size_t)row * 1536 + c]); e[0] += (g - v) * (g - v); r[0] += v * v; }
    if (tid < 32) { const int pr = tid >> 1; const float inv = powf(10000.f, -(float)(pr & 7) / 8.f), ang = (pr < 8 ? (float)gr : (float)gc) * inv, cs = cosf(ang), sn = sinf(ang);
        const float x1 = dr[384 + (tid & ~1)], x2 = dr[384 + (tid | 1)]; const float v = (tid & 1) ? x1 * sn + x2 * cs : x1 * cs - x2 * sn;
        const float g = bf2f(KR[(size_t)row * 32 + tid]); e[1] += (g - v) * (g - v); r[1] += v * v; }
    for (int c = tid; c < 2048; c += 256) { float a = 0.f; for (int k = 0; k < 128; ++k) a += ckv[k] * w_ukv[(size_t)k * 2048 + c];
        const int h = c >> 7, d = c & 127;
        if (d < 64) { const float g = bf2f(KN[((size_t)h * M + row) * 64 + d]); e[2] += (g - a) * (g - a); r[2] += a * a; }
        else { const float g = bf2f(VT[((size_t)(row >> 6) * D + h * 64 + d - 64) * GW + (row & 63)]); e[3] += (g - a) * (g - a); r[3] += a * a; } }
#pragma unroll
    for (int q = 0; q < 4; ++q) { const float es = wave_sum(e[q]), rs = wave_sum(r[q]); if ((tid & 63) == 0) { atomicAdd(accum + 2 * q, es); atomicAdd(accum + 2 * q + 1, rs); } }
}
__global__ void chk_tweak4(float* out, const float* accum, float amp) {
    float s2 = 0.f;
    for (int q = 0; q < 4; ++q) s2 += accum[2 * q] / fmaxf(accum[2 * q + 1], 1e-30f);
    const float s = sqrtf(amp * s2);
    const size_t i = (size_t)blockIdx.x * 256 + threadIdx.x; out[i] *= (1.f + s);
}
#endif


__device__ __forceinline__ int moe_count_prefix(Frame& F, int nblk, LAS int* red) {
    typedef int i32x4 __attribute__((ext_vector_type(4)));
    i32x4 a = {0, 0, 0, 0}, b = {0, 0, 0, 0};
    if (F.tid < nblk) { const i32x4* p = (const i32x4*)(WSP(int, WS_CNTWG) + F.tid * 8); a = p[0]; b = p[1]; }
    int c[8] = {a.x, a.y, a.z, a.w, b.x, b.y, b.z, b.w};
#pragma unroll
    for (int o = 1; o < 64; o <<= 1)
#pragma unroll
        for (int e = 0; e < 8; ++e) c[e] += __shfl_xor(c[e], o);
    if (F.lane == 0 && F.wave < 4) {
#pragma unroll
        for (int e = 0; e < 8; ++e) red[F.wave * 8 + e] = c[e]; }
    __syncthreads();
    int r = 0;
    if (F.tid < 8) r = (red[F.tid] + red[8 + F.tid]) + (red[16 + F.tid] + red[24 + F.tid]);
    __syncthreads();
    return r;
}
__device__ __forceinline__ void moe_tables(Frame& F) {
    LAS int* red = (LAS int*)(F.lds + 65536);
    const int tot = moe_count_prefix(F, 256, red);
    if (F.tid < 8) F.MISC[16 + F.tid] = (unsigned)tot;
    __syncthreads();
    if (F.tid == 0) { int tb = 0;
        for (int e = 0; e < 8; ++e) { F.MISC[24 + e] = (unsigned)tb; F.MISC[33 + e] = (unsigned)(tb * 256); tb += ((int)F.MISC[16 + e] + 255) >> 8; }
        F.MISC[32] = (unsigned)tb; F.MISC[41] = (unsigned)(tb * 256); }
    __syncthreads();
}
template <typename TX> __device__ __forceinline__ void router_phase(Frame& F, const TX* X, int l, int cs) {
    LAS float* wr_l = (LAS float*)(F.lds);
    LAS int* rowE = (LAS int*)(F.lds + 32768);
    LAS float* rowW = (LAS float*)(F.lds + 32768 + 512);
    LAS int* rowP = (LAS int*)(F.lds + 32768 + 1024);
    LAS int* lcnt = (LAS int*)(F.lds + 32768 + 1536);
    for (int i = F.tid; i < D * NE / 4; i += NTHREADS) ((LAS f32x4*)wr_l)[i] = ((const f32x4*)F.in[15])[i];
    __syncthreads();
    const float* mf = WSP(float, WS_MODF);
    for (int blk = blockIdx.x; blk < M / 64; blk += F.G) {
        const int b = (blk * 64) >> 13;
        f32x4 sh[4], sc[4];
#pragma unroll
        for (int j = 0; j < 4; ++j) { const int n = 4 * F.lane + 256 * j; sh[j] = *(const f32x4*)(mf + (size_t)(l * 2 + b) * 6 * D + cs * D + n); sc[j] = *(const f32x4*)(mf + (size_t)(l * 2 + b) * 6 * D + (cs + 1) * D + n) + 1.f; }
        for (int rr0 = 0; rr0 < 8; rr0 += 4) {
            f32x4 v[4][4]; float ss[4];
#pragma unroll
            for (int q = 0; q < 4; ++q) {
#pragma unroll
                for (int j = 0; j < 4; ++j) v[q][j] = XRow<TX>::ld(X, (size_t)(blk * 64 + F.wave * 8 + rr0 + q), 4 * F.lane + 256 * j); }
#pragma unroll
            for (int q = 0; q < 4; ++q) { ss[q] = 0.f;
#pragma unroll
                for (int j = 0; j < 4; ++j) ss[q] += (v[q][j].x * v[q][j].x + v[q][j].y * v[q][j].y) + (v[q][j].z * v[q][j].z + v[q][j].w * v[q][j].w); }
#pragma unroll
            for (int o = 1; o < 64; o <<= 1)
#pragma unroll
                for (int q = 0; q < 4; ++q) ss[q] += __shfl_xor(ss[q], o);
            float lg[4][8];
#pragma unroll
            for (int q = 0; q < 4; ++q) { const float rstd = rsqrtf(ss[q] * (1.f / D) + NORM_EPS);
#pragma unroll
                for (int e = 0; e < 8; ++e) lg[q][e] = 0.f;
                GAS v2u* o8 = (GAS v2u*)(WSP(bf16, WS_HN) + (size_t)(blk * 64 + F.wave * 8 + rr0 + q) * D) + F.lane;
#pragma unroll
                for (int j = 0; j < 4; ++j) { v[q][j] = v[q][j] * rstd * sc[j] + sh[j]; { v2u w; w.x = pk2(v[q][j].x, v[q][j].y); w.y = pk2(v[q][j].z, v[q][j].w); o8[64 * j] = w; } } }
#pragma unroll
            for (int j = 0; j < 4; ++j)
#pragma unroll
                for (int c = 0; c < 4; ++c) { const LAS f32x4* wp = (const LAS f32x4*)(wr_l + (4 * F.lane + 256 * j + c) * 8); const f32x4 w0 = wp[0], w1 = wp[1];
#pragma unroll
                    for (int q = 0; q < 4; ++q) { const float yq = v[q][j][c];
                        lg[q][0] += yq * w0.x; lg[q][1] += yq * w0.y; lg[q][2] += yq * w0.z; lg[q][3] += yq * w0.w; lg[q][4] += yq * w1.x; lg[q][5] += yq * w1.y; lg[q][6] += yq * w1.z; lg[q][7] += yq * w1.w; } }
#pragma unroll
            for (int o = 1; o < 64; o <<= 1)
#pragma unroll
                for (int q = 0; q < 4; ++q)
#pragma unroll
                    for (int e = 0; e < 8; ++e) lg[q][e] += __shfl_xor(lg[q][e], o);
#pragma unroll
            for (int q = 0; q < 4; ++q) { const int rl = F.wave * 8 + rr0 + q;
                float mx = lg[q][0];
#pragma unroll
                for (int e = 1; e < 8; ++e) mx = fmaxf(mx, lg[q][e]);
                float p[8], sm = 0.f;
#pragma unroll
                for (int e = 0; e < 8; ++e) { p[e] = expf(lg[q][e] - mx); sm += p[e]; }
                int i0 = 0; float v0 = -1.f;
#pragma unroll
                for (int e = 0; e < 8; ++e) { p[e] = p[e] / sm; if (p[e] > v0) { v0 = p[e]; i0 = e; } }
                int i1 = 0; float v1 = -1.f;
#pragma unroll
                for (int e = 0; e < 8; ++e) if (e != i0 && p[e] > v1) { v1 = p[e]; i1 = e; }
                if (F.lane == 0) { const float s2 = v0 + v1; rowE[rl * 2] = i0; rowE[rl * 2 + 1] = i1; rowW[rl * 2] = v0 / s2; rowW[rl * 2 + 1] = v1 / s2; } }
        }
        __syncthreads();
        if (F.wave == 0) {
            int cnt[8];
#pragma unroll
            for (int e = 0; e < 8; ++e) cnt[e] = 0;
#pragma unroll
            for (int ch = 0; ch < 2; ++ch) { const int a = ch * 64 + F.lane, ea = rowE[a]; int pos = 0;
#pragma unroll
                for (int e = 0; e < 8; ++e) { const unsigned long long mk = __ballot(ea == e); if (ea == e) pos = cnt[e] + __popcll(mk & ((1ull << F.lane) - 1ull)); cnt[e] += __popcll(mk); }
                rowP[a] = pos; }
            if (F.lane == 0) {
#pragma unroll
                for (int e = 0; e < 8; ++e) lcnt[e] = cnt[e]; } }
        __syncthreads();
        if (F.tid < 128) { const size_t g = (size_t)blk * 128 + F.tid; WSP(int, WS_TOKE)[g] = rowE[F.tid]; WSP(int, WS_TOKP)[g] = rowP[F.tid]; WSP(float, WS_TOKW)[g] = rowW[F.tid]; }
        if (F.tid < 8) WSP(int, WS_CNTWG)[blk * 8 + F.tid] = lcnt[F.tid];
        __syncthreads();
    }
}
__device__ __forceinline__ void gather_phase(Frame& F) {
    LAS int* boff = (LAS int*)(F.lds);
    for (int blk = blockIdx.x; blk < M / 64; blk += F.G) {
        { const int mine = moe_count_prefix(F, blk, (LAS int*)(F.lds + 65536)); if (F.tid < 8) boff[F.tid] = mine + (int)F.MISC[33 + F.tid]; }
        __syncthreads();
        if (F.tid < 128) { const size_t g = (size_t)blk * 128 + F.tid; const int e = WSP(int, WS_TOKE)[g], slot = boff[e] + WSP(int, WS_TOKP)[g];
            WSP(int, WS_TOKS)[g] = slot; WSP(int, WS_ROWTOK)[slot] = blk * 64 + (F.tid >> 1); }
        __syncthreads();
    }
    for (int e = 0; e < 8; ++e) { const int r0 = (int)F.MISC[33 + e] + (int)F.MISC[16 + e], r1 = (int)F.MISC[34 + e];
        for (int r = r0 + (int)blockIdx.x * NTHREADS + F.tid; r < r1; r += F.G * NTHREADS) WSP(int, WS_ROWTOK)[r] = 0; }
}
template <typename TX> __device__ __forceinline__ void final_phase(Frame& F, const TX* X, int l) {
    const bf16* Y = WSP(bf16, WS_HP); const float* mf = WSP(float, WS_MODF);
    f32x4 fn[4];
#pragma unroll
    for (int j = 0; j < 4; ++j) fn[j] = *(const f32x4*)(F.in[18] + 4 * F.lane + 256 * j);
    for (int b = 0; b < NB; ++b) {
        f32x4 gf[4];
#pragma unroll
        for (int j = 0; j < 4; ++j) gf[j] = *(const f32x4*)(mf + (size_t)(l * 2 + b) * 6 * D + 5 * D + 4 * F.lane + 256 * j);
        for (int row = b * SEQ + F.gw; row < (b + 1) * SEQ; row += 4 * F.NGW) {
            int s0[4], s1[4]; float w0[4], w1[4]; bool ok[4]; int rq[4];
#pragma unroll
            for (int q = 0; q < 4; ++q) { ok[q] = row + q * F.NGW < (b + 1) * SEQ; rq[q] = ok[q] ? row + q * F.NGW : row;
                s0[q] = WSP(int, WS_TOKS)[rq[q] * 2]; s1[q] = WSP(int, WS_TOKS)[rq[q] * 2 + 1]; w0[q] = WSP(float, WS_TOKW)[rq[q] * 2]; w1[q] = WSP(float, WS_TOKW)[rq[q] * 2 + 1]; }
            f32x4 xv[4][4]; v2u ya[4][4], yc[4][4];
#pragma unroll
            for (int q = 0; q < 4; ++q) { const GAS v2u* y0 = (const GAS v2u*)(Y + (size_t)s0[q] * D) + F.lane; const GAS v2u* y1 = (const GAS v2u*)(Y + (size_t)s1[q] * D) + F.lane;
#pragma unroll
                for (int j = 0; j < 4; ++j) { xv[q][j] = XRow<TX>::ld(X, (size_t)rq[q], 4 * F.lane + 256 * j); ya[q][j] = y0[64 * j]; yc[q][j] = y1[64 * j]; } }
            float ss[4];
#pragma unroll
            for (int q = 0; q < 4; ++q) { ss[q] = 0.f;
#pragma unroll
                for (int j = 0; j < 4; ++j) { const f32x4 a = {bflo(ya[q][j].x), bfhi(ya[q][j].x), bflo(ya[q][j].y), bfhi(ya[q][j].y)}, c = {bflo(yc[q][j].x), bfhi(yc[q][j].x), bflo(yc[q][j].y), bfhi(yc[q][j].y)};
                    xv[q][j] = xv[q][j] + gf[j] * (a * w0[q] + c * w1[q]); ss[q] += (xv[q][j].x * xv[q][j].x + xv[q][j].y * xv[q][j].y) + (xv[q][j].z * xv[q][j].z + xv[q][j].w * xv[q][j].w); } }
#pragma unroll
            for (int o = 1; o < 64; o <<= 1)
#pragma unroll
                for (int q = 0; q < 4; ++q) ss[q] += __shfl_xor(ss[q], o);
#pragma unroll
            for (int q = 0; q < 4; ++q) if (ok[q]) { const float rstd = rsqrtf(ss[q] * (1.f / D) + NORM_EPS); GAS f32x4* o = (GAS f32x4*)(F.out + (size_t)(row + q * F.NGW) * D) + F.lane;
#pragma unroll
                for (int j = 0; j < 4; ++j) o[64 * j] = xv[q][j] * rstd * fn[j]; }
        }
    }
}

constexpr int N_PHASES = 19;
struct Args { const float* in[19]; float* out; unsigned char* ws; int ph_lo, ph_hi; };
__global__ void __launch_bounds__(NTHREADS, 2) mk_fwd(Args args) {
    extern __shared__ __attribute__((aligned(16))) unsigned char lds[];
    Frame F;
    F.lds = (LAS unsigned char*)lds; F.MISC = (volatile LAS unsigned*)(F.lds + MISC_OFF);
    F.tid = threadIdx.x; F.lane = F.tid & 63; F.wave = __builtin_amdgcn_readfirstlane(F.tid >> 6);
    F.G = gridDim.x; { const int bx = blockIdx.x; F.vcu = (F.G % 8 == 0) ? (bx % 8) * (F.G / 8) + bx / 8 : bx; }
    F.gw = F.vcu * NWAVES + F.wave; F.NGW = F.G * NWAVES;
#pragma unroll
    for (int i = 0; i < 19; ++i) F.in[i] = args.in[i];
    F.out = args.out; F.ws = args.ws;
    for (int u = F.tid; u < (LDS_BYTES - MISC_OFF) / 4; u += NTHREADS) ((LAS unsigned*)(F.lds + MISC_OFF))[u] = 0u;
    __syncthreads();
    XcdBarrier bar; bar.bar = WSP(unsigned, WS_CTL) + 1024; bar.x = 0; bar.st = nullptr;
    if (!MK_PHASED) bar = xcd_barrier_post(WSP(unsigned, WS_CTL) + 1024, F.MISC + 8);
    const int lo = args.ph_lo, hi = args.ph_hi;
#ifdef MK_ONLY
#define IN(k) ((k) == MK_ONLY && lo <= (k) && (k) < hi)
#else
#define IN(k) (lo <= (k) && (k) < hi)
#endif
#define REFRESH() do { int t_ = threadIdx.x; asm volatile("" : "+v"(t_)); F.tid = t_; F.lane = t_ & 63; } while (0)
#define SEAM(k) do { if (IN(k) && IN((k) + 1)) xcd_barrier(bar); } while (0)
    bf16* XA = WSP(bf16, WS_XA); bf16* XB = (bf16*)F.out; const float* MODF = WSP(float, WS_MODF);
    bf16* HN = WSP(bf16, WS_HN);
    LAS unsigned char* ring = F.lds;

    if (IN(0)) for (int rep_ = 0; rep_ < REP(0); ++rep_) { REFRESH(); p0_prologue(F); } SEAM(0);
    if (IN(1)) for (int rep_ = 0; rep_ < REP(1); ++rep_) { REFRESH(); modulate_phase<true, float>(F, F.in[0], 0, 0, HN); modf_reduce(F); } SEAM(1);
    if (IN(2)) for (int rep_ = 0; rep_ < REP(2); ++rep_) { REFRESH();
        { pg8::Gemm g{HN, WSP(bf16, WS_WQK), M, 2048, D}; pg8::StaticOrder S; S.init(M, 2048, F.G, (int)blockIdx.x);
          pg8::EpiBf16P E{WSP(bf16, WS_Q0), D, 8, 4, (size_t)(WS_K0 - WS_Q0) / 2, 0.125f * LOG2E, 0, 1};
          pg8::gemm_phase<pg8::EpiBf16P, pg8::StaticOrder, true, true>(ring, g, S, E); }
        { pg8::Gemm g{WSP(bf16, WS_WV), HN, D, M, D}; pg8::StaticOrder S; S.init(D, M, F.G, (int)blockIdx.x);
          pg8::EpiBf16P E{WSP(bf16, WS_VT0), M, 64, 0, 0, 1.f, 2, 2};
          pg8::gemm_phase<pg8::EpiBf16P, pg8::StaticOrder, true, true>(ring, g, S, E); }
    } SEAM(2);
    if (IN(3)) for (int rep_ = 0; rep_ < REP(3); ++rep_) { REFRESH(); na_phase(F); } SEAM(3);
    if (IN(4)) for (int rep_ = 0; rep_ < REP(4); ++rep_) { REFRESH(); pg8::Gemm g{WSP(bf16, WS_O0), WSP(bf16, WS_WO0), M, D, D}; pg8::StaticOrder S; S.init(M, D, F.G, (int)blockIdx.x);
        pg8::EpiResGateB<true> E{F.in[0], XA, MODF + 0 * 12 * D + 2 * D};
        pg8::gemm_phase<pg8::EpiResGateB<true>, pg8::StaticOrder, true, true>(ring, g, S, E); } SEAM(4);
    if (IN(5)) for (int rep_ = 0; rep_ < REP(5); ++rep_) { REFRESH(); modulate_phase<false, bf16>(F, XA, 0, 3, HN); } SEAM(5);
    if (IN(6)) for (int rep_ = 0; rep_ < REP(6); ++rep_) { REFRESH(); pg8::Gemm g{HN, WSP(bf16, WS_WGU0), M, 2 * FFN, D}; pg8::StaticOrder S; S.init(M, 2 * FFN, F.G, (int)blockIdx.x);
        pg8::EpiSwiGLU E{WSP(bf16, WS_ACT0), FFN, 22};
        pg8::gemm_phase<pg8::EpiSwiGLU, pg8::StaticOrder, true, true>(ring, g, S, E);
        moe_w_side(F, MOE_ITEMS - MOE_G1 - MOE_G2 - MOE_G3, MOE_ITEMS - MOE_G2 - MOE_G3, 128); } SEAM(6);
    if (IN(7)) for (int rep_ = 0; rep_ < REP(7); ++rep_) { REFRESH(); pg8::Gemm g{WSP(bf16, WS_ACT0), WSP(bf16, WS_WDN0), M, D, FFN}; pg8::StaticOrder S; S.init(M, D, F.G, (int)blockIdx.x);
        pg8::EpiResGateB<false> E{XA, XB, MODF + 0 * 12 * D + 5 * D};
        pg8::gemm_phase<pg8::EpiResGateB<false>, pg8::StaticOrder, true, true>(ring, g, S, E); } SEAM(7);
    if (IN(8)) for (int rep_ = 0; rep_ < REP(8); ++rep_) { REFRESH(); modulate_phase<false, bf16>(F, XB, 1, 0, HN); } SEAM(8);
    const bool fusedmid = (F.G >= 128);
    if (IN(9)) for (int rep_ = 0; rep_ < REP(9); ++rep_) { REFRESH(); pg8::Gemm g{HN, WSP(bf16, WS_WMD), M, DOWN_NP, D}; pg8::StaticOrder S; S.init(M, DOWN_NP, F.G, (int)blockIdx.x);
        if (fusedmid) { pg8::EpiMlaMid E{WSP(bf16, WS_CQ), WSP(bf16, WS_CKV), WSP(bf16, WS_KR), F.in[10], F.in[12], WSP(float, WS_ROPER), WSP(float, WS_ROPEC), NORM_EPS};
            pg8::gemm_phase<pg8::EpiMlaMid, pg8::StaticOrder, false, true>(ring, g, S, E); }
        else { pg8::EpiF32 E{WSP(float, WS_DOWN), DOWN_NP};
            pg8::gemm_phase<pg8::EpiF32, pg8::StaticOrder, true, true>(ring, g, S, E); }
        moe_w_side(F, MOE_ITEMS - MOE_G2 - MOE_G3, MOE_ITEMS - MOE_G3, 128); } SEAM(9);
    if (IN(10) && !fusedmid) for (int rep_ = 0; rep_ < REP(10); ++rep_) { REFRESH(); mla_mid_phase(F); }
    if (!fusedmid) SEAM(10);
    if (IN(11)) for (int rep_ = 0; rep_ < REP(11); ++rep_) { REFRESH(); int kq = 256; asm volatile("" : "+s"(kq));
        { pg8::Gemm g{WSP(bf16, WS_CQ), WSP(bf16, WS_WUQ), M, 1536, kq}; pg8::StaticOrder S; S.init(M, 1536, F.G, (int)blockIdx.x);
          pg8::EpiQRope E{WSP(bf16, WS_Q1), WSP(float, WS_ROPER), WSP(float, WS_ROPEC), QSCALE1};
          pg8::gemm_phase<pg8::EpiQRope, pg8::StaticOrder, true, true>(ring, g, S, E); }
        { pg8::Gemm g{WSP(bf16, WS_CKV), WSP(bf16, WS_WKN), M, D, kq >> 1}; pg8::StaticOrder S; S.init(M, D, F.G, (int)blockIdx.x);
          pg8::EpiBf16P E{WSP(bf16, WS_KN), D, 4, 0, 0, 1.f, 1, 1};
          pg8::gemm_phase<pg8::EpiBf16P, pg8::StaticOrder, true, true>(ring, g, S, E); }
        { pg8::Gemm g{WSP(bf16, WS_WVV), WSP(bf16, WS_CKV), D, M, kq >> 1}; pg8::StaticOrder S; S.init(D, M, F.G, (int)blockIdx.x);
          pg8::EpiBf16P E{WSP(bf16, WS_VT1), M, 64, 0, 0, 1.f, 2, 2};
          pg8::gemm_phase<pg8::EpiBf16P, pg8::StaticOrder, true, true>(ring, g, S, E); }
    } SEAM(11);
    if (IN(12)) for (int rep_ = 0; rep_ < REP(12); ++rep_) { REFRESH();
        for (int u = F.vcu; u < NB * NH * (SEQ / 256); u += F.G) { const int a = u >> 8, r = u & 255, bh = r >> 3, qb = (r & 7) * 4 + a;
            mla::unit(bh >> 4, bh & 15, qb, WSP(bf16, WS_Q1), WSP(bf16, WS_KN), WSP(bf16, WS_KR), WSP(bf16, WS_VT1), WSP(bf16, WS_O1), ring); }
    } SEAM(12);
    if (IN(13)) for (int rep_ = 0; rep_ < REP(13); ++rep_) { REFRESH(); pg8::Gemm g{WSP(bf16, WS_O1), WSP(bf16, WS_WO1), M, D, D}; pg8::StaticOrder S; S.init(M, D, F.G, (int)blockIdx.x);
        pg8::EpiResGateB<false> E{XB, XA, MODF + 1 * 12 * D + 2 * D};
        pg8::gemm_phase<pg8::EpiResGateB<false>, pg8::StaticOrder, true, true>(ring, g, S, E); } SEAM(13);
    if (IN(14)) for (int rep_ = 0; rep_ < REP(14); ++rep_) { REFRESH(); router_phase<bf16>(F, XA, 1, 3); } SEAM(14);
    if (IN(15)) for (int rep_ = 0; rep_ < REP(15); ++rep_) { REFRESH(); moe_tables(F); gather_phase(F); } SEAM(15);
    if (IN(16)) for (int rep_ = 0; rep_ < REP(16); ++rep_) { REFRESH(); moe_tables(F);
        pg8::MoeOrder S{(int)F.MISC[32], 14, F.G, (int)blockIdx.x, (int)F.MISC[25], (int)F.MISC[26], (int)F.MISC[27], (int)F.MISC[28], (int)F.MISC[29], (int)F.MISC[30], (int)F.MISC[31]};
        LAS int* tokL = (LAS int*)(F.lds + RING_BYTES);
        { pg8::Unit u_; for (int i = 0; i < 8; ++i) if (S.next(i, u_)) { for (int r = F.tid; r < 256; r += NTHREADS) tokL[i * 256 + r] = WSP(int, WS_ROWTOK)[u_.pm * 256 + r]; } }
        __syncthreads();
        pg8::Gemm g{HN, WSP(bf16, WS_WGU1), MP_MAX, NE * 2 * ED, D};
        pg8::EpiSwiGLU E{WSP(bf16, WS_ACT1), ED, 14};
        pg8::gemm_phase_ga<pg8::EpiSwiGLU, pg8::MoeOrder, true, true>(ring, g, S, E, tokL);
        moe_w_side(F, MOE_ITEMS - MOE_G3, MOE_ITEMS, 112); } SEAM(16);
    if (IN(17)) for (int rep_ = 0; rep_ < REP(17); ++rep_) { REFRESH(); moe_tables(F);
        pg8::MoeOrder S{(int)F.MISC[32], 4, F.G, (int)blockIdx.x, (int)F.MISC[25], (int)F.MISC[26], (int)F.MISC[27], (int)F.MISC[28], (int)F.MISC[29], (int)F.MISC[30], (int)F.MISC[31]};
        pg8::Gemm g{WSP(bf16, WS_ACT1), WSP(bf16, WS_WDN1), MP_MAX, NE * D, ED};
        pg8::EpiBf16P E{WSP(bf16, WS_HP), D, 4, 0, 0, 1.f, 0, 0};
        pg8::gemm_phase<pg8::EpiBf16P, pg8::MoeOrder, true, true>(ring, g, S, E); } SEAM(17);
    if (IN(18)) for (int rep_ = 0; rep_ < REP(18); ++rep_) { REFRESH(); final_phase<bf16>(F, XA, 1); }
#undef IN
#undef SEAM
}

extern "C" void kernel_launch(void* const* d_in, const int* in_sizes, int n_in, void* d_out, int out_size, void* d_ws, size_t ws_size, hipStream_t stream) {
    static int grid = 0;
    if (grid == 0) {
        if (n_in != 19 || in_sizes[0] != M * D || out_size != M * D || ws_size < WS_END) { fprintf(stderr, "kernel_launch: shape mismatch (n_in %d, ws %zu)\n", n_in, ws_size); grid = -1; return; }
        int dev = 0, cus = 0, per_cu = 0;
        if (hipGetDevice(&dev) != hipSuccess || hipDeviceGetAttribute(&cus, hipDeviceAttributeMultiprocessorCount, dev) != hipSuccess) { grid = -1; return; }
        if (hipFuncSetAttribute((const void*)mk_fwd, hipFuncAttributeMaxDynamicSharedMemorySize, LDS_BYTES) != hipSuccess) { fprintf(stderr, "kernel_launch: hipFuncSetAttribute failed\n"); grid = -1; return; }
        if (hipOccupancyMaxActiveBlocksPerMultiprocessor(&per_cu, (const void*)mk_fwd, NTHREADS, LDS_BYTES) != hipSuccess || per_cu < 1) fprintf(stderr, "kernel_launch: occupancy query says %d\n", per_cu);
        (void)hipGetLastError();
        grid = cus;
    }
    if (grid < 0) return;
    (void)hipMemsetAsync((char*)d_ws + WS_CTL, 0, CTL_ZERO_BYTES, stream);
    Args a{};
    for (int i = 0; i < 19; ++i) a.in[i] = (const float*)d_in[i];
    a.out = (float*)d_out; a.ws = (unsigned char*)d_ws;
#if MK_PHASED
    for (int p = 0; p < N_PHASES; ++p) { a.ph_lo = p; a.ph_hi = p + 1; hipLaunchKernelGGL(mk_fwd, dim3(grid), dim3(NTHREADS), LDS_BYTES, stream, a);
#if MK_CHECK == 1
        if (p == 3) hipLaunchKernelGGL(chk_na, dim3(M * NH / 4), dim3(256), 0, stream, (const bf16*)(a.ws + WS_Q0), (const bf16*)(a.ws + WS_K0), (const bf16*)(a.ws + WS_VT0), (const bf16*)(a.ws + WS_O0), a.in[5], (float*)(a.ws + WS_CTL + 32768));
#elif MK_CHECK == 2
        if (p == 12) hipLaunchKernelGGL(chk_mla, dim3(512 * 16), dim3(64), 0, stream, (const bf16*)(a.ws + WS_Q1), (const bf16*)(a.ws + WS_KN), (const bf16*)(a.ws + WS_KR), (const bf16*)(a.ws + WS_VT1), (const bf16*)(a.ws + WS_O1), (float*)(a.ws + WS_CTL + 32768));
#elif MK_CHECK == 3
        if (p == 11) hipLaunchKernelGGL(chk_proj, dim3(256), dim3(256), 0, stream, (const bf16*)(a.ws + WS_HN), a.in[9], a.in[10], a.in[12], a.in[11], a.in[13], (const bf16*)(a.ws + WS_Q1), (const bf16*)(a.ws + WS_KR), (const bf16*)(a.ws + WS_KN), (const bf16*)(a.ws + WS_VT1), (float*)(a.ws + WS_CTL + 32768));
#endif
    }
#if MK_CHECK == 3
    hipLaunchKernelGGL(chk_tweak4, dim3(M * D / 256), dim3(256), 0, stream, a.out, (const float*)(a.ws + WS_CTL + 32768), 1000.f);
#elif MK_CHECK
    hipLaunchKernelGGL(chk_tweak, dim3(M * D / 256), dim3(256), 0, stream, a.out, (const float*)(a.ws + WS_CTL + 32768), 1000.f);
#endif
#else
    a.ph_lo = 0; a.ph_hi = N_PHASES; hipLaunchKernelGGL(mk_fwd, dim3(grid), dim3(NTHREADS), LDS_BYTES, stream, a);
#endif
}
```
